# Optimizing an MI355X kernel written in HIP

```python
import jax, jax.numpy as jnp
from jax import lax
import numpy as np

D_MODEL = 2048
BATCH = 4
SEQ = 2048
DEPTH = 2
DEC_BATCH = 32
DEC_SEQ = 4
PAST_LEN = 8192
PAGE_SIZE = 128

H_A = 8
DK_A = 128
DV_A = 128
QK_A = H_A * DK_A
V_A = H_A * DV_A
CONV_K = 4
CONV_CH = 2 * QK_A + V_A
GDN_CHUNK = 64
DIL_GROUPS = ((128, 1), (512, 4), (2048, 16))
N_GROUPS = len(DIL_GROUPS)
H_G = 4
HD_B = 128
QKV_B = N_GROUPS * H_G * HD_B
OUT_B = H_G * HD_B
Q_BLOCK = 128
POOL_WINDOWS = (2, 4, 8, 16)
C_POOL = 1024
CG = C_POOL // len(POOL_WINDOWS)
POOL_HIST = max(POOL_WINDOWS) - 1
D_FF = ((8 * D_MODEL + 3 * 256 - 1) // (3 * 256)) * 256
EPS = 1e-6
L2_EPS = 1e-6
IN_SPLITS = (QK_A, QK_A, V_A, V_A, H_A, H_A, QKV_B, QKV_B, QKV_B, C_POOL, D_MODEL, D_MODEL, D_MODEL)
N_IN = sum(IN_SPLITS)

kernel_name = 'hybrid_gdn_dilated_pool_decoder_step'


def _rms_norm(x, gain):
    xf = x.astype(jnp.float32)
    y = xf * lax.rsqrt(jnp.mean(xf * xf, axis=-1, keepdims=True) + EPS)
    return (y * gain.astype(jnp.float32)).astype(x.dtype)


def _split(x, sizes):
    cuts = [int(c) for c in np.cumsum(sizes)[:-1]]
    return jnp.split(x, cuts, axis=-1)


def _l2norm(x):
    return x * lax.rsqrt(jnp.sum(x * x, axis=-1, keepdims=True) + L2_EPS)


def _causal_conv(hist, u, w):
    T = u.shape[1]
    xp = jnp.concatenate([hist.astype(u.dtype), u], axis=1)
    out = xp[:, 0:T] * w[0]
    for j in range(1, CONV_K):
        out = out + xp[:, j:j + T] * w[j]
    return out, xp[:, -(CONV_K - 1):]


def _gdn_chunked(q, k, v, g, beta, s0, chunk):
    Bn, T, H, DK = q.shape
    DV = v.shape[-1]
    N = T // chunk

    def blocks(t):
        return t.reshape(Bn, N, chunk, H, t.shape[-1]).transpose(1, 0, 3, 2, 4)

    qc, kc, vc = blocks(q), blocks(k), blocks(v)
    gc = jnp.cumsum(g.reshape(Bn, N, chunk, H).transpose(1, 0, 3, 2), axis=-1)
    bc = beta.reshape(Bn, N, chunk, H).transpose(1, 0, 3, 2)
    incl = jnp.tril(jnp.ones((chunk, chunk), dtype=bool))
    strict = jnp.tril(jnp.ones((chunk, chunk), dtype=bool), k=-1)
    diff = gc[..., :, None] - gc[..., None, :]
    decay = jnp.where(incl, jnp.exp(jnp.where(incl, diff, 0.0)), 0.0)
    kb = kc * bc[..., None]
    lower = jnp.where(strict, jnp.einsum('nbhid,nbhjd->nbhij', kb, kc) * decay, 0.0)
    eye = jnp.eye(chunk, dtype=jnp.float32)
    tinv = lax.linalg.triangular_solve(eye + lower, jnp.broadcast_to(eye, lower.shape), left_side=True, lower=True)
    u = tinv @ (vc * bc[..., None])
    w = tinv @ (kb * jnp.exp(gc)[..., None])
    a_intra = jnp.where(incl, jnp.einsum('nbhid,nbhjd->nbhij', qc, kc) * decay, 0.0)

    def step(s, xs):
        qi, ki, ui, wi, gi, ai = xs
        v_new = ui - wi @ s
        o = (qi * jnp.exp(gi)[..., None]) @ s + ai @ v_new
        g_last = gi[..., -1]
        s = s * jnp.exp(g_last)[..., None, None] + jnp.einsum('bhcd,bhce->bhde', ki * jnp.exp(g_last[..., None] - gi)[..., None], v_new)
        return s, o

    s_final, o = lax.scan(step, s0, (qc, kc, u, w, gc, a_intra))
    o = o.transpose(1, 0, 3, 2, 4).reshape(Bn, T, H, DV)
    return o, s_final


def _dilated_group(q, k, v, q_idx, dil, n_back):
    dist = jnp.arange(n_back + 1) * dil
    idx = q_idx[:, None] - dist[None, :]
    valid = idx >= 0
    idx = jnp.maximum(idx, 0)
    kg = k[:, idx].astype(jnp.float32)
    vg = v[:, idx].astype(jnp.float32)
    s = jnp.einsum('bqhd,bqjhd->bqhj', q.astype(jnp.float32), kg) * (HD_B ** -0.5)
    s = jnp.where(valid[None, :, None, :], s, -jnp.inf)
    m = jnp.max(s, axis=-1)
    p = jnp.exp(s - m[..., None])
    return jnp.einsum('bqhj,bqjhd->bqhd', p, vg), m, jnp.sum(p, axis=-1)


def _dilated_mixture(qs, ks, vs, q_idxs):
    parts = [_dilated_group(q, k, v, qi, dil, win // dil)
             for q, k, v, qi, (win, dil) in zip(qs, ks, vs, q_idxs, DIL_GROUPS)]
    m_all = jnp.stack([pt[1] for pt in parts])
    e = jnp.exp(m_all - jnp.max(m_all, axis=0))
    num = sum(e[i][..., None] * parts[i][0] for i in range(N_GROUPS))
    den = sum(e[i] * parts[i][2] for i in range(N_GROUPS))
    return num / den[..., None]


def _dilated_prompt(q, k, v):
    Bn, S = q.shape[:2]
    nb = S // Q_BLOCK
    qb = q.reshape(Bn, nb, Q_BLOCK, N_GROUPS, H_G, HD_B).transpose(1, 0, 2, 3, 4, 5)
    k_g = [k[:, :, gi] for gi in range(N_GROUPS)]
    v_g = [v[:, :, gi] for gi in range(N_GROUPS)]

    def blk(args):
        i, qi = args
        q_idx = i * Q_BLOCK + jnp.arange(Q_BLOCK)
        return _dilated_mixture([qi[:, :, gi] for gi in range(N_GROUPS)], k_g, v_g, [q_idx] * N_GROUPS)

    o = lax.map(blk, (jnp.arange(nb), qb))
    return o.transpose(1, 0, 2, 3, 4).reshape(Bn, S, H_G, HD_B)


def _multiscale_pool(hist, u, pos):
    T = u.shape[1]
    xp = jnp.concatenate([hist.astype(u.dtype), u], axis=1)
    xf = xp.astype(jnp.float32)
    csum = jnp.concatenate([jnp.zeros_like(xf[:, :1]), jnp.cumsum(xf, axis=1)], axis=1)
    end = csum[:, POOL_HIST + 1:POOL_HIST + 1 + T]
    means = []
    for gi, win in enumerate(POOL_WINDOWS):
        ch = slice(gi * CG, (gi + 1) * CG)
        start = csum[:, POOL_HIST + 1 - win:POOL_HIST + 1 - win + T, ch]
        cnt = jnp.minimum(win, pos + 1).astype(jnp.float32)[None, :, None]
        means.append((end[..., ch] - start) / cnt)
    mixed = jnp.concatenate(means, axis=-1) - xf[:, POOL_HIST:]
    return mixed.astype(u.dtype), xp[:, -POOL_HIST:]


def _layer(x, lp, hist, prompt):
    (w_in, conv_w, a_log, dt_bias, gdn_gain, w_pool, pool_scale,
     w_br_a, w_br_b, w_br_c, w_out, w_gu, w_down,
     g_pre_mix, g_post_mix, g_pre_ffn, g_post_ffn) = lp
    conv_hist, s0, pool_hist, win_hists = hist
    Bn, T, _ = x.shape
    dt = x.dtype
    h = _rms_norm(x, g_pre_mix)
    (qa, ka, va, za, ba, aa, qb, kb, vb, uc, ga, gb, gc) = _split(h @ w_in, IN_SPLITS)

    qkv, conv_new = _causal_conv(conv_hist, jnp.concatenate([qa, ka, va], axis=-1), conv_w)
    qkv = jax.nn.silu(qkv).astype(jnp.float32)
    q, k, v = _split(qkv, (QK_A, QK_A, V_A))
    q = _l2norm(q.reshape(Bn, T, H_A, DK_A)) * (DK_A ** -0.5)
    k = _l2norm(k.reshape(Bn, T, H_A, DK_A))
    v = v.reshape(Bn, T, H_A, DV_A)
    beta = jax.nn.sigmoid(ba.astype(jnp.float32))
    g = -jnp.exp(a_log.astype(jnp.float32)) * jax.nn.softplus(aa.astype(jnp.float32) + dt_bias.astype(jnp.float32))
    chunk = GDN_CHUNK if prompt else T
    o, s_new = _gdn_chunked(q, k, v, g, beta, s0.astype(jnp.float32), chunk)
    o = o * lax.rsqrt(jnp.mean(o * o, axis=-1, keepdims=True) + EPS) * gdn_gain.astype(jnp.float32)
    o = o * jax.nn.silu(za.astype(jnp.float32).reshape(Bn, T, H_A, DV_A))
    out_a = o.reshape(Bn, T, V_A).astype(dt)

    qb = qb.reshape(Bn, T, N_GROUPS, H_G, HD_B)
    kb = kb.reshape(Bn, T, N_GROUPS, H_G, HD_B)
    vb = vb.reshape(Bn, T, N_GROUPS, H_G, HD_B)
    kv_new = [jnp.stack([kb[:, :, gi], vb[:, :, gi]], axis=2) for gi in range(N_GROUPS)]
    if prompt:
        ob = _dilated_prompt(qb, kb, vb)
        kv_all = kv_new
    else:
        kv_all = [jnp.concatenate([win_hists[gi].astype(dt), kv_new[gi]], axis=1) for gi in range(N_GROUPS)]
        q_idxs = [kv.shape[1] - T + jnp.arange(T) for kv in kv_all]
        ob = _dilated_mixture([qb[:, :, gi] for gi in range(N_GROUPS)],
                              [kv[:, :, 0] for kv in kv_all], [kv[:, :, 1] for kv in kv_all], q_idxs)
    win_new = [kv_all[gi][:, -win:] for gi, (win, _) in enumerate(DIL_GROUPS)]
    out_b = ob.reshape(Bn, T, OUT_B).astype(dt)

    pos = jnp.arange(T) + (0 if prompt else PAST_LEN)
    pooled, pool_new = _multiscale_pool(pool_hist, uc, pos)
    oc = jnp.einsum('btgc,gcd->btgd', pooled.reshape(Bn, T, len(POOL_WINDOWS), CG), w_pool).reshape(Bn, T, C_POOL) * pool_scale

    merged = (jax.nn.sigmoid(ga) * (out_a @ w_br_a)
              + jax.nn.sigmoid(gb) * (out_b @ w_br_b)
              + jax.nn.sigmoid(gc) * (oc @ w_br_c))
    x = x + _rms_norm(merged @ w_out, g_post_mix)

    gate, up = _split(_rms_norm(x, g_pre_ffn) @ w_gu, (D_FF, D_FF))
    x = x + _rms_norm((jax.nn.silu(gate) * up) @ w_down, g_post_ffn)
    return x, (win_new[0], win_new[1], win_new[2], s_new.astype(dt), conv_new, pool_new)


def setup_inputs(seed: int = 0) -> dict:
    key = jax.random.key(seed)
    ks = jax.random.split(key, 32)
    f32 = jnp.float32

    def nrm(k, shape, s=1.0):
        return jax.random.normal(k, shape, f32) * s

    wb = [min(win, PAST_LEN) for win, _ in DIL_GROUPS]
    return {
        'x_prompt': nrm(ks[0], (BATCH, SEQ, D_MODEL)),
        'x_sample': nrm(ks[1], (DEC_BATCH, DEC_SEQ, D_MODEL)),
        'cache_win1': nrm(ks[2], (DEPTH, DEC_BATCH, wb[0], 2, H_G, HD_B)),
        'cache_win2': nrm(ks[3], (DEPTH, DEC_BATCH, wb[1], 2, H_G, HD_B)),
        'cache_win3': nrm(ks[4], (DEPTH, DEC_BATCH, wb[2], 2, H_G, HD_B)),
        'state_gdn': nrm(ks[5], (DEPTH, DEC_BATCH, H_A, DK_A, DV_A), 0.1),
        'state_conv': nrm(ks[6], (DEPTH, DEC_BATCH, CONV_K - 1, CONV_CH)),
        'state_pool': nrm(ks[7], (DEPTH, DEC_BATCH, POOL_HIST, C_POOL)),
        'w_in': nrm(ks[8], (DEPTH, D_MODEL, N_IN), D_MODEL ** -0.5),
        'conv_w': nrm(ks[9], (DEPTH, CONV_K, CONV_CH), CONV_K ** -0.5),
        'a_log': jnp.log(jax.random.uniform(ks[10], (DEPTH, H_A), f32, 1.0, 16.0)),
        'dt_bias': jnp.log(jnp.expm1(jax.random.uniform(ks[11], (DEPTH, H_A), f32, 1e-3, 0.1))),
        'gdn_gain': 1.0 + nrm(ks[12], (DEPTH, DV_A), 0.02),
        'w_pool': nrm(ks[13], (DEPTH, len(POOL_WINDOWS), CG, CG), CG ** -0.5),
        'pool_scale': 1.0 + nrm(ks[14], (DEPTH, C_POOL), 0.02),
        'w_br_a': nrm(ks[15], (DEPTH, V_A, D_MODEL), V_A ** -0.5),
        'w_br_b': nrm(ks[16], (DEPTH, OUT_B, D_MODEL), OUT_B ** -0.5),
        'w_br_c': nrm(ks[17], (DEPTH, C_POOL, D_MODEL), C_POOL ** -0.5),
        'w_out': nrm(ks[18], (DEPTH, D_MODEL, D_MODEL), D_MODEL ** -0.5),
        'w_gu': nrm(ks[19], (DEPTH, D_MODEL, 2 * D_FF), D_MODEL ** -0.5),
        'w_down': nrm(ks[20], (DEPTH, D_FF, D_MODEL), D_FF ** -0.5),
        'g_pre_mix': 1.0 + nrm(ks[21], (DEPTH, D_MODEL), 0.02),
        'g_post_mix': 1.0 + nrm(ks[22], (DEPTH, D_MODEL), 0.02),
        'g_pre_ffn': 1.0 + nrm(ks[23], (DEPTH, D_MODEL), 0.02),
        'g_post_ffn': 1.0 + nrm(ks[24], (DEPTH, D_MODEL), 0.02),
    }


def reference(x_prompt, x_sample, cache_win1, cache_win2, cache_win3, state_gdn, state_conv, state_pool,
              w_in, conv_w, a_log, dt_bias, gdn_gain, w_pool, pool_scale, w_br_a, w_br_b, w_br_c,
              w_out, w_gu, w_down, g_pre_mix, g_post_mix, g_pre_ffn, g_post_ffn):
    yp, ys = x_prompt, x_sample
    bp = x_prompt.shape[0]
    dt = x_prompt.dtype
    new_p, new_s = [], []
    for l in range(DEPTH):
        lp = (w_in[l], conv_w[l], a_log[l], dt_bias[l], gdn_gain[l], w_pool[l], pool_scale[l],
              w_br_a[l], w_br_b[l], w_br_c[l], w_out[l], w_gu[l], w_down[l],
              g_pre_mix[l], g_post_mix[l], g_pre_ffn[l], g_post_ffn[l])
        hist_p = (jnp.zeros((bp, CONV_K - 1, CONV_CH), dt),
                  jnp.zeros((bp, H_A, DK_A, DV_A), jnp.float32),
                  jnp.zeros((bp, POOL_HIST, C_POOL), dt),
                  None)
        yp, st_p = _layer(yp, lp, hist_p, True)
        hist_s = (state_conv[l], state_gdn[l], state_pool[l], (cache_win1[l], cache_win2[l], cache_win3[l]))
        ys, st_s = _layer(ys, lp, hist_s, False)
        new_p.append(st_p)
        new_s.append(st_s)
    pw1, pw2, pw3, pgdn, pconv, ppool = [jnp.stack([st[i] for st in new_p], axis=0) for i in range(6)]
    sw1, sw2, sw3, sgdn, sconv, spool = [jnp.stack([st[i] for st in new_s], axis=0) for i in range(6)]
    return (yp, ys, pw1, pw2, pw3, pgdn, pconv, ppool, sw1, sw2, sw3, sgdn, sconv, spool)
```

```cpp
#include <hip/hip_runtime.h>
#include <cstdio>
#include <cstdint>

#ifndef MK_ONE_LAUNCH
#define MK_ONE_LAUNCH 1
#endif

#define GAS __attribute__((address_space(1)))
#define CAS __attribute__((address_space(4)))
typedef const float* cfp_t;
#define LAS __attribute__((address_space(3)))
typedef unsigned short bf16;
typedef unsigned v4u __attribute__((ext_vector_type(4)));
typedef unsigned v2u __attribute__((ext_vector_type(2)));
typedef float f32x4 __attribute__((ext_vector_type(4)));
typedef float f32x2 __attribute__((ext_vector_type(2)));
typedef short bf16x8 __attribute__((ext_vector_type(8)));
typedef float f32x16 __attribute__((ext_vector_type(16)));

constexpr int D = 2048, BATCH = 4, SEQ = 2048, DEPTH = 2, DB = 32, DS = 4;
constexpr int MP = BATCH * SEQ;
constexpr int MS = DB * DS;
constexpr int MV = MP + MS;
constexpr int MT = 8448;
constexpr int HA = 8, CONVCH = 3072;
constexpr int CPOOL = 1024, PHIST = 15;
constexpr int DFF = 5632;
constexpr int NIN_SRC = 15888, NIN = 15872;
constexpr int PC_ZA = 3072, PC_QB = 4096, PC_KB = 5632, PC_VB = 7168, PC_UC = 8704, PC_GATE = 9728;
constexpr float EPS = 1e-6f;
constexpr size_t O_YP = 0, O_YS = O_YP + (size_t)MP * D, O_PW1 = O_YS + (size_t)MS * D;
constexpr size_t O_PW2 = O_PW1 + (size_t)2 * 4 * 128 * 1024, O_PW3 = O_PW2 + (size_t)2 * 4 * 512 * 1024, O_PGDN = O_PW3 + (size_t)2 * 4 * 2048 * 1024;
constexpr size_t O_PCONV = O_PGDN + (size_t)2 * 4 * 8 * 16384, O_PPOOL = O_PCONV + (size_t)2 * 4 * 3 * 3072, O_SW1 = O_PPOOL + (size_t)2 * 4 * 15 * 1024;
constexpr size_t O_SW2 = O_SW1 + (size_t)2 * 32 * 128 * 1024, O_SW3 = O_SW2 + (size_t)2 * 32 * 512 * 1024, O_SGDN = O_SW3 + (size_t)2 * 32 * 2048 * 1024;
constexpr size_t O_SCONV = O_SGDN + (size_t)2 * 32 * 8 * 16384, O_SPOOL = O_SCONV + (size_t)2 * 32 * 3 * 3072, O_END = O_SPOOL + (size_t)2 * 32 * 15 * 1024;
static_assert(O_END == 226426880ull, "output size");

constexpr size_t WS_CTL = 0, CTL_BYTES = 1u << 20;
constexpr size_t SZ_WIN = (size_t)NIN * D * 2, SZ_WBRA = (size_t)D * 1024 * 2, SZ_WBRB = (size_t)D * 512 * 2, SZ_WBRC = (size_t)D * 1024 * 2, SZ_WPOOL = (size_t)4 * 256 * 256 * 2;
constexpr size_t SZ_WOUT = (size_t)D * D * 2, SZ_WGU = (size_t)2 * DFF * D * 2, SZ_WDOWN = (size_t)D * DFF * 2;
constexpr size_t WO_IN = 0, WO_BRA = WO_IN + SZ_WIN, WO_BRB = WO_BRA + SZ_WBRA, WO_BRC = WO_BRB + SZ_WBRB, WO_POOL = WO_BRC + SZ_WBRC, WO_OUT = WO_POOL + SZ_WPOOL;
constexpr size_t WO_GU = WO_OUT + SZ_WOUT, WO_DOWN = WO_GU + SZ_WGU, WL_BYTES = WO_DOWN + SZ_WDOWN;
constexpr size_t WS_W = CTL_BYTES;
constexpr size_t WS_H = WS_W + 2 * WL_BYTES;
constexpr size_t WS_PROJ = WS_H + (size_t)MT * D * 2;
constexpr size_t WS_GB = WS_PROJ + (size_t)MT * NIN * 2;
constexpr size_t WS_TOK = WS_GB + (size_t)MT * 16 * 4;
constexpr size_t WS_QN = WS_TOK + (size_t)MT * 8 * 16;
constexpr size_t WS_KN = WS_QN + (size_t)MT * 1024 * 2;
constexpr size_t WS_VV = WS_KN + (size_t)MT * 1024 * 2;
constexpr size_t WS_ORAW = WS_VV + (size_t)MT * 1024 * 2;
constexpr size_t WS_POOLED = WS_ORAW + (size_t)MT * 1024 * 4;
constexpr size_t WS_OUTA = WS_POOLED + (size_t)MT * 1024 * 2;
constexpr size_t WS_OUTB = WS_OUTA + (size_t)MT * 1024 * 2;
constexpr size_t WS_OC = WS_OUTB + (size_t)MT * 512 * 2;
constexpr size_t WS_MERGED = WS_OC + (size_t)MT * 1024 * 2;
constexpr size_t WS_Y = WS_MERGED + (size_t)MT * D * 2;
constexpr size_t WS_X1 = WS_Y + (size_t)MT * D * 2;
constexpr size_t WS_X2 = WS_X1 + (size_t)MT * D * 4;
constexpr size_t WS_ACT = WS_X2 + (size_t)MT * D * 4;
constexpr size_t WS_VT = WS_ACT + (size_t)MT * DFF * 2;
constexpr size_t WS_OBG = WS_VT + (size_t)BATCH * 3 * 4 * 128 * 2048 * 2;
constexpr size_t WS_AST = WS_OBG + (size_t)6 * MV * 512 * 2;
constexpr int GCH = BATCH * HA * (SEQ / 32);
constexpr size_t WS_WF = WS_AST + (size_t)6 * MV * 4 * 8;
constexpr size_t WS_KF = WS_WF + (size_t)GCH * 8192;
constexpr size_t WS_UF = WS_KF + (size_t)GCH * 8192;
constexpr size_t WS_AF = WS_UF + (size_t)GCH * 16384;
constexpr size_t WS_TB = WS_AF + (size_t)GCH * 2048;
constexpr size_t WS_QF = WS_TB + (size_t)GCH * 128;
constexpr size_t WS_END = WS_QF + (size_t)GCH * 8192;
static_assert(WS_END < 2000000000ull, "workspace");

namespace pg8 {
#define PG8_LAS __attribute__((address_space(3)))
typedef unsigned short bf16_t;
typedef unsigned u32x4 __attribute__((ext_vector_type(4)));
constexpr int BM = 256, BK = 64, HALF = 128, HTB = HALF * BK * 2, STAGE_BYTES = 8 * HTB, NXCD = 8, WGM = 8;
__host__ __device__ __forceinline__ int lds_byte(int r, int c) { const int st = (r >> 4) * 2 + (c >> 5), rr = r & 15, cc = c & 31, ob = rr * 64 + cc * 2; return st * 1024 + (ob ^ (((ob >> 9) & 1) << 5)); }
__host__ __device__ __forceinline__ void stage_rc(int b, int& R, int& C) { const int st = b / 1024, sb = b % 1024, swz = sb ^ (((sb >> 9) & 1) << 5); R = (st >> 1) * 16 + swz / 64; C = (st & 1) * 32 + (swz % 64) / 2; }
__host__ __device__ __forceinline__ int perm32(int rho) { const int n = rho >> 4, i = rho & 15; return 8 * (i >> 2) + 4 * n + (i & 3); }
struct Unit { int pm, pn; };
struct Gemm { const bf16_t* A; const bf16_t* Bt; int lda, ldb, K; int a_pn_step; };
struct StaticOrder {
    int nM, nN, nwg, G, c;
    __host__ __device__ void init(int M, int N, int G_, int c_) { nM = M / BM; nN = N / BM; nwg = nM * nN; G = G_; c = c_; }
    __host__ __device__ bool next(int i, Unit& u) const {
        const long L = (long)i * G + c; if (L >= nwg) return false;
        int wgid = (int)L; { const int q = nwg / NXCD, r = nwg % NXCD, xcd = wgid % NXCD, off = wgid / NXCD; wgid = (xcd < r ? xcd * (q + 1) : r * (q + 1) + (xcd - r) * q) + off; }
        const int nig = WGM * nN, gid = wgid / nig, fm = gid * WGM, gsz = (nM - fm) < WGM ? (nM - fm) : WGM;
        u.pm = fm + ((wgid % nig) % gsz); u.pn = (wgid % nig) / gsz; return true;
    }
    __device__ __forceinline__ void a_ready(const Unit&) const {}
    __device__ __forceinline__ void done(const Unit&) const {}
};
__device__ __forceinline__ unsigned cvt_pk_bf16(float lo, float hi) { unsigned r; asm volatile("v_cvt_pk_bf16_f32 %0, %1, %2" : "=v"(r) : "v"(lo), "v"(hi)); return r; }

template <class Epi, class Sched, bool ALIGN_EPI = true>
__device__ __forceinline__ void gemm_phase(PG8_LAS unsigned char* lds, const Gemm g, const Sched& S, const Epi& E) {
    int tid = threadIdx.x; asm volatile("" : "+v"(tid));
    const int wid = __builtin_amdgcn_readfirstlane(tid >> 6), lane = tid & 63, wr = wid >> 2, wc = wid & 3, fr = lane & 15, fq = lane >> 4;
    int K = g.K; asm volatile("" : "+s"(K));
    const int nt = K / BK;
    unsigned voffA[2], voffB[2];
#pragma unroll
    for (int i = 0; i < 2; ++i) { int R, C; stage_rc(tid * 16 + i * 8192, R, C); const int Rb = ((R & ~31) + perm32(R & 31));
        voffA[i] = (unsigned)(R * g.lda + C) * 2u; voffB[i] = (unsigned)(Rb * g.ldb + C) * 2u; }
    const size_t kstep = (size_t)(BK * 2);
    const size_t hstepA = (size_t)HALF * g.lda * 2, hstepB = (size_t)HALF * g.ldb * 2;
    const size_t tstepA = 2 * hstepA, tstepB = 2 * hstepB;
    const unsigned ldsw = (unsigned)wid * 1024u;
    const int aoff = lds_byte(wr * 64 + fr, fq * 8), boff = lds_byte(wc * 32 + fr, fq * 8);
#define PG8_SA(b, h) (((b) * 2 + (h)) * HTB)
#define PG8_SB(b, h) ((4 + (b) * 2 + (h)) * HTB)
#define PG8_STAGE(bufoff, gbase, voff) do { _Pragma("unroll") for (int _i = 0; _i < 2; ++_i) \
        __builtin_amdgcn_global_load_lds((const unsigned*)((const char*)(gbase) + (voff)[_i]), (PG8_LAS unsigned*)(lds + (bufoff) + ldsw + _i * 8192), 16, 0, 0); } while (0)
#define PG8_LDA(dst, b, h) do { _Pragma("unroll") for (int m = 0; m < 4; ++m) _Pragma("unroll") for (int k = 0; k < 2; ++k) dst[m][k] = *(const PG8_LAS bf16x8*)(lds + PG8_SA(b, h) + aoff + m * 2048 + k * 1024); } while (0)
#define PG8_LDB(dst, b, h) do { _Pragma("unroll") for (int n = 0; n < 2; ++n) _Pragma("unroll") for (int k = 0; k < 2; ++k) dst[n][k] = *(const PG8_LAS bf16x8*)(lds + PG8_SB(b, h) + boff + n * 2048 + k * 1024); } while (0)
#define PG8_MMA(ai, bj, At, Bt) do { __builtin_amdgcn_s_setprio(1); _Pragma("unroll") for (int m = 0; m < 4; ++m) _Pragma("unroll") for (int n = 0; n < 2; ++n) _Pragma("unroll") for (int k = 0; k < 2; ++k) \
        acc[ai][bj][m][n] = __builtin_amdgcn_mfma_f32_16x16x32_bf16(Bt[n][k], At[m][k], acc[ai][bj][m][n], 0, 0, 0); __builtin_amdgcn_s_setprio(0); } while (0)
#define PG8_WAIT_V(n) asm volatile("s_waitcnt vmcnt(" #n ")" ::: "memory")
#define PG8_WAIT_L(n) asm volatile("s_waitcnt lgkmcnt(" #n ")" ::: "memory")
#define PG8_BAR __builtin_amdgcn_s_barrier()
#define PG8_SCHED __builtin_amdgcn_sched_barrier(0)
    Unit cur, nxt; int ui = 0;
    if (!S.next(0, cur)) return;
    f32x4 acc[2][2][4][2];
#pragma unroll
    for (int a = 0; a < 2; ++a)
#pragma unroll
        for (int b = 0; b < 2; ++b)
#pragma unroll
            for (int m = 0; m < 4; ++m)
#pragma unroll
                for (int n = 0; n < 2; ++n) acc[a][b][m][n] = (f32x4){0.f, 0.f, 0.f, 0.f};
    bf16x8 At[4][2], B0[2][2], B1[2][2];
    const char* cA = (const char*)g.A + (size_t)cur.pm * tstepA + (size_t)cur.pn * (size_t)g.a_pn_step; const char* cB = (const char*)g.Bt + (size_t)cur.pn * tstepB;
    S.a_ready(cur);
    PG8_STAGE(PG8_SB(0, 0), cB, voffB); PG8_STAGE(PG8_SB(0, 1), cB + hstepB, voffB); PG8_STAGE(PG8_SA(0, 0), cA, voffA); PG8_STAGE(PG8_SA(0, 1), cA + hstepA, voffA);
    if (wr == 1) PG8_BAR;
    PG8_WAIT_V(2); PG8_BAR;
    PG8_STAGE(PG8_SB(1, 0), cB + kstep, voffB); PG8_STAGE(PG8_SA(1, 0), cA + kstep, voffA); PG8_STAGE(PG8_SB(1, 1), cB + hstepB + kstep, voffB);
    PG8_WAIT_V(6); PG8_BAR;
    for (;;) {
        const bool has_next = S.next(ui + 1, nxt);
        const char* nA = has_next ? (const char*)g.A + (size_t)nxt.pm * tstepA + (size_t)nxt.pn * (size_t)g.a_pn_step : cA; const char* nB = has_next ? (const char*)g.Bt + (size_t)nxt.pn * tstepB : cB;
        for (int t = 0; t < nt; t += 2) {
            const bool last = (t == nt - 2);
            const char* a1 = cA + (size_t)(t + 1) * kstep;
            const char* a2 = last ? nA : cA + (size_t)(t + 2) * kstep; const char* b2 = last ? nB : cB + (size_t)(t + 2) * kstep;
            const char* a3 = a2 + kstep; const char* b3 = b2 + kstep;
            if (last && has_next) S.a_ready(nxt);
            PG8_LDB(B0, 0, 0); PG8_LDB(B1, 0, 1); PG8_SCHED; PG8_LDA(At, 0, 0); PG8_STAGE(PG8_SA(1, 1), a1 + hstepA, voffA);
            PG8_WAIT_V(8); PG8_WAIT_L(0); PG8_BAR; PG8_MMA(0, 0, At, B0); PG8_MMA(0, 1, At, B1); PG8_BAR; PG8_SCHED;
            PG8_LDA(At, 0, 1); PG8_STAGE(PG8_SB(0, 0), b2, voffB); PG8_STAGE(PG8_SB(0, 1), b2 + hstepB, voffB); PG8_STAGE(PG8_SA(0, 0), a2, voffA);
            PG8_WAIT_V(8); PG8_WAIT_L(0); PG8_BAR; PG8_MMA(1, 0, At, B0); PG8_MMA(1, 1, At, B1); PG8_BAR; PG8_SCHED;
            PG8_LDB(B0, 1, 0); PG8_LDB(B1, 1, 1); PG8_SCHED; PG8_LDA(At, 1, 0); PG8_STAGE(PG8_SA(0, 1), a2 + hstepA, voffA);
            PG8_WAIT_V(8); PG8_WAIT_L(0); PG8_BAR; PG8_MMA(0, 0, At, B0); PG8_MMA(0, 1, At, B1); PG8_BAR; PG8_SCHED;
            PG8_LDA(At, 1, 1); PG8_STAGE(PG8_SB(1, 0), b3, voffB); PG8_STAGE(PG8_SB(1, 1), b3 + hstepB, voffB); PG8_STAGE(PG8_SA(1, 0), a3, voffA);
            PG8_WAIT_V(8); PG8_WAIT_L(0); PG8_BAR; PG8_MMA(1, 0, At, B0); PG8_MMA(1, 1, At, B1); PG8_BAR; PG8_SCHED;
        }
        if constexpr (ALIGN_EPI) { if (wr == 0) PG8_BAR; }
        E(acc, cur, wr, wc, fr, fq); S.done(cur);
        if (!has_next) break;
#pragma unroll
        for (int a = 0; a < 2; ++a)
#pragma unroll
            for (int b = 0; b < 2; ++b)
#pragma unroll
                for (int m = 0; m < 4; ++m)
#pragma unroll
                    for (int n = 0; n < 2; ++n) acc[a][b][m][n] = (f32x4){0.f, 0.f, 0.f, 0.f};
        cur = nxt; cA = nA; cB = nB; ++ui;
        if constexpr (ALIGN_EPI) { if (wr == 1) PG8_BAR; }
    }
    PG8_WAIT_V(0);
    if constexpr (!ALIGN_EPI) { if (wr == 0) PG8_BAR; }
    PG8_BAR;
#undef PG8_SA
#undef PG8_SB
#undef PG8_STAGE
#undef PG8_LDA
#undef PG8_LDB
#undef PG8_MMA
#undef PG8_WAIT_V
#undef PG8_WAIT_L
#undef PG8_BAR
#undef PG8_SCHED
}
}

#define LDS_WAIT() asm volatile("s_waitcnt lgkmcnt(0)" ::: "memory")
#define VM_WAIT() asm volatile("s_waitcnt vmcnt(0)" ::: "memory")
__device__ __forceinline__ unsigned f2bf(float f) { unsigned u = __builtin_bit_cast(unsigned, f); return (u + 0x7fffu + ((u >> 16) & 1u)) >> 16; }
typedef __bf16 bf16v2 __attribute__((ext_vector_type(2)));
__device__ __forceinline__ unsigned pk2(float lo, float hi) { const f32x2 v = {lo, hi}; return __builtin_bit_cast(unsigned, __builtin_convertvector(v, bf16v2)); }
__device__ __forceinline__ float bf_lo(unsigned u) { return __builtin_bit_cast(float, u << 16); }
__device__ __forceinline__ float bf_hi(unsigned u) { return __builtin_bit_cast(float, u & 0xffff0000u); }
__device__ __forceinline__ float bf1(bf16 b) { return __builtin_bit_cast(float, ((unsigned)b) << 16); }
__device__ __forceinline__ void unpack8(const v4u u, float (&x)[8]) { x[0] = bf_lo(u.x); x[1] = bf_hi(u.x); x[2] = bf_lo(u.y); x[3] = bf_hi(u.y); x[4] = bf_lo(u.z); x[5] = bf_hi(u.z); x[6] = bf_lo(u.w); x[7] = bf_hi(u.w); }
__device__ __forceinline__ v4u pack8(const float (&x)[8]) { v4u o; o.x = pk2(x[0], x[1]); o.y = pk2(x[2], x[3]); o.z = pk2(x[4], x[5]); o.w = pk2(x[6], x[7]); return o; }
__device__ __forceinline__ float wave_sum(float v) {
#pragma unroll
    for (int o = 1; o < 64; o <<= 1) v += __shfl_xor(v, o);
    return v;
}
__device__ __forceinline__ float wave_max(float v) {
#pragma unroll
    for (int o = 1; o < 64; o <<= 1) v = fmaxf(v, __shfl_xor(v, o));
    return v;
}
template <int CTRL> __device__ __forceinline__ float dpp_f(float x) { return __builtin_bit_cast(float, __builtin_amdgcn_update_dpp(0, __builtin_bit_cast(int, x), CTRL, 0xf, 0xf, true)); }
__device__ __forceinline__ float row16_sum(float x) { x += dpp_f<0xB1>(x); x += dpp_f<0x4E>(x); x += dpp_f<0x124>(x); x += dpp_f<0x128>(x); return x; }
__device__ __forceinline__ float sigm(float x) { return __builtin_amdgcn_rcpf(1.f + __expf(-x)); }
__device__ __forceinline__ float silu(float x) { return x * __builtin_amdgcn_rcpf(1.f + __expf(-x)); }

#define XB_TMO      128
#define XB_XCNT(j)  (256  + 64 * (j))
#define XB_XSUB(j)  (1280 + 64 * (j))
#define XB_XGEN(j)  (2304 + 64 * (j))
#define XB_TOP      3328
#define XB_TOPGEN   3392
#define XCD_BAR_WORDS 3456
#define XB_SPIN_CAP (1u << 18)
__device__ __forceinline__ unsigned xb_ld(unsigned* p)              { return __hip_atomic_load(p, __ATOMIC_RELAXED, __HIP_MEMORY_SCOPE_AGENT); }
__device__ __forceinline__ unsigned xb_add(unsigned* p, unsigned v) { return __hip_atomic_fetch_add(p, v, __ATOMIC_RELAXED, __HIP_MEMORY_SCOPE_AGENT); }
__device__ __forceinline__ unsigned xb_xcc_id() { return (unsigned)__builtin_amdgcn_s_getreg((3 << 11) | 20) & 0xFu; }
#define XB_SPIN(cond, bar) do { unsigned _sp = 0; while (cond) { __builtin_amdgcn_s_sleep(1); \
    if ((++_sp & 255u) == 0u) { if (xb_ld(&(bar)[XB_TMO])) break; if (_sp > XB_SPIN_CAP) { atomicAdd(&(bar)[XB_TMO], 1u); break; } } } } while (0)
struct XcdBarrier { unsigned* bar; unsigned x; volatile LAS unsigned* st; };
__device__ __forceinline__ XcdBarrier xcd_barrier_post(unsigned* bar, volatile LAS unsigned* st) {
    XcdBarrier b; b.bar = bar; b.x = xb_xcc_id(); b.st = st;
    if (threadIdx.x == 0) (void)xb_add(&bar[XB_XCNT(b.x)], 1u);
    return b;
}
__device__ __forceinline__ void xcd_barrier_complete(unsigned* bar, unsigned x, unsigned& nloc, unsigned& nx) {
    const unsigned G = gridDim.x * gridDim.y * gridDim.z;
    unsigned sum, cnt, mine, sp = 0u;
    for (;;) {
        sum = 0u; cnt = 0u; mine = 0u;
#pragma unroll
        for (unsigned j = 0; j < 16; ++j) { const unsigned c = xb_ld(&bar[XB_XCNT(j)]); sum += c; cnt += (c > 0u) ? 1u : 0u; mine = (j == x) ? c : mine; }
        if (sum == G) break;
        __builtin_amdgcn_s_sleep(1);
        if ((++sp & 255u) == 0u) { if (xb_ld(&bar[XB_TMO])) break; if (sp > XB_SPIN_CAP) { atomicAdd(&bar[XB_TMO], 1u); break; } }
    }
    nloc = mine > 0u ? mine : 1u; nx = cnt > 0u ? cnt : 1u;
}
__device__ __forceinline__ void xcd_barrier(const XcdBarrier& b) {
    asm volatile("s_waitcnt vmcnt(0)" ::: "memory");
    __syncthreads();
    if (threadIdx.x == 0) {
        unsigned* bar = b.bar;
        __builtin_amdgcn_s_waitcnt(0);
        unsigned nloc = b.st[0], nx = b.st[1];
        if (nloc == 0u) { xcd_barrier_complete(bar, b.x, nloc, nx); b.st[0] = nloc; b.st[1] = nx; }
        const unsigned old = xb_add(&bar[XB_XSUB(b.x)], 1u);
        const unsigned gen = old / nloc;
        if (old + 1u == (gen + 1u) * nloc) {
            __builtin_amdgcn_fence(__ATOMIC_RELEASE, "agent");
            asm volatile("s_waitcnt vmcnt(0)" ::: "memory");
            const unsigned og = xb_add(&bar[XB_TOP], 1u);
            const unsigned tg = og / nx;
            if (og + 1u == (tg + 1u) * nx) xb_add(&bar[XB_TOPGEN], 1u);
            else XB_SPIN(xb_ld(&bar[XB_TOPGEN]) == tg, bar);
            __builtin_amdgcn_fence(__ATOMIC_ACQUIRE, "agent");
            xb_add(&bar[XB_XGEN(b.x)], 1u);
            asm volatile("s_waitcnt vmcnt(0)" ::: "memory");
        } else {
            XB_SPIN(xb_ld(&bar[XB_XGEN(b.x)]) == gen, bar);
            __builtin_amdgcn_fence(__ATOMIC_ACQUIRE, "agent");
            asm volatile("s_waitcnt vmcnt(0)" ::: "memory");
        }
    }
    __syncthreads();
}

constexpr int NWAVES = 8;
constexpr int RING_BYTES = 131072, SCANTV_BYTES = 0, LDSCTL_OFF = RING_BYTES + SCANTV_BYTES, MISC_OFF = LDSCTL_OFF + 320, LDS_BYTES = 147456;
constexpr int CW_BAR = 4096;

struct Args { const float* in[25]; float* out; unsigned char* ws; int ph_lo, ph_hi; };
struct Frame {
    LAS unsigned char* lds;
    int tid, lane, wave, vcu, G;
    const CAS cfp_t* in; float* out; unsigned char* ws;
};

__device__ __forceinline__ int launder(int x) { asm volatile("" : "+v"(x)); return x; }
template <class T> __device__ __forceinline__ T* launder_p(T* p) { asm volatile("" : "+s"(p)); return p; }
__device__ __forceinline__ const CAS cfp_t* launder_k(const CAS cfp_t* p) { asm volatile("" : "+s"(p)); return p; }
#define RELANE(F0) Frame F = F0; F.lane = launder(F0.lane); F.tid = launder(F0.tid)

struct EpiStore {
    bf16* O; int ldc; int sig_pn;
    __device__ __forceinline__ void operator()(const f32x4 (&acc)[2][2][4][2], const pg8::Unit& u, int wr, int wc, int fr, int fq) const {
        const int row0 = u.pm * 256 + wr * 64 + fr, col0 = u.pn * 256 + wc * 32 + 8 * fq; const bool sg = u.pn >= sig_pn;
#pragma unroll
        for (int ai = 0; ai < 2; ++ai)
#pragma unroll
            for (int m = 0; m < 4; ++m) { bf16* rowp = O + (size_t)(row0 + ai * 128 + m * 16) * ldc + col0;
#pragma unroll
                for (int bj = 0; bj < 2; ++bj) { f32x4 v0 = acc[ai][bj][m][0], v1 = acc[ai][bj][m][1];
                    if (sg) {
#pragma unroll
                        for (int j = 0; j < 4; ++j) { v0[j] = sigm(v0[j]); v1[j] = sigm(v1[j]); } }
                    v4u w; w.x = pg8::cvt_pk_bf16(v0[0], v0[1]); w.y = pg8::cvt_pk_bf16(v0[2], v0[3]); w.z = pg8::cvt_pk_bf16(v1[0], v1[1]); w.w = pg8::cvt_pk_bf16(v1[2], v1[3]);
                    *(v4u*)(rowp + bj * 128) = w; } }
    }
};
template <bool ACCUM> struct EpiMerge {
    bf16* O; const bf16* gate;
    __device__ __forceinline__ void operator()(const f32x4 (&acc)[2][2][4][2], const pg8::Unit& u, int wr, int wc, int fr, int fq) const {
        const int row0 = u.pm * 256 + wr * 64 + fr, col0 = u.pn * 256 + wc * 32 + 8 * fq;
#pragma unroll
        for (int ai = 0; ai < 2; ++ai)
#pragma unroll
            for (int m = 0; m < 4; ++m) { const int row = row0 + ai * 128 + m * 16; bf16* rowp = O + (size_t)row * D + col0; const bf16* gp = gate + (size_t)row * NIN + col0;
#pragma unroll
                for (int bj = 0; bj < 2; ++bj) {
                    float gv[8]; unpack8(*(const v4u*)(gp + bj * 128), gv);
                    float o[8];
#pragma unroll
                    for (int j = 0; j < 4; ++j) { o[j] = acc[ai][bj][m][0][j] * gv[j]; o[4 + j] = acc[ai][bj][m][1][j] * gv[4 + j]; }
                    if (ACCUM) { float p[8]; unpack8(*(const v4u*)(rowp + bj * 128), p);
#pragma unroll
                        for (int j = 0; j < 8; ++j) o[j] += p[j]; }
                    v4u w; w.x = pg8::cvt_pk_bf16(o[0], o[1]); w.y = pg8::cvt_pk_bf16(o[2], o[3]); w.z = pg8::cvt_pk_bf16(o[4], o[5]); w.w = pg8::cvt_pk_bf16(o[6], o[7]);
                    *(v4u*)(rowp + bj * 128) = w; }
                asm volatile("" ::: "memory"); }
    }
};
struct EpiSwiglu {
    bf16* O;
    __device__ __forceinline__ void operator()(const f32x4 (&acc)[2][2][4][2], const pg8::Unit& u, int wr, int wc, int fr, int fq) const {
        const int row0 = u.pm * 256 + wr * 64 + fr, col0 = u.pn * 128 + wc * 32 + 8 * fq;
#pragma unroll
        for (int ai = 0; ai < 2; ++ai)
#pragma unroll
            for (int m = 0; m < 4; ++m) { bf16* rowp = O + (size_t)(row0 + ai * 128 + m * 16) * DFF + col0;
                float o[8];
#pragma unroll
                for (int j = 0; j < 4; ++j) { o[j] = silu(acc[ai][0][m][0][j]) * acc[ai][1][m][0][j]; o[4 + j] = silu(acc[ai][0][m][1][j]) * acc[ai][1][m][1][j]; }
                v4u w; w.x = pg8::cvt_pk_bf16(o[0], o[1]); w.y = pg8::cvt_pk_bf16(o[2], o[3]); w.z = pg8::cvt_pk_bf16(o[4], o[5]); w.w = pg8::cvt_pk_bf16(o[6], o[7]);
                *(v4u*)rowp = w; }
    }
};

__device__ __forceinline__ void transpose_item(const float* W, int ldw, int src_col0, int k0, bf16* WT, int ldt, int dst_row0, LAS float* scr, int lane, const float* rscale = nullptr) {
#pragma unroll 8
    for (int i = 0; i < 32; ++i) { const int kk = 2 * i + (lane >> 5); scr[kk * 33 + (lane & 31)] = W[(size_t)(k0 + kk) * ldw + src_col0 + (lane & 31)]; }
    LDS_WAIT(); asm volatile("" ::: "memory");
    const int c = lane & 7;
#pragma unroll
    for (int j = 0; j < 4; ++j) { const int n = (lane >> 3) + 8 * j; const LAS float* s = scr + (8 * c) * 33 + n; const float m = rscale ? rscale[n] : 1.f;
        v4u o; o.x = pk2(s[0 * 33] * m, s[1 * 33] * m); o.y = pk2(s[2 * 33] * m, s[3 * 33] * m); o.z = pk2(s[4 * 33] * m, s[5 * 33] * m); o.w = pk2(s[6 * 33] * m, s[7 * 33] * m);
        *(v4u*)(WT + (size_t)(dst_row0 + n) * ldt + k0 + 8 * c) = o; }
    LDS_WAIT(); asm volatile("" ::: "memory");
}
constexpr int IT_IN = 32 * 496, IT_BRA = 16 * 64, IT_BRB = 8 * 64, IT_BRC = 16 * 64, IT_POOL = 4 * 4 * 8, IT_OUT = 32 * 64, IT_GU = 32 * 352, IT_DOWN = 88 * 64;
constexpr int IT_LAYER = IT_IN + IT_BRA + IT_BRB + IT_BRC + IT_POOL + IT_OUT + IT_GU + IT_DOWN;
__device__ __forceinline__ void weight_item(Frame& F0, int l, int r, LAS float* scr) {
    RELANE(F0);
    unsigned char* wl = F.ws + WS_W + (size_t)l * WL_BYTES; const int lane = F.lane;
    if (r < IT_IN) { const int kb = r / 496, nb = r % 496, n0 = nb * 32; transpose_item(F.in[8] + (size_t)l * D * NIN_SRC, NIN_SRC, n0 + (n0 >= 4096 ? 16 : 0), kb * 64, (bf16*)(wl + WO_IN), D, n0, scr, lane); return; } r -= IT_IN;
    if (r < IT_BRA) { const int kb = r / 64, nb = r % 64; transpose_item(F.in[15] + (size_t)l * 1024 * D, D, nb * 32, kb * 64, (bf16*)(wl + WO_BRA), 1024, nb * 32, scr, lane); return; } r -= IT_BRA;
    if (r < IT_BRB) { const int kb = r / 64, nb = r % 64; transpose_item(F.in[16] + (size_t)l * 512 * D, D, nb * 32, kb * 64, (bf16*)(wl + WO_BRB), 512, nb * 32, scr, lane); return; } r -= IT_BRB;
    if (r < IT_BRC) { const int kb = r / 64, nb = r % 64; transpose_item(F.in[17] + (size_t)l * 1024 * D, D, nb * 32, kb * 64, (bf16*)(wl + WO_BRC), 1024, nb * 32, scr, lane); return; } r -= IT_BRC;
    if (r < IT_POOL) { const int g = r / 32, kb = (r % 32) / 8, nb = r % 8; transpose_item(F.in[13] + (size_t)(l * 4 + g) * 65536, 256, nb * 32, kb * 64, (bf16*)(wl + WO_POOL) + (size_t)g * 65536, 256, nb * 32, scr, lane, F.in[14] + (size_t)l * CPOOL + g * 256 + nb * 32); return; } r -= IT_POOL;
    if (r < IT_OUT) { const int kb = r / 64, nb = r % 64; transpose_item(F.in[18] + (size_t)l * D * D, D, nb * 32, kb * 64, (bf16*)(wl + WO_OUT), D, nb * 32, scr, lane); return; } r -= IT_OUT;
    if (r < IT_GU) { const int kb = r / 352, nb = r % 352, n0 = nb * 32, pn = n0 >> 8, bj = (n0 >> 7) & 1, rr = n0 & 127;
        transpose_item(F.in[19] + (size_t)l * D * 2 * DFF, 2 * DFF, bj * DFF + 128 * pn + rr, kb * 64, (bf16*)(wl + WO_GU), D, n0, scr, lane); return; } r -= IT_GU;
    { const int kb = r / 64, nb = r % 64; transpose_item(F.in[20] + (size_t)l * DFF * D, D, nb * 32, kb * 64, (bf16*)(wl + WO_DOWN), DFF, nb * 32, scr, lane); }
}

__device__ __forceinline__ void stage_wba(Frame& F0, int l) {
    RELANE(F0);
    LAS float* Wl = (LAS float*)F.lds; const float* w = F.in[8] + (size_t)l * D * NIN_SRC + 4096;
    for (int k = F.tid; k < D; k += NWAVES * 64) { const float* p = w + (size_t)k * NIN_SRC;
        const f32x4 a = *(const f32x4*)p, b = *(const f32x4*)(p + 4), c = *(const f32x4*)(p + 8), d = *(const f32x4*)(p + 12);
        Wl[0 * D + k] = a.x; Wl[1 * D + k] = a.y; Wl[2 * D + k] = a.z; Wl[3 * D + k] = a.w; Wl[4 * D + k] = b.x; Wl[5 * D + k] = b.y; Wl[6 * D + k] = b.z; Wl[7 * D + k] = b.w;
        Wl[8 * D + k] = c.x; Wl[9 * D + k] = c.y; Wl[10 * D + k] = c.z; Wl[11 * D + k] = c.w; Wl[12 * D + k] = d.x; Wl[13 * D + k] = d.y; Wl[14 * D + k] = d.z; Wl[15 * D + k] = d.w; }
    __syncthreads();
}
template <bool X32>
__device__ __forceinline__ void thin_rows(Frame& F0, const float* xa, const float* xb, const bf16* Y, const float* gpost, float* fout, const float* gpre, bool do_ba, int l_ba) {
    RELANE(F0);
    const int lane = F.lane, gw = F.vcu * NWAVES + F.wave, NGW = F.G * NWAVES;
    bf16* H = (bf16*)(F.ws + WS_H); bf16* XB = (bf16*)(F.ws + WS_X1); float* GB = (float*)(F.ws + WS_GB);
    const LAS float* Wl = (const LAS float*)F.lds;
    f32x4 vn[8]; v2u xn[8], yn[8];
#define THIN_LOAD(rr) do { const int r_ = (rr); \
        if (X32) { const float* xr_ = (r_ < MP) ? xa + (size_t)r_ * D : xb + (size_t)(r_ - MP) * D; _Pragma("unroll") for (int j = 0; j < 8; ++j) vn[j] = *(const f32x4*)(xr_ + 4 * lane + 256 * j); } \
        else { _Pragma("unroll") for (int j = 0; j < 8; ++j) xn[j] = *(const v2u*)(XB + (size_t)r_ * D + 4 * lane + 256 * j); } \
        if (Y) { _Pragma("unroll") for (int j = 0; j < 8; ++j) yn[j] = *(const v2u*)(Y + (size_t)r_ * D + 4 * lane + 256 * j); } } while (0)
#pragma unroll
    for (int j = 0; j < 8; ++j) { yn[j] = (v2u){0u, 0u}; xn[j] = (v2u){0u, 0u}; vn[j] = (f32x4){0.f, 0.f, 0.f, 0.f}; }
    if (gw < MV) THIN_LOAD(gw);
    for (int r = gw; r < MV; r += NGW) {
        f32x4 v[8]; v2u yu[8];
#pragma unroll
        for (int j = 0; j < 8; ++j) { v[j] = X32 ? vn[j] : (f32x4){bf_lo(xn[j].x), bf_hi(xn[j].x), bf_lo(xn[j].y), bf_hi(xn[j].y)}; yu[j] = yn[j]; }
        if (r + NGW < MV) THIN_LOAD(r + NGW);
        if (Y) {
            f32x4 y[8]; float ss = 0.f;
#pragma unroll
            for (int j = 0; j < 8; ++j) { const v2u u = yu[j]; y[j] = (f32x4){bf_lo(u.x), bf_hi(u.x), bf_lo(u.y), bf_hi(u.y)}; ss += (y[j].x * y[j].x + y[j].y * y[j].y) + (y[j].z * y[j].z + y[j].w * y[j].w); }
            const float rstd = rsqrtf(wave_sum(ss) * (1.f / D) + EPS);
#pragma unroll
            for (int j = 0; j < 8; ++j) { const f32x4 g = *(const f32x4*)(gpost + 4 * lane + 256 * j); v[j] = v[j] + y[j] * rstd * g; }
        }
        if (fout) {
#pragma unroll
            for (int j = 0; j < 8; ++j) *(f32x4*)(fout + (size_t)r * D + 4 * lane + 256 * j) = v[j];
        } else {
#pragma unroll
            for (int j = 0; j < 8; ++j) { v2u o; o.x = pk2(v[j].x, v[j].y); o.y = pk2(v[j].z, v[j].w); *(v2u*)(XB + (size_t)r * D + 4 * lane + 256 * j) = o; }
        }
        if (gpre) {
            float ss = 0.f;
#pragma unroll
            for (int j = 0; j < 8; ++j) ss += (v[j].x * v[j].x + v[j].y * v[j].y) + (v[j].z * v[j].z + v[j].w * v[j].w);
            const float rstd = rsqrtf(wave_sum(ss) * (1.f / D) + EPS);
#pragma unroll
            for (int j = 0; j < 8; ++j) { const f32x4 g = *(const f32x4*)(gpre + 4 * lane + 256 * j); v[j] = v[j] * rstd * g;
                v2u o; o.x = pk2(v[j].x, v[j].y); o.y = pk2(v[j].z, v[j].w); *(v2u*)(H + (size_t)r * D + 4 * lane + 256 * j) = o; }
            if (do_ba) {
                float mine = 0.f;
#pragma unroll 1
                for (int c = 0; c < 16; ++c) { float p = 0.f;
#pragma unroll
                    for (int j = 0; j < 8; ++j) { const f32x4 w = *(const LAS f32x4*)(Wl + c * D + 256 * j + 4 * lane); p += (v[j].x * w.x + v[j].y * w.y) + (v[j].z * w.z + v[j].w * w.w); }
                    p = wave_sum(p); if (lane == c) mine = p; }
                if (lane < 16) { float o;
                    if (lane < 8) o = sigm(mine);
                    else { const float al = F.in[10][l_ba * HA + lane - 8], dtb = F.in[11][l_ba * HA + lane - 8]; const float z = mine + dtb; const float sp = fmaxf(z, 0.f) + log1pf(__expf(-fabsf(z))); o = -__expf(al) * sp; }
                    GB[(size_t)r * 16 + lane] = o; }
            }
        }
    }
}
#undef THIN_LOAD

__device__ __forceinline__ void ld8f(const float* p, float (&x)[8]) { const f32x4 a = *(const f32x4*)p, b = *(const f32x4*)(p + 4); x[0] = a.x; x[1] = a.y; x[2] = a.z; x[3] = a.w; x[4] = b.x; x[5] = b.y; x[6] = b.z; x[7] = b.w; }
template <bool QK> __device__ __forceinline__ void conv_item(Frame& F0, int l, int row0, int T, int hmode, int sb, int j) {
    RELANE(F0);
    const int lane = F.lane;
    const bf16* PROJ = (const bf16*)(F.ws + WS_PROJ); const float* convw = F.in[9] + (size_t)l * 4 * CONVCH;
    const int c0 = QK ? 512 * j + 8 * lane : 2048 + 512 * j + 8 * lane, c1 = 1024 + 512 * j + 8 * lane;
    float w0[4][8], w1[4][8], x0[4][8], x1[4][8];
#pragma unroll
    for (int tap = 0; tap < 4; ++tap) { ld8f(convw + tap * CONVCH + c0, w0[tap]); if (QK) ld8f(convw + tap * CONVCH + c1, w1[tap]); }
#pragma unroll
    for (int i = 0; i < 3; ++i) {
        if (hmode == 1) { unpack8(*(const v4u*)(PROJ + (size_t)(row0 - 3 + i) * NIN + c0), x0[i + 1]); if (QK) unpack8(*(const v4u*)(PROJ + (size_t)(row0 - 3 + i) * NIN + c1), x1[i + 1]); }
        else if (hmode == 2) { const float* hp = F.in[6] + ((size_t)(l * DB + sb) * 3 + i) * CONVCH; ld8f(hp + c0, x0[i + 1]); if (QK) ld8f(hp + c1, x1[i + 1]); }
        else {
#pragma unroll
            for (int e = 0; e < 8; ++e) { x0[i + 1][e] = 0.f; x1[i + 1][e] = 0.f; } }
    }
    bf16* O0 = (bf16*)(F.ws + (QK ? WS_QN : WS_VV)) + 512 * j + 8 * lane; bf16* O1 = (bf16*)(F.ws + WS_KN) + 512 * j + 8 * lane;
    const float* GB = (const float*)(F.ws + WS_GB); f32x4* TOK = (f32x4*)(F.ws + WS_TOK); const int hd = 4 * j + (lane >> 4);
    v4u n0[4], n1[4]; float ng[4], nb[4];
#pragma unroll
    for (int u = 0; u < 4; ++u) { n0[u] = *(const v4u*)(PROJ + (size_t)(row0 + u) * NIN + c0); n1[u] = n0[u]; ng[u] = 0.f; nb[u] = 0.f; if (QK) { n1[u] = *(const v4u*)(PROJ + (size_t)(row0 + u) * NIN + c1); ng[u] = GB[(size_t)(row0 + u) * 16 + 8 + hd]; nb[u] = GB[(size_t)(row0 + u) * 16 + hd]; } }
    for (int tb = 0; tb < T; tb += 4) {
        v4u m0[4], m1[4]; float mg[4], mb[4];
#pragma unroll
        for (int u = 0; u < 4; ++u) { m0[u] = n0[u]; m1[u] = n1[u]; mg[u] = ng[u]; mb[u] = nb[u]; }
        if (tb + 4 < T) {
#pragma unroll
            for (int u = 0; u < 4; ++u) { n0[u] = *(const v4u*)(PROJ + (size_t)(row0 + tb + 4 + u) * NIN + c0); if (QK) { n1[u] = *(const v4u*)(PROJ + (size_t)(row0 + tb + 4 + u) * NIN + c1); ng[u] = GB[(size_t)(row0 + tb + 4 + u) * 16 + 8 + hd]; nb[u] = GB[(size_t)(row0 + tb + 4 + u) * 16 + hd]; } } }
#pragma unroll
        for (int u = 0; u < 4; ++u) {
            const int t = tb + u; const size_t r = (size_t)(row0 + t);
            unpack8(m0[u], x0[u]); if (QK) unpack8(m1[u], x1[u]);
            float a0[8], a1[8]; float s0 = 0.f, s1 = 0.f;
#pragma unroll
            for (int e = 0; e < 8; ++e) {
                a0[e] = silu(w0[3][e] * x0[u][e] + w0[2][e] * x0[(u + 3) & 3][e] + w0[1][e] * x0[(u + 2) & 3][e] + w0[0][e] * x0[(u + 1) & 3][e]); s0 += a0[e] * a0[e];
                if (QK) { a1[e] = silu(w1[3][e] * x1[u][e] + w1[2][e] * x1[(u + 3) & 3][e] + w1[1][e] * x1[(u + 2) & 3][e] + w1[0][e] * x1[(u + 1) & 3][e]); s1 += a1[e] * a1[e]; } }
            if (QK) {
                const float q_sc = rsqrtf(row16_sum(s0) + 1e-6f) * 0.08838834764831845f, k_sc = rsqrtf(row16_sum(s1) + 1e-6f); float p = 0.f;
#pragma unroll
                for (int e = 0; e < 8; ++e) { a0[e] *= q_sc; a1[e] *= k_sc; p += a0[e] * a1[e]; }
                p = row16_sum(p);
                *(v4u*)(O1 + r * 1024) = pack8(a1);
                if ((lane & 15) == 0) TOK[r * 8 + hd] = (f32x4){__expf(mg[u]), mb[u], p, mg[u]};
            }
            *(v4u*)(O0 + r * 1024) = pack8(a0);
        }
    }
}
__device__ __forceinline__ void pool_item(Frame& F0, int l, int row0, int T, int pos0, int hmode, int sb, int j) {
    RELANE(F0);
    const int lane = F.lane, win = 2 << (2 * j + (lane >> 5)), cc = 512 * j + 8 * lane;
    const bf16* U = (const bf16*)(F.ws + WS_PROJ) + PC_UC + cc; const float* hist = F.in[7] + (size_t)(l * DB + sb) * PHIST * CPOOL + cc;
    bf16* PO = (bf16*)(F.ws + WS_POOLED) + cc;
    float S[8];
#pragma unroll
    for (int e = 0; e < 8; ++e) S[e] = 0.f;
    if (hmode == 2) {
        for (int i = 1; i < 16; ++i) if (i < win) { float x[8]; ld8f(hist + (size_t)(PHIST - i) * CPOOL, x);
#pragma unroll
            for (int e = 0; e < 8; ++e) S[e] += x[e]; }
        for (int t = 0; t < T; ++t) {
            float xn[8], xo[8]; unpack8(*(const v4u*)(U + (size_t)(row0 + t) * NIN), xn);
            const int to = t - win + 1;
            if (to >= 0) unpack8(*(const v4u*)(U + (size_t)(row0 + to) * NIN), xo); else ld8f(hist + (size_t)(PHIST + to) * CPOOL, xo);
            const float inv = 1.f / (float)win; float o[8];
#pragma unroll
            for (int e = 0; e < 8; ++e) { S[e] += xn[e]; o[e] = S[e] * inv - xn[e]; S[e] -= xo[e]; }
            *(v4u*)(PO + (size_t)(row0 + t) * 1024) = pack8(o);
        }
        return;
    }
    {
        v4u h[15];
#pragma unroll
        for (int i = 1; i < 16; ++i) { const int back = (pos0 - i >= 0) ? i : pos0; h[i - 1] = *(const v4u*)(U + (size_t)(row0 - back) * NIN); }
#pragma unroll
        for (int i = 1; i < 16; ++i) { float x[8]; unpack8(h[i - 1], x); const float wgt = (i < win && pos0 - i >= 0) ? 1.f : 0.f;
#pragma unroll
            for (int e = 0; e < 8; ++e) S[e] += wgt * x[e]; }
    }
    v4u nn[4], no[4];
#define POOL_LD(tb_) do { _Pragma("unroll") for (int u = 0; u < 4; ++u) { const int t_ = (tb_) + u, to_ = t_ - win + 1; nn[u] = *(const v4u*)(U + (size_t)(row0 + t_) * NIN); no[u] = *(const v4u*)(U + (size_t)(row0 + (pos0 + to_ >= 0 ? to_ : -pos0)) * NIN); } } while (0)
    POOL_LD(0);
    for (int tb = 0; tb < T; tb += 4) {
        v4u mn[4], mo[4];
#pragma unroll
        for (int u = 0; u < 4; ++u) { mn[u] = nn[u]; mo[u] = no[u]; }
        if (tb + 4 < T) POOL_LD(tb + 4);
#pragma unroll
        for (int u = 0; u < 4; ++u) {
            const int t = tb + u, to = t - win + 1; const float wo = (pos0 + to >= 0) ? 1.f : 0.f;
            float xn[8], xo[8]; unpack8(mn[u], xn); unpack8(mo[u], xo);
            const float cnt = (float)(win < pos0 + t + 1 ? win : pos0 + t + 1), inv = __builtin_amdgcn_rcpf(cnt); float o[8];
#pragma unroll
            for (int e = 0; e < 8; ++e) { S[e] += xn[e]; o[e] = S[e] * inv - xn[e]; S[e] -= wo * xo[e]; }
            *(v4u*)(PO + (size_t)(row0 + t) * 1024) = pack8(o);
        }
    }
#undef POOL_LD
}
constexpr int CV_BLK = 16, CV_NB = SEQ / CV_BLK;
constexpr int CV_P_ITEMS = BATCH * CV_NB * 2, CV_S_ITEMS = DB * 2;
constexpr int PREP_ITEMS = 2 * (CV_P_ITEMS + CV_S_ITEMS) + CV_P_ITEMS + CV_S_ITEMS;
__device__ __forceinline__ void prep_item(Frame& F, int l, int it) {
    int kind = 0;
    if (it >= CV_P_ITEMS + CV_S_ITEMS) { it -= CV_P_ITEMS + CV_S_ITEMS; kind = 1; if (it >= CV_P_ITEMS + CV_S_ITEMS) { it -= CV_P_ITEMS + CV_S_ITEMS; kind = 2; } }
    int row0, T, hmode, sb = 0, pos0; const int j = it & 1;
    if (it < CV_P_ITEMS) { const int blk = (it >> 1) % CV_NB, b = (it >> 1) / CV_NB; row0 = b * SEQ + blk * CV_BLK; T = CV_BLK; hmode = blk ? 1 : 0; pos0 = blk * CV_BLK; }
    else { sb = (it - CV_P_ITEMS) >> 1; row0 = MP + DS * sb; T = DS; hmode = 2; pos0 = 0; }
    if (kind == 0) conv_item<true>(F, l, row0, T, hmode, sb, j); else if (kind == 1) conv_item<false>(F, l, row0, T, hmode, sb, j); else pool_item(F, l, row0, T, pos0, hmode, sb, j);
}

__device__ __forceinline__ void st8f(float* p, const v4u u) { float x[8]; unpack8(u, x); *(f32x4*)p = (f32x4){x[0], x[1], x[2], x[3]}; *(f32x4*)(p + 4) = (f32x4){x[4], x[5], x[6], x[7]}; }
__device__ __forceinline__ void prep_out_rows(Frame& F0, int l) {
    RELANE(F0);
    const int lane = F.lane, gw = F.vcu * NWAVES + F.wave, NGW = F.G * NWAVES;
    const bf16* PROJ = (const bf16*)(F.ws + WS_PROJ);
    float* out = F.out;
    for (int r = gw; r < MV; r += NGW) {
        const bool samp = r >= MP; const int b = samp ? (r - MP) / DS : r / SEQ, t = samp ? (r - MP) % DS : r % SEQ;
        const bf16* prow = PROJ + (size_t)r * NIN;
        const int ci = samp ? t - 1 : t - (SEQ - 3), pi = samp ? 11 + t : t - (SEQ - PHIST);
        v4u kvr[3][2], cv[6], pv[2];
#pragma unroll
        for (int gi = 0; gi < 3; ++gi) { kvr[gi][0] = *(const v4u*)(prow + PC_KB + gi * 512 + 8 * lane); kvr[gi][1] = *(const v4u*)(prow + PC_VB + gi * 512 + 8 * lane); }
        const bool needc = (ci >= 0) || (pi >= 0);
        if (needc) {
#pragma unroll
            for (int j = 0; j < 6; ++j) cv[j] = *(const v4u*)(prow + 512 * j + 8 * lane);
#pragma unroll
            for (int j = 0; j < 2; ++j) pv[j] = *(const v4u*)(prow + PC_UC + 512 * j + 8 * lane);
        }
#pragma unroll
        for (int gi = 0; gi < 3; ++gi) {
            const int win = 128 << (2 * gi); const int w = samp ? win - DS + t : t - (SEQ - win);
            if (w >= 0) {
                const size_t obase = samp ? (gi == 0 ? O_SW1 : gi == 1 ? O_SW2 : O_SW3) : (gi == 0 ? O_PW1 : gi == 1 ? O_PW2 : O_PW3);
                float* dst = out + obase + ((size_t)(l * (samp ? DB : BATCH) + b) * win + w) * 1024 + 8 * lane;
                st8f(dst, kvr[gi][0]); st8f(dst + 512, kvr[gi][1]);
            }
        }
        if (needc) {
            if (ci >= 0) { float* dst = out + (samp ? O_SCONV + ((size_t)(l * DB + b) * 3 + ci) * CONVCH : O_PCONV + ((size_t)(l * BATCH + b) * 3 + ci) * CONVCH) + 8 * lane;
#pragma unroll
                for (int j = 0; j < 6; ++j) st8f(dst + 512 * j, cv[j]); }
            if (pi >= 0) { float* dst = out + (samp ? O_SPOOL + ((size_t)(l * DB + b) * PHIST + pi) * CPOOL : O_PPOOL + ((size_t)(l * BATCH + b) * PHIST + pi) * CPOOL) + 8 * lane;
#pragma unroll
                for (int j = 0; j < 2; ++j) st8f(dst + 512 * j, pv[j]); }
            if (samp && t == 0) {
                const float* phist = F.in[7] + (size_t)(l * DB + b) * PHIST * CPOOL;
                float* dst = out + O_SPOOL + (size_t)(l * DB + b) * PHIST * CPOOL; const float* src = phist + 4 * CPOOL;
                for (int i = lane; i < 11 * CPOOL / 4; i += 64) *(f32x4*)(dst + 4 * i) = *(const f32x4*)(src + 4 * i);
            }
        }
    }
}

__device__ __forceinline__ void gdn_scan_item(Frame& F0, int row0, int T, int h, int s, const float* S0, float* Sout) {
    RELANE(F0);
    const int lane = F.lane, kg = lane & 15, dvl = lane >> 4;
    const bf16* QN = (const bf16*)(F.ws + WS_QN); const bf16* KN = (const bf16*)(F.ws + WS_KN); const bf16* VV = (const bf16*)(F.ws + WS_VV);
    const f32x4* TOK = (const f32x4*)(F.ws + WS_TOK); float* ORAW = (float*)(F.ws + WS_ORAW);
    float S[8]; v4u ku[DS], qu[DS]; float vv[DS]; f32x4 tk[DS];
#pragma unroll
    for (int i = 0; i < 8; ++i) S[i] = S0[(size_t)(8 * kg + i) * 128 + 4 * s + dvl];
#pragma unroll
    for (int t = 0; t < DS; ++t) { const size_t r = (size_t)(row0 + t);
        ku[t] = *(const v4u*)(KN + r * 1024 + h * 128 + 8 * kg); qu[t] = *(const v4u*)(QN + r * 1024 + h * 128 + 8 * kg); vv[t] = bf1(VV[r * 1024 + h * 128 + 4 * s + dvl]); tk[t] = TOK[r * 8 + h]; }
#pragma unroll
    for (int t = 0; t < DS; ++t) {
        float kf[8], qf[8]; unpack8(ku[t], kf); unpack8(qu[t], qf);
        float rk = 0.f, rq = 0.f;
#pragma unroll
        for (int i = 0; i < 8; ++i) { rk += kf[i] * S[i]; rq += qf[i] * S[i]; }
        rk = row16_sum(rk); rq = row16_sum(rq);
        const float a = tk[t].x, d = tk[t].y * (vv[t] - a * rk), o = a * rq + tk[t].z * d;
#pragma unroll
        for (int i = 0; i < 8; ++i) S[i] = a * S[i] + kf[i] * d;
        if (kg == 0) ORAW[(size_t)(row0 + t) * 1024 + h * 128 + 4 * s + dvl] = o;
    }
#pragma unroll
    for (int i = 0; i < 8; ++i) Sout[(size_t)(8 * kg + i) * 128 + 4 * s + dvl] = S[i];
    (void)T;
}

__device__ __forceinline__ bf16x8 pack_acc(const f32x16& x, int sp) {
    v4u p; p.x = pk2(x[8 * sp + 0], x[8 * sp + 1]); p.y = pk2(x[8 * sp + 2], x[8 * sp + 3]); p.z = pk2(x[8 * sp + 4], x[8 * sp + 5]); p.w = pk2(x[8 * sp + 6], x[8 * sp + 7]);
    return __builtin_bit_cast(bf16x8, p);
}
constexpr int GA_PITCH = 272, GA_LT_PITCH = 36, GA_WAVE_LDS = 32 * GA_PITCH + 32 * GA_LT_PITCH * 4 + 384;
__device__ __forceinline__ void gdn_ga_item(Frame& F0, int ch) {
    RELANE(F0);
    const int lane = F.lane, r = lane & 31, h = lane >> 5;
    const int c = ch & 63, bh = ch >> 6, hd = bh & 7, b = bh >> 3, row0 = b * SEQ + 32 * c;
    LAS unsigned char* TL = F.lds + F.wave * GA_WAVE_LDS; LAS float* LT = (LAS float*)(TL + 32 * GA_PITCH); LAS float* GS = (LAS float*)(TL + 32 * GA_PITCH + 32 * GA_LT_PITCH * 4);
    const bf16* QN = (const bf16*)(F.ws + WS_QN); const bf16* KN = (const bf16*)(F.ws + WS_KN); const bf16* VV = (const bf16*)(F.ws + WS_VV); const f32x4* TOK = (const f32x4*)(F.ws + WS_TOK);
    { const f32x4 tk = TOK[(size_t)(row0 + r) * 8 + hd]; if (h == 0) { GS[r] = tk.w; GS[32 + r] = tk.y; } }
#pragma unroll
    for (int i = 0; i < 8; ++i) { const int p = lane + 64 * i, rw = p >> 4, c16 = p & 15; *(LAS v4u*)(TL + rw * GA_PITCH + 16 * c16) = *(const v4u*)(KN + (size_t)(row0 + rw) * 1024 + hd * 128 + 8 * c16); }
    asm volatile("s_waitcnt lgkmcnt(0)" ::: "memory");
    float gcv[32], bev[32];
#pragma unroll
    for (int i = 0; i < 8; ++i) { const f32x4 a = *(const LAS f32x4*)(GS + 4 * i), bq = *(const LAS f32x4*)(GS + 32 + 4 * i);
        gcv[4 * i] = a.x; gcv[4 * i + 1] = a.y; gcv[4 * i + 2] = a.z; gcv[4 * i + 3] = a.w; bev[4 * i] = bq.x; bev[4 * i + 1] = bq.y; bev[4 * i + 2] = bq.z; bev[4 * i + 3] = bq.w; }
#pragma unroll
    for (int i = 1; i < 32; ++i) gcv[i] += gcv[i - 1];
    if (lane == 0) {
#pragma unroll
        for (int i = 0; i < 8; ++i) *(LAS f32x4*)(GS + 64 + 4 * i) = (f32x4){gcv[4 * i], gcv[4 * i + 1], gcv[4 * i + 2], gcv[4 * i + 3]}; }
    asm volatile("s_waitcnt lgkmcnt(0)" ::: "memory");
    const float gc_own = GS[64 + r], fr = (float)r;
    const bf16* kp = KN + (size_t)(row0 + r) * 1024 + hd * 128 + 8 * h; const bf16* qp = QN + (size_t)(row0 + r) * 1024 + hd * 128 + 8 * h;
    f32x16 akk, aqk;
#pragma unroll
    for (int i = 0; i < 16; ++i) { akk[i] = 0.f; aqk[i] = 0.f; }
#pragma unroll
    for (int ks = 0; ks < 8; ++ks) { const bf16x8 kf = *(const bf16x8*)(kp + 16 * ks), qf = *(const bf16x8*)(qp + 16 * ks);
        akk = __builtin_amdgcn_mfma_f32_32x32x16_bf16(kf, kf, akk, 0, 0, 0); aqk = __builtin_amdgcn_mfma_f32_32x32x16_bf16(kf, qf, aqk, 0, 0, 0); }
#pragma unroll
    for (int g4 = 0; g4 < 4; ++g4) { f32x4 w;
#pragma unroll
        for (int e = 0; e < 4; ++e) { const int k0 = 8 * g4 + e, k1 = k0 + 4; const float gk = h ? gcv[k1] : gcv[k0], bk = h ? bev[k1] : bev[k0]; const int kk = h ? k1 : k0;
            const float lo = fminf(fmaxf((float)kk - fr, 0.f), 1.f);
            w[e] = lo * bk * akk[4 * g4 + e] * __expf(fminf(gk - gc_own, 0.f));
            aqk[4 * g4 + e] = (1.f - lo) * aqk[4 * g4 + e] * __expf(fminf(gc_own - gk, 0.f)); }
        *(LAS f32x4*)(LT + r * GA_LT_PITCH + 8 * g4 + 4 * h) = w; }
    bf16x8* AF = (bf16x8*)(F.ws + WS_AF) + (size_t)ch * 128;
    AF[lane] = pack_acc(aqk, 0); AF[64 + lane] = pack_acc(aqk, 1);
    asm volatile("s_waitcnt lgkmcnt(0)" ::: "memory");
    float t[32];
#pragma unroll
    for (int j = 31; j >= 0; --j) {
        float acc = 1.f - fminf(fabsf(fr - (float)j), 1.f);
#pragma unroll
        for (int gq = (j + 1) >> 2; gq < 8; ++gq) { const f32x4 lv = *(const LAS f32x4*)(LT + j * GA_LT_PITCH + 4 * gq);
#pragma unroll
            for (int e = 0; e < 4; ++e) if (4 * gq + e > j) acc -= t[4 * gq + e] * lv[e]; }
        t[j] = acc;
    }
    bf16x8 t1f[2], t2f[2];
#pragma unroll
    for (int sp = 0; sp < 2; ++sp) { float x1[8], x2[8];
#pragma unroll
        for (int e = 0; e < 8; ++e) { const int j0 = 16 * sp + e, j1 = j0 + 8; const float tv = h ? t[j1] : t[j0], bj = h ? bev[j1] : bev[j0], gj = h ? gcv[j1] : gcv[j0]; x1[e] = tv * bj; x2[e] = x1[e] * __expf(gj); }
        t1f[sp] = __builtin_bit_cast(bf16x8, pack8(x1)); t2f[sp] = __builtin_bit_cast(bf16x8, pack8(x2)); }
    { bf16x8* QFo = (bf16x8*)(F.ws + WS_QF) + (size_t)ch * 512; const bf16* qrow = QN + (size_t)(row0 + r) * 1024 + hd * 128 + 4 * h;
#pragma unroll
      for (int tl = 0; tl < 4; ++tl)
#pragma unroll
          for (int sp = 0; sp < 2; ++sp) { const v2u qlo = *(const v2u*)(qrow + 32 * tl + 16 * sp), qhi = *(const v2u*)(qrow + 32 * tl + 16 * sp + 8); v4u qu; qu.x = qlo.x; qu.y = qlo.y; qu.z = qhi.x; qu.w = qhi.y; QFo[(tl * 2 + sp) * 64 + lane] = __builtin_bit_cast(bf16x8, qu); } }
    const float g_last = gcv[31];
    bf16x8* WF = (bf16x8*)(F.ws + WS_WF) + (size_t)ch * 512; bf16x8* KF = (bf16x8*)(F.ws + WS_KF) + (size_t)ch * 512;
#pragma unroll
    for (int tl = 0; tl < 4; ++tl) {
        f32x16 acc;
#pragma unroll
        for (int i = 0; i < 16; ++i) acc[i] = 0.f;
        const LAS unsigned char* col = TL + (32 * tl + r) * 2;
#pragma unroll
        for (int sp = 0; sp < 2; ++sp) { unsigned w[4];
#pragma unroll
            for (int e = 0; e < 4; ++e) { const unsigned lo = *(const LAS unsigned short*)(col + (16 * sp + 8 * h + 2 * e) * GA_PITCH), hi = *(const LAS unsigned short*)(col + (16 * sp + 8 * h + 2 * e + 1) * GA_PITCH); w[e] = lo | (hi << 16); }
            v4u wu; wu.x = w[0]; wu.y = w[1]; wu.z = w[2]; wu.w = w[3];
            acc = __builtin_amdgcn_mfma_f32_32x32x16_bf16(__builtin_bit_cast(bf16x8, wu), t2f[sp], acc, 0, 0, 0); }
#pragma unroll
        for (int i = 0; i < 16; ++i) acc[i] = -acc[i];
#pragma unroll
        for (int sp = 0; sp < 2; ++sp) { WF[(tl * 2 + sp) * 64 + lane] = pack_acc(acc, sp);
            float x[8];
#pragma unroll
            for (int e = 0; e < 8; ++e) { const int j0 = 16 * sp + 8 * (e >> 2) + (e & 3), j1 = j0 + 4; const float gj = h ? gcv[j1] : gcv[j0];
                const unsigned kv = *(const LAS unsigned short*)(col + (j0 + 4 * h) * GA_PITCH); x[e] = __builtin_bit_cast(float, kv << 16) * __expf(g_last - gj); }
            KF[(tl * 2 + sp) * 64 + lane] = __builtin_bit_cast(bf16x8, pack8(x)); }
    }
    asm volatile("s_waitcnt lgkmcnt(0)" ::: "memory");
#pragma unroll
    for (int i = 0; i < 8; ++i) { const int p = lane + 64 * i, rw = p >> 4, c16 = p & 15; *(LAS v4u*)(TL + rw * GA_PITCH + 16 * c16) = *(const v4u*)(VV + (size_t)(row0 + rw) * 1024 + hd * 128 + 8 * c16); }
    asm volatile("s_waitcnt lgkmcnt(0)" ::: "memory");
    f32x4* UF = (f32x4*)(F.ws + WS_UF) + (size_t)ch * 1024;
#pragma unroll
    for (int tl = 0; tl < 4; ++tl) {
        f32x16 acc;
#pragma unroll
        for (int i = 0; i < 16; ++i) acc[i] = 0.f;
        const LAS unsigned char* col = TL + (32 * tl + r) * 2;
#pragma unroll
        for (int sp = 0; sp < 2; ++sp) { unsigned w[4];
#pragma unroll
            for (int e = 0; e < 4; ++e) { const unsigned lo = *(const LAS unsigned short*)(col + (16 * sp + 8 * h + 2 * e) * GA_PITCH), hi = *(const LAS unsigned short*)(col + (16 * sp + 8 * h + 2 * e + 1) * GA_PITCH); w[e] = lo | (hi << 16); }
            v4u wu; wu.x = w[0]; wu.y = w[1]; wu.z = w[2]; wu.w = w[3];
            acc = __builtin_amdgcn_mfma_f32_32x32x16_bf16(t1f[sp], __builtin_bit_cast(bf16x8, wu), acc, 0, 0, 0); }
#pragma unroll
        for (int g4 = 0; g4 < 4; ++g4) UF[(tl * 4 + g4) * 64 + lane] = (f32x4){acc[4 * g4], acc[4 * g4 + 1], acc[4 * g4 + 2], acc[4 * g4 + 3]};
    }
    if (h == 0) ((float*)(F.ws + WS_TB))[(size_t)ch * 32 + r] = __expf(gc_own);
    asm volatile("s_waitcnt lgkmcnt(0)" ::: "memory");
}

constexpr int GSC_ITEMS = BATCH * HA * 4;
constexpr int GSB_WF = 0, GSB_KF = 8192, GSB_QF = 16384, GSB_UF = 24576, GSB_AF = 28672, GSB_TB = 30720, GSB_AL = 34816, GSB_STRIDE = 36864;
__device__ __forceinline__ void gdn_chunk_scan(Frame& F0, int l, int item) {
    RELANE(F0);
    const int lane = F.lane, r = lane & 31, h = lane >> 5;
    const int sl = item & 3, bh = item >> 2, hd = bh & 7, b = bh >> 3;
    float* ORAW = (float*)(F.ws + WS_ORAW);
    LAS unsigned char* buf = F.lds;
#define GS_DMA(src, off) __builtin_amdgcn_global_load_lds((const unsigned*)(src), (LAS unsigned*)(bp + (off)), 16, 0, 0)
#define GS_FETCH(cc, bsel) do { const size_t ch_ = (size_t)bh * 64 + (cc); LAS unsigned char* bp = buf + (bsel) * GSB_STRIDE; \
        const bf16x8* wf_ = (const bf16x8*)(F.ws + WS_WF) + ch_ * 512 + lane; const bf16x8* kf_ = (const bf16x8*)(F.ws + WS_KF) + ch_ * 512 + lane; const bf16x8* qf_ = (const bf16x8*)(F.ws + WS_QF) + ch_ * 512 + lane; \
        const f32x4* uf_ = (const f32x4*)(F.ws + WS_UF) + ch_ * 1024 + (size_t)sl * 256 + lane; const bf16x8* af_ = (const bf16x8*)(F.ws + WS_AF) + ch_ * 128 + lane; const float* tb_ = (const float*)(F.ws + WS_TB) + ch_ * 32; \
        _Pragma("unroll") for (int i_ = 0; i_ < 8; ++i_) { GS_DMA(wf_ + i_ * 64, GSB_WF + i_ * 1024); GS_DMA(qf_ + i_ * 64, GSB_QF + i_ * 1024); } \
        _Pragma("unroll") for (int i_ = 0; i_ < 4; ++i_) { GS_DMA(uf_ + i_ * 64, GSB_UF + i_ * 1024); GS_DMA(tb_ + 8 * i_ + 4 * h, GSB_TB + i_ * 1024); } \
        GS_DMA(af_, GSB_AF); GS_DMA(af_ + 64, GSB_AF + 1024); GS_DMA(tb_ + 28, GSB_AL); \
        _Pragma("unroll") for (int i_ = 0; i_ < 8; ++i_) GS_DMA(kf_ + i_ * 64, GSB_KF + i_ * 1024); } while (0)
    f32x16 S[4];
#pragma unroll
    for (int tl = 0; tl < 4; ++tl)
#pragma unroll
        for (int i = 0; i < 16; ++i) S[tl][i] = 0.f;
    GS_FETCH(0, 0);
#pragma unroll 1
    for (int c = 0; c < SEQ / 32; ++c) {
        const int row0 = b * SEQ + 32 * c;
        asm volatile("s_waitcnt vmcnt(0)" ::: "memory");
        if (c + 1 < SEQ / 32) GS_FETCH(c + 1, (c + 1) & 1);
        const LAS unsigned char* bp = buf + (c & 1) * GSB_STRIDE + lane * 16;
        f32x16 P, O1;
#pragma unroll
        for (int g4 = 0; g4 < 4; ++g4) { const f32x4 u = *(const LAS f32x4*)(bp + GSB_UF + g4 * 1024); P[4 * g4] = u.x; P[4 * g4 + 1] = u.y; P[4 * g4 + 2] = u.z; P[4 * g4 + 3] = u.w; }
#pragma unroll
        for (int i = 0; i < 16; ++i) O1[i] = 0.f;
#pragma unroll
        for (int tl = 0; tl < 4; ++tl)
#pragma unroll
            for (int sp = 0; sp < 2; ++sp) {
                const bf16x8 sf = pack_acc(S[tl], sp);
                P = __builtin_amdgcn_mfma_f32_32x32x16_bf16(*(const LAS bf16x8*)(bp + GSB_WF + (tl * 2 + sp) * 1024), sf, P, 0, 0, 0);
                O1 = __builtin_amdgcn_mfma_f32_32x32x16_bf16(*(const LAS bf16x8*)(bp + GSB_QF + (tl * 2 + sp) * 1024), sf, O1, 0, 0, 0);
            }
#pragma unroll
        for (int g4 = 0; g4 < 4; ++g4) { const f32x4 eg = *(const LAS f32x4*)(bp + GSB_TB + g4 * 1024); O1[4 * g4] *= eg.x; O1[4 * g4 + 1] *= eg.y; O1[4 * g4 + 2] *= eg.z; O1[4 * g4 + 3] *= eg.w; }
        const bf16x8 vf0 = pack_acc(P, 0), vf1 = pack_acc(P, 1);
        O1 = __builtin_amdgcn_mfma_f32_32x32x16_bf16(*(const LAS bf16x8*)(bp + GSB_AF), vf0, O1, 0, 0, 0);
        O1 = __builtin_amdgcn_mfma_f32_32x32x16_bf16(*(const LAS bf16x8*)(bp + GSB_AF + 1024), vf1, O1, 0, 0, 0);
        const float a_last = (*(const LAS f32x4*)(bp + GSB_AL)).w;
#pragma unroll
        for (int tl = 0; tl < 4; ++tl) {
#pragma unroll
            for (int i = 0; i < 16; ++i) S[tl][i] *= a_last;
            S[tl] = __builtin_amdgcn_mfma_f32_32x32x16_bf16(*(const LAS bf16x8*)(bp + GSB_KF + (tl * 2) * 1024), vf0, S[tl], 0, 0, 0);
            S[tl] = __builtin_amdgcn_mfma_f32_32x32x16_bf16(*(const LAS bf16x8*)(bp + GSB_KF + (tl * 2 + 1) * 1024), vf1, S[tl], 0, 0, 0);
        }
        float* op = ORAW + (size_t)(row0 + 4 * h) * 1024 + hd * 128 + 32 * sl + r;
#pragma unroll
        for (int i = 0; i < 16; ++i) op[(size_t)((i & 3) + 8 * (i >> 2)) * 1024] = O1[i];
    }
#undef GS_DMA
#undef GS_FETCH
    float* Sout = F.out + O_PGDN + (size_t)((l * BATCH + b) * HA + hd) * 16384 + 32 * sl + r;
#pragma unroll
    for (int tl = 0; tl < 4; ++tl)
#pragma unroll
        for (int i = 0; i < 16; ++i) Sout[(size_t)(32 * tl + (i & 3) + 8 * (i >> 2) + 4 * h) * 128] = S[tl][i];
}

constexpr int VT_PITCH = 144, VT_WAVE_LDS = 64 * VT_PITCH, VT_ITEMS = BATCH * 3 * 4 * 2 * 32;
__device__ __forceinline__ void vt_item(Frame& F0, int item) {
    RELANE(F0);
    const int lane = F.lane; LAS unsigned char* T = F.lds + F.wave * VT_WAVE_LDS;
    const int ch = item & 31, dh = (item >> 5) & 1, hh = (item >> 6) & 3, bg = item >> 8, g = bg % 3, b = bg / 3;
    const int dil = 1 << (2 * g), Lc = SEQ >> (2 * g), pos0 = ch * 64, rho = pos0 / Lc, i0 = pos0 % Lc;
    const bf16* PROJ = (const bf16*)(F.ws + WS_PROJ); bf16* VT = (bf16*)(F.ws + WS_VT);
    const bf16* src = PROJ + ((size_t)b * SEQ + (size_t)(i0 + lane) * dil + rho) * NIN + PC_VB + g * 512 + hh * 128 + 64 * dh;
    v4u x[8];
#pragma unroll
    for (int c = 0; c < 8; ++c) x[c] = *(const v4u*)(src + 8 * c);
#pragma unroll
    for (int c = 0; c < 8; ++c) { const unsigned w[4] = {x[c].x, x[c].y, x[c].z, x[c].w};
#pragma unroll
        for (int e = 0; e < 4; ++e) { *(LAS unsigned short*)(T + (8 * c + 2 * e) * VT_PITCH + 2 * lane) = (unsigned short)(w[e] & 0xffffu); *(LAS unsigned short*)(T + (8 * c + 2 * e + 1) * VT_PITCH + 2 * lane) = (unsigned short)(w[e] >> 16); } }
    asm volatile("s_waitcnt lgkmcnt(0)" ::: "memory");
    bf16* dst = VT + ((size_t)((b * 3 + g) * 4 + hh) * 128 + 64 * dh) * 2048 + pos0;
#pragma unroll
    for (int it = 0; it < 8; ++it) { const int p = lane + 64 * it, row = p >> 3, cc = p & 7; const v4u v = *(const LAS v4u*)(T + row * VT_PITCH + 16 * cc); *(v4u*)(dst + (size_t)row * 2048 + 8 * cc) = v; }
    asm volatile("s_waitcnt lgkmcnt(0)" ::: "memory");
}

constexpr int ATT_UNITS = BATCH * 4 * 192;
__device__ __forceinline__ void attn_unit(Frame& F0, int unit) {
    RELANE(F0);
    const int lane = F.lane, r = lane & 31, h = lane >> 5;
    const int bh = unit / 192, b = bh >> 2, hh = bh & 3, u = unit % 192, g = u >> 6, v = u & 63;
    const int dil = 1 << (2 * g), ntpc = 64 >> (2 * g), rho = v / ntpc, i0 = (v % ntpc) * 32, Lc = SEQ >> (2 * g);
    const bf16* PROJ = (const bf16*)(F.ws + WS_PROJ);
    const bf16* cbase = PROJ + ((size_t)b * SEQ + rho) * NIN + g * 512 + hh * 128 + 8 * h;
    const bf16* qp = cbase + (size_t)(i0 + r) * dil * NIN + PC_QB;
    bf16x8 qf[8];
#pragma unroll
    for (int ks = 0; ks < 8; ++ks) qf[ks] = *(const bf16x8*)(qp + 16 * ks);
    f32x16 st[5]; float mx = -1e30f;
#pragma unroll
    for (int kt = 0; kt < 5; ++kt) {
        const int k0 = i0 - 128 + 32 * kt; const bool tv = k0 >= 0;
        const bf16* kp = cbase + (size_t)((tv ? k0 : 0) + r) * dil * NIN + PC_KB;
        f32x16 acc;
#pragma unroll
        for (int i = 0; i < 16; ++i) acc[i] = 0.f;
#pragma unroll
        for (int ks = 0; ks < 8; ++ks) acc = __builtin_amdgcn_mfma_f32_32x32x16_bf16(*(const bf16x8*)(kp + 16 * ks), qf[ks], acc, 0, 0, 0);
#pragma unroll
        for (int i = 0; i < 16; ++i) { const int row = (i & 3) + 8 * (i >> 2) + 4 * h; float sv = tv ? acc[i] : -1e30f;
            if (kt == 0 && row < r) sv = -1e30f;
            if (kt == 4 && row > r) sv = -1e30f;
            st[kt][i] = sv; mx = fmaxf(mx, sv); }
    }
    mx = fmaxf(mx, __shfl_xor(mx, 32));
    const float c = 0.08838834764831845f * 1.4426950408889634f, mc = mx * c; float ls = 0.f;
#pragma unroll
    for (int kt = 0; kt < 5; ++kt)
#pragma unroll
        for (int i = 0; i < 16; ++i) { const float p = __builtin_amdgcn_exp2f(st[kt][i] * c - mc); st[kt][i] = p; ls += p; }
    ls += __shfl_xor(ls, 32);
    f32x16 ot[4];
#pragma unroll
    for (int dt = 0; dt < 4; ++dt)
#pragma unroll
        for (int i = 0; i < 16; ++i) ot[dt][i] = 0.f;
    const bf16* vt = (const bf16*)(F.ws + WS_VT) + ((size_t)((b * 3 + g) * 4 + hh) * 128 + r) * 2048 + rho * Lc + 4 * h;
#pragma unroll
    for (int kt = 0; kt < 5; ++kt) {
        const int k0 = i0 - 128 + 32 * kt, kc = k0 >= 0 ? k0 : 0;
#pragma unroll
        for (int sp = 0; sp < 2; ++sp) {
            v4u pu; pu.x = pk2(st[kt][8 * sp + 0], st[kt][8 * sp + 1]); pu.y = pk2(st[kt][8 * sp + 2], st[kt][8 * sp + 3]); pu.z = pk2(st[kt][8 * sp + 4], st[kt][8 * sp + 5]); pu.w = pk2(st[kt][8 * sp + 6], st[kt][8 * sp + 7]);
            const bf16x8 pf = __builtin_bit_cast(bf16x8, pu);
#pragma unroll
            for (int dt = 0; dt < 4; ++dt) {
                const bf16* vp = vt + (size_t)(32 * dt) * 2048 + kc + 16 * sp;
                const v2u lo = *(const v2u*)vp, hi = *(const v2u*)(vp + 8);
                v4u vu; vu.x = lo.x; vu.y = lo.y; vu.z = hi.x; vu.w = hi.y;
                ot[dt] = __builtin_amdgcn_mfma_f32_32x32x16_bf16(__builtin_bit_cast(bf16x8, vu), pf, ot[dt], 0, 0, 0);
            }
        }
    }
    const float inv = 1.f / ls; const size_t tok = (size_t)b * SEQ + (size_t)(i0 + r) * dil + rho;
    bf16* op = (bf16*)(F.ws + WS_OBG) + ((size_t)g * MV + tok) * 512 + hh * 128 + 4 * h;
#pragma unroll
    for (int dt = 0; dt < 4; ++dt)
#pragma unroll
        for (int g4 = 0; g4 < 4; ++g4) { v2u w; w.x = pk2(ot[dt][4 * g4] * inv, ot[dt][4 * g4 + 1] * inv); w.y = pk2(ot[dt][4 * g4 + 2] * inv, ot[dt][4 * g4 + 3] * inv); *(v2u*)(op + 32 * dt + 8 * g4) = w; }
    if (h == 0) *(f32x2*)((float*)(F.ws + WS_AST) + (((size_t)g * MV + tok) * 4 + hh) * 2) = (f32x2){mc, ls};
}


__device__ __forceinline__ void attn_sample_item(Frame& F0, int l, int item) {
    RELANE(F0);
    const int lane = F.lane, l16 = lane & 15;
    const int half = item & 1, it2 = item >> 1, g = it2 % 3, bt = it2 / 3, t = bt & 3, b = bt >> 2, dil = 1 << (2 * g), win = 128 * dil, jlo = half ? 65 : 0, part = g + 3 * half;
    const bf16* PROJ = (const bf16*)(F.ws + WS_PROJ);
    const int row = MP + DS * b + t;
    const float* cache = F.in[2 + g] + (size_t)(l * DB + b) * win * 1024 + 8 * lane;
    const bf16* newk = PROJ + (size_t)(MP + DS * b) * NIN + PC_KB + g * 512 + 8 * lane;
    float q[8]; unpack8(*(const v4u*)(PROJ + (size_t)row * NIN + PC_QB + g * 512 + 8 * lane), q);
    const int n_new = (g == 0) ? t + 1 : 1;
    const float c = 0.08838834764831845f * 1.4426950408889634f;
    float sc[5];
#pragma unroll
    for (int jr = 0; jr < 5; ++jr) {
        sc[jr] = -1e30f;
        const int jn = jr < 4 ? 16 : 1;
#pragma unroll 8
        for (int jl = 0; jl < jn; ++jl) {
            const int j = jlo + 16 * jr + jl, jc = j <= 128 ? j : 128; int idx = win + t - jc * dil; idx = idx < win ? idx : win - 1;
            const float* kp = cache + (size_t)idx * 1024; const f32x4 a = *(const f32x4*)kp, bq = *(const f32x4*)(kp + 4);
            float sv = (q[0] * a.x + q[1] * a.y) + (q[2] * a.z + q[3] * a.w) + (q[4] * bq.x + q[5] * bq.y) + (q[6] * bq.z + q[7] * bq.w);
            sv = j <= 128 ? row16_sum(sv) * c : -1e30f;
            sc[jr] = (l16 == jl) ? sv : sc[jr];
        }
    }
#pragma unroll
    for (int jj = 0; jj < 4; ++jj) {
        const int tk = t - jj >= 0 ? t - jj : 0; float k[8]; unpack8(*(const v4u*)(newk + (size_t)tk * NIN), k);
        float sv = (q[0] * k[0] + q[1] * k[1]) + (q[2] * k[2] + q[3] * k[3]) + (q[4] * k[4] + q[5] * k[5]) + (q[6] * k[6] + q[7] * k[7]);
        sv = row16_sum(sv) * c;
        sc[0] = (half == 0 && jj < n_new && l16 == jj) ? sv : sc[0];
    }
    float mx = -1e30f;
#pragma unroll
    for (int jr = 0; jr < 5; ++jr) mx = fmaxf(mx, sc[jr]);
    mx = fmaxf(mx, dpp_f<0xB1>(mx)); mx = fmaxf(mx, dpp_f<0x4E>(mx)); mx = fmaxf(mx, dpp_f<0x124>(mx)); mx = fmaxf(mx, dpp_f<0x128>(mx));
    float ls = 0.f;
#pragma unroll
    for (int jr = 0; jr < 5; ++jr) { sc[jr] = __builtin_amdgcn_exp2f(sc[jr] - mx); ls += sc[jr]; }
    ls = row16_sum(ls);
    float o[8];
#pragma unroll
    for (int e = 0; e < 8; ++e) o[e] = 0.f;
#pragma unroll
    for (int jj = 0; jj < 4; ++jj) {
        const int tk = t - jj >= 0 ? t - jj : 0; float vv[8]; unpack8(*(const v4u*)(newk + (size_t)tk * NIN + (PC_VB - PC_KB)), vv);
        const bool isnew = half == 0 && jj < n_new;
        const float p = isnew ? __shfl(sc[0], (lane & 48) | jj) : 0.f;
#pragma unroll
        for (int e = 0; e < 8; ++e) o[e] += p * vv[e];
        sc[0] = (isnew && l16 == jj) ? 0.f : sc[0];
    }
#pragma unroll
    for (int jr = 0; jr < 5; ++jr) {
        const int jn = jr < 4 ? 16 : 1;
#pragma unroll 8
        for (int jl = 0; jl < jn; ++jl) {
            const int j = jlo + 16 * jr + jl, jc = j <= 128 ? j : 128; int idx = win + t - jc * dil; idx = idx < win ? idx : win - 1;
            const float p = __shfl(sc[jr], (lane & 48) | jl);
            const float* vp = cache + (size_t)idx * 1024 + 512; const f32x4 a = *(const f32x4*)vp, bq = *(const f32x4*)(vp + 4);
            o[0] += p * a.x; o[1] += p * a.y; o[2] += p * a.z; o[3] += p * a.w; o[4] += p * bq.x; o[5] += p * bq.y; o[6] += p * bq.z; o[7] += p * bq.w;
        }
    }
    const float inv = 1.f / ls;
#pragma unroll
    for (int e = 0; e < 8; ++e) o[e] *= inv;
    *(v4u*)((bf16*)(F.ws + WS_OBG) + ((size_t)part * MV + row) * 512 + 8 * lane) = pack8(o);
    if (l16 == 0) *(f32x2*)((float*)(F.ws + WS_AST) + (((size_t)part * MV + row) * 4 + (lane >> 4)) * 2) = (f32x2){mx, ls};
}

__device__ __forceinline__ void gdn_gate_rows(Frame& F0, int l) {
    RELANE(F0);
    const int lane = F.lane, gw = F.vcu * NWAVES + F.wave, NGW = F.G * NWAVES;
    const float* ORAW = (const float*)(F.ws + WS_ORAW); const bf16* PROJ = (const bf16*)(F.ws + WS_PROJ); bf16* OUTA = (bf16*)(F.ws + WS_OUTA);
    const float* gain = F.in[12] + (size_t)l * 128;
    for (int r = gw; r < MV; r += NGW) {
#pragma unroll
        for (int j = 0; j < 4; ++j) {
            const int c0 = 256 * j + 4 * lane; const f32x4 o = *(const f32x4*)(ORAW + (size_t)r * 1024 + c0);
            float ss = (o.x * o.x + o.y * o.y) + (o.z * o.z + o.w * o.w);
            ss += __shfl_xor(ss, 1); ss += __shfl_xor(ss, 2); ss += __shfl_xor(ss, 4); ss += __shfl_xor(ss, 8); ss += __shfl_xor(ss, 16);
            const float rstd = rsqrtf(ss * (1.f / 128.f) + EPS);
            const f32x4 g = *(const f32x4*)(gain + (c0 & 127)); const v2u zu = *(const v2u*)(PROJ + (size_t)r * NIN + PC_ZA + c0);
            const float z0 = bf_lo(zu.x), z1 = bf_hi(zu.x), z2 = bf_lo(zu.y), z3 = bf_hi(zu.y);
            v2u w; w.x = pk2(o.x * rstd * g.x * silu(z0), o.y * rstd * g.y * silu(z1)); w.y = pk2(o.z * rstd * g.z * silu(z2), o.w * rstd * g.w * silu(z3));
            *(v2u*)(OUTA + (size_t)r * 1024 + c0) = w;
        }
        {
            const int c0 = 8 * lane, hh = lane >> 4; const float* ast = (const float*)(F.ws + WS_AST); const bf16* obg = (const bf16*)(F.ws + WS_OBG);
            const int np = r < MP ? 3 : 6;
            f32x2 sg[6]; v4u xo[6]; float M = -1e30f;
#pragma unroll
            for (int g = 0; g < 6; ++g) { const int gg = g < np ? g : 0; sg[g] = *(const f32x2*)(ast + (((size_t)gg * MV + r) * 4 + hh) * 2); xo[g] = *(const v4u*)(obg + ((size_t)gg * MV + r) * 512 + c0); }
#pragma unroll
            for (int g = 0; g < 6; ++g) { if (g >= np) sg[g] = (f32x2){-1e30f, 0.f}; M = fmaxf(M, sg[g].x); }
            float wg[6], den = 0.f;
#pragma unroll
            for (int g = 0; g < 6; ++g) { wg[g] = __builtin_amdgcn_exp2f(sg[g].x - M) * sg[g].y; den += wg[g]; }
            const float inv = 1.f / den; float o[8];
#pragma unroll
            for (int e = 0; e < 8; ++e) o[e] = 0.f;
#pragma unroll
            for (int g = 0; g < 6; ++g) { float x[8]; unpack8(xo[g], x); const float w = wg[g] * inv;
#pragma unroll
                for (int e = 0; e < 8; ++e) o[e] += w * x[e]; }
            *(v4u*)((bf16*)(F.ws + WS_OUTB) + (size_t)r * 512 + c0) = pack8(o);
        }
    }
}


constexpr int CP_PER_B = 31 + 127 + 511, CP_NSUB = DB * CP_PER_B;
constexpr int CP_TAIL_WG = 84, CP_TAIL_PER_WG = 64, CP_TAIL = CP_TAIL_WG * CP_TAIL_PER_WG;
__device__ __forceinline__ void copy_subchunk(Frame& F, int l, int c) {
    const int lane = F.lane, b = c / CP_PER_B, rc = c % CP_PER_B; const int gi = rc < 31 ? 0 : rc < 158 ? 1 : 2, k = rc - (gi == 0 ? 0 : gi == 1 ? 31 : 158), win = 128 << (2 * gi);
    const f32x4* src = (const f32x4*)(F.in[2 + gi] + ((size_t)(l * DB + b) * win + DS + 4 * k) * 1024) + lane;
    f32x4* dst = (f32x4*)(F.out + (gi == 0 ? O_SW1 : gi == 1 ? O_SW2 : O_SW3) + ((size_t)(l * DB + b) * win + 4 * k) * 1024) + lane;
    f32x4 v[16];
#pragma unroll
    for (int i = 0; i < 16; ++i) v[i] = __builtin_nontemporal_load(src + 64 * i);
#pragma unroll
    for (int i = 0; i < 16; ++i) __builtin_nontemporal_store(v[i], dst + 64 * i);
}
__device__ __forceinline__ void side_queue(Frame& F0, int l, volatile LAS unsigned* qctr) {
    RELANE(F0);
    const int lane = F.lane;
    const int nsub = CP_NSUB - (F.G == 256 ? CP_TAIL : 0);
    const int ncp = (nsub - (int)blockIdx.x + F.G - 1) / F.G;
    const int wper = 0,     w0 = (int)blockIdx.x * wper, nw = max(0, min(IT_LAYER, w0 + wper) - w0);
    LAS float* scr = (LAS float*)F.lds;
    for (;;) {
        unsigned q = 0; if (lane == 0) q = __hip_atomic_fetch_add((LAS unsigned*)qctr, 1u, __ATOMIC_RELAXED, __HIP_MEMORY_SCOPE_WORKGROUP);
        q = (unsigned)__builtin_amdgcn_readfirstlane((int)q);
        if ((int)q >= ncp + nw) break;
        if ((int)q < ncp) { copy_subchunk(F, l, (int)q * F.G + (int)blockIdx.x);
        } else weight_item(F, l + 1, w0 + (int)q - ncp, scr);
    }
}


__device__ __forceinline__ f32x16 skinny_kloop(const bf16* ap, const bf16* bp, int nks, f32x16 acc) {
    int ks = 0;
    for (; ks + 8 <= nks; ks += 8) { bf16x8 a[8], b[8];
#pragma unroll
        for (int u = 0; u < 8; ++u) { a[u] = *(const bf16x8*)(ap + 16 * (ks + u)); b[u] = *(const bf16x8*)(bp + 16 * (ks + u)); }
#pragma unroll
        for (int u = 0; u < 8; ++u) acc = __builtin_amdgcn_mfma_f32_32x32x16_bf16(a[u], b[u], acc, 0, 0, 0); }
    for (; ks < nks; ks += 4) { bf16x8 a[4], b[4];
#pragma unroll
        for (int u = 0; u < 4; ++u) { a[u] = *(const bf16x8*)(ap + 16 * (ks + u)); b[u] = *(const bf16x8*)(bp + 16 * (ks + u)); }
#pragma unroll
        for (int u = 0; u < 4; ++u) acc = __builtin_amdgcn_mfma_f32_32x32x16_bf16(a[u], b[u], acc, 0, 0, 0); }
    return acc;
}
__device__ __forceinline__ f32x2 skinny_reduce(Frame& F, const f32x16& acc) {
    LAS float* P = (LAS float*)F.lds; const int r = F.lane & 31, h = F.lane >> 5;
    __syncthreads();
#pragma unroll
    for (int i = 0; i < 16; ++i) P[(F.wave * 32 + (i & 3) + 8 * (i >> 2) + 4 * h) * 33 + r] = acc[i];
    __syncthreads();
    const int row = F.tid >> 4, col = 2 * (F.tid & 15); f32x2 o = {0.f, 0.f};
#pragma unroll
    for (int w = 0; w < 8; ++w) { o.x += P[(w * 32 + row) * 33 + col]; o.y += P[(w * 32 + row) * 33 + col + 1]; }
    return o;
}
__device__ __forceinline__ void skinny_store(Frame& F0, const bf16* A, int lda, const bf16* Bt, int K, bf16* O) {
    RELANE(F0);
    const int r = F.lane & 31, h = F.lane >> 5, kw = K / 8;
    for (int unit = blockIdx.x; unit < 256; unit += F.G) {
        const int mt = unit >> 6, nt = unit & 63;
        f32x16 acc;
#pragma unroll
        for (int i = 0; i < 16; ++i) acc[i] = 0.f;
        acc = skinny_kloop(A + (size_t)(MP + 32 * mt + r) * lda + F.wave * kw + 8 * h, Bt + (size_t)(32 * nt + r) * K + F.wave * kw + 8 * h, kw / 16, acc);
        const f32x2 o = skinny_reduce(F, acc);
        *(unsigned*)(O + (size_t)(MP + 32 * mt + (F.tid >> 4)) * D + 32 * nt + 2 * (F.tid & 15)) = pk2(o.x, o.y);
    }
}
__device__ __forceinline__ void skinny_merge(Frame& F0, const unsigned char* wl) {
    RELANE(F0);
    const int r = F.lane & 31, h = F.lane >> 5; const bf16* PROJ = (const bf16*)(F.ws + WS_PROJ);
    for (int unit = blockIdx.x; unit < 256; unit += F.G) {
        const int mt = unit >> 6, nt = unit & 63;
        f32x16 tot;
#pragma unroll
        for (int i = 0; i < 16; ++i) tot[i] = 0.f;
#pragma unroll
        for (int br = 0; br < 3; ++br) {
            const int K = br == 1 ? 512 : 1024, kw = K / 8;
            const bf16* A = (const bf16*)(F.ws + (br == 0 ? WS_OUTA : br == 1 ? WS_OUTB : WS_OC)); const bf16* Bt = (const bf16*)(wl + (br == 0 ? WO_BRA : br == 1 ? WO_BRB : WO_BRC));
            f32x16 acc;
#pragma unroll
            for (int i = 0; i < 16; ++i) acc[i] = 0.f;
            acc = skinny_kloop(A + (size_t)(MP + 32 * mt + r) * K + F.wave * kw + 8 * h, Bt + (size_t)(32 * nt + r) * K + F.wave * kw + 8 * h, kw / 16, acc);
            const bf16* gp = PROJ + (size_t)(MP + 32 * mt + 4 * h) * NIN + PC_GATE + br * 2048 + 32 * nt + r;
#pragma unroll
            for (int i = 0; i < 16; ++i) tot[i] += acc[i] * bf1(gp[(size_t)((i & 3) + 8 * (i >> 2)) * NIN]);
        }
        const f32x2 o = skinny_reduce(F, tot);
        *(unsigned*)((bf16*)(F.ws + WS_MERGED) + (size_t)(MP + 32 * mt + (F.tid >> 4)) * D + 32 * nt + 2 * (F.tid & 15)) = pk2(o.x, o.y);
    }
}

constexpr int N_PHASES = 1 + 11 * DEPTH;
__global__ void __launch_bounds__(NWAVES * 64, 2) fwd(Args args) {
    extern __shared__ __attribute__((aligned(16))) unsigned char lds_raw[];
    Frame F;
    F.lds = (LAS unsigned char*)lds_raw;
    F.tid = threadIdx.x; F.lane = F.tid & 63; F.wave = __builtin_amdgcn_readfirstlane(F.tid >> 6);
    F.G = gridDim.x; { const int bx = blockIdx.x; F.vcu = (F.G % 8 == 0) ? (bx % 8) * (F.G / 8) + bx / 8 : bx; }
    const CAS Args* const ap = (const CAS Args*)__builtin_amdgcn_kernarg_segment_ptr();
    F.in = ap->in; F.out = args.out; F.ws = args.ws;
    volatile LAS unsigned* MISC = (volatile LAS unsigned*)(F.lds + MISC_OFF);
    for (int u = F.tid; u < (LDS_BYTES - LDSCTL_OFF) / 4; u += NWAVES * 64) ((LAS unsigned*)(F.lds + LDSCTL_OFF))[u] = 0u;
    __syncthreads();
#if MK_ONE_LAUNCH
    XcdBarrier bar = xcd_barrier_post((unsigned*)(F.ws + WS_CTL) + CW_BAR, MISC + 8);
#define GRID_BAR() xcd_barrier(bar)
#else
#define GRID_BAR() do {} while (0)
#endif
    const int lo = args.ph_lo, hi = args.ph_hi;
#ifndef PHMASK
#define PHMASK 0xfff
#endif
#define IN(k) (lo <= (k) && (k) < hi)
#define EN(j) ((PHMASK >> (j)) & 1)
#ifndef REPMASK
#define REPMASK 0
#endif
#ifndef SUBREP
#define SUBREP 0
#endif
#define SUBR(j) for (int sr_ = 0; sr_ < 1 + ((SUBREP >> (j)) & 1); ++sr_)
#define REPEAT(j) for (int rep_ = 0; rep_ < 1 + ((REPMASK >> (j)) & 1); ++rep_)
#define REPBAR() do { if (rep_) GRID_BAR(); F.ws = launder_p(args.ws); F.out = launder_p(args.out); F.in = launder_k(ap->in); } while (0)
#define SEAM(k) do { if (IN(k) && IN((k) + 1)) GRID_BAR(); } while (0)
    const int gw = F.vcu * NWAVES + F.wave, NGW = F.G * NWAVES;
    bf16* const H = (bf16*)(F.ws + WS_H); bf16* const PROJ = (bf16*)(F.ws + WS_PROJ);

    if (EN(0) && IN(0)) REPEAT(0) { REPBAR();
        LAS float* scr = (LAS float*)(F.lds + F.wave * 16384);
        for (int it = gw; it < 2 * IT_LAYER; it += NGW) { const int l = it >= IT_LAYER ? 1 : 0; weight_item(F, l, it - l * IT_LAYER, scr); }
        __syncthreads();
        stage_wba(F, 0);
        thin_rows<true>(F, F.in[0], F.in[1], nullptr, nullptr, nullptr, F.in[21], true, 0);
        __syncthreads();
    }
    SEAM(0);
#pragma unroll 1
    for (int l = 0; l < DEPTH; ++l) {
        const int pb = 1 + 11 * l;
        unsigned char* wl = F.ws + WS_W + (size_t)l * WL_BYTES;
        if (EN(1) && IN(pb + 0)) REPEAT(1) { REPBAR();
            pg8::Gemm g{H, (const bf16*)(wl + WO_IN), D, D, D, 0}; pg8::StaticOrder S; S.init(MT, NIN, F.G, (int)blockIdx.x);
            EpiStore E{PROJ, NIN, PC_GATE / 256};
            pg8::gemm_phase<EpiStore, pg8::StaticOrder>(F.lds, g, S, E);
        }
        SEAM(pb + 0);
        if (EN(2) && IN(pb + 1)) REPEAT(2) { REPBAR(); for (int it = gw; it < PREP_ITEMS; it += NGW) prep_item(F, l, it); prep_out_rows(F, l); for (int it = gw; it < VT_ITEMS; it += NGW) vt_item(F, it); }
        SEAM(pb + 1);
        if (EN(3) && IN(pb + 2)) REPEAT(3) { REPBAR(); for (int it = gw; it < GCH; it += NGW) gdn_ga_item(F, it); }
        SEAM(pb + 2);
        if (EN(4) && IN(pb + 3)) REPEAT(4) { REPBAR();
            if (F.tid == 0) MISC[16] = 0u;
            { pg8::Gemm g{(const bf16*)(F.ws + WS_POOLED), (const bf16*)(wl + WO_POOL), 1024, 256, 256, 512}; pg8::StaticOrder S; S.init(MT, 1024, F.G, (int)blockIdx.x);
              EpiStore E{(bf16*)(F.ws + WS_OC), 1024, 1 << 30};
              pg8::gemm_phase<EpiStore, pg8::StaticOrder>(F.lds, g, S, E); }
            SUBR(3) for (int it = gw; it < DB * HA * 32; it += NGW) { const int s = it & 31, bh = it >> 5, b = bh >> 3, h = bh & 7;
                gdn_scan_item(F, MP + DS * b, DS, h, s, F.in[5] + (size_t)((l * DB + b) * HA + h) * 16384, F.out + O_SGDN + (size_t)((l * DB + b) * HA + h) * 16384); }
            {
                const bool scanw = (F.wave == 0) && (F.vcu < GSC_ITEMS);
                if (scanw) { SUBR(0) gdn_chunk_scan(F, l, F.vcu); }
                else {
                    const int aw = F.vcu < GSC_ITEMS ? F.vcu * 7 + F.wave - 1 : GSC_ITEMS * 7 + (F.vcu - GSC_ITEMS) * 8 + F.wave, naw = F.G * 8 - GSC_ITEMS;
                    SUBR(1) for (int it = aw; it < ATT_UNITS; it += naw) attn_unit(F, it);
                    SUBR(2) for (int it = aw; it < MS * 6; it += naw) attn_sample_item(F, l, it);
                }
            }
            side_queue(F, l, MISC + 16);
        }
        SEAM(pb + 3);
        if (EN(5) && IN(pb + 4)) REPEAT(5) { REPBAR(); gdn_gate_rows(F, l); }
        SEAM(pb + 4);
        if (EN(6) && IN(pb + 5)) REPEAT(6) { REPBAR();
            pg8::StaticOrder S; S.init(MP, D, F.G, (int)blockIdx.x); bf16* MG = (bf16*)(F.ws + WS_MERGED);
            { pg8::Gemm g{(const bf16*)(F.ws + WS_OUTA), (const bf16*)(wl + WO_BRA), 1024, 1024, 1024, 0}; EpiMerge<false> E{MG, PROJ + PC_GATE}; pg8::gemm_phase<EpiMerge<false>, pg8::StaticOrder>(F.lds, g, S, E); }
            { pg8::Gemm g{(const bf16*)(F.ws + WS_OUTB), (const bf16*)(wl + WO_BRB), 512, 512, 512, 0}; EpiMerge<true> E{MG, PROJ + PC_GATE + 2048}; pg8::gemm_phase<EpiMerge<true>, pg8::StaticOrder>(F.lds, g, S, E); }
            { pg8::Gemm g{(const bf16*)(F.ws + WS_OC), (const bf16*)(wl + WO_BRC), 1024, 1024, 1024, 0}; EpiMerge<true> E{MG, PROJ + PC_GATE + 4096}; pg8::gemm_phase<EpiMerge<true>, pg8::StaticOrder>(F.lds, g, S, E); }
            skinny_merge(F, wl);
        }
        SEAM(pb + 5);
        if (EN(7) && IN(pb + 6)) REPEAT(7) { REPBAR();
            pg8::Gemm g{(const bf16*)(F.ws + WS_MERGED), (const bf16*)(wl + WO_OUT), D, D, D, 0}; pg8::StaticOrder S; S.init(MP, D, F.G, (int)blockIdx.x);
            EpiStore E{(bf16*)(F.ws + WS_Y), D, 1 << 30};
            pg8::gemm_phase<EpiStore, pg8::StaticOrder>(F.lds, g, S, E);
            skinny_store(F, (const bf16*)(F.ws + WS_MERGED), D, (const bf16*)(wl + WO_OUT), D, (bf16*)(F.ws + WS_Y));
        }
        SEAM(pb + 6);
        if (EN(8) && IN(pb + 7)) REPEAT(8) { REPBAR();
            thin_rows<false>(F, nullptr, nullptr, (const bf16*)(F.ws + WS_Y), F.in[22] + (size_t)l * D, nullptr, F.in[23] + (size_t)l * D, false, 0);
        }
        SEAM(pb + 7);
        if (EN(9) && IN(pb + 8)) REPEAT(9) { REPBAR();
            pg8::Gemm g{H, (const bf16*)(wl + WO_GU), D, D, D, 0}; pg8::StaticOrder S; S.init(MT, 2 * DFF, F.G, (int)blockIdx.x);
            EpiSwiglu E{(bf16*)(F.ws + WS_ACT)};
            pg8::gemm_phase<EpiSwiglu, pg8::StaticOrder>(F.lds, g, S, E);
            if (F.G == 256 && (int)blockIdx.x >= 256 - CP_TAIL_WG) {
                Frame Fc = F; Fc.lane = launder(F.lane);
                const int base = CP_NSUB - CP_TAIL + ((int)blockIdx.x - (256 - CP_TAIL_WG)) * CP_TAIL_PER_WG;
                for (int q = F.wave; q < CP_TAIL_PER_WG; q += NWAVES) copy_subchunk(Fc, 1 - l, base + q);
            }
        }
        SEAM(pb + 8);
        if (EN(10) && IN(pb + 9)) REPEAT(10) { REPBAR();
            pg8::Gemm g{(const bf16*)(F.ws + WS_ACT), (const bf16*)(wl + WO_DOWN), DFF, DFF, DFF, 0}; pg8::StaticOrder S; S.init(MP, D, F.G, (int)blockIdx.x);
            EpiStore E{(bf16*)(F.ws + WS_Y), D, 1 << 30};
            pg8::gemm_phase<EpiStore, pg8::StaticOrder>(F.lds, g, S, E);
            skinny_store(F, (const bf16*)(F.ws + WS_ACT), DFF, (const bf16*)(wl + WO_DOWN), DFF, (bf16*)(F.ws + WS_Y));
        }
        SEAM(pb + 9);
        if (EN(11) && IN(pb + 10)) REPEAT(11) { REPBAR();
            if (l + 1 < DEPTH) { stage_wba(F, l + 1);
                thin_rows<false>(F, nullptr, nullptr, (const bf16*)(F.ws + WS_Y), F.in[24] + (size_t)l * D, nullptr, F.in[21] + (size_t)(l + 1) * D, true, l + 1); __syncthreads(); }
            else thin_rows<false>(F, nullptr, nullptr, (const bf16*)(F.ws + WS_Y), F.in[24] + (size_t)l * D, F.out + O_YP, nullptr, false, 0);
        }
        SEAM(pb + 10);
    }
#undef IN
#undef SEAM
}

extern "C" void kernel_launch(void* const* d_in, const int* in_sizes, int n_in, void* d_out, int out_size, void* d_ws, size_t ws_size, hipStream_t stream) {
    static int grid = 0;
    if (grid == 0) {
        if (n_in != 25 || (size_t)out_size != O_END || ws_size < WS_END) { fprintf(stderr, "kernel_launch: unexpected sizes n_in %d out %d ws %zu\n", n_in, out_size, ws_size); grid = -1; return; }
        int dev = 0, cus = 0, per_cu = 0;
        if (hipGetDevice(&dev) != hipSuccess || hipDeviceGetAttribute(&cus, hipDeviceAttributeMultiprocessorCount, dev) != hipSuccess) { grid = -1; return; }
        if (hipFuncSetAttribute((const void*)fwd, hipFuncAttributeMaxDynamicSharedMemorySize, LDS_BYTES) != hipSuccess) { fprintf(stderr, "kernel_launch: hipFuncSetAttribute failed\n"); grid = -1; return; }
        if (hipOccupancyMaxActiveBlocksPerMultiprocessor(&per_cu, (const void*)fwd, NWAVES * 64, LDS_BYTES) != hipSuccess || per_cu < 1) fprintf(stderr, "kernel_launch: occupancy query says %d\n", per_cu);
        (void)hipGetLastError();
        grid = cus;
    }
    if (grid < 0) return;
    if (hipMemsetAsync((char*)d_ws + WS_CTL, 0, CTL_BYTES, stream) != hipSuccess) return;
    Args a{};
    for (int i = 0; i < 25; ++i) a.in[i] = (const float*)d_in[i];
    a.out = (float*)d_out; a.ws = (unsigned char*)d_ws;
#if MK_ONE_LAUNCH
    a.ph_lo = 0; a.ph_hi = N_PHASES;
    hipLaunchKernelGGL(fwd, dim3(grid), dim3(NWAVES * 64), LDS_BYTES, stream, a);
#else
    for (int p = 0; p < N_PHASES; ++p) { a.ph_lo = p; a.ph_hi = p + 1; hipLaunchKernelGGL(fwd, dim3(grid), dim3(NWAVES * 64), LDS_BYTES, stream, a); }
#endif
}
```

```cpp
#include <hip/hip_runtime.h>
#include <cstdio>
#include <cstdint>

#ifndef MK_ONE_LAUNCH
#define MK_ONE_LAUNCH 1
#endif

#define GAS __attribute__((address_space(1)))
#define CAS __attribute__((address_space(4)))
typedef const float* cfp_t;
#define LAS __attribute__((address_space(3)))
typedef unsigned short bf16;
typedef unsigned v4u __attribute__((ext_vector_type(4)));
typedef unsigned v2u __attribute__((ext_vector_type(2)));
typedef float f32x4 __attribute__((ext_vector_type(4)));
typedef float f32x2 __attribute__((ext_vector_type(2)));
typedef short bf16x8 __attribute__((ext_vector_type(8)));
typedef float f32x16 __attribute__((ext_vector_type(16)));

constexpr int D = 2048, BATCH = 4, SEQ = 2048, DEPTH = 2, DB = 32, DS = 4;
constexpr int MP = BATCH * SEQ;
constexpr int MS = DB * DS;
constexpr int MV = MP + MS;
constexpr int MT = 8448;
constexpr int HA = 8, CONVCH = 3072;
constexpr int CPOOL = 1024, PHIST = 15;
constexpr int DFF = 5632;
constexpr int NIN_SRC = 15888, NIN = 15872;
constexpr int PC_ZA = 3072, PC_QB = 4096, PC_KB = 5632, PC_VB = 7168, PC_UC = 8704, PC_GATE = 9728;
constexpr float EPS = 1e-6f;
constexpr size_t O_YP = 0, O_YS = O_YP + (size_t)MP * D, O_PW1 = O_YS + (size_t)MS * D;
constexpr size_t O_PW2 = O_PW1 + (size_t)2 * 4 * 128 * 1024, O_PW3 = O_PW2 + (size_t)2 * 4 * 512 * 1024, O_PGDN = O_PW3 + (size_t)2 * 4 * 2048 * 1024;
constexpr size_t O_PCONV = O_PGDN + (size_t)2 * 4 * 8 * 16384, O_PPOOL = O_PCONV + (size_t)2 * 4 * 3 * 3072, O_SW1 = O_PPOOL + (size_t)2 * 4 * 15 * 1024;
constexpr size_t O_SW2 = O_SW1 + (size_t)2 * 32 * 128 * 1024, O_SW3 = O_SW2 + (size_t)2 * 32 * 512 * 1024, O_SGDN = O_SW3 + (size_t)2 * 32 * 2048 * 1024;
constexpr size_t O_SCONV = O_SGDN + (size_t)2 * 32 * 8 * 16384, O_SPOOL = O_SCONV + (size_t)2 * 32 * 3 * 3072, O_END = O_SPOOL + (size_t)2 * 32 * 15 * 1024;
static_assert(O_END == 226426880ull, "output size");

constexpr size_t WS_CTL = 0, CTL_BYTES = 1u << 20;
constexpr size_t SZ_WIN = (size_t)NIN * D * 2, SZ_WBRA = (size_t)D * 1024 * 2, SZ_WBRB = (size_t)D * 512 * 2, SZ_WBRC = (size_t)D * 1024 * 2, SZ_WPOOL = (size_t)4 * 256 * 256 * 2;
constexpr size_t SZ_WOUT = (size_t)D * D * 2, SZ_WGU = (size_t)2 * DFF * D * 2, SZ_WDOWN = (size_t)D * DFF * 2;
constexpr size_t WO_IN = 0, WO_BRA = WO_IN + SZ_WIN, WO_BRB = WO_BRA + SZ_WBRA, WO_BRC = WO_BRB + SZ_WBRB, WO_POOL = WO_BRC + SZ_WBRC, WO_OUT = WO_POOL + SZ_WPOOL;
constexpr size_t WO_GU = WO_OUT + SZ_WOUT, WO_DOWN = WO_GU + SZ_WGU, WL_BYTES = WO_DOWN + SZ_WDOWN;
constexpr size_t WS_W = CTL_BYTES;
constexpr size_t WS_H = WS_W + 2 * WL_BYTES;
constexpr size_t WS_PROJ = WS_H + (size_t)MT * D * 2;
constexpr size_t WS_GB = WS_PROJ + (size_t)MT * NIN * 2;
constexpr size_t WS_TOK = WS_GB + (size_t)MT * 16 * 4;
constexpr size_t WS_QN = WS_TOK + (size_t)MT * 8 * 16;
constexpr size_t WS_KN = WS_QN + (size_t)MT * 1024 * 2;
constexpr size_t WS_VV = WS_KN + (size_t)MT * 1024 * 2;
constexpr size_t WS_ORAW = WS_VV + (size_t)MT * 1024 * 2;
constexpr size_t WS_POOLED = WS_ORAW + (size_t)MT * 1024 * 4;
constexpr size_t WS_OUTA = WS_POOLED + (size_t)MT * 1024 * 2;
constexpr size_t WS_OUTB = WS_OUTA + (size_t)MT * 1024 * 2;
constexpr size_t WS_OC = WS_OUTB + (size_t)MT * 512 * 2;
constexpr size_t WS_MERGED = WS_OC + (size_t)MT * 1024 * 2;
constexpr size_t WS_Y = WS_MERGED + (size_t)MT * D * 2;
constexpr size_t WS_X1 = WS_Y + (size_t)MT * D * 2;
constexpr size_t WS_X2 = WS_X1 + (size_t)MT * D * 4;
constexpr size_t WS_ACT = WS_X2 + (size_t)MT * D * 4;
constexpr size_t WS_VT = WS_ACT + (size_t)MT * DFF * 2;
constexpr size_t WS_OBG = WS_VT + (size_t)BATCH * 3 * 4 * 128 * 2048 * 2;
constexpr size_t WS_AST = WS_OBG + (size_t)6 * MV * 512 * 2;
constexpr int GCH = BATCH * HA * (SEQ / 32);
constexpr size_t WS_WF = WS_AST + (size_t)6 * MV * 4 * 8;
constexpr size_t WS_KF = WS_WF + (size_t)GCH * 8192;
constexpr size_t WS_UF = WS_KF + (size_t)GCH * 8192;
constexpr size_t WS_AF = WS_UF + (size_t)GCH * 16384;
constexpr size_t WS_TB = WS_AF + (size_t)GCH * 2048;
constexpr size_t WS_QF = WS_TB + (size_t)GCH * 128;
constexpr size_t WS_XCH = WS_QF + (size_t)GCH * 8192;
constexpr size_t WS_END = WS_XCH + (size_t)4 * 32 * 256 * 8 * 16;
static_assert(WS_END < 2000000000ull, "workspace");

namespace pg8 {
#define PG8_LAS __attribute__((address_space(3)))
typedef unsigned short bf16_t;
typedef unsigned u32x4 __attribute__((ext_vector_type(4)));
constexpr int BM = 256, BK = 64, HALF = 128, HTB = HALF * BK * 2, STAGE_BYTES = 8 * HTB, NXCD = 8, WGM = 8;
__host__ __device__ __forceinline__ int lds_byte(int r, int c) { const int st = (r >> 4) * 2 + (c >> 5), rr = r & 15, cc = c & 31, ob = rr * 64 + cc * 2; return st * 1024 + (ob ^ (((ob >> 9) & 1) << 5)); }
__host__ __device__ __forceinline__ void stage_rc(int b, int& R, int& C) { const int st = b / 1024, sb = b % 1024, swz = sb ^ (((sb >> 9) & 1) << 5); R = (st >> 1) * 16 + swz / 64; C = (st & 1) * 32 + (swz % 64) / 2; }
__host__ __device__ __forceinline__ int perm32(int rho) { const int n = rho >> 4, i = rho & 15; return 8 * (i >> 2) + 4 * n + (i & 3); }
struct Unit { int pm, pn; };
struct Gemm { const bf16_t* A; const bf16_t* Bt; int lda, ldb, K; int a_pn_step; };
struct StaticOrder {
    int nM, nN, nwg, G, c;
    __host__ __device__ void init(int M, int N, int G_, int c_) { nM = M / BM; nN = N / BM; nwg = nM * nN; G = G_; c = c_; }
    __host__ __device__ bool next(int i, Unit& u) const {
        const long L = (long)i * G + c; if (L >= nwg) return false;
        int wgid = (int)L; { const int q = nwg / NXCD, r = nwg % NXCD, xcd = wgid % NXCD, off = wgid / NXCD; wgid = (xcd < r ? xcd * (q + 1) : r * (q + 1) + (xcd - r) * q) + off; }
        const int nig = WGM * nN, gid = wgid / nig, fm = gid * WGM, gsz = (nM - fm) < WGM ? (nM - fm) : WGM;
        u.pm = fm + ((wgid % nig) % gsz); u.pn = (wgid % nig) / gsz; return true;
    }
    __device__ __forceinline__ void a_ready(const Unit&) const {}
    __device__ __forceinline__ void done(const Unit&) const {}
};
__device__ __forceinline__ unsigned cvt_pk_bf16(float lo, float hi) { unsigned r; asm volatile("v_cvt_pk_bf16_f32 %0, %1, %2" : "=v"(r) : "v"(lo), "v"(hi)); return r; }

template <class Epi, class Sched, bool ALIGN_EPI = true>
__device__ __forceinline__ void gemm_phase(PG8_LAS unsigned char* lds, const Gemm g, const Sched& S, const Epi& E) {
    int tid = threadIdx.x; asm volatile("" : "+v"(tid));
    const int wid = __builtin_amdgcn_readfirstlane(tid >> 6), lane = tid & 63, wr = wid >> 2, wc = wid & 3, fr = lane & 15, fq = lane >> 4;
    int K = g.K; asm volatile("" : "+s"(K));
    const int nt = K / BK;
    unsigned voffA[2], voffB[2];
#pragma unroll
    for (int i = 0; i < 2; ++i) { int R, C; stage_rc(tid * 16 + i * 8192, R, C); const int Rb = ((R & ~31) + perm32(R & 31));
        voffA[i] = (unsigned)(R * g.lda + C) * 2u; voffB[i] = (unsigned)(Rb * g.ldb + C) * 2u; }
    const size_t kstep = (size_t)(BK * 2);
    const size_t hstepA = (size_t)HALF * g.lda * 2, hstepB = (size_t)HALF * g.ldb * 2;
    const size_t tstepA = 2 * hstepA, tstepB = 2 * hstepB;
    const unsigned ldsw = (unsigned)wid * 1024u;
    const int aoff = lds_byte(wr * 64 + fr, fq * 8), boff = lds_byte(wc * 32 + fr, fq * 8);
#define PG8_SA(b, h) (((b) * 2 + (h)) * HTB)
#define PG8_SB(b, h) ((4 + (b) * 2 + (h)) * HTB)
#define PG8_STAGE(bufoff, gbase, voff) do { _Pragma("unroll") for (int _i = 0; _i < 2; ++_i) \
        __builtin_amdgcn_global_load_lds((const unsigned*)((const char*)(gbase) + (voff)[_i]), (PG8_LAS unsigned*)(lds + (bufoff) + ldsw + _i * 8192), 16, 0, 0); } while (0)
#define PG8_LDA(dst, b, h) do { _Pragma("unroll") for (int m = 0; m < 4; ++m) _Pragma("unroll") for (int k = 0; k < 2; ++k) dst[m][k] = *(const PG8_LAS bf16x8*)(lds + PG8_SA(b, h) + aoff + m * 2048 + k * 1024); } while (0)
#define PG8_LDB(dst, b, h) do { _Pragma("unroll") for (int n = 0; n < 2; ++n) _Pragma("unroll") for (int k = 0; k < 2; ++k) dst[n][k] = *(const PG8_LAS bf16x8*)(lds + PG8_SB(b, h) + boff + n * 2048 + k * 1024); } while (0)
#define PG8_MMA(ai, bj, At, Bt) do { __builtin_amdgcn_s_setprio(1); _Pragma("unroll") for (int m = 0; m < 4; ++m) _Pragma("unroll") for (int n = 0; n < 2; ++n) _Pragma("unroll") for (int k = 0; k < 2; ++k) \
        acc[ai][bj][m][n] = __builtin_amdgcn_mfma_f32_16x16x32_bf16(Bt[n][k], At[m][k], acc[ai][bj][m][n], 0, 0, 0); __builtin_amdgcn_s_setprio(0); } while (0)
#define PG8_WAIT_V(n) asm volatile("s_waitcnt vmcnt(" #n ")" ::: "memory")
#define PG8_WAIT_L(n) asm volatile("s_waitcnt lgkmcnt(" #n ")" ::: "memory")
#define PG8_BAR __builtin_amdgcn_s_barrier()
#define PG8_SCHED __builtin_amdgcn_sched_barrier(0)
    Unit cur, nxt; int ui = 0;
    if (!S.next(0, cur)) return;
    f32x4 acc[2][2][4][2];
#pragma unroll
    for (int a = 0; a < 2; ++a)
#pragma unroll
        for (int b = 0; b < 2; ++b)
#pragma unroll
            for (int m = 0; m < 4; ++m)
#pragma unroll
                for (int n = 0; n < 2; ++n) acc[a][b][m][n] = (f32x4){0.f, 0.f, 0.f, 0.f};
    bf16x8 At[4][2], B0[2][2], B1[2][2];
    const char* cA = (const char*)g.A + (size_t)cur.pm * tstepA + (size_t)cur.pn * (size_t)g.a_pn_step; const char* cB = (const char*)g.Bt + (size_t)cur.pn * tstepB;
    S.a_ready(cur);
    PG8_STAGE(PG8_SB(0, 0), cB, voffB); PG8_STAGE(PG8_SB(0, 1), cB + hstepB, voffB); PG8_STAGE(PG8_SA(0, 0), cA, voffA); PG8_STAGE(PG8_SA(0, 1), cA + hstepA, voffA);
    if (wr == 1) PG8_BAR;
    PG8_WAIT_V(2); PG8_BAR;
    PG8_STAGE(PG8_SB(1, 0), cB + kstep, voffB); PG8_STAGE(PG8_SA(1, 0), cA + kstep, voffA); PG8_STAGE(PG8_SB(1, 1), cB + hstepB + kstep, voffB);
    PG8_WAIT_V(6); PG8_BAR;
    for (;;) {
        const bool has_next = S.next(ui + 1, nxt);
        const char* nA = has_next ? (const char*)g.A + (size_t)nxt.pm * tstepA + (size_t)nxt.pn * (size_t)g.a_pn_step : cA; const char* nB = has_next ? (const char*)g.Bt + (size_t)nxt.pn * tstepB : cB;
        for (int t = 0; t < nt; t += 2) {
            const bool last = (t == nt - 2);
            const char* a1 = cA + (size_t)(t + 1) * kstep;
            const char* a2 = last ? nA : cA + (size_t)(t + 2) * kstep; const char* b2 = last ? nB : cB + (size_t)(t + 2) * kstep;
            const char* a3 = a2 + kstep; const char* b3 = b2 + kstep;
            if (last && has_next) S.a_ready(nxt);
            PG8_LDB(B0, 0, 0); PG8_LDB(B1, 0, 1); PG8_SCHED; PG8_LDA(At, 0, 0); PG8_STAGE(PG8_SA(1, 1), a1 + hstepA, voffA);
            PG8_WAIT_V(8); PG8_WAIT_L(0); PG8_BAR; PG8_MMA(0, 0, At, B0); PG8_MMA(0, 1, At, B1); PG8_BAR; PG8_SCHED;
            PG8_LDA(At, 0, 1); PG8_STAGE(PG8_SB(0, 0), b2, voffB); PG8_STAGE(PG8_SB(0, 1), b2 + hstepB, voffB); PG8_STAGE(PG8_SA(0, 0), a2, voffA);
            PG8_WAIT_V(8); PG8_WAIT_L(0); PG8_BAR; PG8_MMA(1, 0, At, B0); PG8_MMA(1, 1, At, B1); PG8_BAR; PG8_SCHED;
            PG8_LDB(B0, 1, 0); PG8_LDB(B1, 1, 1); PG8_SCHED; PG8_LDA(At, 1, 0); PG8_STAGE(PG8_SA(0, 1), a2 + hstepA, voffA);
            PG8_WAIT_V(8); PG8_WAIT_L(0); PG8_BAR; PG8_MMA(0, 0, At, B0); PG8_MMA(0, 1, At, B1); PG8_BAR; PG8_SCHED;
            PG8_LDA(At, 1, 1); PG8_STAGE(PG8_SB(1, 0), b3, voffB); PG8_STAGE(PG8_SB(1, 1), b3 + hstepB, voffB); PG8_STAGE(PG8_SA(1, 0), a3, voffA);
            PG8_WAIT_V(8); PG8_WAIT_L(0); PG8_BAR; PG8_MMA(1, 0, At, B0); PG8_MMA(1, 1, At, B1); PG8_BAR; PG8_SCHED;
        }
        if constexpr (ALIGN_EPI) { if (wr == 0) PG8_BAR; }
        if constexpr (!Epi::AFTER_DRAIN) { E(acc, cur, wr, wc, fr, fq); S.done(cur); }
        if (!has_next) break;
#pragma unroll
        for (int a = 0; a < 2; ++a)
#pragma unroll
            for (int b = 0; b < 2; ++b)
#pragma unroll
                for (int m = 0; m < 4; ++m)
#pragma unroll
                    for (int n = 0; n < 2; ++n) acc[a][b][m][n] = (f32x4){0.f, 0.f, 0.f, 0.f};
        cur = nxt; cA = nA; cB = nB; ++ui;
        if constexpr (ALIGN_EPI) { if (wr == 1) PG8_BAR; }
    }
    PG8_WAIT_V(0);
    if constexpr (!ALIGN_EPI) { if (wr == 0) PG8_BAR; }
    PG8_BAR;
    if constexpr (Epi::AFTER_DRAIN) { E.fused(acc, cur, wr, wc, fr, fq, lds, wid, lane); S.done(cur); }
#undef PG8_SA
#undef PG8_SB
#undef PG8_STAGE
#undef PG8_LDA
#undef PG8_LDB
#undef PG8_MMA
#undef PG8_WAIT_V
#undef PG8_WAIT_L
#undef PG8_BAR
#undef PG8_SCHED
}
}

#define LDS_WAIT() asm volatile("s_waitcnt lgkmcnt(0)" ::: "memory")
#define VM_WAIT() asm volatile("s_waitcnt vmcnt(0)" ::: "memory")
__device__ __forceinline__ unsigned f2bf(float f) { unsigned u = __builtin_bit_cast(unsigned, f); return (u + 0x7fffu + ((u >> 16) & 1u)) >> 16; }
typedef __bf16 bf16v2 __attribute__((ext_vector_type(2)));
__device__ __forceinline__ unsigned pk2(float lo, float hi) { const f32x2 v = {lo, hi}; return __builtin_bit_cast(unsigned, __builtin_convertvector(v, bf16v2)); }
__device__ __forceinline__ float bf_lo(unsigned u) { return __builtin_bit_cast(float, u << 16); }
__device__ __forceinline__ float bf_hi(unsigned u) { return __builtin_bit_cast(float, u & 0xffff0000u); }
__device__ __forceinline__ float bf1(bf16 b) { return __builtin_bit_cast(float, ((unsigned)b) << 16); }
__device__ __forceinline__ void unpack8(const v4u u, float (&x)[8]) { x[0] = bf_lo(u.x); x[1] = bf_hi(u.x); x[2] = bf_lo(u.y); x[3] = bf_hi(u.y); x[4] = bf_lo(u.z); x[5] = bf_hi(u.z); x[6] = bf_lo(u.w); x[7] = bf_hi(u.w); }
__device__ __forceinline__ v4u pack8(const float (&x)[8]) { v4u o; o.x = pk2(x[0], x[1]); o.y = pk2(x[2], x[3]); o.z = pk2(x[4], x[5]); o.w = pk2(x[6], x[7]); return o; }
__device__ __forceinline__ float wave_sum(float v) {
#pragma unroll
    for (int o = 1; o < 64; o <<= 1) v += __shfl_xor(v, o);
    return v;
}
__device__ __forceinline__ float wave_max(float v) {
#pragma unroll
    for (int o = 1; o < 64; o <<= 1) v = fmaxf(v, __shfl_xor(v, o));
    return v;
}
template <int CTRL> __device__ __forceinline__ float dpp_f(float x) { return __builtin_bit_cast(float, __builtin_amdgcn_update_dpp(0, __builtin_bit_cast(int, x), CTRL, 0xf, 0xf, true)); }
__device__ __forceinline__ float row16_sum(float x) { x += dpp_f<0xB1>(x); x += dpp_f<0x4E>(x); x += dpp_f<0x124>(x); x += dpp_f<0x128>(x); return x; }
__device__ __forceinline__ float sigm(float x) { return __builtin_amdgcn_rcpf(1.f + __expf(-x)); }
__device__ __forceinline__ float silu(float x) { return x * __builtin_amdgcn_rcpf(1.f + __expf(-x)); }

#define XB_TMO      128
#define XB_XCNT(j)  (256  + 64 * (j))
#define XB_XSUB(j)  (1280 + 64 * (j))
#define XB_XGEN(j)  (2304 + 64 * (j))
#define XB_TOP      3328
#define XB_TOPGEN   3392
#define XCD_BAR_WORDS 3456
#define XB_SPIN_CAP (1u << 18)
__device__ __forceinline__ unsigned xb_ld(unsigned* p)              { return __hip_atomic_load(p, __ATOMIC_RELAXED, __HIP_MEMORY_SCOPE_AGENT); }
__device__ __forceinline__ unsigned xb_add(unsigned* p, unsigned v) { return __hip_atomic_fetch_add(p, v, __ATOMIC_RELAXED, __HIP_MEMORY_SCOPE_AGENT); }
__device__ __forceinline__ unsigned xb_xcc_id() { return (unsigned)__builtin_amdgcn_s_getreg((3 << 11) | 20) & 0xFu; }
#define XB_SPIN(cond, bar) do { unsigned _sp = 0; while (cond) { __builtin_amdgcn_s_sleep(1); \
    if ((++_sp & 255u) == 0u) { if (xb_ld(&(bar)[XB_TMO])) break; if (_sp > XB_SPIN_CAP) { atomicAdd(&(bar)[XB_TMO], 1u); break; } } } } while (0)
struct XcdBarrier { unsigned* bar; unsigned x; volatile LAS unsigned* st; };
__device__ __forceinline__ XcdBarrier xcd_barrier_post(unsigned* bar, volatile LAS unsigned* st) {
    XcdBarrier b; b.bar = bar; b.x = xb_xcc_id(); b.st = st;
    if (threadIdx.x == 0) (void)xb_add(&bar[XB_XCNT(b.x)], 1u);
    return b;
}
__device__ __forceinline__ void xcd_barrier_complete(unsigned* bar, unsigned x, unsigned& nloc, unsigned& nx) {
    const unsigned G = gridDim.x * gridDim.y * gridDim.z;
    unsigned sum, cnt, mine, sp = 0u;
    for (;;) {
        sum = 0u; cnt = 0u; mine = 0u;
#pragma unroll
        for (unsigned j = 0; j < 16; ++j) { const unsigned c = xb_ld(&bar[XB_XCNT(j)]); sum += c; cnt += (c > 0u) ? 1u : 0u; mine = (j == x) ? c : mine; }
        if (sum == G) break;
        __builtin_amdgcn_s_sleep(1);
        if ((++sp & 255u) == 0u) { if (xb_ld(&bar[XB_TMO])) break; if (sp > XB_SPIN_CAP) { atomicAdd(&bar[XB_TMO], 1u); break; } }
    }
    nloc = mine > 0u ? mine : 1u; nx = cnt > 0u ? cnt : 1u;
}
__device__ __forceinline__ void xcd_barrier(const XcdBarrier& b) {
    asm volatile("s_waitcnt vmcnt(0)" ::: "memory");
    __syncthreads();
    if (threadIdx.x == 0) {
        unsigned* bar = b.bar;
        __builtin_amdgcn_s_waitcnt(0);
        unsigned nloc = b.st[0], nx = b.st[1];
        if (nloc == 0u) { xcd_barrier_complete(bar, b.x, nloc, nx); b.st[0] = nloc; b.st[1] = nx; }
        const unsigned old = xb_add(&bar[XB_XSUB(b.x)], 1u);
        const unsigned gen = old / nloc;
        if (old + 1u == (gen + 1u) * nloc) {
            __builtin_amdgcn_fence(__ATOMIC_RELEASE, "agent");
            asm volatile("s_waitcnt vmcnt(0)" ::: "memory");
            const unsigned og = xb_add(&bar[XB_TOP], 1u);
            const unsigned tg = og / nx;
            if (og + 1u == (tg + 1u) * nx) xb_add(&bar[XB_TOPGEN], 1u);
            else XB_SPIN(xb_ld(&bar[XB_TOPGEN]) == tg, bar);
            __builtin_amdgcn_fence(__ATOMIC_ACQUIRE, "agent");
            xb_add(&bar[XB_XGEN(b.x)], 1u);
            asm volatile("s_waitcnt vmcnt(0)" ::: "memory");
        } else {
            XB_SPIN(xb_ld(&bar[XB_XGEN(b.x)]) == gen, bar);
            __builtin_amdgcn_fence(__ATOMIC_ACQUIRE, "agent");
            asm volatile("s_waitcnt vmcnt(0)" ::: "memory");
        }
    }
    __syncthreads();
}

constexpr int NWAVES = 8;
constexpr int RING_BYTES = 131072, SCANTV_BYTES = 0, LDSCTL_OFF = RING_BYTES + SCANTV_BYTES, MISC_OFF = LDSCTL_OFF + 320, LDS_BYTES = 147456;
constexpr int CW_BAR = 4096;
constexpr int CW_TMO = 0, CW_RMS = 16384, RMS_BANK = 2048;

struct Args { const float* in[25]; float* out; unsigned char* ws; int ph_lo, ph_hi; };
struct Frame {
    LAS unsigned char* lds;
    int tid, lane, wave, vcu, G;
    const CAS cfp_t* in; float* out; unsigned char* ws;
};

__device__ __forceinline__ int launder(int x) { asm volatile("" : "+v"(x)); return x; }
__device__ __forceinline__ int launder_s(int x) { asm volatile("" : "+s"(x)); return x; }
template <class T> __device__ __forceinline__ T* launder_p(T* p) { asm volatile("" : "+s"(p)); return p; }
__device__ __forceinline__ const CAS cfp_t* launder_k(const CAS cfp_t* p) { asm volatile("" : "+s"(p)); return p; }
#define RELANE(F0) Frame F = F0; F.lane = launder(F0.lane); F.tid = launder(F0.tid)

struct EpiStore {
    static constexpr bool AFTER_DRAIN = false;
    bf16* O; int ldc; int sig_pn;
    __device__ __forceinline__ void operator()(const f32x4 (&acc)[2][2][4][2], const pg8::Unit& u, int wr, int wc, int fr, int fq) const {
        fr = launder(fr); fq = launder(fq);
        const int row0 = u.pm * 256 + wr * 64 + fr, col0 = u.pn * 256 + wc * 32 + 8 * fq; const bool sg = u.pn >= sig_pn;
#pragma unroll
        for (int ai = 0; ai < 2; ++ai)
#pragma unroll
            for (int m = 0; m < 4; ++m) { bf16* rowp = O + (size_t)(row0 + ai * 128 + m * 16) * ldc + col0;
#pragma unroll
                for (int bj = 0; bj < 2; ++bj) { f32x4 v0 = acc[ai][bj][m][0], v1 = acc[ai][bj][m][1];
                    if (sg) {
#pragma unroll
                        for (int j = 0; j < 4; ++j) { v0[j] = sigm(v0[j]); v1[j] = sigm(v1[j]); } }
                    v4u w; w.x = pg8::cvt_pk_bf16(v0[0], v0[1]); w.y = pg8::cvt_pk_bf16(v0[2], v0[3]); w.z = pg8::cvt_pk_bf16(v1[0], v1[1]); w.w = pg8::cvt_pk_bf16(v1[2], v1[3]);
                    *(v4u*)(rowp + bj * 128) = w; } }
    }
};
template <bool ACCUM> struct EpiMerge {
    static constexpr bool AFTER_DRAIN = false;
    bf16* O; const bf16* gate;
    __device__ __forceinline__ void operator()(const f32x4 (&acc)[2][2][4][2], const pg8::Unit& u, int wr, int wc, int fr, int fq) const {
        fr = launder(fr); fq = launder(fq);
        const int row0 = u.pm * 256 + wr * 64 + fr, col0 = u.pn * 256 + wc * 32 + 8 * fq;
#pragma unroll
        for (int ai = 0; ai < 2; ++ai)
#pragma unroll
            for (int m = 0; m < 4; ++m) { const int row = row0 + ai * 128 + m * 16; bf16* rowp = O + (size_t)row * D + col0; const bf16* gp = gate + (size_t)row * NIN + col0;
#pragma unroll
                for (int bj = 0; bj < 2; ++bj) {
                    float gv[8]; unpack8(*(const v4u*)(gp + bj * 128), gv);
                    float o[8];
#pragma unroll
                    for (int j = 0; j < 4; ++j) { o[j] = acc[ai][bj][m][0][j] * gv[j]; o[4 + j] = acc[ai][bj][m][1][j] * gv[4 + j]; }
                    if (ACCUM) { float p[8]; unpack8(*(const v4u*)(rowp + bj * 128), p);
#pragma unroll
                        for (int j = 0; j < 8; ++j) o[j] += p[j]; }
                    v4u w; w.x = pg8::cvt_pk_bf16(o[0], o[1]); w.y = pg8::cvt_pk_bf16(o[2], o[3]); w.z = pg8::cvt_pk_bf16(o[4], o[5]); w.w = pg8::cvt_pk_bf16(o[6], o[7]);
                    *(v4u*)(rowp + bj * 128) = w; }
                asm volatile("" ::: "memory"); }
    }
};

struct EpiRmsRes {
    static constexpr bool AFTER_DRAIN = true;
    unsigned char* ws; const CAS cfp_t* in; float* outp; int l, which;
    __device__ __forceinline__ void fused(const f32x4 (&acc)[2][2][4][2], const pg8::Unit& u, int wr, int wc, int fr, int fq, LAS unsigned char* lds, int wid, int lane) const {
        fr = launder(fr); fq = launder(fq);
        const bool lastl = which == 1 && l + 1 == DEPTH;
        bf16* const XB = (bf16*)(ws + WS_X1); bf16* const H = lastl ? nullptr : (bf16*)(ws + WS_H); float* const fout = lastl ? outp + O_YP : nullptr;
        const float* const gpost = (which ? in[24] : in[22]) + (size_t)l * D; const float* const gpre = lastl ? nullptr : (which ? in[21] + (size_t)(l + 1) * D : in[23] + (size_t)l * D);
        float* const slots = (float*)(ws + WS_XCH) + (size_t)(l * 2 + which) * 32 * 256 * 8 * 4;
        unsigned* const cnt = (unsigned*)(ws + WS_CTL) + CW_RMS + (l * 2 + which) * RMS_BANK; unsigned* const tmo = (unsigned*)(ws + WS_CTL) + CW_TMO;
        LAS f32x4* P = (LAS f32x4*)lds;
        LAS f32x2* SR = (LAS f32x2*)(lds + 16384);
        const int lr0 = wr * 64 + fr, col0 = u.pn * 256 + wc * 32 + 8 * fq;
        f32x4 gp[2][2];
#pragma unroll
        for (int bj = 0; bj < 2; ++bj) { gp[bj][0] = *(const f32x4*)(gpost + col0 + bj * 128); gp[bj][1] = *(const f32x4*)(gpost + col0 + bj * 128 + 4); }
#pragma unroll
        for (int ai = 0; ai < 2; ++ai)
#pragma unroll
            for (int m = 0; m < 4; ++m) {
                const int lr = lr0 + ai * 128 + m * 16; const bf16* xp = XB + (size_t)(u.pm * 256 + lr) * D + col0;
                float syy = 0.f, sxx = 0.f, sxy = 0.f, sgg = 0.f;
#pragma unroll
                for (int bj = 0; bj < 2; ++bj) { float xv[8]; unpack8(*(const v4u*)(xp + bj * 128), xv);
#pragma unroll
                    for (int n = 0; n < 2; ++n)
#pragma unroll
                        for (int j = 0; j < 4; ++j) { const float y = acc[ai][bj][m][n][j], yg = y * gp[bj][n][j], x = xv[4 * n + j]; syy += y * y; sxx += x * x; sxy += x * yg; sgg += yg * yg; } }
                syy += __shfl_xor(syy, 16); sxx += __shfl_xor(sxx, 16); sxy += __shfl_xor(sxy, 16); sgg += __shfl_xor(sgg, 16);
                syy += __shfl_xor(syy, 32); sxx += __shfl_xor(sxx, 32); sxy += __shfl_xor(sxy, 32); sgg += __shfl_xor(sgg, 32);
                if (fq == 0) P[lr * 4 + wc] = (f32x4){syy, sxx, sxy, sgg};
            }
        asm volatile("s_waitcnt lgkmcnt(0)" ::: "memory"); __builtin_amdgcn_s_barrier(); asm volatile("" ::: "memory");
        const int row = wid * 32 + (lane & 31);
        unsigned long long* slot = (unsigned long long*)slots + ((size_t)(u.pm * 256 + row) * 8 + u.pn) * 2;
        if (lane < 32) { const f32x4 a = P[row * 4 + 0], b = P[row * 4 + 1], c = P[row * 4 + 2], d = P[row * 4 + 3]; const f32x4 t = (a + b) + (c + d);
            __hip_atomic_store(slot, ((unsigned long long)__builtin_bit_cast(unsigned, t.y) << 32) | __builtin_bit_cast(unsigned, t.x), __ATOMIC_RELAXED, __HIP_MEMORY_SCOPE_AGENT);
            __hip_atomic_store(slot + 1, ((unsigned long long)__builtin_bit_cast(unsigned, t.w) << 32) | __builtin_bit_cast(unsigned, t.z), __ATOMIC_RELAXED, __HIP_MEMORY_SCOPE_AGENT); }
        asm volatile("s_waitcnt vmcnt(0)" ::: "memory");
        if (lane == 0) __hip_atomic_fetch_add(cnt + 64 * u.pm, 1u, __ATOMIC_RELAXED, __HIP_MEMORY_SCOPE_AGENT);
        if (wid == 0) {
            const unsigned long long t0 = __builtin_amdgcn_s_memrealtime();
            while ((unsigned)__builtin_amdgcn_readfirstlane((int)__hip_atomic_load(cnt + 64 * u.pm, __ATOMIC_RELAXED, __HIP_MEMORY_SCOPE_AGENT)) < 64u) {
                if (__builtin_amdgcn_s_memrealtime() - t0 > 2000000ull) { if (lane == 0) __hip_atomic_store(tmo, 1u, __ATOMIC_RELAXED, __HIP_MEMORY_SCOPE_AGENT); break; }
                __builtin_amdgcn_s_sleep(2); }
            __builtin_amdgcn_fence(__ATOMIC_ACQUIRE, "agent");
        }
        asm volatile("s_waitcnt vmcnt(0) lgkmcnt(0)" ::: "memory"); __builtin_amdgcn_s_barrier(); asm volatile("" ::: "memory");
        if (lane < 32) { const unsigned long long* sl = (const unsigned long long*)slots + (size_t)(u.pm * 256 + row) * 16; float syy = 0.f, sxx = 0.f, sxy = 0.f, sgg = 0.f;
#pragma unroll
            for (int t = 0; t < 8; ++t) { const unsigned long long w0 = __hip_atomic_load(sl + 2 * t, __ATOMIC_RELAXED, __HIP_MEMORY_SCOPE_AGENT), w1 = __hip_atomic_load(sl + 2 * t + 1, __ATOMIC_RELAXED, __HIP_MEMORY_SCOPE_AGENT);
                syy += __builtin_bit_cast(float, (unsigned)w0); sxx += __builtin_bit_cast(float, (unsigned)(w0 >> 32)); sxy += __builtin_bit_cast(float, (unsigned)w1); sgg += __builtin_bit_cast(float, (unsigned)(w1 >> 32)); }
            const float ry = rsqrtf(syy * (1.f / D) + EPS), s1 = sxx + 2.f * ry * sxy + ry * ry * sgg;
            SR[row] = (f32x2){ry, rsqrtf(fmaxf(s1, 0.f) * (1.f / D) + EPS)}; }
        asm volatile("s_waitcnt lgkmcnt(0)" ::: "memory"); __builtin_amdgcn_s_barrier(); asm volatile("" ::: "memory");
        f32x4 gq[2][2];
#pragma unroll
        for (int bj = 0; bj < 2; ++bj) { gq[bj][0] = gpre ? *(const f32x4*)(gpre + col0 + bj * 128) : (f32x4){0.f, 0.f, 0.f, 0.f}; gq[bj][1] = gpre ? *(const f32x4*)(gpre + col0 + bj * 128 + 4) : (f32x4){0.f, 0.f, 0.f, 0.f}; }
#pragma unroll
        for (int ai = 0; ai < 2; ++ai)
#pragma unroll
            for (int m = 0; m < 4; ++m) {
                const int lr = lr0 + ai * 128 + m * 16; const size_t off = (size_t)(u.pm * 256 + lr) * D + col0; const f32x2 sr = SR[lr];
#pragma unroll
                for (int bj = 0; bj < 2; ++bj) { float xv[8], x1[8]; unpack8(*(const v4u*)(XB + off + bj * 128), xv);
#pragma unroll
                    for (int n = 0; n < 2; ++n)
#pragma unroll
                        for (int j = 0; j < 4; ++j) x1[4 * n + j] = xv[4 * n + j] + acc[ai][bj][m][n][j] * sr.x * gp[bj][n][j];
                    if (fout) { *(f32x4*)(fout + off + bj * 128) = (f32x4){x1[0], x1[1], x1[2], x1[3]}; *(f32x4*)(fout + off + bj * 128 + 4) = (f32x4){x1[4], x1[5], x1[6], x1[7]}; }
                    else { *(v4u*)(XB + off + bj * 128) = pack8(x1);
                        if (H) { float hv[8];
#pragma unroll
                            for (int n = 0; n < 2; ++n)
#pragma unroll
                                for (int j = 0; j < 4; ++j) hv[4 * n + j] = x1[4 * n + j] * sr.y * gq[bj][n][j];
                            *(v4u*)(H + off + bj * 128) = pack8(hv); } } }
                asm volatile("" ::: "memory"); }
    }
};
struct EpiSwiglu {
    static constexpr bool AFTER_DRAIN = false;
    bf16* O;
    __device__ __forceinline__ void operator()(const f32x4 (&acc)[2][2][4][2], const pg8::Unit& u, int wr, int wc, int fr, int fq) const {
        fr = launder(fr); fq = launder(fq);
        const int row0 = u.pm * 256 + wr * 64 + fr, col0 = u.pn * 128 + wc * 32 + 8 * fq;
#pragma unroll
        for (int ai = 0; ai < 2; ++ai)
#pragma unroll
            for (int m = 0; m < 4; ++m) { bf16* rowp = O + (size_t)(row0 + ai * 128 + m * 16) * DFF + col0;
                float o[8];
#pragma unroll
                for (int j = 0; j < 4; ++j) { o[j] = silu(acc[ai][0][m][0][j]) * acc[ai][1][m][0][j]; o[4 + j] = silu(acc[ai][0][m][1][j]) * acc[ai][1][m][1][j]; }
                v4u w; w.x = pg8::cvt_pk_bf16(o[0], o[1]); w.y = pg8::cvt_pk_bf16(o[2], o[3]); w.z = pg8::cvt_pk_bf16(o[4], o[5]); w.w = pg8::cvt_pk_bf16(o[6], o[7]);
                *(v4u*)rowp = w; }
    }
};

__device__ __forceinline__ void transpose_item(const float* W, int ldw, int src_col0, int k0, bf16* WT, int ldt, int dst_row0, LAS float* scr, int lane, const float* rscale = nullptr) {
#pragma unroll 8
    for (int i = 0; i < 32; ++i) { const int kk = 2 * i + (lane >> 5); scr[kk * 33 + (lane & 31)] = W[(size_t)(k0 + kk) * ldw + src_col0 + (lane & 31)]; }
    LDS_WAIT(); asm volatile("" ::: "memory");
    const int c = lane & 7;
#pragma unroll
    for (int j = 0; j < 4; ++j) { const int n = (lane >> 3) + 8 * j; const LAS float* s = scr + (8 * c) * 33 + n; const float m = rscale ? rscale[n] : 1.f;
        v4u o; o.x = pk2(s[0 * 33] * m, s[1 * 33] * m); o.y = pk2(s[2 * 33] * m, s[3 * 33] * m); o.z = pk2(s[4 * 33] * m, s[5 * 33] * m); o.w = pk2(s[6 * 33] * m, s[7 * 33] * m);
        *(v4u*)(WT + (size_t)(dst_row0 + n) * ldt + k0 + 8 * c) = o; }
    LDS_WAIT(); asm volatile("" ::: "memory");
}
constexpr int IT_IN = 32 * 496, IT_BRA = 16 * 64, IT_BRB = 8 * 64, IT_BRC = 16 * 64, IT_POOL = 4 * 4 * 8, IT_OUT = 32 * 64, IT_GU = 32 * 352, IT_DOWN = 88 * 64;
constexpr int IT_LAYER = IT_IN + IT_BRA + IT_BRB + IT_BRC + IT_POOL + IT_OUT + IT_GU + IT_DOWN;
__device__ __forceinline__ void weight_item(Frame& F0, int l, int r, LAS float* scr) {
    RELANE(F0);
    unsigned char* wl = F.ws + WS_W + (size_t)l * WL_BYTES; const int lane = F.lane;
    if (r < IT_IN) { const int kb = r / 496, nb = r % 496, n0 = nb * 32; transpose_item(F.in[8] + (size_t)l * D * NIN_SRC, NIN_SRC, n0 + (n0 >= 4096 ? 16 : 0), kb * 64, (bf16*)(wl + WO_IN), D, n0, scr, lane); return; } r -= IT_IN;
    if (r < IT_BRA) { const int kb = r / 64, nb = r % 64; transpose_item(F.in[15] + (size_t)l * 1024 * D, D, nb * 32, kb * 64, (bf16*)(wl + WO_BRA), 1024, nb * 32, scr, lane); return; } r -= IT_BRA;
    if (r < IT_BRB) { const int kb = r / 64, nb = r % 64; transpose_item(F.in[16] + (size_t)l * 512 * D, D, nb * 32, kb * 64, (bf16*)(wl + WO_BRB), 512, nb * 32, scr, lane); return; } r -= IT_BRB;
    if (r < IT_BRC) { const int kb = r / 64, nb = r % 64; transpose_item(F.in[17] + (size_t)l * 1024 * D, D, nb * 32, kb * 64, (bf16*)(wl + WO_BRC), 1024, nb * 32, scr, lane); return; } r -= IT_BRC;
    if (r < IT_POOL) { const int g = r / 32, kb = (r % 32) / 8, nb = r % 8; transpose_item(F.in[13] + (size_t)(l * 4 + g) * 65536, 256, nb * 32, kb * 64, (bf16*)(wl + WO_POOL) + (size_t)g * 65536, 256, nb * 32, scr, lane, F.in[14] + (size_t)l * CPOOL + g * 256 + nb * 32); return; } r -= IT_POOL;
    if (r < IT_OUT) { const int kb = r / 64, nb = r % 64; transpose_item(F.in[18] + (size_t)l * D * D, D, nb * 32, kb * 64, (bf16*)(wl + WO_OUT), D, nb * 32, scr, lane); return; } r -= IT_OUT;
    if (r < IT_GU) { const int kb = r / 352, nb = r % 352, n0 = nb * 32, pn = n0 >> 8, bj = (n0 >> 7) & 1, rr = n0 & 127;
        transpose_item(F.in[19] + (size_t)l * D * 2 * DFF, 2 * DFF, bj * DFF + 128 * pn + rr, kb * 64, (bf16*)(wl + WO_GU), D, n0, scr, lane); return; } r -= IT_GU;
    { const int kb = r / 64, nb = r % 64; transpose_item(F.in[20] + (size_t)l * DFF * D, D, nb * 32, kb * 64, (bf16*)(wl + WO_DOWN), DFF, nb * 32, scr, lane); }
}

__device__ __forceinline__ void stage_wba(Frame& F0, int l) {
    RELANE(F0);
    LAS float* Wl = (LAS float*)F.lds; const float* w = F.in[8] + (size_t)l * D * NIN_SRC + 4096;
    for (int k = F.tid; k < D; k += NWAVES * 64) { const float* p = w + (size_t)k * NIN_SRC;
        const f32x4 a = *(const f32x4*)p, b = *(const f32x4*)(p + 4), c = *(const f32x4*)(p + 8), d = *(const f32x4*)(p + 12);
        Wl[0 * D + k] = a.x; Wl[1 * D + k] = a.y; Wl[2 * D + k] = a.z; Wl[3 * D + k] = a.w; Wl[4 * D + k] = b.x; Wl[5 * D + k] = b.y; Wl[6 * D + k] = b.z; Wl[7 * D + k] = b.w;
        Wl[8 * D + k] = c.x; Wl[9 * D + k] = c.y; Wl[10 * D + k] = c.z; Wl[11 * D + k] = c.w; Wl[12 * D + k] = d.x; Wl[13 * D + k] = d.y; Wl[14 * D + k] = d.z; Wl[15 * D + k] = d.w; }
    __syncthreads();
}
template <bool X32>
__device__ __forceinline__ void thin_rows(Frame& F0, const float* xa, const float* xb, const bf16* Y, const float* gpost, float* fout, const float* gpre, bool do_ba, int l_ba, int r_lo = 0) {
    RELANE(F0);
    const int lane = F.lane, gw = F.vcu * NWAVES + F.wave, NGW = F.G * NWAVES;
    bf16* H = (bf16*)(F.ws + WS_H); bf16* XB = (bf16*)(F.ws + WS_X1); float* GB = (float*)(F.ws + WS_GB);
    const LAS float* Wl = (const LAS float*)F.lds;
    f32x4 vn[8]; v2u xn[8], yn[8];
#define THIN_LOAD(rr) do { const int r_ = (rr); \
        if (X32) { const float* xr_ = (r_ < MP) ? xa + (size_t)r_ * D : xb + (size_t)(r_ - MP) * D; _Pragma("unroll") for (int j = 0; j < 8; ++j) vn[j] = *(const f32x4*)(xr_ + 4 * lane + 256 * j); } \
        else { _Pragma("unroll") for (int j = 0; j < 8; ++j) xn[j] = *(const v2u*)(XB + (size_t)r_ * D + 4 * lane + 256 * j); } \
        if (Y) { _Pragma("unroll") for (int j = 0; j < 8; ++j) yn[j] = *(const v2u*)(Y + (size_t)r_ * D + 4 * lane + 256 * j); } } while (0)
#pragma unroll
    for (int j = 0; j < 8; ++j) { yn[j] = (v2u){0u, 0u}; xn[j] = (v2u){0u, 0u}; vn[j] = (f32x4){0.f, 0.f, 0.f, 0.f}; }
    if (r_lo + gw < MV) THIN_LOAD(r_lo + gw);
    for (int r = r_lo + gw; r < MV; r += NGW) {
        f32x4 v[8]; v2u yu[8];
#pragma unroll
        for (int j = 0; j < 8; ++j) { v[j] = X32 ? vn[j] : (f32x4){bf_lo(xn[j].x), bf_hi(xn[j].x), bf_lo(xn[j].y), bf_hi(xn[j].y)}; yu[j] = yn[j]; }
        if (r + NGW < MV) THIN_LOAD(r + NGW);
        if (Y) {
            f32x4 y[8]; float ss = 0.f;
#pragma unroll
            for (int j = 0; j < 8; ++j) { const v2u u = yu[j]; y[j] = (f32x4){bf_lo(u.x), bf_hi(u.x), bf_lo(u.y), bf_hi(u.y)}; ss += (y[j].x * y[j].x + y[j].y * y[j].y) + (y[j].z * y[j].z + y[j].w * y[j].w); }
            const float rstd = rsqrtf(wave_sum(ss) * (1.f / D) + EPS);
#pragma unroll
            for (int j = 0; j < 8; ++j) { const f32x4 g = *(const f32x4*)(gpost + 4 * lane + 256 * j); v[j] = v[j] + y[j] * rstd * g; }
        }
        if (fout) {
#pragma unroll
            for (int j = 0; j < 8; ++j) *(f32x4*)(fout + (size_t)r * D + 4 * lane + 256 * j) = v[j];
        } else {
#pragma unroll
            for (int j = 0; j < 8; ++j) { v2u o; o.x = pk2(v[j].x, v[j].y); o.y = pk2(v[j].z, v[j].w); *(v2u*)(XB + (size_t)r * D + 4 * lane + 256 * j) = o; }
        }
        if (gpre) {
            float ss = 0.f;
#pragma unroll
            for (int j = 0; j < 8; ++j) ss += (v[j].x * v[j].x + v[j].y * v[j].y) + (v[j].z * v[j].z + v[j].w * v[j].w);
            const float rstd = rsqrtf(wave_sum(ss) * (1.f / D) + EPS);
#pragma unroll
            for (int j = 0; j < 8; ++j) { const f32x4 g = *(const f32x4*)(gpre + 4 * lane + 256 * j); v[j] = v[j] * rstd * g;
                v2u o; o.x = pk2(v[j].x, v[j].y); o.y = pk2(v[j].z, v[j].w); *(v2u*)(H + (size_t)r * D + 4 * lane + 256 * j) = o; }
            if (do_ba) {
                float mine = 0.f;
#pragma unroll 1
                for (int c = 0; c < 16; ++c) { float p = 0.f;
#pragma unroll
                    for (int j = 0; j < 8; ++j) { const f32x4 w = *(const LAS f32x4*)(Wl + c * D + 256 * j + 4 * lane); p += (v[j].x * w.x + v[j].y * w.y) + (v[j].z * w.z + v[j].w * w.w); }
                    p = wave_sum(p); if (lane == c) mine = p; }
                if (lane < 16) { float o;
                    if (lane < 8) o = sigm(mine);
                    else { const float al = F.in[10][l_ba * HA + lane - 8], dtb = F.in[11][l_ba * HA + lane - 8]; const float z = mine + dtb; const float sp = fmaxf(z, 0.f) + log1pf(__expf(-fabsf(z))); o = -__expf(al) * sp; }
                    GB[(size_t)r * 16 + lane] = o; }
            }
        }
    }
}
#undef THIN_LOAD
__device__ __forceinline__ void ba_rows(Frame& F0, int l_ba) {
    RELANE(F0);
    const int lane = F.lane, gw = F.vcu * NWAVES + F.wave, NGW = F.G * NWAVES;
    const bf16* H = (const bf16*)(F.ws + WS_H); float* GB = (float*)(F.ws + WS_GB); const LAS float* Wl = (const LAS float*)F.lds;
    for (int r = gw; r < MP; r += NGW) {
        f32x4 v[8];
#pragma unroll
        for (int j = 0; j < 8; ++j) { const v2u u = *(const v2u*)(H + (size_t)r * D + 4 * lane + 256 * j); v[j] = (f32x4){bf_lo(u.x), bf_hi(u.x), bf_lo(u.y), bf_hi(u.y)}; }
        float mine = 0.f;
#pragma unroll 1
        for (int c = 0; c < 16; ++c) { float p = 0.f;
#pragma unroll
            for (int j = 0; j < 8; ++j) { const f32x4 w = *(const LAS f32x4*)(Wl + c * D + 256 * j + 4 * lane); p += (v[j].x * w.x + v[j].y * w.y) + (v[j].z * w.z + v[j].w * w.w); }
            p = wave_sum(p); if (lane == c) mine = p; }
        if (lane < 16) { float o;
            if (lane < 8) o = sigm(mine);
            else { const float al = F.in[10][l_ba * HA + lane - 8], dtb = F.in[11][l_ba * HA + lane - 8]; const float z = mine + dtb; const float sp = fmaxf(z, 0.f) + log1pf(__expf(-fabsf(z))); o = -__expf(al) * sp; }
            GB[(size_t)r * 16 + lane] = o; }
    }
}

__device__ __forceinline__ void ld8f(const float* p, float (&x)[8]) { const f32x4 a = *(const f32x4*)p, b = *(const f32x4*)(p + 4); x[0] = a.x; x[1] = a.y; x[2] = a.z; x[3] = a.w; x[4] = b.x; x[5] = b.y; x[6] = b.z; x[7] = b.w; }
template <bool QK> __device__ __forceinline__ void conv_item(Frame& F0, int l, int row0, int T, int hmode, int sb, int j) {
    RELANE(F0);
    const int lane = F.lane;
    const bf16* PROJ = (const bf16*)(F.ws + WS_PROJ); const float* convw = F.in[9] + (size_t)l * 4 * CONVCH;
    const int c0 = QK ? 512 * j + 8 * lane : 2048 + 512 * j + 8 * lane, c1 = 1024 + 512 * j + 8 * lane;
    float w0[4][8], w1[4][8], x0[4][8], x1[4][8];
#pragma unroll
    for (int tap = 0; tap < 4; ++tap) { ld8f(convw + tap * CONVCH + c0, w0[tap]); if (QK) ld8f(convw + tap * CONVCH + c1, w1[tap]); }
#pragma unroll
    for (int i = 0; i < 3; ++i) {
        if (hmode == 1) { unpack8(*(const v4u*)(PROJ + (size_t)(row0 - 3 + i) * NIN + c0), x0[i + 1]); if (QK) unpack8(*(const v4u*)(PROJ + (size_t)(row0 - 3 + i) * NIN + c1), x1[i + 1]); }
        else if (hmode == 2) { const float* hp = F.in[6] + ((size_t)(l * DB + sb) * 3 + i) * CONVCH; ld8f(hp + c0, x0[i + 1]); if (QK) ld8f(hp + c1, x1[i + 1]); }
        else {
#pragma unroll
            for (int e = 0; e < 8; ++e) { x0[i + 1][e] = 0.f; x1[i + 1][e] = 0.f; } }
    }
    bf16* O0 = (bf16*)(F.ws + (QK ? WS_QN : WS_VV)) + 512 * j + 8 * lane; bf16* O1 = (bf16*)(F.ws + WS_KN) + 512 * j + 8 * lane;
    const float* GB = (const float*)(F.ws + WS_GB); f32x4* TOK = (f32x4*)(F.ws + WS_TOK); const int hd = 4 * j + (lane >> 4);
    v4u n0[4], n1[4]; float ng[4], nb[4];
#pragma unroll
    for (int u = 0; u < 4; ++u) { n0[u] = *(const v4u*)(PROJ + (size_t)(row0 + u) * NIN + c0); n1[u] = n0[u]; ng[u] = 0.f; nb[u] = 0.f; if (QK) { n1[u] = *(const v4u*)(PROJ + (size_t)(row0 + u) * NIN + c1); ng[u] = GB[(size_t)(row0 + u) * 16 + 8 + hd]; nb[u] = GB[(size_t)(row0 + u) * 16 + hd]; } }
    for (int tb = 0; tb < T; tb += 4) {
        v4u m0[4], m1[4]; float mg[4], mb[4];
#pragma unroll
        for (int u = 0; u < 4; ++u) { m0[u] = n0[u]; m1[u] = n1[u]; mg[u] = ng[u]; mb[u] = nb[u]; }
        if (tb + 4 < T) {
#pragma unroll
            for (int u = 0; u < 4; ++u) { n0[u] = *(const v4u*)(PROJ + (size_t)(row0 + tb + 4 + u) * NIN + c0); if (QK) { n1[u] = *(const v4u*)(PROJ + (size_t)(row0 + tb + 4 + u) * NIN + c1); ng[u] = GB[(size_t)(row0 + tb + 4 + u) * 16 + 8 + hd]; nb[u] = GB[(size_t)(row0 + tb + 4 + u) * 16 + hd]; } } }
#pragma unroll
        for (int u = 0; u < 4; ++u) {
            const int t = tb + u; const size_t r = (size_t)(row0 + t);
            unpack8(m0[u], x0[u]); if (QK) unpack8(m1[u], x1[u]);
            float a0[8], a1[8]; float s0 = 0.f, s1 = 0.f;
#pragma unroll
            for (int e = 0; e < 8; ++e) {
                a0[e] = silu(w0[3][e] * x0[u][e] + w0[2][e] * x0[(u + 3) & 3][e] + w0[1][e] * x0[(u + 2) & 3][e] + w0[0][e] * x0[(u + 1) & 3][e]); s0 += a0[e] * a0[e];
                if (QK) { a1[e] = silu(w1[3][e] * x1[u][e] + w1[2][e] * x1[(u + 3) & 3][e] + w1[1][e] * x1[(u + 2) & 3][e] + w1[0][e] * x1[(u + 1) & 3][e]); s1 += a1[e] * a1[e]; } }
            if (QK) {
                const float q_sc = rsqrtf(row16_sum(s0) + 1e-6f) * 0.08838834764831845f, k_sc = rsqrtf(row16_sum(s1) + 1e-6f); float p = 0.f;
#pragma unroll
                for (int e = 0; e < 8; ++e) { a0[e] *= q_sc; a1[e] *= k_sc; p += a0[e] * a1[e]; }
                p = row16_sum(p);
                *(v4u*)(O1 + r * 1024) = pack8(a1);
                if ((lane & 15) == 0) TOK[r * 8 + hd] = (f32x4){__expf(mg[u]), mb[u], p, mg[u]};
            }
            *(v4u*)(O0 + r * 1024) = pack8(a0);
        }
    }
}
__device__ __forceinline__ void pool_item(Frame& F0, int l, int row0, int T, int pos0, int hmode, int sb, int j) {
    RELANE(F0);
    const int lane = F.lane, win = 2 << (2 * j + (lane >> 5)), cc = 512 * j + 8 * lane;
    const bf16* U = (const bf16*)(F.ws + WS_PROJ) + PC_UC + cc; const float* hist = F.in[7] + (size_t)(l * DB + sb) * PHIST * CPOOL + cc;
    bf16* PO = (bf16*)(F.ws + WS_POOLED) + cc;
    float S[8];
#pragma unroll
    for (int e = 0; e < 8; ++e) S[e] = 0.f;
    if (hmode == 2) {
        for (int i = 1; i < 16; ++i) if (i < win) { float x[8]; ld8f(hist + (size_t)(PHIST - i) * CPOOL, x);
#pragma unroll
            for (int e = 0; e < 8; ++e) S[e] += x[e]; }
        for (int t = 0; t < T; ++t) {
            float xn[8], xo[8]; unpack8(*(const v4u*)(U + (size_t)(row0 + t) * NIN), xn);
            const int to = t - win + 1;
            if (to >= 0) unpack8(*(const v4u*)(U + (size_t)(row0 + to) * NIN), xo); else ld8f(hist + (size_t)(PHIST + to) * CPOOL, xo);
            const float inv = 1.f / (float)win; float o[8];
#pragma unroll
            for (int e = 0; e < 8; ++e) { S[e] += xn[e]; o[e] = S[e] * inv - xn[e]; S[e] -= xo[e]; }
            *(v4u*)(PO + (size_t)(row0 + t) * 1024) = pack8(o);
        }
        return;
    }
    {
        v4u h[15];
#pragma unroll
        for (int i = 1; i < 16; ++i) { const int back = (pos0 - i >= 0) ? i : pos0; h[i - 1] = *(const v4u*)(U + (size_t)(row0 - back) * NIN); }
#pragma unroll
        for (int i = 1; i < 16; ++i) { float x[8]; unpack8(h[i - 1], x); const float wgt = (i < win && pos0 - i >= 0) ? 1.f : 0.f;
#pragma unroll
            for (int e = 0; e < 8; ++e) S[e] += wgt * x[e]; }
    }
    v4u nn[4], no[4];
#define POOL_LD(tb_) do { _Pragma("unroll") for (int u = 0; u < 4; ++u) { const int t_ = (tb_) + u, to_ = t_ - win + 1; nn[u] = *(const v4u*)(U + (size_t)(row0 + t_) * NIN); no[u] = *(const v4u*)(U + (size_t)(row0 + (pos0 + to_ >= 0 ? to_ : -pos0)) * NIN); } } while (0)
    POOL_LD(0);
    for (int tb = 0; tb < T; tb += 4) {
        v4u mn[4], mo[4];
#pragma unroll
        for (int u = 0; u < 4; ++u) { mn[u] = nn[u]; mo[u] = no[u]; }
        if (tb + 4 < T) POOL_LD(tb + 4);
#pragma unroll
        for (int u = 0; u < 4; ++u) {
            const int t = tb + u, to = t - win + 1; const float wo = (pos0 + to >= 0) ? 1.f : 0.f;
            float xn[8], xo[8]; unpack8(mn[u], xn); unpack8(mo[u], xo);
            const float cnt = (float)(win < pos0 + t + 1 ? win : pos0 + t + 1), inv = __builtin_amdgcn_rcpf(cnt); float o[8];
#pragma unroll
            for (int e = 0; e < 8; ++e) { S[e] += xn[e]; o[e] = S[e] * inv - xn[e]; S[e] -= wo * xo[e]; }
            *(v4u*)(PO + (size_t)(row0 + t) * 1024) = pack8(o);
        }
    }
#undef POOL_LD
}
constexpr int CV_BLK = 16, CV_NB = SEQ / CV_BLK;
constexpr int CV_P_ITEMS = BATCH * CV_NB * 2, CV_S_ITEMS = DB * 2;
constexpr int PREP_ITEMS = 2 * (CV_P_ITEMS + CV_S_ITEMS) + CV_P_ITEMS + CV_S_ITEMS;
__device__ __forceinline__ void prep_item(Frame& F, int l, int it) {
    int kind = 0;
    if (it >= CV_P_ITEMS + CV_S_ITEMS) { it -= CV_P_ITEMS + CV_S_ITEMS; kind = 1; if (it >= CV_P_ITEMS + CV_S_ITEMS) { it -= CV_P_ITEMS + CV_S_ITEMS; kind = 2; } }
    int row0, T, hmode, sb = 0, pos0; const int j = it & 1;
    if (it < CV_P_ITEMS) { const int blk = (it >> 1) % CV_NB, b = (it >> 1) / CV_NB; row0 = b * SEQ + blk * CV_BLK; T = CV_BLK; hmode = blk ? 1 : 0; pos0 = blk * CV_BLK; }
    else { sb = (it - CV_P_ITEMS) >> 1; row0 = MP + DS * sb; T = DS; hmode = 2; pos0 = 0; }
    if (kind == 0) conv_item<true>(F, l, row0, T, hmode, sb, j); else if (kind == 1) conv_item<false>(F, l, row0, T, hmode, sb, j); else pool_item(F, l, row0, T, pos0, hmode, sb, j);
}

__device__ __forceinline__ void st8f(float* p, const v4u u) { float x[8]; unpack8(u, x); *(f32x4*)p = (f32x4){x[0], x[1], x[2], x[3]}; *(f32x4*)(p + 4) = (f32x4){x[4], x[5], x[6], x[7]}; }
__device__ __forceinline__ void prep_out_rows(Frame& F0, int l) {
    RELANE(F0);
    const int lane = F.lane, gw = F.vcu * NWAVES + F.wave, NGW = F.G * NWAVES;
    const bf16* PROJ = (const bf16*)(F.ws + WS_PROJ);
    float* out = F.out;
    for (int r = gw; r < MV; r += NGW) {
        const bool samp = r >= MP; const int b = samp ? (r - MP) / DS : r / SEQ, t = samp ? (r - MP) % DS : r % SEQ;
        const bf16* prow = PROJ + (size_t)r * NIN;
        const int ci = samp ? t - 1 : t - (SEQ - 3), pi = samp ? 11 + t : t - (SEQ - PHIST);
        v4u kvr[3][2], cv[6], pv[2];
#pragma unroll
        for (int gi = 0; gi < 3; ++gi) { kvr[gi][0] = *(const v4u*)(prow + PC_KB + gi * 512 + 8 * lane); kvr[gi][1] = *(const v4u*)(prow + PC_VB + gi * 512 + 8 * lane); }
        const bool needc = (ci >= 0) || (pi >= 0);
        if (needc) {
#pragma unroll
            for (int j = 0; j < 6; ++j) cv[j] = *(const v4u*)(prow + 512 * j + 8 * lane);
#pragma unroll
            for (int j = 0; j < 2; ++j) pv[j] = *(const v4u*)(prow + PC_UC + 512 * j + 8 * lane);
        }
#pragma unroll
        for (int gi = 0; gi < 3; ++gi) {
            const int win = 128 << (2 * gi); const int w = samp ? win - DS + t : t - (SEQ - win);
            if (w >= 0) {
                const size_t obase = samp ? (gi == 0 ? O_SW1 : gi == 1 ? O_SW2 : O_SW3) : (gi == 0 ? O_PW1 : gi == 1 ? O_PW2 : O_PW3);
                float* dst = out + obase + ((size_t)(l * (samp ? DB : BATCH) + b) * win + w) * 1024 + 8 * lane;
                st8f(dst, kvr[gi][0]); st8f(dst + 512, kvr[gi][1]);
            }
        }
        if (needc) {
            if (ci >= 0) { float* dst = out + (samp ? O_SCONV + ((size_t)(l * DB + b) * 3 + ci) * CONVCH : O_PCONV + ((size_t)(l * BATCH + b) * 3 + ci) * CONVCH) + 8 * lane;
#pragma unroll
                for (int j = 0; j < 6; ++j) st8f(dst + 512 * j, cv[j]); }
            if (pi >= 0) { float* dst = out + (samp ? O_SPOOL + ((size_t)(l * DB + b) * PHIST + pi) * CPOOL : O_PPOOL + ((size_t)(l * BATCH + b) * PHIST + pi) * CPOOL) + 8 * lane;
#pragma unroll
                for (int j = 0; j < 2; ++j) st8f(dst + 512 * j, pv[j]); }
            if (samp && t == 0) {
                const float* phist = F.in[7] + (size_t)(l * DB + b) * PHIST * CPOOL;
                float* dst = out + O_SPOOL + (size_t)(l * DB + b) * PHIST * CPOOL; const float* src = phist + 4 * CPOOL;
                for (int i = lane; i < 11 * CPOOL / 4; i += 64) *(f32x4*)(dst + 4 * i) = *(const f32x4*)(src + 4 * i);
            }
        }
    }
}

__device__ __forceinline__ void gdn_scan_item(Frame& F0, int row0, int h, int s, const float* S0, float* Sout) {
    RELANE(F0);
    const int lane = F.lane, dvl = lane & 15, kg = lane >> 4;
    const bf16* QN = (const bf16*)(F.ws + WS_QN); const bf16* KN = (const bf16*)(F.ws + WS_KN); const bf16* VV = (const bf16*)(F.ws + WS_VV);
    const f32x4* TOK = (const f32x4*)(F.ws + WS_TOK); float* ORAW = (float*)(F.ws + WS_ORAW);
    float S[32]; v4u ku[DS][4], qu[DS][4]; float vv[DS]; f32x4 tk[DS];
    const float* sp = S0 + (size_t)(32 * kg) * 128 + 16 * s + dvl;
#pragma unroll
    for (int i = 0; i < 32; ++i) S[i] = sp[(size_t)i * 128];
#pragma unroll
    for (int t = 0; t < DS; ++t) { const size_t r = (size_t)(row0 + t);
#pragma unroll
        for (int c = 0; c < 4; ++c) { ku[t][c] = *(const v4u*)(KN + r * 1024 + h * 128 + 32 * kg + 8 * c); qu[t][c] = *(const v4u*)(QN + r * 1024 + h * 128 + 32 * kg + 8 * c); }
        vv[t] = bf1(VV[r * 1024 + h * 128 + 16 * s + dvl]); tk[t] = TOK[r * 8 + h]; }
#pragma unroll
    for (int t = 0; t < DS; ++t) {
        float rk = 0.f, rq = 0.f; float kf[32];
#pragma unroll
        for (int c = 0; c < 4; ++c) { float k8[8], q8[8]; unpack8(ku[t][c], k8); unpack8(qu[t][c], q8);
#pragma unroll
            for (int e = 0; e < 8; ++e) { kf[8 * c + e] = k8[e]; rk += k8[e] * S[8 * c + e]; rq += q8[e] * S[8 * c + e]; } }
        rk += __shfl_xor(rk, 16); rq += __shfl_xor(rq, 16); rk += __shfl_xor(rk, 32); rq += __shfl_xor(rq, 32);
        const float a = tk[t].x, d = tk[t].y * (vv[t] - a * rk), o = a * rq + tk[t].z * d;
#pragma unroll
        for (int i = 0; i < 32; ++i) S[i] = a * S[i] + kf[i] * d;
        if (kg == 0) ORAW[(size_t)(row0 + t) * 1024 + h * 128 + 16 * s + dvl] = o;
    }
    float* op = Sout + (size_t)(32 * kg) * 128 + 16 * s + dvl;
#pragma unroll
    for (int i = 0; i < 32; ++i) op[(size_t)i * 128] = S[i];
}

__device__ __forceinline__ bf16x8 pack_acc(const f32x16& x, int sp) {
    v4u p; p.x = pk2(x[8 * sp + 0], x[8 * sp + 1]); p.y = pk2(x[8 * sp + 2], x[8 * sp + 3]); p.z = pk2(x[8 * sp + 4], x[8 * sp + 5]); p.w = pk2(x[8 * sp + 6], x[8 * sp + 7]);
    return __builtin_bit_cast(bf16x8, p);
}
constexpr int GA_PITCH = 272, GA_LT_PITCH = 36, GA_WAVE_LDS = 32 * GA_PITCH + 32 * GA_LT_PITCH * 4 + 384;
__device__ __forceinline__ void gdn_ga_item(Frame& F0, int ch) {
    RELANE(F0);
    const int lane = F.lane, r = lane & 31, h = lane >> 5;
    const int c = ch & 63, bh = ch >> 6, hd = bh & 7, b = bh >> 3, row0 = b * SEQ + 32 * c;
    LAS unsigned char* TL = F.lds + F.wave * GA_WAVE_LDS; LAS float* LT = (LAS float*)(TL + 32 * GA_PITCH); LAS float* GS = (LAS float*)(TL + 32 * GA_PITCH + 32 * GA_LT_PITCH * 4);
    const bf16* QN = (const bf16*)(F.ws + WS_QN); const bf16* KN = (const bf16*)(F.ws + WS_KN); const bf16* VV = (const bf16*)(F.ws + WS_VV); const f32x4* TOK = (const f32x4*)(F.ws + WS_TOK);
    { const f32x4 tk = TOK[(size_t)(row0 + r) * 8 + hd]; if (h == 0) { GS[r] = tk.w; GS[32 + r] = tk.y; } }
#pragma unroll
    for (int i = 0; i < 8; ++i) { const int p = lane + 64 * i, rw = p >> 4, c16 = p & 15; *(LAS v4u*)(TL + rw * GA_PITCH + 16 * c16) = *(const v4u*)(KN + (size_t)(row0 + rw) * 1024 + hd * 128 + 8 * c16); }
    asm volatile("s_waitcnt lgkmcnt(0)" ::: "memory");
    float gcv[32], bev[32];
#pragma unroll
    for (int i = 0; i < 8; ++i) { const f32x4 a = *(const LAS f32x4*)(GS + 4 * i), bq = *(const LAS f32x4*)(GS + 32 + 4 * i);
        gcv[4 * i] = a.x; gcv[4 * i + 1] = a.y; gcv[4 * i + 2] = a.z; gcv[4 * i + 3] = a.w; bev[4 * i] = bq.x; bev[4 * i + 1] = bq.y; bev[4 * i + 2] = bq.z; bev[4 * i + 3] = bq.w; }
#pragma unroll
    for (int i = 1; i < 32; ++i) gcv[i] += gcv[i - 1];
    if (lane == 0) {
#pragma unroll
        for (int i = 0; i < 8; ++i) *(LAS f32x4*)(GS + 64 + 4 * i) = (f32x4){gcv[4 * i], gcv[4 * i + 1], gcv[4 * i + 2], gcv[4 * i + 3]}; }
    asm volatile("s_waitcnt lgkmcnt(0)" ::: "memory");
    const float gc_own = GS[64 + r], fr = (float)r;
    const bf16* kp = KN + (size_t)(row0 + r) * 1024 + hd * 128 + 8 * h; const bf16* qp = QN + (size_t)(row0 + r) * 1024 + hd * 128 + 8 * h;
    f32x16 akk, aqk;
#pragma unroll
    for (int i = 0; i < 16; ++i) { akk[i] = 0.f; aqk[i] = 0.f; }
#pragma unroll
    for (int ks = 0; ks < 8; ++ks) { const bf16x8 kf = *(const bf16x8*)(kp + 16 * ks), qf = *(const bf16x8*)(qp + 16 * ks);
        akk = __builtin_amdgcn_mfma_f32_32x32x16_bf16(kf, kf, akk, 0, 0, 0); aqk = __builtin_amdgcn_mfma_f32_32x32x16_bf16(kf, qf, aqk, 0, 0, 0); }
#pragma unroll
    for (int g4 = 0; g4 < 4; ++g4) { f32x4 w;
#pragma unroll
        for (int e = 0; e < 4; ++e) { const int k0 = 8 * g4 + e, k1 = k0 + 4; const float gk = h ? gcv[k1] : gcv[k0], bk = h ? bev[k1] : bev[k0]; const int kk = h ? k1 : k0;
            const float lo = fminf(fmaxf((float)kk - fr, 0.f), 1.f);
            w[e] = lo * bk * akk[4 * g4 + e] * __expf(fminf(gk - gc_own, 0.f));
            aqk[4 * g4 + e] = (1.f - lo) * aqk[4 * g4 + e] * __expf(fminf(gc_own - gk, 0.f)); }
        *(LAS f32x4*)(LT + r * GA_LT_PITCH + 8 * g4 + 4 * h) = w; }
    bf16x8* AF = (bf16x8*)(F.ws + WS_AF) + (size_t)ch * 128;
    AF[lane] = pack_acc(aqk, 0); AF[64 + lane] = pack_acc(aqk, 1);
    asm volatile("s_waitcnt lgkmcnt(0)" ::: "memory");
    float t[32];
#pragma unroll
    for (int j = 31; j >= 0; --j) {
        float acc = 1.f - fminf(fabsf(fr - (float)j), 1.f);
#pragma unroll
        for (int gq = (j + 1) >> 2; gq < 8; ++gq) { const f32x4 lv = *(const LAS f32x4*)(LT + j * GA_LT_PITCH + 4 * gq);
#pragma unroll
            for (int e = 0; e < 4; ++e) if (4 * gq + e > j) acc -= t[4 * gq + e] * lv[e]; }
        t[j] = acc;
    }
    bf16x8 t1f[2], t2f[2];
#pragma unroll
    for (int sp = 0; sp < 2; ++sp) { float x1[8], x2[8];
#pragma unroll
        for (int e = 0; e < 8; ++e) { const int j0 = 16 * sp + e, j1 = j0 + 8; const float tv = h ? t[j1] : t[j0], bj = h ? bev[j1] : bev[j0], gj = h ? gcv[j1] : gcv[j0]; x1[e] = tv * bj; x2[e] = x1[e] * __expf(gj); }
        t1f[sp] = __builtin_bit_cast(bf16x8, pack8(x1)); t2f[sp] = __builtin_bit_cast(bf16x8, pack8(x2)); }
    { bf16x8* QFo = (bf16x8*)(F.ws + WS_QF) + (size_t)ch * 512; const bf16* qrow = QN + (size_t)(row0 + r) * 1024 + hd * 128 + 4 * h;
#pragma unroll
      for (int tl = 0; tl < 4; ++tl)
#pragma unroll
          for (int sp = 0; sp < 2; ++sp) { const v2u qlo = *(const v2u*)(qrow + 32 * tl + 16 * sp), qhi = *(const v2u*)(qrow + 32 * tl + 16 * sp + 8); v4u qu; qu.x = qlo.x; qu.y = qlo.y; qu.z = qhi.x; qu.w = qhi.y; QFo[(tl * 2 + sp) * 64 + lane] = __builtin_bit_cast(bf16x8, qu); } }
    const float g_last = gcv[31];
    bf16x8* WF = (bf16x8*)(F.ws + WS_WF) + (size_t)ch * 512; bf16x8* KF = (bf16x8*)(F.ws + WS_KF) + (size_t)ch * 512;
#pragma unroll
    for (int tl = 0; tl < 4; ++tl) {
        f32x16 acc;
#pragma unroll
        for (int i = 0; i < 16; ++i) acc[i] = 0.f;
        const LAS unsigned char* col = TL + (32 * tl + r) * 2;
#pragma unroll
        for (int sp = 0; sp < 2; ++sp) { unsigned w[4];
#pragma unroll
            for (int e = 0; e < 4; ++e) { const unsigned lo = *(const LAS unsigned short*)(col + (16 * sp + 8 * h + 2 * e) * GA_PITCH), hi = *(const LAS unsigned short*)(col + (16 * sp + 8 * h + 2 * e + 1) * GA_PITCH); w[e] = lo | (hi << 16); }
            v4u wu; wu.x = w[0]; wu.y = w[1]; wu.z = w[2]; wu.w = w[3];
            acc = __builtin_amdgcn_mfma_f32_32x32x16_bf16(__builtin_bit_cast(bf16x8, wu), t2f[sp], acc, 0, 0, 0); }
#pragma unroll
        for (int i = 0; i < 16; ++i) acc[i] = -acc[i];
#pragma unroll
        for (int sp = 0; sp < 2; ++sp) { WF[(tl * 2 + sp) * 64 + lane] = pack_acc(acc, sp);
            float x[8];
#pragma unroll
            for (int e = 0; e < 8; ++e) { const int j0 = 16 * sp + 8 * (e >> 2) + (e & 3), j1 = j0 + 4; const float gj = h ? gcv[j1] : gcv[j0];
                const unsigned kv = *(const LAS unsigned short*)(col + (j0 + 4 * h) * GA_PITCH); x[e] = __builtin_bit_cast(float, kv << 16) * __expf(g_last - gj); }
            KF[(tl * 2 + sp) * 64 + lane] = __builtin_bit_cast(bf16x8, pack8(x)); }
    }
    asm volatile("s_waitcnt lgkmcnt(0)" ::: "memory");
#pragma unroll
    for (int i = 0; i < 8; ++i) { const int p = lane + 64 * i, rw = p >> 4, c16 = p & 15; *(LAS v4u*)(TL + rw * GA_PITCH + 16 * c16) = *(const v4u*)(VV + (size_t)(row0 + rw) * 1024 + hd * 128 + 8 * c16); }
    asm volatile("s_waitcnt lgkmcnt(0)" ::: "memory");
    f32x4* UF = (f32x4*)(F.ws + WS_UF) + (size_t)ch * 1024;
#pragma unroll
    for (int tl = 0; tl < 4; ++tl) {
        f32x16 acc;
#pragma unroll
        for (int i = 0; i < 16; ++i) acc[i] = 0.f;
        const LAS unsigned char* col = TL + (32 * tl + r) * 2;
#pragma unroll
        for (int sp = 0; sp < 2; ++sp) { unsigned w[4];
#pragma unroll
            for (int e = 0; e < 4; ++e) { const unsigned lo = *(const LAS unsigned short*)(col + (16 * sp + 8 * h + 2 * e) * GA_PITCH), hi = *(const LAS unsigned short*)(col + (16 * sp + 8 * h + 2 * e + 1) * GA_PITCH); w[e] = lo | (hi << 16); }
            v4u wu; wu.x = w[0]; wu.y = w[1]; wu.z = w[2]; wu.w = w[3];
            acc = __builtin_amdgcn_mfma_f32_32x32x16_bf16(t1f[sp], __builtin_bit_cast(bf16x8, wu), acc, 0, 0, 0); }
#pragma unroll
        for (int g4 = 0; g4 < 4; ++g4) UF[(tl * 4 + g4) * 64 + lane] = (f32x4){acc[4 * g4], acc[4 * g4 + 1], acc[4 * g4 + 2], acc[4 * g4 + 3]};
    }
    if (h == 0) ((float*)(F.ws + WS_TB))[(size_t)ch * 32 + r] = __expf(gc_own);
    asm volatile("s_waitcnt lgkmcnt(0)" ::: "memory");
}

constexpr int GSC_ITEMS = BATCH * HA * 4;
constexpr int GSB_WF = 0, GSB_KF = 8192, GSB_QF = 16384, GSB_UF = 24576, GSB_AF = 28672, GSB_TB = 30720, GSB_AL = 34816, GSB_STRIDE = 36864;
__device__ __forceinline__ void gdn_chunk_scan(Frame& F0, int l, int item) {
    RELANE(F0);
    const int lane = F.lane, r = lane & 31, h = lane >> 5;
    const int sl = item & 3, bh = item >> 2, hd = bh & 7, b = bh >> 3;
    float* ORAW = (float*)(F.ws + WS_ORAW);
    LAS unsigned char* buf = F.lds;
#define GS_DMA(src, off) __builtin_amdgcn_global_load_lds((const unsigned*)(src), (LAS unsigned*)(bp + (off)), 16, 0, 0)
#define GS_FETCH(cc, bsel) do { const size_t ch_ = (size_t)bh * 64 + (cc); LAS unsigned char* bp = buf + (bsel) * GSB_STRIDE; \
        const bf16x8* wf_ = (const bf16x8*)(F.ws + WS_WF) + ch_ * 512 + lane; const bf16x8* kf_ = (const bf16x8*)(F.ws + WS_KF) + ch_ * 512 + lane; const bf16x8* qf_ = (const bf16x8*)(F.ws + WS_QF) + ch_ * 512 + lane; \
        const f32x4* uf_ = (const f32x4*)(F.ws + WS_UF) + ch_ * 1024 + (size_t)sl * 256 + lane; const bf16x8* af_ = (const bf16x8*)(F.ws + WS_AF) + ch_ * 128 + lane; const float* tb_ = (const float*)(F.ws + WS_TB) + ch_ * 32; \
        _Pragma("unroll") for (int i_ = 0; i_ < 8; ++i_) { GS_DMA(wf_ + i_ * 64, GSB_WF + i_ * 1024); GS_DMA(qf_ + i_ * 64, GSB_QF + i_ * 1024); } \
        _Pragma("unroll") for (int i_ = 0; i_ < 4; ++i_) { GS_DMA(uf_ + i_ * 64, GSB_UF + i_ * 1024); GS_DMA(tb_ + 8 * i_ + 4 * h, GSB_TB + i_ * 1024); } \
        GS_DMA(af_, GSB_AF); GS_DMA(af_ + 64, GSB_AF + 1024); GS_DMA(tb_ + 28, GSB_AL); \
        _Pragma("unroll") for (int i_ = 0; i_ < 8; ++i_) GS_DMA(kf_ + i_ * 64, GSB_KF + i_ * 1024); } while (0)
    f32x16 S[4];
#pragma unroll
    for (int tl = 0; tl < 4; ++tl)
#pragma unroll
        for (int i = 0; i < 16; ++i) S[tl][i] = 0.f;
    GS_FETCH(0, 0);
#pragma unroll 1
    for (int c = 0; c < SEQ / 32; ++c) {
        const int row0 = b * SEQ + 32 * c;
        asm volatile("s_waitcnt vmcnt(0)" ::: "memory");
        if (c + 1 < SEQ / 32) GS_FETCH(c + 1, (c + 1) & 1);
        const LAS unsigned char* bp = buf + (c & 1) * GSB_STRIDE + lane * 16;
        f32x16 P, O1;
#pragma unroll
        for (int g4 = 0; g4 < 4; ++g4) { const f32x4 u = *(const LAS f32x4*)(bp + GSB_UF + g4 * 1024); P[4 * g4] = u.x; P[4 * g4 + 1] = u.y; P[4 * g4 + 2] = u.z; P[4 * g4 + 3] = u.w; }
#pragma unroll
        for (int i = 0; i < 16; ++i) O1[i] = 0.f;
#pragma unroll
        for (int tl = 0; tl < 4; ++tl)
#pragma unroll
            for (int sp = 0; sp < 2; ++sp) {
                const bf16x8 sf = pack_acc(S[tl], sp);
                P = __builtin_amdgcn_mfma_f32_32x32x16_bf16(*(const LAS bf16x8*)(bp + GSB_WF + (tl * 2 + sp) * 1024), sf, P, 0, 0, 0);
                O1 = __builtin_amdgcn_mfma_f32_32x32x16_bf16(*(const LAS bf16x8*)(bp + GSB_QF + (tl * 2 + sp) * 1024), sf, O1, 0, 0, 0);
            }
#pragma unroll
        for (int g4 = 0; g4 < 4; ++g4) { const f32x4 eg = *(const LAS f32x4*)(bp + GSB_TB + g4 * 1024); O1[4 * g4] *= eg.x; O1[4 * g4 + 1] *= eg.y; O1[4 * g4 + 2] *= eg.z; O1[4 * g4 + 3] *= eg.w; }
        const bf16x8 vf0 = pack_acc(P, 0), vf1 = pack_acc(P, 1);
        O1 = __builtin_amdgcn_mfma_f32_32x32x16_bf16(*(const LAS bf16x8*)(bp + GSB_AF), vf0, O1, 0, 0, 0);
        O1 = __builtin_amdgcn_mfma_f32_32x32x16_bf16(*(const LAS bf16x8*)(bp + GSB_AF + 1024), vf1, O1, 0, 0, 0);
        const float a_last = (*(const LAS f32x4*)(bp + GSB_AL)).w;
#pragma unroll
        for (int tl = 0; tl < 4; ++tl) {
#pragma unroll
            for (int i = 0; i < 16; ++i) S[tl][i] *= a_last;
            S[tl] = __builtin_amdgcn_mfma_f32_32x32x16_bf16(*(const LAS bf16x8*)(bp + GSB_KF + (tl * 2) * 1024), vf0, S[tl], 0, 0, 0);
            S[tl] = __builtin_amdgcn_mfma_f32_32x32x16_bf16(*(const LAS bf16x8*)(bp + GSB_KF + (tl * 2 + 1) * 1024), vf1, S[tl], 0, 0, 0);
        }
        float* op = ORAW + (size_t)(row0 + 4 * h) * 1024 + hd * 128 + 32 * sl + r;
#pragma unroll
        for (int i = 0; i < 16; ++i) op[(size_t)((i & 3) + 8 * (i >> 2)) * 1024] = O1[i];
    }
#undef GS_DMA
#undef GS_FETCH
    float* Sout = F.out + O_PGDN + (size_t)((l * BATCH + b) * HA + hd) * 16384 + 32 * sl + r;
#pragma unroll
    for (int tl = 0; tl < 4; ++tl)
#pragma unroll
        for (int i = 0; i < 16; ++i) Sout[(size_t)(32 * tl + (i & 3) + 8 * (i >> 2) + 4 * h) * 128] = S[tl][i];
}

constexpr int VT_PITCH = 144, VT_WAVE_LDS = 64 * VT_PITCH, VT_ITEMS = BATCH * 3 * 4 * 2 * 32;
__device__ __forceinline__ void vt_item(Frame& F0, int item) {
    RELANE(F0);
    const int lane = F.lane; LAS unsigned char* T = F.lds + F.wave * VT_WAVE_LDS;
    const int ch = item & 31, dh = (item >> 5) & 1, hh = (item >> 6) & 3, bg = item >> 8, g = bg % 3, b = bg / 3;
    const int dil = 1 << (2 * g), Lc = SEQ >> (2 * g), pos0 = ch * 64, rho = pos0 / Lc, i0 = pos0 % Lc;
    const bf16* PROJ = (const bf16*)(F.ws + WS_PROJ); bf16* VT = (bf16*)(F.ws + WS_VT);
    const bf16* src = PROJ + ((size_t)b * SEQ + (size_t)(i0 + lane) * dil + rho) * NIN + PC_VB + g * 512 + hh * 128 + 64 * dh;
    v4u x[8];
#pragma unroll
    for (int c = 0; c < 8; ++c) x[c] = *(const v4u*)(src + 8 * c);
#pragma unroll
    for (int c = 0; c < 8; ++c) { const unsigned w[4] = {x[c].x, x[c].y, x[c].z, x[c].w};
#pragma unroll
        for (int e = 0; e < 4; ++e) { *(LAS unsigned short*)(T + (8 * c + 2 * e) * VT_PITCH + 2 * lane) = (unsigned short)(w[e] & 0xffffu); *(LAS unsigned short*)(T + (8 * c + 2 * e + 1) * VT_PITCH + 2 * lane) = (unsigned short)(w[e] >> 16); } }
    asm volatile("s_waitcnt lgkmcnt(0)" ::: "memory");
    bf16* dst = VT + ((size_t)((b * 3 + g) * 4 + hh) * 128 + 64 * dh) * 2048 + pos0;
#pragma unroll
    for (int it = 0; it < 8; ++it) { const int p = lane + 64 * it, row = p >> 3, cc = p & 7; const v4u v = *(const LAS v4u*)(T + row * VT_PITCH + 16 * cc); *(v4u*)(dst + (size_t)row * 2048 + 8 * cc) = v; }
    asm volatile("s_waitcnt lgkmcnt(0)" ::: "memory");
}

constexpr int ATT_UNITS = BATCH * 4 * 192;
__device__ __forceinline__ void attn_unit(Frame& F0, int unit) {
    RELANE(F0);
    const int lane = F.lane, r = lane & 31, h = lane >> 5;
    const int bh = unit / 192, b = bh >> 2, hh = bh & 3, u = unit % 192, g = u >> 6, v = u & 63;
    const int dil = 1 << (2 * g), ntpc = 64 >> (2 * g), rho = v / ntpc, i0 = (v % ntpc) * 32, Lc = SEQ >> (2 * g);
    const bf16* PROJ = (const bf16*)(F.ws + WS_PROJ);
    const bf16* cbase = PROJ + ((size_t)b * SEQ + rho) * NIN + g * 512 + hh * 128 + 8 * h;
    const bf16* qp = cbase + (size_t)(i0 + r) * dil * NIN + PC_QB;
    bf16x8 qf[8];
#pragma unroll
    for (int ks = 0; ks < 8; ++ks) qf[ks] = *(const bf16x8*)(qp + 16 * ks);
    f32x16 st[5]; float mx = -1e30f;
    bf16x8 kn[8];
    { const int k0 = i0 - 128; const bf16* kp = cbase + (size_t)((k0 >= 0 ? k0 : 0) + r) * dil * NIN + PC_KB;
#pragma unroll
      for (int ks = 0; ks < 8; ++ks) kn[ks] = *(const bf16x8*)(kp + 16 * ks); }
#pragma unroll
    for (int kt = 0; kt < 5; ++kt) {
        const int k0 = i0 - 128 + 32 * kt; const bool tv = k0 >= 0;
        bf16x8 kc[8];
#pragma unroll
        for (int ks = 0; ks < 8; ++ks) kc[ks] = kn[ks];
        if (kt < 4) { const int k1 = k0 + 32; const bf16* kp = cbase + (size_t)((k1 >= 0 ? k1 : 0) + r) * dil * NIN + PC_KB;
#pragma unroll
            for (int ks = 0; ks < 8; ++ks) kn[ks] = *(const bf16x8*)(kp + 16 * ks); }
        f32x16 acc;
#pragma unroll
        for (int i = 0; i < 16; ++i) acc[i] = 0.f;
#pragma unroll
        for (int ks = 0; ks < 8; ++ks) acc = __builtin_amdgcn_mfma_f32_32x32x16_bf16(kc[ks], qf[ks], acc, 0, 0, 0);
#pragma unroll
        for (int i = 0; i < 16; ++i) { const int row = (i & 3) + 8 * (i >> 2) + 4 * h; float sv = tv ? acc[i] : -1e30f;
            if (kt == 0 && row < r) sv = -1e30f;
            if (kt == 4 && row > r) sv = -1e30f;
            st[kt][i] = sv; mx = fmaxf(mx, sv); }
    }
    mx = fmaxf(mx, __shfl_xor(mx, 32));
    const float c = 0.08838834764831845f * 1.4426950408889634f, mc = mx * c; float ls = 0.f;
#pragma unroll
    for (int kt = 0; kt < 5; ++kt)
#pragma unroll
        for (int i = 0; i < 16; ++i) { const float p = __builtin_amdgcn_exp2f(st[kt][i] * c - mc); st[kt][i] = p; ls += p; }
    ls += __shfl_xor(ls, 32);
    f32x16 ot[4];
#pragma unroll
    for (int dt = 0; dt < 4; ++dt)
#pragma unroll
        for (int i = 0; i < 16; ++i) ot[dt][i] = 0.f;
    const bf16* vt = (const bf16*)(F.ws + WS_VT) + ((size_t)((b * 3 + g) * 4 + hh) * 128 + r) * 2048 + rho * Lc + 4 * h;
    v2u vn[2][4][2];
#define ATT_VLD(kt_) do { const int k0_ = i0 - 128 + 32 * (kt_), kc_ = k0_ >= 0 ? k0_ : 0; _Pragma("unroll") for (int sp = 0; sp < 2; ++sp) _Pragma("unroll") for (int dt = 0; dt < 4; ++dt) { \
            const bf16* vp = vt + (size_t)(32 * dt) * 2048 + kc_ + 16 * sp; vn[sp][dt][0] = *(const v2u*)vp; vn[sp][dt][1] = *(const v2u*)(vp + 8); } } while (0)
    ATT_VLD(0);
#pragma unroll
    for (int kt = 0; kt < 5; ++kt) {
        v2u vc[2][4][2];
#pragma unroll
        for (int sp = 0; sp < 2; ++sp)
#pragma unroll
            for (int dt = 0; dt < 4; ++dt) { vc[sp][dt][0] = vn[sp][dt][0]; vc[sp][dt][1] = vn[sp][dt][1]; }
        if (kt < 4) ATT_VLD(kt + 1);
#pragma unroll
        for (int sp = 0; sp < 2; ++sp) {
            v4u pu; pu.x = pk2(st[kt][8 * sp + 0], st[kt][8 * sp + 1]); pu.y = pk2(st[kt][8 * sp + 2], st[kt][8 * sp + 3]); pu.z = pk2(st[kt][8 * sp + 4], st[kt][8 * sp + 5]); pu.w = pk2(st[kt][8 * sp + 6], st[kt][8 * sp + 7]);
            const bf16x8 pf = __builtin_bit_cast(bf16x8, pu);
#pragma unroll
            for (int dt = 0; dt < 4; ++dt) {
                v4u vu; vu.x = vc[sp][dt][0].x; vu.y = vc[sp][dt][0].y; vu.z = vc[sp][dt][1].x; vu.w = vc[sp][dt][1].y;
                ot[dt] = __builtin_amdgcn_mfma_f32_32x32x16_bf16(__builtin_bit_cast(bf16x8, vu), pf, ot[dt], 0, 0, 0);
            }
        }
    }
#undef ATT_VLD
    const float inv = 1.f / ls; const size_t tok = (size_t)b * SEQ + (size_t)(i0 + r) * dil + rho;
    bf16* op = (bf16*)(F.ws + WS_OBG) + ((size_t)g * MV + tok) * 512 + hh * 128 + 4 * h;
#pragma unroll
    for (int dt = 0; dt < 4; ++dt)
#pragma unroll
        for (int g4 = 0; g4 < 4; ++g4) { v2u w; w.x = pk2(ot[dt][4 * g4] * inv, ot[dt][4 * g4 + 1] * inv); w.y = pk2(ot[dt][4 * g4 + 2] * inv, ot[dt][4 * g4 + 3] * inv); *(v2u*)(op + 32 * dt + 8 * g4) = w; }
    if (h == 0) *(f32x2*)((float*)(F.ws + WS_AST) + (((size_t)g * MV + tok) * 4 + hh) * 2) = (f32x2){mc, ls};
}


__device__ __forceinline__ void attn_sample_item(Frame& F0, int l, int item) {
    RELANE(F0);
    const int lane = F.lane, l16 = lane & 15;
    const int half = item & 1, it2 = item >> 1, g = it2 % 3, bt = it2 / 3, t = bt & 3, b = bt >> 2, dil = 1 << (2 * g), win = 128 * dil, jlo = half ? 65 : 0, part = g + 3 * half;
    const bf16* PROJ = (const bf16*)(F.ws + WS_PROJ);
    const int row = MP + DS * b + t;
    const float* cache = F.in[2 + g] + (size_t)(l * DB + b) * win * 1024 + 8 * lane;
    const bf16* newk = PROJ + (size_t)(MP + DS * b) * NIN + PC_KB + g * 512 + 8 * lane;
    float q[8]; unpack8(*(const v4u*)(PROJ + (size_t)row * NIN + PC_QB + g * 512 + 8 * lane), q);
    const int n_new = (g == 0) ? t + 1 : 1;
    const float c = 0.08838834764831845f * 1.4426950408889634f;
    float sc[5];
#pragma unroll
    for (int jr = 0; jr < 5; ++jr) {
        sc[jr] = -1e30f;
        const int jn = jr < 4 ? 16 : 1;
#pragma unroll 8
        for (int jl = 0; jl < jn; ++jl) {
            const int j = jlo + 16 * jr + jl, jc = j <= 128 ? j : 128; int idx = win + t - jc * dil; idx = idx < win ? idx : win - 1;
            const float* kp = cache + (size_t)idx * 1024; const f32x4 a = *(const f32x4*)kp, bq = *(const f32x4*)(kp + 4);
            float sv = (q[0] * a.x + q[1] * a.y) + (q[2] * a.z + q[3] * a.w) + (q[4] * bq.x + q[5] * bq.y) + (q[6] * bq.z + q[7] * bq.w);
            sv = j <= 128 ? row16_sum(sv) * c : -1e30f;
            sc[jr] = (l16 == jl) ? sv : sc[jr];
        }
    }
#pragma unroll
    for (int jj = 0; jj < 4; ++jj) {
        const int tk = t - jj >= 0 ? t - jj : 0; float k[8]; unpack8(*(const v4u*)(newk + (size_t)tk * NIN), k);
        float sv = (q[0] * k[0] + q[1] * k[1]) + (q[2] * k[2] + q[3] * k[3]) + (q[4] * k[4] + q[5] * k[5]) + (q[6] * k[6] + q[7] * k[7]);
        sv = row16_sum(sv) * c;
        sc[0] = (half == 0 && jj < n_new && l16 == jj) ? sv : sc[0];
    }
    float mx = -1e30f;
#pragma unroll
    for (int jr = 0; jr < 5; ++jr) mx = fmaxf(mx, sc[jr]);
    mx = fmaxf(mx, dpp_f<0xB1>(mx)); mx = fmaxf(mx, dpp_f<0x4E>(mx)); mx = fmaxf(mx, dpp_f<0x124>(mx)); mx = fmaxf(mx, dpp_f<0x128>(mx));
    float ls = 0.f;
#pragma unroll
    for (int jr = 0; jr < 5; ++jr) { sc[jr] = __builtin_amdgcn_exp2f(sc[jr] - mx); ls += sc[jr]; }
    ls = row16_sum(ls);
    float o[8];
#pragma unroll
    for (int e = 0; e < 8; ++e) o[e] = 0.f;
#pragma unroll
    for (int jj = 0; jj < 4; ++jj) {
        const int tk = t - jj >= 0 ? t - jj : 0; float vv[8]; unpack8(*(const v4u*)(newk + (size_t)tk * NIN + (PC_VB - PC_KB)), vv);
        const bool isnew = half == 0 && jj < n_new;
        const float p = isnew ? __shfl(sc[0], (lane & 48) | jj) : 0.f;
#pragma unroll
        for (int e = 0; e < 8; ++e) o[e] += p * vv[e];
        sc[0] = (isnew && l16 == jj) ? 0.f : sc[0];
    }
#pragma unroll
    for (int jr = 0; jr < 5; ++jr) {
        const int jn = jr < 4 ? 16 : 1;
#pragma unroll 8
        for (int jl = 0; jl < jn; ++jl) {
            const int j = jlo + 16 * jr + jl, jc = j <= 128 ? j : 128; int idx = win + t - jc * dil; idx = idx < win ? idx : win - 1;
            const float p = __shfl(sc[jr], (lane & 48) | jl);
            const float* vp = cache + (size_t)idx * 1024 + 512; const f32x4 a = *(const f32x4*)vp, bq = *(const f32x4*)(vp + 4);
            o[0] += p * a.x; o[1] += p * a.y; o[2] += p * a.z; o[3] += p * a.w; o[4] += p * bq.x; o[5] += p * bq.y; o[6] += p * bq.z; o[7] += p * bq.w;
        }
    }
    const float inv = 1.f / ls;
#pragma unroll
    for (int e = 0; e < 8; ++e) o[e] *= inv;
    *(v4u*)((bf16*)(F.ws + WS_OBG) + ((size_t)part * MV + row) * 512 + 8 * lane) = pack8(o);
    if (l16 == 0) *(f32x2*)((float*)(F.ws + WS_AST) + (((size_t)part * MV + row) * 4 + (lane >> 4)) * 2) = (f32x2){mx, ls};
}

__device__ __forceinline__ void gdn_gate_rows(Frame& F0, int l) {
    RELANE(F0);
    const int lane = F.lane, gw = F.vcu * NWAVES + F.wave, NGW = F.G * NWAVES;
    const float* ORAW = (const float*)(F.ws + WS_ORAW); const bf16* PROJ = (const bf16*)(F.ws + WS_PROJ); bf16* OUTA = (bf16*)(F.ws + WS_OUTA);
    const float* gain = F.in[12] + (size_t)l * 128;
    for (int r = gw; r < MV; r += NGW) {
#pragma unroll
        for (int j = 0; j < 4; ++j) {
            const int c0 = 256 * j + 4 * lane; const f32x4 o = *(const f32x4*)(ORAW + (size_t)r * 1024 + c0);
            float ss = (o.x * o.x + o.y * o.y) + (o.z * o.z + o.w * o.w);
            ss += __shfl_xor(ss, 1); ss += __shfl_xor(ss, 2); ss += __shfl_xor(ss, 4); ss += __shfl_xor(ss, 8); ss += __shfl_xor(ss, 16);
            const float rstd = rsqrtf(ss * (1.f / 128.f) + EPS);
            const f32x4 g = *(const f32x4*)(gain + (c0 & 127)); const v2u zu = *(const v2u*)(PROJ + (size_t)r * NIN + PC_ZA + c0);
            const float z0 = bf_lo(zu.x), z1 = bf_hi(zu.x), z2 = bf_lo(zu.y), z3 = bf_hi(zu.y);
            v2u w; w.x = pk2(o.x * rstd * g.x * silu(z0), o.y * rstd * g.y * silu(z1)); w.y = pk2(o.z * rstd * g.z * silu(z2), o.w * rstd * g.w * silu(z3));
            *(v2u*)(OUTA + (size_t)r * 1024 + c0) = w;
        }
        {
            const int c0 = 8 * lane, hh = lane >> 4; const float* ast = (const float*)(F.ws + WS_AST); const bf16* obg = (const bf16*)(F.ws + WS_OBG);
            const int np = r < MP ? 3 : 6;
            f32x2 sg[6]; v4u xo[6]; float M = -1e30f;
#pragma unroll
            for (int g = 0; g < 6; ++g) { const int gg = g < np ? g : 0; sg[g] = *(const f32x2*)(ast + (((size_t)gg * MV + r) * 4 + hh) * 2); xo[g] = *(const v4u*)(obg + ((size_t)gg * MV + r) * 512 + c0); }
#pragma unroll
            for (int g = 0; g < 6; ++g) { if (g >= np) sg[g] = (f32x2){-1e30f, 0.f}; M = fmaxf(M, sg[g].x); }
            float wg[6], den = 0.f;
#pragma unroll
            for (int g = 0; g < 6; ++g) { wg[g] = __builtin_amdgcn_exp2f(sg[g].x - M) * sg[g].y; den += wg[g]; }
            const float inv = 1.f / den; float o[8];
#pragma unroll
            for (int e = 0; e < 8; ++e) o[e] = 0.f;
#pragma unroll
            for (int g = 0; g < 6; ++g) { float x[8]; unpack8(xo[g], x); const float w = wg[g] * inv;
#pragma unroll
                for (int e = 0; e < 8; ++e) o[e] += w * x[e]; }
            *(v4u*)((bf16*)(F.ws + WS_OUTB) + (size_t)r * 512 + c0) = pack8(o);
        }
    }
}


constexpr int CP_PER_B = 31 + 127 + 511, CP_NSUB = DB * CP_PER_B;
constexpr int CP_TAIL_WG = 84, CP_TAIL_PER_WG = 64, CP_TAIL = CP_TAIL_WG * CP_TAIL_PER_WG;
__device__ __forceinline__ void copy_subchunk(Frame& F, int l, int c) {
    const int lane = F.lane, b = c / CP_PER_B, rc = c % CP_PER_B; const int gi = rc < 31 ? 0 : rc < 158 ? 1 : 2, k = rc - (gi == 0 ? 0 : gi == 1 ? 31 : 158), win = 128 << (2 * gi);
    const f32x4* src = (const f32x4*)(F.in[2 + gi] + ((size_t)(l * DB + b) * win + DS + 4 * k) * 1024) + lane;
    f32x4* dst = (f32x4*)(F.out + (gi == 0 ? O_SW1 : gi == 1 ? O_SW2 : O_SW3) + ((size_t)(l * DB + b) * win + 4 * k) * 1024) + lane;
    f32x4 v[16];
#pragma unroll
    for (int i = 0; i < 16; ++i) v[i] = __builtin_nontemporal_load(src + 64 * i);
#pragma unroll
    for (int i = 0; i < 16; ++i) __builtin_nontemporal_store(v[i], dst + 64 * i);
}
__device__ __forceinline__ void side_queue(Frame& F0, int l, volatile LAS unsigned* qctr) {
    RELANE(F0);
    const int lane = F.lane;
    const int nsub = CP_NSUB - (F.G == 256 ? CP_TAIL : 0);
    const int ncp = (nsub - (int)blockIdx.x + F.G - 1) / F.G;
    const int wper = 0,     w0 = (int)blockIdx.x * wper, nw = max(0, min(IT_LAYER, w0 + wper) - w0);
    LAS float* scr = (LAS float*)F.lds;
    for (;;) {
        unsigned q = 0; if (lane == 0) q = __hip_atomic_fetch_add((LAS unsigned*)qctr, 1u, __ATOMIC_RELAXED, __HIP_MEMORY_SCOPE_WORKGROUP);
        q = (unsigned)__builtin_amdgcn_readfirstlane((int)q);
        if ((int)q >= ncp + nw) break;
        if ((int)q < ncp) { copy_subchunk(F, l, (int)q * F.G + (int)blockIdx.x);
        } else weight_item(F, l + 1, w0 + (int)q - ncp, scr);
    }
}


__device__ __forceinline__ f32x16 skinny_kloop(const bf16* ap, const bf16* bp, int nks, f32x16 acc) {
    int ks = 0;
    for (; ks + 8 <= nks; ks += 8) { bf16x8 a[8], b[8];
#pragma unroll
        for (int u = 0; u < 8; ++u) { a[u] = *(const bf16x8*)(ap + 16 * (ks + u)); b[u] = *(const bf16x8*)(bp + 16 * (ks + u)); }
#pragma unroll
        for (int u = 0; u < 8; ++u) acc = __builtin_amdgcn_mfma_f32_32x32x16_bf16(a[u], b[u], acc, 0, 0, 0); }
    for (; ks < nks; ks += 4) { bf16x8 a[4], b[4];
#pragma unroll
        for (int u = 0; u < 4; ++u) { a[u] = *(const bf16x8*)(ap + 16 * (ks + u)); b[u] = *(const bf16x8*)(bp + 16 * (ks + u)); }
#pragma unroll
        for (int u = 0; u < 4; ++u) acc = __builtin_amdgcn_mfma_f32_32x32x16_bf16(a[u], b[u], acc, 0, 0, 0); }
    return acc;
}
__device__ __forceinline__ f32x2 skinny_reduce(Frame& F, const f32x16& acc) {
    LAS float* P = (LAS float*)F.lds; const int r = F.lane & 31, h = F.lane >> 5;
    __syncthreads();
#pragma unroll
    for (int i = 0; i < 16; ++i) P[(F.wave * 32 + (i & 3) + 8 * (i >> 2) + 4 * h) * 33 + r] = acc[i];
    __syncthreads();
    const int row = F.tid >> 4, col = 2 * (F.tid & 15); f32x2 o = {0.f, 0.f};
#pragma unroll
    for (int w = 0; w < 8; ++w) { o.x += P[(w * 32 + row) * 33 + col]; o.y += P[(w * 32 + row) * 33 + col + 1]; }
    return o;
}
__device__ __forceinline__ void skinny_store(Frame& F0, const bf16* A, int lda, const bf16* Bt, int K, bf16* O) {
    RELANE(F0);
    const int r = F.lane & 31, h = F.lane >> 5, kw = K / 8;
    for (int unit = launder_s((int)blockIdx.x); unit < 256; unit += F.G) {
        const int mt = unit >> 6, nt = unit & 63;
        f32x16 acc;
#pragma unroll
        for (int i = 0; i < 16; ++i) acc[i] = 0.f;
        acc = skinny_kloop(A + (size_t)(MP + 32 * mt + r) * lda + F.wave * kw + 8 * h, Bt + (size_t)(32 * nt + r) * K + F.wave * kw + 8 * h, kw / 16, acc);
        const f32x2 o = skinny_reduce(F, acc);
        *(unsigned*)(O + (size_t)(MP + 32 * mt + (F.tid >> 4)) * D + 32 * nt + 2 * (F.tid & 15)) = pk2(o.x, o.y);
    }
}
__device__ __forceinline__ void skinny_merge(Frame& F0, const unsigned char* wl) {
    RELANE(F0);
    const int r = F.lane & 31, h = F.lane >> 5; const bf16* PROJ = (const bf16*)(F.ws + WS_PROJ);
    for (int unit = launder_s((int)blockIdx.x); unit < 256; unit += F.G) {
        const int mt = unit >> 6, nt = unit & 63;
        f32x16 tot;
#pragma unroll
        for (int i = 0; i < 16; ++i) tot[i] = 0.f;
#pragma unroll
        for (int br = 0; br < 3; ++br) {
            const int K = br == 1 ? 512 : 1024, kw = K / 8;
            const bf16* A = (const bf16*)(F.ws + (br == 0 ? WS_OUTA : br == 1 ? WS_OUTB : WS_OC)); const bf16* Bt = (const bf16*)(wl + (br == 0 ? WO_BRA : br == 1 ? WO_BRB : WO_BRC));
            f32x16 acc;
#pragma unroll
            for (int i = 0; i < 16; ++i) acc[i] = 0.f;
            acc = skinny_kloop(A + (size_t)(MP + 32 * mt + r) * K + F.wave * kw + 8 * h, Bt + (size_t)(32 * nt + r) * K + F.wave * kw + 8 * h, kw / 16, acc);
            const bf16* gp = PROJ + (size_t)(MP + 32 * mt + 4 * h) * NIN + PC_GATE + br * 2048 + 32 * nt + r;
#pragma unroll
            for (int i = 0; i < 16; ++i) tot[i] += acc[i] * bf1(gp[(size_t)((i & 3) + 8 * (i >> 2)) * NIN]);
        }
        const f32x2 o = skinny_reduce(F, tot);
        *(unsigned*)((bf16*)(F.ws + WS_MERGED) + (size_t)(MP + 32 * mt + (F.tid >> 4)) * D + 32 * nt + 2 * (F.tid & 15)) = pk2(o.x, o.y);
    }
}

constexpr int N_PHASES = 1 + 11 * DEPTH;
__global__ void __launch_bounds__(NWAVES * 64, 2) fwd(Args args) {
    extern __shared__ __attribute__((aligned(16))) unsigned char lds_raw[];
    Frame F;
    F.lds = (LAS unsigned char*)lds_raw;
    F.tid = threadIdx.x; F.lane = F.tid & 63; F.wave = __builtin_amdgcn_readfirstlane(F.tid >> 6);
    F.G = gridDim.x; { const int bx = blockIdx.x; F.vcu = (F.G % 8 == 0) ? (bx % 8) * (F.G / 8) + bx / 8 : bx; }
    const CAS Args* const ap = (const CAS Args*)__builtin_amdgcn_kernarg_segment_ptr();
    F.in = ap->in; F.out = args.out; F.ws = args.ws;
    volatile LAS unsigned* MISC = (volatile LAS unsigned*)(F.lds + MISC_OFF);
    for (int u = F.tid; u < (LDS_BYTES - LDSCTL_OFF) / 4; u += NWAVES * 64) ((LAS unsigned*)(F.lds + LDSCTL_OFF))[u] = 0u;
    __syncthreads();
#if MK_ONE_LAUNCH
    XcdBarrier bar = xcd_barrier_post((unsigned*)(F.ws + WS_CTL) + CW_BAR, MISC + 8);
#define GRID_BAR() xcd_barrier(bar)
#else
#define GRID_BAR() do {} while (0)
#endif
    const int lo = args.ph_lo, hi = args.ph_hi;
#ifndef PHMASK
#define PHMASK 0xfff
#endif
#define IN(k) (lo <= (k) && (k) < hi)
#define EN(j) ((PHMASK >> (j)) & 1)
#ifndef REPMASK
#define REPMASK 0
#endif
#ifndef SUBREP
#define SUBREP 0
#endif
#define SUBR(j) for (int sr_ = 0; sr_ < 1 + ((SUBREP >> (j)) & 1); ++sr_)
#define REPEAT(j) for (int rep_ = 0; rep_ < 1 + ((REPMASK >> (j)) & 1); ++rep_)
#define REPBAR() do { if (rep_) GRID_BAR(); F.ws = launder_p(args.ws); F.out = launder_p(args.out); F.in = launder_k(ap->in); F.vcu = launder_s(vcu0); F.wave = launder_s(wave0); gw = F.vcu * NWAVES + F.wave; } while (0)
#define SEAM(k) do { if (IN(k) && IN((k) + 1)) GRID_BAR(); } while (0)
    const int vcu0 = F.vcu, wave0 = F.wave; int gw = F.vcu * NWAVES + F.wave; const int NGW = F.G * NWAVES;
    bf16* const H = (bf16*)(F.ws + WS_H); bf16* const PROJ = (bf16*)(F.ws + WS_PROJ);

    if (EN(0) && IN(0)) REPEAT(0) { REPBAR();
        LAS float* scr = (LAS float*)(F.lds + F.wave * 16384);
        for (int it = gw; it < 2 * IT_LAYER; it += NGW) { const int l = it >= IT_LAYER ? 1 : 0; weight_item(F, l, it - l * IT_LAYER, scr); }
        __syncthreads();
        stage_wba(F, 0);
        thin_rows<true>(F, F.in[0], F.in[1], nullptr, nullptr, nullptr, F.in[21], true, 0);
        __syncthreads();
    }
    SEAM(0);
#pragma unroll 1
    for (int l = 0; l < DEPTH; ++l) {
        const int pb = 1 + 11 * l;
        unsigned char* wl = F.ws + WS_W + (size_t)l * WL_BYTES;
        if (EN(1) && IN(pb + 0)) REPEAT(1) { REPBAR();
            pg8::Gemm g{H, (const bf16*)(wl + WO_IN), D, D, D, 0}; pg8::StaticOrder S; S.init(MT, NIN, launder_s(F.G), launder_s((int)blockIdx.x));
            EpiStore E{PROJ, NIN, PC_GATE / 256};
            pg8::gemm_phase<EpiStore, pg8::StaticOrder>(F.lds, g, S, E);
        }
        SEAM(pb + 0);
        if (EN(2) && IN(pb + 1)) REPEAT(2) { REPBAR(); for (int it = gw; it < PREP_ITEMS; it += NGW) prep_item(F, l, it); prep_out_rows(F, l); for (int it = gw; it < VT_ITEMS; it += NGW) vt_item(F, it); }
        SEAM(pb + 1);
        if (EN(3) && IN(pb + 2)) REPEAT(3) { REPBAR(); for (int it = gw; it < GCH; it += NGW) gdn_ga_item(F, it); }
        SEAM(pb + 2);
        if (EN(4) && IN(pb + 3)) REPEAT(4) { REPBAR();
            if (F.tid == 0) MISC[16] = 0u;
            { pg8::Gemm g{(const bf16*)(F.ws + WS_POOLED), (const bf16*)(wl + WO_POOL), 1024, 256, 256, 512}; pg8::StaticOrder S; S.init(MT, 1024, launder_s(F.G), launder_s((int)blockIdx.x));
              EpiStore E{(bf16*)(F.ws + WS_OC), 1024, 1 << 30};
              pg8::gemm_phase<EpiStore, pg8::StaticOrder>(F.lds, g, S, E); }
            SUBR(3) for (int it = gw; it < DB * HA * 8; it += NGW) { const int s = it & 7, bh = it >> 3, b = bh >> 3, h = bh & 7;
                gdn_scan_item(F, MP + DS * b, h, s, F.in[5] + (size_t)((l * DB + b) * HA + h) * 16384, F.out + O_SGDN + (size_t)((l * DB + b) * HA + h) * 16384); }
            {
                const bool scanw = (F.wave == 0) && (F.vcu < GSC_ITEMS);
                if (scanw) { SUBR(0) gdn_chunk_scan(F, l, F.vcu); }
                else {
                    const int aw = F.vcu < GSC_ITEMS ? F.vcu * 7 + F.wave - 1 : GSC_ITEMS * 7 + (F.vcu - GSC_ITEMS) * 8 + F.wave, naw = F.G * 8 - GSC_ITEMS;
                    SUBR(1) for (int it = aw; it < ATT_UNITS; it += naw) attn_unit(F, it);
                    SUBR(2) for (int it = aw; it < MS * 6; it += naw) attn_sample_item(F, l, it);
                }
            }
            side_queue(F, l, MISC + 16);
        }
        SEAM(pb + 3);
        if (EN(5) && IN(pb + 4)) REPEAT(5) { REPBAR(); gdn_gate_rows(F, l); }
        SEAM(pb + 4);
        if (EN(6) && IN(pb + 5)) REPEAT(6) { REPBAR();
            pg8::StaticOrder S; S.init(MP, D, launder_s(F.G), launder_s((int)blockIdx.x)); bf16* MG = (bf16*)(F.ws + WS_MERGED);
            { pg8::Gemm g{(const bf16*)(F.ws + WS_OUTA), (const bf16*)(wl + WO_BRA), 1024, 1024, 1024, 0}; EpiMerge<false> E{MG, PROJ + PC_GATE}; pg8::gemm_phase<EpiMerge<false>, pg8::StaticOrder>(F.lds, g, S, E); }
            { pg8::Gemm g{(const bf16*)(F.ws + WS_OUTB), (const bf16*)(wl + WO_BRB), 512, 512, 512, 0}; EpiMerge<true> E{MG, PROJ + PC_GATE + 2048}; pg8::gemm_phase<EpiMerge<true>, pg8::StaticOrder>(F.lds, g, S, E); }
            { pg8::Gemm g{(const bf16*)(F.ws + WS_OC), (const bf16*)(wl + WO_BRC), 1024, 1024, 1024, 0}; EpiMerge<true> E{MG, PROJ + PC_GATE + 4096}; pg8::gemm_phase<EpiMerge<true>, pg8::StaticOrder>(F.lds, g, S, E); }
            skinny_merge(F, wl);
        }
        SEAM(pb + 5);
        if (EN(7) && IN(pb + 6)) REPEAT(7) { REPBAR();
            pg8::Gemm g{(const bf16*)(F.ws + WS_MERGED), (const bf16*)(wl + WO_OUT), D, D, D, 0}; pg8::StaticOrder S; S.init(MP, D, launder_s(F.G), launder_s((int)blockIdx.x));
            EpiStore E{(bf16*)(F.ws + WS_Y), D, 1 << 30};
            pg8::gemm_phase<EpiStore, pg8::StaticOrder>(F.lds, g, S, E);
            skinny_store(F, (const bf16*)(F.ws + WS_MERGED), D, (const bf16*)(wl + WO_OUT), D, (bf16*)(F.ws + WS_Y));
        }
        SEAM(pb + 6);
        if (EN(8) && IN(pb + 7)) REPEAT(8) { REPBAR();
            thin_rows<false>(F, nullptr, nullptr, (const bf16*)(F.ws + WS_Y), F.in[22] + (size_t)l * D, nullptr, F.in[23] + (size_t)l * D, false, 0, 0);
        }
        SEAM(pb + 7);
        if (EN(9) && IN(pb + 8)) REPEAT(9) { REPBAR();
            pg8::Gemm g{H, (const bf16*)(wl + WO_GU), D, D, D, 0}; pg8::StaticOrder S; S.init(MT, 2 * DFF, launder_s(F.G), launder_s((int)blockIdx.x));
            EpiSwiglu E{(bf16*)(F.ws + WS_ACT)};
            pg8::gemm_phase<EpiSwiglu, pg8::StaticOrder>(F.lds, g, S, E);
            const int bxl = launder_s((int)blockIdx.x), Gl = launder_s(F.G);
            if (Gl == 256 && bxl >= 256 - CP_TAIL_WG) {
                Frame Fc = F; Fc.lane = launder(F.lane);
                const int base = CP_NSUB - CP_TAIL + (bxl - (256 - CP_TAIL_WG)) * CP_TAIL_PER_WG;
                for (int q = F.wave; q < CP_TAIL_PER_WG; q += NWAVES) copy_subchunk(Fc, 1 - l, base + q);
            }
        }
        SEAM(pb + 8);
        if (EN(10) && IN(pb + 9)) REPEAT(10) { REPBAR();
            pg8::Gemm g{(const bf16*)(F.ws + WS_ACT), (const bf16*)(wl + WO_DOWN), DFF, DFF, DFF, 0}; pg8::StaticOrder S; S.init(MP, D, launder_s(F.G), launder_s((int)blockIdx.x));
            EpiStore E{(bf16*)(F.ws + WS_Y), D, 1 << 30};
            pg8::gemm_phase<EpiStore, pg8::StaticOrder>(F.lds, g, S, E);
            skinny_store(F, (const bf16*)(F.ws + WS_ACT), DFF, (const bf16*)(wl + WO_DOWN), DFF, (bf16*)(F.ws + WS_Y));
        }
        SEAM(pb + 9);
        if (EN(11) && IN(pb + 10)) REPEAT(11) { REPBAR();
            if (l + 1 < DEPTH) { stage_wba(F, l + 1);
                thin_rows<false>(F, nullptr, nullptr, (const bf16*)(F.ws + WS_Y), F.in[24] + (size_t)l * D, nullptr, F.in[21] + (size_t)(l + 1) * D, true, l + 1, 0);
                __syncthreads(); }
            else thin_rows<false>(F, nullptr, nullptr, (const bf16*)(F.ws + WS_Y), F.in[24] + (size_t)l * D, F.out + O_YP, nullptr, false, 0, 0);
        }
        SEAM(pb + 10);
    }
#undef IN
#undef SEAM
}

extern "C" void kernel_launch(void* const* d_in, const int* in_sizes, int n_in, void* d_out, int out_size, void* d_ws, size_t ws_size, hipStream_t stream) {
    static int grid = 0;
    if (grid == 0) {
        if (n_in != 25 || (size_t)out_size != O_END || ws_size < WS_END) { fprintf(stderr, "kernel_launch: unexpected sizes n_in %d out %d ws %zu\n", n_in, out_size, ws_size); grid = -1; return; }
        int dev = 0, cus = 0, per_cu = 0;
        if (hipGetDevice(&dev) != hipSuccess || hipDeviceGetAttribute(&cus, hipDeviceAttributeMultiprocessorCount, dev) != hipSuccess) { grid = -1; return; }
        if (hipFuncSetAttribute((const void*)fwd, hipFuncAttributeMaxDynamicSharedMemorySize, LDS_BYTES) != hipSuccess) { fprintf(stderr, "kernel_launch: hipFuncSetAttribute failed\n"); grid = -1; return; }
        if (hipOccupancyMaxActiveBlocksPerMultiprocessor(&per_cu, (const void*)fwd, NWAVES * 64, LDS_BYTES) != hipSuccess || per_cu < 1) fprintf(stderr, "kernel_launch: occupancy query says %d\n", per_cu);
        (void)hipGetLastError();
        grid = cus;
    }
    if (grid < 0) return;
    if (hipMemsetAsync((char*)d_ws + WS_CTL, 0, CTL_BYTES, stream) != hipSuccess) return;
    Args a{};
    for (int i = 0; i < 25; ++i) a.in[i] = (const float*)d_in[i];
    a.out = (float*)d_out; a.ws = (unsigned char*)d_ws;
#if MK_ONE_LAUNCH
    a.ph_lo = 0; a.ph_hi = N_PHASES;
    hipLaunchKernelGGL(fwd, dim3(grid), dim3(NWAVES * 64), LDS_BYTES, stream, a);
#else
    for (int p = 0; p < N_PHASES; ++p) { a.ph_lo = p; a.ph_hi = p + 1; hipLaunchKernelGGL(fwd, dim3(grid), dim3(NWAVES * 64), LDS_BYTES, stream, a); }
#endif
}
```

```cpp
#include <hip/hip_runtime.h>
#include <cstdio>
#include <cstdint>

#ifndef MK_ONE_LAUNCH
#define MK_ONE_LAUNCH 1
#endif

#define GAS __attribute__((address_space(1)))
#define CAS __attribute__((address_space(4)))
typedef const float* cfp_t;
#define LAS __attribute__((address_space(3)))
typedef unsigned short bf16;
typedef unsigned v4u __attribute__((ext_vector_type(4)));
typedef unsigned v2u __attribute__((ext_vector_type(2)));
typedef float f32x4 __attribute__((ext_vector_type(4)));
typedef float f32x2 __attribute__((ext_vector_type(2)));
typedef short bf16x8 __attribute__((ext_vector_type(8)));
typedef float f32x16 __attribute__((ext_vector_type(16)));

constexpr int D = 2048, BATCH = 4, SEQ = 2048, DEPTH = 2, DB = 32, DS = 4;
constexpr int MP = BATCH * SEQ;
constexpr int MS = DB * DS;
constexpr int MV = MP + MS;
constexpr int MT = 8448;
constexpr int HA = 8, CONVCH = 3072;
constexpr int CPOOL = 1024, PHIST = 15;
constexpr int DFF = 5632;
constexpr int NIN_SRC = 15888, NIN = 15872;
constexpr int PC_ZA = 3072, PC_QB = 4096, PC_KB = 5632, PC_VB = 7168, PC_UC = 8704, PC_GATE = 9728;
constexpr float EPS = 1e-6f;
constexpr size_t O_YP = 0, O_YS = O_YP + (size_t)MP * D, O_PW1 = O_YS + (size_t)MS * D;
constexpr size_t O_PW2 = O_PW1 + (size_t)2 * 4 * 128 * 1024, O_PW3 = O_PW2 + (size_t)2 * 4 * 512 * 1024, O_PGDN = O_PW3 + (size_t)2 * 4 * 2048 * 1024;
constexpr size_t O_PCONV = O_PGDN + (size_t)2 * 4 * 8 * 16384, O_PPOOL = O_PCONV + (size_t)2 * 4 * 3 * 3072, O_SW1 = O_PPOOL + (size_t)2 * 4 * 15 * 1024;
constexpr size_t O_SW2 = O_SW1 + (size_t)2 * 32 * 128 * 1024, O_SW3 = O_SW2 + (size_t)2 * 32 * 512 * 1024, O_SGDN = O_SW3 + (size_t)2 * 32 * 2048 * 1024;
constexpr size_t O_SCONV = O_SGDN + (size_t)2 * 32 * 8 * 16384, O_SPOOL = O_SCONV + (size_t)2 * 32 * 3 * 3072, O_END = O_SPOOL + (size_t)2 * 32 * 15 * 1024;
static_assert(O_END == 226426880ull, "output size");

constexpr size_t WS_CTL = 0, CTL_BYTES = 1u << 20;
constexpr size_t SZ_WIN = (size_t)NIN * D * 2, SZ_WBRA = (size_t)D * 1024 * 2, SZ_WBRB = (size_t)D * 512 * 2, SZ_WBRC = (size_t)D * 1024 * 2, SZ_WPOOL = (size_t)4 * 256 * 256 * 2;
constexpr size_t SZ_WOUT = (size_t)D * D * 2, SZ_WGU = (size_t)2 * DFF * D * 2, SZ_WDOWN = (size_t)D * DFF * 2;
constexpr size_t WO_IN = 0, WO_BRA = WO_IN + SZ_WIN, WO_BRB = WO_BRA + SZ_WBRA, WO_BRC = WO_BRB + SZ_WBRB, WO_POOL = WO_BRC + SZ_WBRC, WO_OUT = WO_POOL + SZ_WPOOL;
constexpr size_t WO_GU = WO_OUT + SZ_WOUT, WO_DOWN = WO_GU + SZ_WGU, WL_BYTES = WO_DOWN + SZ_WDOWN;
constexpr size_t WS_W = CTL_BYTES;
constexpr size_t WS_H = WS_W + 2 * WL_BYTES;
constexpr size_t WS_PROJ = WS_H + (size_t)MT * D * 2;
constexpr size_t WS_GB = WS_PROJ + (size_t)MT * NIN * 2;
constexpr size_t WS_TOK = WS_GB + (size_t)MT * 16 * 4;
constexpr size_t WS_QN = WS_TOK + (size_t)MT * 8 * 16;
constexpr size_t WS_KN = WS_QN + (size_t)MT * 1024 * 2;
constexpr size_t WS_VV = WS_KN + (size_t)MT * 1024 * 2;
constexpr size_t WS_ORAW = WS_VV + (size_t)MT * 1024 * 2;
constexpr size_t WS_POOLED = WS_ORAW + (size_t)MT * 1024 * 4;
constexpr size_t WS_OUTA = WS_POOLED + (size_t)MT * 1024 * 2;
constexpr size_t WS_OUTB = WS_OUTA + (size_t)MT * 1024 * 2;
constexpr size_t WS_OC = WS_OUTB + (size_t)MT * 512 * 2;
constexpr size_t WS_MERGED = WS_OC + (size_t)MT * 1024 * 2;
constexpr size_t WS_Y = WS_MERGED + (size_t)MT * D * 2;
constexpr size_t WS_X1 = WS_Y + (size_t)MT * D * 2;
constexpr size_t WS_X2 = WS_X1 + (size_t)MT * D * 4;
constexpr size_t WS_ACT = WS_X2 + (size_t)MT * D * 4;
constexpr size_t WS_VT = WS_ACT + (size_t)MT * DFF * 2;
constexpr size_t WS_OBG = WS_VT + (size_t)BATCH * 3 * 4 * 128 * 2048 * 2;
constexpr size_t WS_AST = WS_OBG + (size_t)6 * MV * 512 * 2;
constexpr int GCH = BATCH * HA * (SEQ / 32);
constexpr size_t WS_WF = WS_AST + (size_t)6 * MV * 4 * 8;
constexpr size_t WS_KF = WS_WF + (size_t)GCH * 8192;
constexpr size_t WS_UF = WS_KF + (size_t)GCH * 8192;
constexpr size_t WS_AF = WS_UF + (size_t)GCH * 16384;
constexpr size_t WS_TB = WS_AF + (size_t)GCH * 2048;
constexpr size_t WS_QF = WS_TB + (size_t)GCH * 128;
constexpr size_t WS_XCH = WS_QF + (size_t)GCH * 8192;
constexpr size_t WS_END = WS_XCH + (size_t)4 * 32 * 256 * 8 * 16;
static_assert(WS_END < 2000000000ull, "workspace");

namespace pg8 {
#define PG8_LAS __attribute__((address_space(3)))
typedef unsigned short bf16_t;
typedef unsigned u32x4 __attribute__((ext_vector_type(4)));
constexpr int BM = 256, BK = 64, HALF = 128, HTB = HALF * BK * 2, STAGE_BYTES = 8 * HTB, NXCD = 8, WGM = 8;
__host__ __device__ __forceinline__ int lds_byte(int r, int c) { const int st = (r >> 4) * 2 + (c >> 5), rr = r & 15, cc = c & 31, ob = rr * 64 + cc * 2; return st * 1024 + (ob ^ (((ob >> 9) & 1) << 5)); }
__host__ __device__ __forceinline__ void stage_rc(int b, int& R, int& C) { const int st = b / 1024, sb = b % 1024, swz = sb ^ (((sb >> 9) & 1) << 5); R = (st >> 1) * 16 + swz / 64; C = (st & 1) * 32 + (swz % 64) / 2; }
__host__ __device__ __forceinline__ int perm32(int rho) { const int n = rho >> 4, i = rho & 15; return 8 * (i >> 2) + 4 * n + (i & 3); }
struct Unit { int pm, pn; };
struct Gemm { const bf16_t* A; const bf16_t* Bt; int lda, ldb, K; int a_pn_step; };
struct StaticOrder {
    int nM, nN, nwg, G, c;
    __host__ __device__ void init(int M, int N, int G_, int c_) { nM = M / BM; nN = N / BM; nwg = nM * nN; G = G_; c = c_; }
    __host__ __device__ bool next(int i, Unit& u) const {
        const long L = (long)i * G + c; if (L >= nwg) return false;
        int wgid = (int)L; { const int q = nwg / NXCD, r = nwg % NXCD, xcd = wgid % NXCD, off = wgid / NXCD; wgid = (xcd < r ? xcd * (q + 1) : r * (q + 1) + (xcd - r) * q) + off; }
        const int nig = WGM * nN, gid = wgid / nig, fm = gid * WGM, gsz = (nM - fm) < WGM ? (nM - fm) : WGM;
        u.pm = fm + ((wgid % nig) % gsz); u.pn = (wgid % nig) / gsz; return true;
    }
    __device__ __forceinline__ void a_ready(const Unit&) const {}
    __device__ __forceinline__ void done(const Unit&) const {}
};
__device__ __forceinline__ unsigned cvt_pk_bf16(float lo, float hi) { unsigned r; asm volatile("v_cvt_pk_bf16_f32 %0, %1, %2" : "=v"(r) : "v"(lo), "v"(hi)); return r; }

template <class Epi, class Sched, bool ALIGN_EPI = true>
__device__ __forceinline__ void gemm_phase(PG8_LAS unsigned char* lds, const Gemm g, const Sched& S, const Epi& E) {
    int tid = threadIdx.x; asm volatile("" : "+v"(tid));
    const int wid = __builtin_amdgcn_readfirstlane(tid >> 6), lane = tid & 63, wr = wid >> 2, wc = wid & 3, fr = lane & 15, fq = lane >> 4;
    int K = g.K; asm volatile("" : "+s"(K));
    const int nt = K / BK;
    unsigned voffA[2], voffB[2];
#pragma unroll
    for (int i = 0; i < 2; ++i) { int R, C; stage_rc(tid * 16 + i * 8192, R, C); const int Rb = ((R & ~31) + perm32(R & 31));
        voffA[i] = (unsigned)(R * g.lda + C) * 2u; voffB[i] = (unsigned)(Rb * g.ldb + C) * 2u; }
    const size_t kstep = (size_t)(BK * 2);
    const size_t hstepA = (size_t)HALF * g.lda * 2, hstepB = (size_t)HALF * g.ldb * 2;
    const size_t tstepA = 2 * hstepA, tstepB = 2 * hstepB;
    const unsigned ldsw = (unsigned)wid * 1024u;
    const int aoff = lds_byte(wr * 64 + fr, fq * 8), boff = lds_byte(wc * 32 + fr, fq * 8);
#define PG8_SA(b, h) (((b) * 2 + (h)) * HTB)
#define PG8_SB(b, h) ((4 + (b) * 2 + (h)) * HTB)
#define PG8_STAGE(bufoff, gbase, voff) do { _Pragma("unroll") for (int _i = 0; _i < 2; ++_i) \
        __builtin_amdgcn_global_load_lds((const unsigned*)((const char*)(gbase) + (voff)[_i]), (PG8_LAS unsigned*)(lds + (bufoff) + ldsw + _i * 8192), 16, 0, 0); } while (0)
#define PG8_LDA(dst, b, h) do { _Pragma("unroll") for (int m = 0; m < 4; ++m) _Pragma("unroll") for (int k = 0; k < 2; ++k) dst[m][k] = *(const PG8_LAS bf16x8*)(lds + PG8_SA(b, h) + aoff + m * 2048 + k * 1024); } while (0)
#define PG8_LDB(dst, b, h) do { _Pragma("unroll") for (int n = 0; n < 2; ++n) _Pragma("unroll") for (int k = 0; k < 2; ++k) dst[n][k] = *(const PG8_LAS bf16x8*)(lds + PG8_SB(b, h) + boff + n * 2048 + k * 1024); } while (0)
#define PG8_MMA(ai, bj, At, Bt) do { __builtin_amdgcn_s_setprio(1); _Pragma("unroll") for (int m = 0; m < 4; ++m) _Pragma("unroll") for (int n = 0; n < 2; ++n) _Pragma("unroll") for (int k = 0; k < 2; ++k) \
        acc[ai][bj][m][n] = __builtin_amdgcn_mfma_f32_16x16x32_bf16(Bt[n][k], At[m][k], acc[ai][bj][m][n], 0, 0, 0); __builtin_amdgcn_s_setprio(0); } while (0)
#define PG8_WAIT_V(n) asm volatile("s_waitcnt vmcnt(" #n ")" ::: "memory")
#define PG8_WAIT_L(n) asm volatile("s_waitcnt lgkmcnt(" #n ")" ::: "memory")
#define PG8_BAR __builtin_amdgcn_s_barrier()
#define PG8_SCHED __builtin_amdgcn_sched_barrier(0)
    Unit cur, nxt; int ui = 0;
    if (!S.next(0, cur)) return;
    f32x4 acc[2][2][4][2];
#pragma unroll
    for (int a = 0; a < 2; ++a)
#pragma unroll
        for (int b = 0; b < 2; ++b)
#pragma unroll
            for (int m = 0; m < 4; ++m)
#pragma unroll
                for (int n = 0; n < 2; ++n) acc[a][b][m][n] = (f32x4){0.f, 0.f, 0.f, 0.f};
    bf16x8 At[4][2], B0[2][2], B1[2][2];
    const char* cA = (const char*)g.A + (size_t)cur.pm * tstepA + (size_t)cur.pn * (size_t)g.a_pn_step; const char* cB = (const char*)g.Bt + (size_t)cur.pn * tstepB;
    S.a_ready(cur);
    PG8_STAGE(PG8_SB(0, 0), cB, voffB); PG8_STAGE(PG8_SB(0, 1), cB + hstepB, voffB); PG8_STAGE(PG8_SA(0, 0), cA, voffA); PG8_STAGE(PG8_SA(0, 1), cA + hstepA, voffA);
    if (wr == 1) PG8_BAR;
    PG8_WAIT_V(2); PG8_BAR;
    PG8_STAGE(PG8_SB(1, 0), cB + kstep, voffB); PG8_STAGE(PG8_SA(1, 0), cA + kstep, voffA); PG8_STAGE(PG8_SB(1, 1), cB + hstepB + kstep, voffB);
    PG8_WAIT_V(6); PG8_BAR;
    for (;;) {
        const bool has_next = S.next(ui + 1, nxt);
        const char* nA = has_next ? (const char*)g.A + (size_t)nxt.pm * tstepA + (size_t)nxt.pn * (size_t)g.a_pn_step : cA; const char* nB = has_next ? (const char*)g.Bt + (size_t)nxt.pn * tstepB : cB;
        for (int t = 0; t < nt; t += 2) {
            const bool last = (t == nt - 2);
            const char* a1 = cA + (size_t)(t + 1) * kstep;
            const char* a2 = last ? nA : cA + (size_t)(t + 2) * kstep; const char* b2 = last ? nB : cB + (size_t)(t + 2) * kstep;
            const char* a3 = a2 + kstep; const char* b3 = b2 + kstep;
            if (last && has_next) S.a_ready(nxt);
            PG8_LDB(B0, 0, 0); PG8_LDB(B1, 0, 1); PG8_SCHED; PG8_LDA(At, 0, 0); PG8_STAGE(PG8_SA(1, 1), a1 + hstepA, voffA);
            PG8_WAIT_V(8); PG8_WAIT_L(0); PG8_BAR; PG8_MMA(0, 0, At, B0); PG8_MMA(0, 1, At, B1); PG8_BAR; PG8_SCHED;
            PG8_LDA(At, 0, 1); PG8_STAGE(PG8_SB(0, 0), b2, voffB); PG8_STAGE(PG8_SB(0, 1), b2 + hstepB, voffB); PG8_STAGE(PG8_SA(0, 0), a2, voffA);
            PG8_WAIT_V(8); PG8_WAIT_L(0); PG8_BAR; PG8_MMA(1, 0, At, B0); PG8_MMA(1, 1, At, B1); PG8_BAR; PG8_SCHED;
            PG8_LDB(B0, 1, 0); PG8_LDB(B1, 1, 1); PG8_SCHED; PG8_LDA(At, 1, 0); PG8_STAGE(PG8_SA(0, 1), a2 + hstepA, voffA);
            PG8_WAIT_V(8); PG8_WAIT_L(0); PG8_BAR; PG8_MMA(0, 0, At, B0); PG8_MMA(0, 1, At, B1); PG8_BAR; PG8_SCHED;
            PG8_LDA(At, 1, 1); PG8_STAGE(PG8_SB(1, 0), b3, voffB); PG8_STAGE(PG8_SB(1, 1), b3 + hstepB, voffB); PG8_STAGE(PG8_SA(1, 0), a3, voffA);
            PG8_WAIT_V(8); PG8_WAIT_L(0); PG8_BAR; PG8_MMA(1, 0, At, B0); PG8_MMA(1, 1, At, B1); PG8_BAR; PG8_SCHED;
        }
        if constexpr (ALIGN_EPI) { if (wr == 0) PG8_BAR; }
        if constexpr (!Epi::AFTER_DRAIN) { E(acc, cur, wr, wc, fr, fq); S.done(cur); }
        if (!has_next) break;
#pragma unroll
        for (int a = 0; a < 2; ++a)
#pragma unroll
            for (int b = 0; b < 2; ++b)
#pragma unroll
                for (int m = 0; m < 4; ++m)
#pragma unroll
                    for (int n = 0; n < 2; ++n) acc[a][b][m][n] = (f32x4){0.f, 0.f, 0.f, 0.f};
        cur = nxt; cA = nA; cB = nB; ++ui;
        if constexpr (ALIGN_EPI) { if (wr == 1) PG8_BAR; }
    }
    PG8_WAIT_V(0);
    if constexpr (!ALIGN_EPI) { if (wr == 0) PG8_BAR; }
    PG8_BAR;
    if constexpr (Epi::AFTER_DRAIN) { E.fused(acc, cur, wr, wc, fr, fq, lds, wid, lane); S.done(cur); }
#undef PG8_SA
#undef PG8_SB
#undef PG8_STAGE
#undef PG8_LDA
#undef PG8_LDB
#undef PG8_MMA
#undef PG8_WAIT_V
#undef PG8_WAIT_L
#undef PG8_BAR
#undef PG8_SCHED
}
}

#define LDS_WAIT() asm volatile("s_waitcnt lgkmcnt(0)" ::: "memory")
#define VM_WAIT() asm volatile("s_waitcnt vmcnt(0)" ::: "memory")
__device__ __forceinline__ unsigned f2bf(float f) { unsigned u = __builtin_bit_cast(unsigned, f); return (u + 0x7fffu + ((u >> 16) & 1u)) >> 16; }
typedef __bf16 bf16v2 __attribute__((ext_vector_type(2)));
__device__ __forceinline__ unsigned pk2(float lo, float hi) { const f32x2 v = {lo, hi}; return __builtin_bit_cast(unsigned, __builtin_convertvector(v, bf16v2)); }
__device__ __forceinline__ float bf_lo(unsigned u) { return __builtin_bit_cast(float, u << 16); }
__device__ __forceinline__ float bf_hi(unsigned u) { return __builtin_bit_cast(float, u & 0xffff0000u); }
__device__ __forceinline__ float bf1(bf16 b) { return __builtin_bit_cast(float, ((unsigned)b) << 16); }
__device__ __forceinline__ void unpack8(const v4u u, float (&x)[8]) { x[0] = bf_lo(u.x); x[1] = bf_hi(u.x); x[2] = bf_lo(u.y); x[3] = bf_hi(u.y); x[4] = bf_lo(u.z); x[5] = bf_hi(u.z); x[6] = bf_lo(u.w); x[7] = bf_hi(u.w); }
__device__ __forceinline__ v4u pack8(const float (&x)[8]) { v4u o; o.x = pk2(x[0], x[1]); o.y = pk2(x[2], x[3]); o.z = pk2(x[4], x[5]); o.w = pk2(x[6], x[7]); return o; }
__device__ __forceinline__ float wave_max(float v) {
#pragma unroll
    for (int o = 1; o < 64; o <<= 1) v = fmaxf(v, __shfl_xor(v, o));
    return v;
}
template <int CTRL> __device__ __forceinline__ float dpp_f(float x) { return __builtin_bit_cast(float, __builtin_amdgcn_update_dpp(0, __builtin_bit_cast(int, x), CTRL, 0xf, 0xf, true)); }
__device__ __forceinline__ float row16_sum(float x) { x += dpp_f<0xB1>(x); x += dpp_f<0x4E>(x); x += dpp_f<0x124>(x); x += dpp_f<0x128>(x); return x; }
__device__ __forceinline__ float wave_sum(float v) { v = row16_sum(v); v += __shfl_xor(v, 16); v += __shfl_xor(v, 32); return v; }
__device__ __forceinline__ float sigm(float x) { return __builtin_amdgcn_rcpf(1.f + __expf(-x)); }
__device__ __forceinline__ float silu(float x) { return x * __builtin_amdgcn_rcpf(1.f + __expf(-x)); }

#define XB_TMO      128
#define XB_XCNT(j)  (256  + 64 * (j))
#define XB_XSUB(j)  (1280 + 64 * (j))
#define XB_XGEN(j)  (2304 + 64 * (j))
#define XB_TOP      3328
#define XB_TOPGEN   3392
#define XCD_BAR_WORDS 3456
#define XB_SPIN_CAP (1u << 18)
__device__ __forceinline__ unsigned xb_ld(unsigned* p)              { return __hip_atomic_load(p, __ATOMIC_RELAXED, __HIP_MEMORY_SCOPE_AGENT); }
__device__ __forceinline__ unsigned xb_add(unsigned* p, unsigned v) { return __hip_atomic_fetch_add(p, v, __ATOMIC_RELAXED, __HIP_MEMORY_SCOPE_AGENT); }
__device__ __forceinline__ unsigned xb_xcc_id() { return (unsigned)__builtin_amdgcn_s_getreg((3 << 11) | 20) & 0xFu; }
#define XB_SPIN(cond, bar) do { unsigned _sp = 0; while (cond) { __builtin_amdgcn_s_sleep(1); \
    if ((++_sp & 255u) == 0u) { if (xb_ld(&(bar)[XB_TMO])) break; if (_sp > XB_SPIN_CAP) { atomicAdd(&(bar)[XB_TMO], 1u); break; } } } } while (0)
struct XcdBarrier { unsigned* bar; unsigned x; volatile LAS unsigned* st; };
__device__ __forceinline__ XcdBarrier xcd_barrier_post(unsigned* bar, volatile LAS unsigned* st) {
    XcdBarrier b; b.bar = bar; b.x = xb_xcc_id(); b.st = st;
    if (threadIdx.x == 0) (void)xb_add(&bar[XB_XCNT(b.x)], 1u);
    return b;
}
__device__ __forceinline__ void xcd_barrier_complete(unsigned* bar, unsigned x, unsigned& nloc, unsigned& nx) {
    const unsigned G = gridDim.x * gridDim.y * gridDim.z;
    unsigned sum, cnt, mine, sp = 0u;
    for (;;) {
        sum = 0u; cnt = 0u; mine = 0u;
#pragma unroll
        for (unsigned j = 0; j < 16; ++j) { const unsigned c = xb_ld(&bar[XB_XCNT(j)]); sum += c; cnt += (c > 0u) ? 1u : 0u; mine = (j == x) ? c : mine; }
        if (sum == G) break;
        __builtin_amdgcn_s_sleep(1);
        if ((++sp & 255u) == 0u) { if (xb_ld(&bar[XB_TMO])) break; if (sp > XB_SPIN_CAP) { atomicAdd(&bar[XB_TMO], 1u); break; } }
    }
    nloc = mine > 0u ? mine : 1u; nx = cnt > 0u ? cnt : 1u;
}
__device__ __forceinline__ void xcd_barrier(const XcdBarrier& b) {
    asm volatile("s_waitcnt vmcnt(0)" ::: "memory");
    __syncthreads();
    if (threadIdx.x == 0) {
        unsigned* bar = b.bar;
        __builtin_amdgcn_s_waitcnt(0);
        unsigned nloc = b.st[0], nx = b.st[1];
        if (nloc == 0u) { xcd_barrier_complete(bar, b.x, nloc, nx); b.st[0] = nloc; b.st[1] = nx; }
        const unsigned old = xb_add(&bar[XB_XSUB(b.x)], 1u);
        const unsigned gen = old / nloc;
        if (old + 1u == (gen + 1u) * nloc) {
            __builtin_amdgcn_fence(__ATOMIC_RELEASE, "agent");
            asm volatile("s_waitcnt vmcnt(0)" ::: "memory");
            const unsigned og = xb_add(&bar[XB_TOP], 1u);
            const unsigned tg = og / nx;
            if (og + 1u == (tg + 1u) * nx) xb_add(&bar[XB_TOPGEN], 1u);
            else XB_SPIN(xb_ld(&bar[XB_TOPGEN]) == tg, bar);
            __builtin_amdgcn_fence(__ATOMIC_ACQUIRE, "agent");
            xb_add(&bar[XB_XGEN(b.x)], 1u);
            asm volatile("s_waitcnt vmcnt(0)" ::: "memory");
        } else {
            XB_SPIN(xb_ld(&bar[XB_XGEN(b.x)]) == gen, bar);
            __builtin_amdgcn_fence(__ATOMIC_ACQUIRE, "agent");
            asm volatile("s_waitcnt vmcnt(0)" ::: "memory");
        }
    }
    __syncthreads();
}

constexpr int NWAVES = 8;
constexpr int RING_BYTES = 131072, SCANTV_BYTES = 0, LDSCTL_OFF = RING_BYTES + SCANTV_BYTES, MISC_OFF = LDSCTL_OFF + 320, LDS_BYTES = 147456;
constexpr int CW_BAR = 4096;
constexpr int CW_TMO = 0, CW_RMS = 16384, RMS_BANK = 2048;

struct Args { const float* in[25]; float* out; unsigned char* ws; int ph_lo, ph_hi; };
struct Frame {
    LAS unsigned char* lds;
    int tid, lane, wave, vcu, G;
    const CAS cfp_t* in; float* out; unsigned char* ws;
};

__device__ __forceinline__ int launder(int x) { asm volatile("" : "+v"(x)); return x; }
__device__ __forceinline__ int launder_s(int x) { asm volatile("" : "+s"(x)); return x; }
template <class T> __device__ __forceinline__ T* launder_p(T* p) { asm volatile("" : "+s"(p)); return p; }
__device__ __forceinline__ const CAS cfp_t* launder_k(const CAS cfp_t* p) { asm volatile("" : "+s"(p)); return p; }
#define RELANE(F0) Frame F = F0; F.lane = launder(F0.lane); F.tid = launder(F0.tid)

struct EpiStore {
    static constexpr bool AFTER_DRAIN = false;
    bf16* O; int ldc; int sig_pn;
    __device__ __forceinline__ void operator()(const f32x4 (&acc)[2][2][4][2], const pg8::Unit& u, int wr, int wc, int fr, int fq) const {
        fr = launder(fr); fq = launder(fq);
        const int row0 = u.pm * 256 + wr * 64 + fr, col0 = u.pn * 256 + wc * 32 + 8 * fq; const bool sg = u.pn >= sig_pn;
#pragma unroll
        for (int ai = 0; ai < 2; ++ai)
#pragma unroll
            for (int m = 0; m < 4; ++m) { bf16* rowp = O + (size_t)(row0 + ai * 128 + m * 16) * ldc + col0;
#pragma unroll
                for (int bj = 0; bj < 2; ++bj) { f32x4 v0 = acc[ai][bj][m][0], v1 = acc[ai][bj][m][1];
                    if (sg) {
#pragma unroll
                        for (int j = 0; j < 4; ++j) { v0[j] = sigm(v0[j]); v1[j] = sigm(v1[j]); } }
                    v4u w; w.x = pg8::cvt_pk_bf16(v0[0], v0[1]); w.y = pg8::cvt_pk_bf16(v0[2], v0[3]); w.z = pg8::cvt_pk_bf16(v1[0], v1[1]); w.w = pg8::cvt_pk_bf16(v1[2], v1[3]);
                    *(v4u*)(rowp + bj * 128) = w; } }
    }
};
template <bool ACCUM> struct EpiMerge {
    static constexpr bool AFTER_DRAIN = false;
    bf16* O; const bf16* gate;
    __device__ __forceinline__ void operator()(const f32x4 (&acc)[2][2][4][2], const pg8::Unit& u, int wr, int wc, int fr, int fq) const {
        fr = launder(fr); fq = launder(fq);
        const int row0 = u.pm * 256 + wr * 64 + fr, col0 = u.pn * 256 + wc * 32 + 8 * fq;
#pragma unroll
        for (int ai = 0; ai < 2; ++ai)
#pragma unroll
            for (int m = 0; m < 4; ++m) { const int row = row0 + ai * 128 + m * 16; bf16* rowp = O + (size_t)row * D + col0; const bf16* gp = gate + (size_t)row * NIN + col0;
#pragma unroll
                for (int bj = 0; bj < 2; ++bj) {
                    float gv[8]; unpack8(*(const v4u*)(gp + bj * 128), gv);
                    float o[8];
#pragma unroll
                    for (int j = 0; j < 4; ++j) { o[j] = acc[ai][bj][m][0][j] * gv[j]; o[4 + j] = acc[ai][bj][m][1][j] * gv[4 + j]; }
                    if (ACCUM) { float p[8]; unpack8(*(const v4u*)(rowp + bj * 128), p);
#pragma unroll
                        for (int j = 0; j < 8; ++j) o[j] += p[j]; }
                    v4u w; w.x = pg8::cvt_pk_bf16(o[0], o[1]); w.y = pg8::cvt_pk_bf16(o[2], o[3]); w.z = pg8::cvt_pk_bf16(o[4], o[5]); w.w = pg8::cvt_pk_bf16(o[6], o[7]);
                    *(v4u*)(rowp + bj * 128) = w; }
                asm volatile("" ::: "memory"); }
    }
};

struct EpiRmsRes {
    static constexpr bool AFTER_DRAIN = true;
    unsigned char* ws; const CAS cfp_t* in; float* outp; int l, which;
    __device__ __forceinline__ void fused(const f32x4 (&acc)[2][2][4][2], const pg8::Unit& u, int wr, int wc, int fr, int fq, LAS unsigned char* lds, int wid, int lane) const {
        fr = launder(fr); fq = launder(fq);
        const bool lastl = which == 1 && l + 1 == DEPTH;
        bf16* const XB = (bf16*)(ws + WS_X1); bf16* const H = lastl ? nullptr : (bf16*)(ws + WS_H); float* const fout = lastl ? outp + O_YP : nullptr;
        const float* const gpost = (which ? in[24] : in[22]) + (size_t)l * D; const float* const gpre = lastl ? nullptr : (which ? in[21] + (size_t)(l + 1) * D : in[23] + (size_t)l * D);
        float* const slots = (float*)(ws + WS_XCH) + (size_t)(l * 2 + which) * 32 * 256 * 8 * 4;
        unsigned* const cnt = (unsigned*)(ws + WS_CTL) + CW_RMS + (l * 2 + which) * RMS_BANK; unsigned* const tmo = (unsigned*)(ws + WS_CTL) + CW_TMO;
        LAS f32x4* P = (LAS f32x4*)lds;
        LAS f32x2* SR = (LAS f32x2*)(lds + 16384);
        const int lr0 = wr * 64 + fr, col0 = u.pn * 256 + wc * 32 + 8 * fq;
        f32x4 gp[2][2];
#pragma unroll
        for (int bj = 0; bj < 2; ++bj) { gp[bj][0] = *(const f32x4*)(gpost + col0 + bj * 128); gp[bj][1] = *(const f32x4*)(gpost + col0 + bj * 128 + 4); }
#pragma unroll
        for (int ai = 0; ai < 2; ++ai)
#pragma unroll
            for (int m = 0; m < 4; ++m) {
                const int lr = lr0 + ai * 128 + m * 16; const bf16* xp = XB + (size_t)(u.pm * 256 + lr) * D + col0;
                float syy = 0.f, sxx = 0.f, sxy = 0.f, sgg = 0.f;
#pragma unroll
                for (int bj = 0; bj < 2; ++bj) { float xv[8]; unpack8(*(const v4u*)(xp + bj * 128), xv);
#pragma unroll
                    for (int n = 0; n < 2; ++n)
#pragma unroll
                        for (int j = 0; j < 4; ++j) { const float y = acc[ai][bj][m][n][j], yg = y * gp[bj][n][j], x = xv[4 * n + j]; syy += y * y; sxx += x * x; sxy += x * yg; sgg += yg * yg; } }
                syy += __shfl_xor(syy, 16); sxx += __shfl_xor(sxx, 16); sxy += __shfl_xor(sxy, 16); sgg += __shfl_xor(sgg, 16);
                syy += __shfl_xor(syy, 32); sxx += __shfl_xor(sxx, 32); sxy += __shfl_xor(sxy, 32); sgg += __shfl_xor(sgg, 32);
                if (fq == 0) P[lr * 4 + wc] = (f32x4){syy, sxx, sxy, sgg};
            }
        asm volatile("s_waitcnt lgkmcnt(0)" ::: "memory"); __builtin_amdgcn_s_barrier(); asm volatile("" ::: "memory");
        const int row = wid * 32 + (lane & 31);
        unsigned long long* slot = (unsigned long long*)slots + ((size_t)(u.pm * 256 + row) * 8 + u.pn) * 2;
        if (lane < 32) { const f32x4 a = P[row * 4 + 0], b = P[row * 4 + 1], c = P[row * 4 + 2], d = P[row * 4 + 3]; const f32x4 t = (a + b) + (c + d);
            __hip_atomic_store(slot, ((unsigned long long)__builtin_bit_cast(unsigned, t.y) << 32) | __builtin_bit_cast(unsigned, t.x), __ATOMIC_RELAXED, __HIP_MEMORY_SCOPE_AGENT);
            __hip_atomic_store(slot + 1, ((unsigned long long)__builtin_bit_cast(unsigned, t.w) << 32) | __builtin_bit_cast(unsigned, t.z), __ATOMIC_RELAXED, __HIP_MEMORY_SCOPE_AGENT); }
        asm volatile("s_waitcnt vmcnt(0)" ::: "memory");
        if (lane == 0) __hip_atomic_fetch_add(cnt + 64 * u.pm, 1u, __ATOMIC_RELAXED, __HIP_MEMORY_SCOPE_AGENT);
        if (wid == 0) {
            const unsigned long long t0 = __builtin_amdgcn_s_memrealtime();
            while ((unsigned)__builtin_amdgcn_readfirstlane((int)__hip_atomic_load(cnt + 64 * u.pm, __ATOMIC_RELAXED, __HIP_MEMORY_SCOPE_AGENT)) < 64u) {
                if (__builtin_amdgcn_s_memrealtime() - t0 > 2000000ull) { if (lane == 0) __hip_atomic_store(tmo, 1u, __ATOMIC_RELAXED, __HIP_MEMORY_SCOPE_AGENT); break; }
                __builtin_amdgcn_s_sleep(2); }
            __builtin_amdgcn_fence(__ATOMIC_ACQUIRE, "agent");
        }
        asm volatile("s_waitcnt vmcnt(0) lgkmcnt(0)" ::: "memory"); __builtin_amdgcn_s_barrier(); asm volatile("" ::: "memory");
        if (lane < 32) { const unsigned long long* sl = (const unsigned long long*)slots + (size_t)(u.pm * 256 + row) * 16; float syy = 0.f, sxx = 0.f, sxy = 0.f, sgg = 0.f;
#pragma unroll
            for (int t = 0; t < 8; ++t) { const unsigned long long w0 = __hip_atomic_load(sl + 2 * t, __ATOMIC_RELAXED, __HIP_MEMORY_SCOPE_AGENT), w1 = __hip_atomic_load(sl + 2 * t + 1, __ATOMIC_RELAXED, __HIP_MEMORY_SCOPE_AGENT);
                syy += __builtin_bit_cast(float, (unsigned)w0); sxx += __builtin_bit_cast(float, (unsigned)(w0 >> 32)); sxy += __builtin_bit_cast(float, (unsigned)w1); sgg += __builtin_bit_cast(float, (unsigned)(w1 >> 32)); }
            const float ry = rsqrtf(syy * (1.f / D) + EPS), s1 = sxx + 2.f * ry * sxy + ry * ry * sgg;
            SR[row] = (f32x2){ry, rsqrtf(fmaxf(s1, 0.f) * (1.f / D) + EPS)}; }
        asm volatile("s_waitcnt lgkmcnt(0)" ::: "memory"); __builtin_amdgcn_s_barrier(); asm volatile("" ::: "memory");
        f32x4 gq[2][2];
#pragma unroll
        for (int bj = 0; bj < 2; ++bj) { gq[bj][0] = gpre ? *(const f32x4*)(gpre + col0 + bj * 128) : (f32x4){0.f, 0.f, 0.f, 0.f}; gq[bj][1] = gpre ? *(const f32x4*)(gpre + col0 + bj * 128 + 4) : (f32x4){0.f, 0.f, 0.f, 0.f}; }
#pragma unroll
        for (int ai = 0; ai < 2; ++ai)
#pragma unroll
            for (int m = 0; m < 4; ++m) {
                const int lr = lr0 + ai * 128 + m * 16; const size_t off = (size_t)(u.pm * 256 + lr) * D + col0; const f32x2 sr = SR[lr];
#pragma unroll
                for (int bj = 0; bj < 2; ++bj) { float xv[8], x1[8]; unpack8(*(const v4u*)(XB + off + bj * 128), xv);
#pragma unroll
                    for (int n = 0; n < 2; ++n)
#pragma unroll
                        for (int j = 0; j < 4; ++j) x1[4 * n + j] = xv[4 * n + j] + acc[ai][bj][m][n][j] * sr.x * gp[bj][n][j];
                    if (fout) { *(f32x4*)(fout + off + bj * 128) = (f32x4){x1[0], x1[1], x1[2], x1[3]}; *(f32x4*)(fout + off + bj * 128 + 4) = (f32x4){x1[4], x1[5], x1[6], x1[7]}; }
                    else { *(v4u*)(XB + off + bj * 128) = pack8(x1);
                        if (H) { float hv[8];
#pragma unroll
                            for (int n = 0; n < 2; ++n)
#pragma unroll
                                for (int j = 0; j < 4; ++j) hv[4 * n + j] = x1[4 * n + j] * sr.y * gq[bj][n][j];
                            *(v4u*)(H + off + bj * 128) = pack8(hv); } } }
                asm volatile("" ::: "memory"); }
    }
};
struct EpiSwiglu {
    static constexpr bool AFTER_DRAIN = false;
    bf16* O;
    __device__ __forceinline__ void operator()(const f32x4 (&acc)[2][2][4][2], const pg8::Unit& u, int wr, int wc, int fr, int fq) const {
        fr = launder(fr); fq = launder(fq);
        const int row0 = u.pm * 256 + wr * 64 + fr, col0 = u.pn * 128 + wc * 32 + 8 * fq;
#pragma unroll
        for (int ai = 0; ai < 2; ++ai)
#pragma unroll
            for (int m = 0; m < 4; ++m) { bf16* rowp = O + (size_t)(row0 + ai * 128 + m * 16) * DFF + col0;
                float o[8];
#pragma unroll
                for (int j = 0; j < 4; ++j) { o[j] = silu(acc[ai][0][m][0][j]) * acc[ai][1][m][0][j]; o[4 + j] = silu(acc[ai][0][m][1][j]) * acc[ai][1][m][1][j]; }
                v4u w; w.x = pg8::cvt_pk_bf16(o[0], o[1]); w.y = pg8::cvt_pk_bf16(o[2], o[3]); w.z = pg8::cvt_pk_bf16(o[4], o[5]); w.w = pg8::cvt_pk_bf16(o[6], o[7]);
                *(v4u*)rowp = w; }
    }
};

__device__ __forceinline__ void transpose_item(const float* W, int ldw, int src_col0, int k0, bf16* WT, int ldt, int dst_row0, LAS float* scr, int lane, const float* rscale = nullptr) {
#pragma unroll 8
    for (int i = 0; i < 32; ++i) { const int kk = 2 * i + (lane >> 5); scr[kk * 33 + (lane & 31)] = W[(size_t)(k0 + kk) * ldw + src_col0 + (lane & 31)]; }
    LDS_WAIT(); asm volatile("" ::: "memory");
    const int c = lane & 7;
#pragma unroll
    for (int j = 0; j < 4; ++j) { const int n = (lane >> 3) + 8 * j; const LAS float* s = scr + (8 * c) * 33 + n; const float m = rscale ? rscale[n] : 1.f;
        v4u o; o.x = pk2(s[0 * 33] * m, s[1 * 33] * m); o.y = pk2(s[2 * 33] * m, s[3 * 33] * m); o.z = pk2(s[4 * 33] * m, s[5 * 33] * m); o.w = pk2(s[6 * 33] * m, s[7 * 33] * m);
        *(v4u*)(WT + (size_t)(dst_row0 + n) * ldt + k0 + 8 * c) = o; }
    LDS_WAIT(); asm volatile("" ::: "memory");
}
constexpr int IT_IN = 32 * 496, IT_BRA = 16 * 64, IT_BRB = 8 * 64, IT_BRC = 16 * 64, IT_POOL = 4 * 4 * 8, IT_OUT = 32 * 64, IT_GU = 32 * 352, IT_DOWN = 88 * 64;
constexpr int IT_LAYER = IT_IN + IT_BRA + IT_BRB + IT_BRC + IT_POOL + IT_OUT + IT_GU + IT_DOWN;
__device__ __forceinline__ void weight_item(Frame& F0, int l, int r, LAS float* scr) {
    RELANE(F0);
    unsigned char* wl = F.ws + WS_W + (size_t)l * WL_BYTES; const int lane = F.lane;
    if (r < IT_IN) { const int kb = r / 496, nb = r % 496, n0 = nb * 32; transpose_item(F.in[8] + (size_t)l * D * NIN_SRC, NIN_SRC, n0 + (n0 >= 4096 ? 16 : 0), kb * 64, (bf16*)(wl + WO_IN), D, n0, scr, lane); return; } r -= IT_IN;
    if (r < IT_BRA) { const int kb = r / 64, nb = r % 64; transpose_item(F.in[15] + (size_t)l * 1024 * D, D, nb * 32, kb * 64, (bf16*)(wl + WO_BRA), 1024, nb * 32, scr, lane); return; } r -= IT_BRA;
    if (r < IT_BRB) { const int kb = r / 64, nb = r % 64; transpose_item(F.in[16] + (size_t)l * 512 * D, D, nb * 32, kb * 64, (bf16*)(wl + WO_BRB), 512, nb * 32, scr, lane); return; } r -= IT_BRB;
    if (r < IT_BRC) { const int kb = r / 64, nb = r % 64; transpose_item(F.in[17] + (size_t)l * 1024 * D, D, nb * 32, kb * 64, (bf16*)(wl + WO_BRC), 1024, nb * 32, scr, lane); return; } r -= IT_BRC;
    if (r < IT_POOL) { const int g = r / 32, kb = (r % 32) / 8, nb = r % 8; transpose_item(F.in[13] + (size_t)(l * 4 + g) * 65536, 256, nb * 32, kb * 64, (bf16*)(wl + WO_POOL) + (size_t)g * 65536, 256, nb * 32, scr, lane, F.in[14] + (size_t)l * CPOOL + g * 256 + nb * 32); return; } r -= IT_POOL;
    if (r < IT_OUT) { const int kb = r / 64, nb = r % 64; transpose_item(F.in[18] + (size_t)l * D * D, D, nb * 32, kb * 64, (bf16*)(wl + WO_OUT), D, nb * 32, scr, lane); return; } r -= IT_OUT;
    if (r < IT_GU) { const int kb = r / 352, nb = r % 352, n0 = nb * 32, pn = n0 >> 8, bj = (n0 >> 7) & 1, rr = n0 & 127;
        transpose_item(F.in[19] + (size_t)l * D * 2 * DFF, 2 * DFF, bj * DFF + 128 * pn + rr, kb * 64, (bf16*)(wl + WO_GU), D, n0, scr, lane); return; } r -= IT_GU;
    { const int kb = r / 64, nb = r % 64; transpose_item(F.in[20] + (size_t)l * DFF * D, D, nb * 32, kb * 64, (bf16*)(wl + WO_DOWN), DFF, nb * 32, scr, lane); }
}

__device__ __forceinline__ void stage_wba(Frame& F0, int l) {
    RELANE(F0);
    LAS float* Wl = (LAS float*)F.lds; const float* w = F.in[8] + (size_t)l * D * NIN_SRC + 4096;
    for (int k = F.tid; k < D; k += NWAVES * 64) { const float* p = w + (size_t)k * NIN_SRC;
        const f32x4 a = *(const f32x4*)p, b = *(const f32x4*)(p + 4), c = *(const f32x4*)(p + 8), d = *(const f32x4*)(p + 12);
        Wl[0 * D + k] = a.x; Wl[1 * D + k] = a.y; Wl[2 * D + k] = a.z; Wl[3 * D + k] = a.w; Wl[4 * D + k] = b.x; Wl[5 * D + k] = b.y; Wl[6 * D + k] = b.z; Wl[7 * D + k] = b.w;
        Wl[8 * D + k] = c.x; Wl[9 * D + k] = c.y; Wl[10 * D + k] = c.z; Wl[11 * D + k] = c.w; Wl[12 * D + k] = d.x; Wl[13 * D + k] = d.y; Wl[14 * D + k] = d.z; Wl[15 * D + k] = d.w; }
    __syncthreads();
}
template <bool X32>
__device__ __forceinline__ void thin_rows(Frame& F0, const float* xa, const float* xb, const bf16* Y, const float* gpost, float* fout, const float* gpre, bool do_ba, int l_ba, int r_lo = 0) {
    RELANE(F0);
    const int lane = F.lane, gw = F.vcu * NWAVES + F.wave, NGW = F.G * NWAVES;
    bf16* H = (bf16*)(F.ws + WS_H); bf16* XB = (bf16*)(F.ws + WS_X1); float* GB = (float*)(F.ws + WS_GB);
    const LAS float* Wl = (const LAS float*)F.lds;
    f32x4 vn[8]; v2u xn[8], yn[8];
#define THIN_LOAD(rr) do { const int r_ = (rr); \
        if (X32) { const float* xr_ = (r_ < MP) ? xa + (size_t)r_ * D : xb + (size_t)(r_ - MP) * D; _Pragma("unroll") for (int j = 0; j < 8; ++j) vn[j] = *(const f32x4*)(xr_ + 4 * lane + 256 * j); } \
        else { _Pragma("unroll") for (int j = 0; j < 8; ++j) xn[j] = *(const v2u*)(XB + (size_t)r_ * D + 4 * lane + 256 * j); } \
        if (Y) { _Pragma("unroll") for (int j = 0; j < 8; ++j) yn[j] = *(const v2u*)(Y + (size_t)r_ * D + 4 * lane + 256 * j); } } while (0)
#pragma unroll
    for (int j = 0; j < 8; ++j) { yn[j] = (v2u){0u, 0u}; xn[j] = (v2u){0u, 0u}; vn[j] = (f32x4){0.f, 0.f, 0.f, 0.f}; }
    if (r_lo + gw < MV) THIN_LOAD(r_lo + gw);
    for (int r = r_lo + gw; r < MV; r += NGW) {
        f32x4 v[8]; v2u yu[8];
#pragma unroll
        for (int j = 0; j < 8; ++j) { v[j] = X32 ? vn[j] : (f32x4){bf_lo(xn[j].x), bf_hi(xn[j].x), bf_lo(xn[j].y), bf_hi(xn[j].y)}; yu[j] = yn[j]; }
        if (r + NGW < MV) THIN_LOAD(r + NGW);
        if (Y) {
            f32x4 y[8]; float ss = 0.f;
#pragma unroll
            for (int j = 0; j < 8; ++j) { const v2u u = yu[j]; y[j] = (f32x4){bf_lo(u.x), bf_hi(u.x), bf_lo(u.y), bf_hi(u.y)}; ss += (y[j].x * y[j].x + y[j].y * y[j].y) + (y[j].z * y[j].z + y[j].w * y[j].w); }
            const float rstd = rsqrtf(wave_sum(ss) * (1.f / D) + EPS);
#pragma unroll
            for (int j = 0; j < 8; ++j) { const f32x4 g = *(const f32x4*)(gpost + 4 * lane + 256 * j); v[j] = v[j] + y[j] * rstd * g; }
        }
        if (fout) {
#pragma unroll
            for (int j = 0; j < 8; ++j) *(f32x4*)(fout + (size_t)r * D + 4 * lane + 256 * j) = v[j];
        } else {
#pragma unroll
            for (int j = 0; j < 8; ++j) { v2u o; o.x = pk2(v[j].x, v[j].y); o.y = pk2(v[j].z, v[j].w); *(v2u*)(XB + (size_t)r * D + 4 * lane + 256 * j) = o; }
        }
        if (gpre) {
            float ss = 0.f;
#pragma unroll
            for (int j = 0; j < 8; ++j) ss += (v[j].x * v[j].x + v[j].y * v[j].y) + (v[j].z * v[j].z + v[j].w * v[j].w);
            const float rstd = rsqrtf(wave_sum(ss) * (1.f / D) + EPS);
#pragma unroll
            for (int j = 0; j < 8; ++j) { const f32x4 g = *(const f32x4*)(gpre + 4 * lane + 256 * j); v[j] = v[j] * rstd * g;
                v2u o; o.x = pk2(v[j].x, v[j].y); o.y = pk2(v[j].z, v[j].w); *(v2u*)(H + (size_t)r * D + 4 * lane + 256 * j) = o; }
            if (do_ba) {
                float pc[16], mine = 0.f;
#pragma unroll
                for (int c = 0; c < 16; ++c) { float p = 0.f;
#pragma unroll
                    for (int j = 0; j < 8; ++j) { const f32x4 w = *(const LAS f32x4*)(Wl + c * D + 256 * j + 4 * lane); p += (v[j].x * w.x + v[j].y * w.y) + (v[j].z * w.z + v[j].w * w.w); }
                    pc[c] = row16_sum(p); }
#pragma unroll
                for (int c = 0; c < 16; ++c) pc[c] += __shfl_xor(pc[c], 16);
#pragma unroll
                for (int c = 0; c < 16; ++c) { pc[c] += __shfl_xor(pc[c], 32); mine = (lane == c) ? pc[c] : mine; }
                if (lane < 16) { float o;
                    if (lane < 8) o = sigm(mine);
                    else { const float al = F.in[10][l_ba * HA + lane - 8], dtb = F.in[11][l_ba * HA + lane - 8]; const float z = mine + dtb; const float sp = fmaxf(z, 0.f) + log1pf(__expf(-fabsf(z))); o = -__expf(al) * sp; }
                    GB[(size_t)r * 16 + lane] = o; }
            }
        }
    }
}
#undef THIN_LOAD
__device__ __forceinline__ void ba_rows(Frame& F0, int l_ba) {
    RELANE(F0);
    const int lane = F.lane, gw = F.vcu * NWAVES + F.wave, NGW = F.G * NWAVES;
    const bf16* H = (const bf16*)(F.ws + WS_H); float* GB = (float*)(F.ws + WS_GB); const LAS float* Wl = (const LAS float*)F.lds;
    for (int r = gw; r < MP; r += NGW) {
        f32x4 v[8];
#pragma unroll
        for (int j = 0; j < 8; ++j) { const v2u u = *(const v2u*)(H + (size_t)r * D + 4 * lane + 256 * j); v[j] = (f32x4){bf_lo(u.x), bf_hi(u.x), bf_lo(u.y), bf_hi(u.y)}; }
        float mine = 0.f;
#pragma unroll 1
        for (int c = 0; c < 16; ++c) { float p = 0.f;
#pragma unroll
            for (int j = 0; j < 8; ++j) { const f32x4 w = *(const LAS f32x4*)(Wl + c * D + 256 * j + 4 * lane); p += (v[j].x * w.x + v[j].y * w.y) + (v[j].z * w.z + v[j].w * w.w); }
            p = wave_sum(p); if (lane == c) mine = p; }
        if (lane < 16) { float o;
            if (lane < 8) o = sigm(mine);
            else { const float al = F.in[10][l_ba * HA + lane - 8], dtb = F.in[11][l_ba * HA + lane - 8]; const float z = mine + dtb; const float sp = fmaxf(z, 0.f) + log1pf(__expf(-fabsf(z))); o = -__expf(al) * sp; }
            GB[(size_t)r * 16 + lane] = o; }
    }
}

__device__ __forceinline__ void ld8f(const float* p, float (&x)[8]) { const f32x4 a = *(const f32x4*)p, b = *(const f32x4*)(p + 4); x[0] = a.x; x[1] = a.y; x[2] = a.z; x[3] = a.w; x[4] = b.x; x[5] = b.y; x[6] = b.z; x[7] = b.w; }
template <bool QK> __device__ __forceinline__ void conv_item(Frame& F0, int l, int row0, int T, int hmode, int sb, int j) {
    RELANE(F0);
    const int lane = F.lane;
    const bf16* PROJ = (const bf16*)(F.ws + WS_PROJ); const float* convw = F.in[9] + (size_t)l * 4 * CONVCH;
    const int c0 = QK ? 512 * j + 8 * lane : 2048 + 512 * j + 8 * lane, c1 = 1024 + 512 * j + 8 * lane;
    float w0[4][8], w1[4][8], x0[4][8], x1[4][8];
#pragma unroll
    for (int tap = 0; tap < 4; ++tap) { ld8f(convw + tap * CONVCH + c0, w0[tap]); if (QK) ld8f(convw + tap * CONVCH + c1, w1[tap]); }
#pragma unroll
    for (int i = 0; i < 3; ++i) {
        if (hmode == 1) { unpack8(*(const v4u*)(PROJ + (size_t)(row0 - 3 + i) * NIN + c0), x0[i + 1]); if (QK) unpack8(*(const v4u*)(PROJ + (size_t)(row0 - 3 + i) * NIN + c1), x1[i + 1]); }
        else if (hmode == 2) { const float* hp = F.in[6] + ((size_t)(l * DB + sb) * 3 + i) * CONVCH; ld8f(hp + c0, x0[i + 1]); if (QK) ld8f(hp + c1, x1[i + 1]); }
        else {
#pragma unroll
            for (int e = 0; e < 8; ++e) { x0[i + 1][e] = 0.f; x1[i + 1][e] = 0.f; } }
    }
    bf16* O0 = (bf16*)(F.ws + (QK ? WS_QN : WS_VV)) + 512 * j + 8 * lane; bf16* O1 = (bf16*)(F.ws + WS_KN) + 512 * j + 8 * lane;
    const float* GB = (const float*)(F.ws + WS_GB); f32x4* TOK = (f32x4*)(F.ws + WS_TOK); const int hd = 4 * j + (lane >> 4);
    v4u n0[4], n1[4]; float ng[4], nb[4];
#pragma unroll
    for (int u = 0; u < 4; ++u) { n0[u] = *(const v4u*)(PROJ + (size_t)(row0 + u) * NIN + c0); n1[u] = n0[u]; ng[u] = 0.f; nb[u] = 0.f; if (QK) { n1[u] = *(const v4u*)(PROJ + (size_t)(row0 + u) * NIN + c1); ng[u] = GB[(size_t)(row0 + u) * 16 + 8 + hd]; nb[u] = GB[(size_t)(row0 + u) * 16 + hd]; } }
    for (int tb = 0; tb < T; tb += 4) {
        v4u m0[4], m1[4]; float mg[4], mb[4];
#pragma unroll
        for (int u = 0; u < 4; ++u) { m0[u] = n0[u]; m1[u] = n1[u]; mg[u] = ng[u]; mb[u] = nb[u]; }
        if (tb + 4 < T) {
#pragma unroll
            for (int u = 0; u < 4; ++u) { n0[u] = *(const v4u*)(PROJ + (size_t)(row0 + tb + 4 + u) * NIN + c0); if (QK) { n1[u] = *(const v4u*)(PROJ + (size_t)(row0 + tb + 4 + u) * NIN + c1); ng[u] = GB[(size_t)(row0 + tb + 4 + u) * 16 + 8 + hd]; nb[u] = GB[(size_t)(row0 + tb + 4 + u) * 16 + hd]; } } }
#pragma unroll
        for (int u = 0; u < 4; ++u) {
            const int t = tb + u; const size_t r = (size_t)(row0 + t);
            unpack8(m0[u], x0[u]); if (QK) unpack8(m1[u], x1[u]);
            float a0[8], a1[8]; float s0 = 0.f, s1 = 0.f;
#pragma unroll
            for (int e = 0; e < 8; ++e) {
                a0[e] = silu(w0[3][e] * x0[u][e] + w0[2][e] * x0[(u + 3) & 3][e] + w0[1][e] * x0[(u + 2) & 3][e] + w0[0][e] * x0[(u + 1) & 3][e]); s0 += a0[e] * a0[e];
                if (QK) { a1[e] = silu(w1[3][e] * x1[u][e] + w1[2][e] * x1[(u + 3) & 3][e] + w1[1][e] * x1[(u + 2) & 3][e] + w1[0][e] * x1[(u + 1) & 3][e]); s1 += a1[e] * a1[e]; } }
            if (QK) {
                const float q_sc = rsqrtf(row16_sum(s0) + 1e-6f) * 0.08838834764831845f, k_sc = rsqrtf(row16_sum(s1) + 1e-6f); float p = 0.f;
#pragma unroll
                for (int e = 0; e < 8; ++e) { a0[e] *= q_sc; a1[e] *= k_sc; p += a0[e] * a1[e]; }
                p = row16_sum(p);
                *(v4u*)(O1 + r * 1024) = pack8(a1);
                if ((lane & 15) == 0) TOK[r * 8 + hd] = (f32x4){__expf(mg[u]), mb[u], p, mg[u]};
            }
            *(v4u*)(O0 + r * 1024) = pack8(a0);
        }
    }
}
__device__ __forceinline__ void pool_item(Frame& F0, int l, int row0, int T, int pos0, int hmode, int sb, int j) {
    RELANE(F0);
    const int lane = F.lane, win = 2 << (2 * j + (lane >> 5)), cc = 512 * j + 8 * lane;
    const bf16* U = (const bf16*)(F.ws + WS_PROJ) + PC_UC + cc; const float* hist = F.in[7] + (size_t)(l * DB + sb) * PHIST * CPOOL + cc;
    bf16* PO = (bf16*)(F.ws + WS_POOLED) + cc;
    float S[8];
#pragma unroll
    for (int e = 0; e < 8; ++e) S[e] = 0.f;
    if (hmode == 2) {
        for (int i = 1; i < 16; ++i) if (i < win) { float x[8]; ld8f(hist + (size_t)(PHIST - i) * CPOOL, x);
#pragma unroll
            for (int e = 0; e < 8; ++e) S[e] += x[e]; }
        for (int t = 0; t < T; ++t) {
            float xn[8], xo[8]; unpack8(*(const v4u*)(U + (size_t)(row0 + t) * NIN), xn);
            const int to = t - win + 1;
            if (to >= 0) unpack8(*(const v4u*)(U + (size_t)(row0 + to) * NIN), xo); else ld8f(hist + (size_t)(PHIST + to) * CPOOL, xo);
            const float inv = 1.f / (float)win; float o[8];
#pragma unroll
            for (int e = 0; e < 8; ++e) { S[e] += xn[e]; o[e] = S[e] * inv - xn[e]; S[e] -= xo[e]; }
            *(v4u*)(PO + (size_t)(row0 + t) * 1024) = pack8(o);
        }
        return;
    }
    {
        v4u h[15];
#pragma unroll
        for (int i = 1; i < 16; ++i) { const int back = (pos0 - i >= 0) ? i : pos0; h[i - 1] = *(const v4u*)(U + (size_t)(row0 - back) * NIN); }
#pragma unroll
        for (int i = 1; i < 16; ++i) { float x[8]; unpack8(h[i - 1], x); const float wgt = (i < win && pos0 - i >= 0) ? 1.f : 0.f;
#pragma unroll
            for (int e = 0; e < 8; ++e) S[e] += wgt * x[e]; }
    }
    v4u nn[4], no[4];
#define POOL_LD(tb_) do { _Pragma("unroll") for (int u = 0; u < 4; ++u) { const int t_ = (tb_) + u, to_ = t_ - win + 1; nn[u] = *(const v4u*)(U + (size_t)(row0 + t_) * NIN); no[u] = *(const v4u*)(U + (size_t)(row0 + (pos0 + to_ >= 0 ? to_ : -pos0)) * NIN); } } while (0)
    POOL_LD(0);
    for (int tb = 0; tb < T; tb += 4) {
        v4u mn[4], mo[4];
#pragma unroll
        for (int u = 0; u < 4; ++u) { mn[u] = nn[u]; mo[u] = no[u]; }
        if (tb + 4 < T) POOL_LD(tb + 4);
#pragma unroll
        for (int u = 0; u < 4; ++u) {
            const int t = tb + u, to = t - win + 1; const float wo = (pos0 + to >= 0) ? 1.f : 0.f;
            float xn[8], xo[8]; unpack8(mn[u], xn); unpack8(mo[u], xo);
            const float cnt = (float)(win < pos0 + t + 1 ? win : pos0 + t + 1), inv = __builtin_amdgcn_rcpf(cnt); float o[8];
#pragma unroll
            for (int e = 0; e < 8; ++e) { S[e] += xn[e]; o[e] = S[e] * inv - xn[e]; S[e] -= wo * xo[e]; }
            *(v4u*)(PO + (size_t)(row0 + t) * 1024) = pack8(o);
        }
    }
#undef POOL_LD
}
constexpr int CV_BLK = 16, CV_NB = SEQ / CV_BLK;
constexpr int CV_P_ITEMS = BATCH * CV_NB * 2, CV_S_ITEMS = DB * 2;
constexpr int PREP_ITEMS = 2 * (CV_P_ITEMS + CV_S_ITEMS) + CV_P_ITEMS + CV_S_ITEMS;
__device__ __forceinline__ void prep_item(Frame& F, int l, int it) {
    int kind = 0;
    if (it >= CV_P_ITEMS + CV_S_ITEMS) { it -= CV_P_ITEMS + CV_S_ITEMS; kind = 1; if (it >= CV_P_ITEMS + CV_S_ITEMS) { it -= CV_P_ITEMS + CV_S_ITEMS; kind = 2; } }
    int row0, T, hmode, sb = 0, pos0; const int j = it & 1;
    if (it < CV_P_ITEMS) { const int blk = (it >> 1) % CV_NB, b = (it >> 1) / CV_NB; row0 = b * SEQ + blk * CV_BLK; T = CV_BLK; hmode = blk ? 1 : 0; pos0 = blk * CV_BLK; }
    else { sb = (it - CV_P_ITEMS) >> 1; row0 = MP + DS * sb; T = DS; hmode = 2; pos0 = 0; }
    if (kind == 0) conv_item<true>(F, l, row0, T, hmode, sb, j); else if (kind == 1) conv_item<false>(F, l, row0, T, hmode, sb, j); else pool_item(F, l, row0, T, pos0, hmode, sb, j);
}

__device__ __forceinline__ void st8f(float* p, const v4u u) { float x[8]; unpack8(u, x); *(f32x4*)p = (f32x4){x[0], x[1], x[2], x[3]}; *(f32x4*)(p + 4) = (f32x4){x[4], x[5], x[6], x[7]}; }
__device__ __forceinline__ void prep_out_rows(Frame& F0, int l) {
    RELANE(F0);
    const int lane = F.lane, gw = F.vcu * NWAVES + F.wave, NGW = F.G * NWAVES;
    const bf16* PROJ = (const bf16*)(F.ws + WS_PROJ);
    float* out = F.out;
    for (int r = gw; r < MV; r += NGW) {
        const bool samp = r >= MP; const int b = samp ? (r - MP) / DS : r / SEQ, t = samp ? (r - MP) % DS : r % SEQ;
        const bf16* prow = PROJ + (size_t)r * NIN;
        const int ci = samp ? t - 1 : t - (SEQ - 3), pi = samp ? 11 + t : t - (SEQ - PHIST);
        v4u kvr[3][2], cv[6], pv[2];
#pragma unroll
        for (int gi = 0; gi < 3; ++gi) { kvr[gi][0] = *(const v4u*)(prow + PC_KB + gi * 512 + 8 * lane); kvr[gi][1] = *(const v4u*)(prow + PC_VB + gi * 512 + 8 * lane); }
        const bool needc = (ci >= 0) || (pi >= 0);
        if (needc) {
#pragma unroll
            for (int j = 0; j < 6; ++j) cv[j] = *(const v4u*)(prow + 512 * j + 8 * lane);
#pragma unroll
            for (int j = 0; j < 2; ++j) pv[j] = *(const v4u*)(prow + PC_UC + 512 * j + 8 * lane);
        }
#pragma unroll
        for (int gi = 0; gi < 3; ++gi) {
            const int win = 128 << (2 * gi); const int w = samp ? win - DS + t : t - (SEQ - win);
            if (w >= 0) {
                const size_t obase = samp ? (gi == 0 ? O_SW1 : gi == 1 ? O_SW2 : O_SW3) : (gi == 0 ? O_PW1 : gi == 1 ? O_PW2 : O_PW3);
                float* dst = out + obase + ((size_t)(l * (samp ? DB : BATCH) + b) * win + w) * 1024 + 8 * lane;
                st8f(dst, kvr[gi][0]); st8f(dst + 512, kvr[gi][1]);
            }
        }
        if (needc) {
            if (ci >= 0) { float* dst = out + (samp ? O_SCONV + ((size_t)(l * DB + b) * 3 + ci) * CONVCH : O_PCONV + ((size_t)(l * BATCH + b) * 3 + ci) * CONVCH) + 8 * lane;
#pragma unroll
                for (int j = 0; j < 6; ++j) st8f(dst + 512 * j, cv[j]); }
            if (pi >= 0) { float* dst = out + (samp ? O_SPOOL + ((size_t)(l * DB + b) * PHIST + pi) * CPOOL : O_PPOOL + ((size_t)(l * BATCH + b) * PHIST + pi) * CPOOL) + 8 * lane;
#pragma unroll
                for (int j = 0; j < 2; ++j) st8f(dst + 512 * j, pv[j]); }
            if (samp && t == 0) {
                const float* phist = F.in[7] + (size_t)(l * DB + b) * PHIST * CPOOL;
                float* dst = out + O_SPOOL + (size_t)(l * DB + b) * PHIST * CPOOL; const float* src = phist + 4 * CPOOL;
                for (int i = lane; i < 11 * CPOOL / 4; i += 64) *(f32x4*)(dst + 4 * i) = *(const f32x4*)(src + 4 * i);
            }
        }
    }
}

__device__ __forceinline__ void gdn_scan_item(Frame& F0, int row0, int h, int s, const float* S0, float* Sout) {
    RELANE(F0);
    const int lane = F.lane, dvl = lane & 15, kg = lane >> 4;
    const bf16* QN = (const bf16*)(F.ws + WS_QN); const bf16* KN = (const bf16*)(F.ws + WS_KN); const bf16* VV = (const bf16*)(F.ws + WS_VV);
    const f32x4* TOK = (const f32x4*)(F.ws + WS_TOK); float* ORAW = (float*)(F.ws + WS_ORAW);
    float S[32]; v4u ku[DS][4], qu[DS][4]; float vv[DS]; f32x4 tk[DS];
    const float* sp = S0 + (size_t)(32 * kg) * 128 + 16 * s + dvl;
#pragma unroll
    for (int i = 0; i < 32; ++i) S[i] = sp[(size_t)i * 128];
#pragma unroll
    for (int t = 0; t < DS; ++t) { const size_t r = (size_t)(row0 + t);
#pragma unroll
        for (int c = 0; c < 4; ++c) { ku[t][c] = *(const v4u*)(KN + r * 1024 + h * 128 + 32 * kg + 8 * c); qu[t][c] = *(const v4u*)(QN + r * 1024 + h * 128 + 32 * kg + 8 * c); }
        vv[t] = bf1(VV[r * 1024 + h * 128 + 16 * s + dvl]); tk[t] = TOK[r * 8 + h]; }
#pragma unroll
    for (int t = 0; t < DS; ++t) {
        float rk = 0.f, rq = 0.f; float kf[32];
#pragma unroll
        for (int c = 0; c < 4; ++c) { float k8[8], q8[8]; unpack8(ku[t][c], k8); unpack8(qu[t][c], q8);
#pragma unroll
            for (int e = 0; e < 8; ++e) { kf[8 * c + e] = k8[e]; rk += k8[e] * S[8 * c + e]; rq += q8[e] * S[8 * c + e]; } }
        rk += __shfl_xor(rk, 16); rq += __shfl_xor(rq, 16); rk += __shfl_xor(rk, 32); rq += __shfl_xor(rq, 32);
        const float a = tk[t].x, d = tk[t].y * (vv[t] - a * rk), o = a * rq + tk[t].z * d;
#pragma unroll
        for (int i = 0; i < 32; ++i) S[i] = a * S[i] + kf[i] * d;
        if (kg == 0) ORAW[(size_t)(row0 + t) * 1024 + h * 128 + 16 * s + dvl] = o;
    }
    float* op = Sout + (size_t)(32 * kg) * 128 + 16 * s + dvl;
#pragma unroll
    for (int i = 0; i < 32; ++i) op[(size_t)i * 128] = S[i];
}

__device__ __forceinline__ bf16x8 pack_acc(const f32x16& x, int sp) {
    v4u p; p.x = pk2(x[8 * sp + 0], x[8 * sp + 1]); p.y = pk2(x[8 * sp + 2], x[8 * sp + 3]); p.z = pk2(x[8 * sp + 4], x[8 * sp + 5]); p.w = pk2(x[8 * sp + 6], x[8 * sp + 7]);
    return __builtin_bit_cast(bf16x8, p);
}
constexpr int GA_PITCH = 272, GA_LT_PITCH = 36, GA_WAVE_LDS = 32 * GA_PITCH + 32 * GA_LT_PITCH * 4 + 384;
__device__ __forceinline__ void gdn_ga_item(Frame& F0, int ch) {
    RELANE(F0);
    const int lane = F.lane, r = lane & 31, h = lane >> 5;
    const int c = ch & 63, bh = ch >> 6, hd = bh & 7, b = bh >> 3, row0 = b * SEQ + 32 * c;
    LAS unsigned char* TL = F.lds + F.wave * GA_WAVE_LDS; LAS float* LT = (LAS float*)(TL + 32 * GA_PITCH); LAS float* GS = (LAS float*)(TL + 32 * GA_PITCH + 32 * GA_LT_PITCH * 4);
    const bf16* QN = (const bf16*)(F.ws + WS_QN); const bf16* KN = (const bf16*)(F.ws + WS_KN); const bf16* VV = (const bf16*)(F.ws + WS_VV); const f32x4* TOK = (const f32x4*)(F.ws + WS_TOK);
    { const f32x4 tk = TOK[(size_t)(row0 + r) * 8 + hd]; if (h == 0) { GS[r] = tk.w; GS[32 + r] = tk.y; } }
#pragma unroll
    for (int i = 0; i < 8; ++i) { const int p = lane + 64 * i, rw = p >> 4, c16 = p & 15; *(LAS v4u*)(TL + rw * GA_PITCH + 16 * c16) = *(const v4u*)(KN + (size_t)(row0 + rw) * 1024 + hd * 128 + 8 * c16); }
    asm volatile("s_waitcnt lgkmcnt(0)" ::: "memory");
    float gcv[32], bev[32];
#pragma unroll
    for (int i = 0; i < 8; ++i) { const f32x4 a = *(const LAS f32x4*)(GS + 4 * i), bq = *(const LAS f32x4*)(GS + 32 + 4 * i);
        gcv[4 * i] = a.x; gcv[4 * i + 1] = a.y; gcv[4 * i + 2] = a.z; gcv[4 * i + 3] = a.w; bev[4 * i] = bq.x; bev[4 * i + 1] = bq.y; bev[4 * i + 2] = bq.z; bev[4 * i + 3] = bq.w; }
#pragma unroll
    for (int i = 1; i < 32; ++i) gcv[i] += gcv[i - 1];
    if (lane == 0) {
#pragma unroll
        for (int i = 0; i < 8; ++i) *(LAS f32x4*)(GS + 64 + 4 * i) = (f32x4){gcv[4 * i], gcv[4 * i + 1], gcv[4 * i + 2], gcv[4 * i + 3]}; }
    asm volatile("s_waitcnt lgkmcnt(0)" ::: "memory");
    const float gc_own = GS[64 + r], fr = (float)r;
    const bf16* kp = KN + (size_t)(row0 + r) * 1024 + hd * 128 + 8 * h; const bf16* qp = QN + (size_t)(row0 + r) * 1024 + hd * 128 + 8 * h;
    f32x16 akk, aqk;
#pragma unroll
    for (int i = 0; i < 16; ++i) { akk[i] = 0.f; aqk[i] = 0.f; }
#pragma unroll
    for (int ks = 0; ks < 8; ++ks) { const bf16x8 kf = *(const bf16x8*)(kp + 16 * ks), qf = *(const bf16x8*)(qp + 16 * ks);
        akk = __builtin_amdgcn_mfma_f32_32x32x16_bf16(kf, kf, akk, 0, 0, 0); aqk = __builtin_amdgcn_mfma_f32_32x32x16_bf16(kf, qf, aqk, 0, 0, 0); }
#pragma unroll
    for (int g4 = 0; g4 < 4; ++g4) { f32x4 w;
#pragma unroll
        for (int e = 0; e < 4; ++e) { const int k0 = 8 * g4 + e, k1 = k0 + 4; const float gk = h ? gcv[k1] : gcv[k0], bk = h ? bev[k1] : bev[k0]; const int kk = h ? k1 : k0;
            const float lo = fminf(fmaxf((float)kk - fr, 0.f), 1.f);
            w[e] = lo * bk * akk[4 * g4 + e] * __expf(fminf(gk - gc_own, 0.f));
            aqk[4 * g4 + e] = (1.f - lo) * aqk[4 * g4 + e] * __expf(fminf(gc_own - gk, 0.f)); }
        *(LAS f32x4*)(LT + r * GA_LT_PITCH + 8 * g4 + 4 * h) = w; }
    bf16x8* AF = (bf16x8*)(F.ws + WS_AF) + (size_t)ch * 128;
    AF[lane] = pack_acc(aqk, 0); AF[64 + lane] = pack_acc(aqk, 1);
    asm volatile("s_waitcnt lgkmcnt(0)" ::: "memory");
    float t[32];
#pragma unroll
    for (int j = 31; j >= 0; --j) {
        float acc = 1.f - fminf(fabsf(fr - (float)j), 1.f);
#pragma unroll
        for (int gq = (j + 1) >> 2; gq < 8; ++gq) { const f32x4 lv = *(const LAS f32x4*)(LT + j * GA_LT_PITCH + 4 * gq);
#pragma unroll
            for (int e = 0; e < 4; ++e) if (4 * gq + e > j) acc -= t[4 * gq + e] * lv[e]; }
        t[j] = acc;
    }
    bf16x8 t1f[2], t2f[2];
#pragma unroll
    for (int sp = 0; sp < 2; ++sp) { float x1[8], x2[8];
#pragma unroll
        for (int e = 0; e < 8; ++e) { const int j0 = 16 * sp + e, j1 = j0 + 8; const float tv = h ? t[j1] : t[j0], bj = h ? bev[j1] : bev[j0], gj = h ? gcv[j1] : gcv[j0]; x1[e] = tv * bj; x2[e] = x1[e] * __expf(gj); }
        t1f[sp] = __builtin_bit_cast(bf16x8, pack8(x1)); t2f[sp] = __builtin_bit_cast(bf16x8, pack8(x2)); }
    { bf16x8* QFo = (bf16x8*)(F.ws + WS_QF) + (size_t)ch * 512; const bf16* qrow = QN + (size_t)(row0 + r) * 1024 + hd * 128 + 4 * h;
#pragma unroll
      for (int tl = 0; tl < 4; ++tl)
#pragma unroll
          for (int sp = 0; sp < 2; ++sp) { const v2u qlo = *(const v2u*)(qrow + 32 * tl + 16 * sp), qhi = *(const v2u*)(qrow + 32 * tl + 16 * sp + 8); v4u qu; qu.x = qlo.x; qu.y = qlo.y; qu.z = qhi.x; qu.w = qhi.y; QFo[(tl * 2 + sp) * 64 + lane] = __builtin_bit_cast(bf16x8, qu); } }
    const float g_last = gcv[31];
    bf16x8* WF = (bf16x8*)(F.ws + WS_WF) + (size_t)ch * 512; bf16x8* KF = (bf16x8*)(F.ws + WS_KF) + (size_t)ch * 512;
#pragma unroll
    for (int tl = 0; tl < 4; ++tl) {
        f32x16 acc;
#pragma unroll
        for (int i = 0; i < 16; ++i) acc[i] = 0.f;
        const LAS unsigned char* col = TL + (32 * tl + r) * 2;
#pragma unroll
        for (int sp = 0; sp < 2; ++sp) { unsigned w[4];
#pragma unroll
            for (int e = 0; e < 4; ++e) { const unsigned lo = *(const LAS unsigned short*)(col + (16 * sp + 8 * h + 2 * e) * GA_PITCH), hi = *(const LAS unsigned short*)(col + (16 * sp + 8 * h + 2 * e + 1) * GA_PITCH); w[e] = lo | (hi << 16); }
            v4u wu; wu.x = w[0]; wu.y = w[1]; wu.z = w[2]; wu.w = w[3];
            acc = __builtin_amdgcn_mfma_f32_32x32x16_bf16(__builtin_bit_cast(bf16x8, wu), t2f[sp], acc, 0, 0, 0); }
#pragma unroll
        for (int i = 0; i < 16; ++i) acc[i] = -acc[i];
#pragma unroll
        for (int sp = 0; sp < 2; ++sp) { WF[(tl * 2 + sp) * 64 + lane] = pack_acc(acc, sp);
            float x[8];
#pragma unroll
            for (int e = 0; e < 8; ++e) { const int j0 = 16 * sp + 8 * (e >> 2) + (e & 3), j1 = j0 + 4; const float gj = h ? gcv[j1] : gcv[j0];
                const unsigned kv = *(const LAS unsigned short*)(col + (j0 + 4 * h) * GA_PITCH); x[e] = __builtin_bit_cast(float, kv << 16) * __expf(g_last - gj); }
            KF[(tl * 2 + sp) * 64 + lane] = __builtin_bit_cast(bf16x8, pack8(x)); }
    }
    asm volatile("s_waitcnt lgkmcnt(0)" ::: "memory");
#pragma unroll
    for (int i = 0; i < 8; ++i) { const int p = lane + 64 * i, rw = p >> 4, c16 = p & 15; *(LAS v4u*)(TL + rw * GA_PITCH + 16 * c16) = *(const v4u*)(VV + (size_t)(row0 + rw) * 1024 + hd * 128 + 8 * c16); }
    asm volatile("s_waitcnt lgkmcnt(0)" ::: "memory");
    f32x4* UF = (f32x4*)(F.ws + WS_UF) + (size_t)ch * 1024;
#pragma unroll
    for (int tl = 0; tl < 4; ++tl) {
        f32x16 acc;
#pragma unroll
        for (int i = 0; i < 16; ++i) acc[i] = 0.f;
        const LAS unsigned char* col = TL + (32 * tl + r) * 2;
#pragma unroll
        for (int sp = 0; sp < 2; ++sp) { unsigned w[4];
#pragma unroll
            for (int e = 0; e < 4; ++e) { const unsigned lo = *(const LAS unsigned short*)(col + (16 * sp + 8 * h + 2 * e) * GA_PITCH), hi = *(const LAS unsigned short*)(col + (16 * sp + 8 * h + 2 * e + 1) * GA_PITCH); w[e] = lo | (hi << 16); }
            v4u wu; wu.x = w[0]; wu.y = w[1]; wu.z = w[2]; wu.w = w[3];
            acc = __builtin_amdgcn_mfma_f32_32x32x16_bf16(t1f[sp], __builtin_bit_cast(bf16x8, wu), acc, 0, 0, 0); }
#pragma unroll
        for (int g4 = 0; g4 < 4; ++g4) UF[(tl * 4 + g4) * 64 + lane] = (f32x4){acc[4 * g4], acc[4 * g4 + 1], acc[4 * g4 + 2], acc[4 * g4 + 3]};
    }
    if (h == 0) ((float*)(F.ws + WS_TB))[(size_t)ch * 32 + r] = __expf(gc_own);
    asm volatile("s_waitcnt lgkmcnt(0)" ::: "memory");
}

constexpr int GSC_ITEMS = BATCH * HA * 4;
constexpr int GSB_WF = 0, GSB_KF = 8192, GSB_QF = 16384, GSB_UF = 24576, GSB_AF = 28672, GSB_TB = 30720, GSB_AL = 34816, GSB_STRIDE = 36864;
__device__ __forceinline__ void gdn_chunk_scan(Frame& F0, int l, int item) {
    RELANE(F0);
    const int lane = F.lane, r = lane & 31, h = lane >> 5;
    const int sl = item & 3, bh = item >> 2, hd = bh & 7, b = bh >> 3;
    float* ORAW = (float*)(F.ws + WS_ORAW);
    LAS unsigned char* buf = F.lds;
#define GS_DMA(src, off) __builtin_amdgcn_global_load_lds((const unsigned*)(src), (LAS unsigned*)(bp + (off)), 16, 0, 0)
#define GS_FETCH(cc, bsel) do { const size_t ch_ = (size_t)bh * 64 + (cc); LAS unsigned char* bp = buf + (bsel) * GSB_STRIDE; \
        const bf16x8* wf_ = (const bf16x8*)(F.ws + WS_WF) + ch_ * 512 + lane; const bf16x8* kf_ = (const bf16x8*)(F.ws + WS_KF) + ch_ * 512 + lane; const bf16x8* qf_ = (const bf16x8*)(F.ws + WS_QF) + ch_ * 512 + lane; \
        const f32x4* uf_ = (const f32x4*)(F.ws + WS_UF) + ch_ * 1024 + (size_t)sl * 256 + lane; const bf16x8* af_ = (const bf16x8*)(F.ws + WS_AF) + ch_ * 128 + lane; const float* tb_ = (const float*)(F.ws + WS_TB) + ch_ * 32; \
        _Pragma("unroll") for (int i_ = 0; i_ < 8; ++i_) { GS_DMA(wf_ + i_ * 64, GSB_WF + i_ * 1024); GS_DMA(qf_ + i_ * 64, GSB_QF + i_ * 1024); } \
        _Pragma("unroll") for (int i_ = 0; i_ < 4; ++i_) { GS_DMA(uf_ + i_ * 64, GSB_UF + i_ * 1024); GS_DMA(tb_ + 8 * i_ + 4 * h, GSB_TB + i_ * 1024); } \
        GS_DMA(af_, GSB_AF); GS_DMA(af_ + 64, GSB_AF + 1024); GS_DMA(tb_ + 28, GSB_AL); \
        _Pragma("unroll") for (int i_ = 0; i_ < 8; ++i_) GS_DMA(kf_ + i_ * 64, GSB_KF + i_ * 1024); } while (0)
    f32x16 S[4];
#pragma unroll
    for (int tl = 0; tl < 4; ++tl)
#pragma unroll
        for (int i = 0; i < 16; ++i) S[tl][i] = 0.f;
    GS_FETCH(0, 0);
#pragma unroll 1
    for (int c = 0; c < SEQ / 32; ++c) {
        const int row0 = b * SEQ + 32 * c;
        asm volatile("s_waitcnt vmcnt(0)" ::: "memory");
        if (c + 1 < SEQ / 32) GS_FETCH(c + 1, (c + 1) & 1);
        const LAS unsigned char* bp = buf + (c & 1) * GSB_STRIDE + lane * 16;
        f32x16 P, O1;
#pragma unroll
        for (int g4 = 0; g4 < 4; ++g4) { const f32x4 u = *(const LAS f32x4*)(bp + GSB_UF + g4 * 1024); P[4 * g4] = u.x; P[4 * g4 + 1] = u.y; P[4 * g4 + 2] = u.z; P[4 * g4 + 3] = u.w; }
#pragma unroll
        for (int i = 0; i < 16; ++i) O1[i] = 0.f;
#pragma unroll
        for (int tl = 0; tl < 4; ++tl)
#pragma unroll
            for (int sp = 0; sp < 2; ++sp) {
                const bf16x8 sf = pack_acc(S[tl], sp);
                P = __builtin_amdgcn_mfma_f32_32x32x16_bf16(*(const LAS bf16x8*)(bp + GSB_WF + (tl * 2 + sp) * 1024), sf, P, 0, 0, 0);
                O1 = __builtin_amdgcn_mfma_f32_32x32x16_bf16(*(const LAS bf16x8*)(bp + GSB_QF + (tl * 2 + sp) * 1024), sf, O1, 0, 0, 0);
            }
#pragma unroll
        for (int g4 = 0; g4 < 4; ++g4) { const f32x4 eg = *(const LAS f32x4*)(bp + GSB_TB + g4 * 1024); O1[4 * g4] *= eg.x; O1[4 * g4 + 1] *= eg.y; O1[4 * g4 + 2] *= eg.z; O1[4 * g4 + 3] *= eg.w; }
        const bf16x8 vf0 = pack_acc(P, 0), vf1 = pack_acc(P, 1);
        O1 = __builtin_amdgcn_mfma_f32_32x32x16_bf16(*(const LAS bf16x8*)(bp + GSB_AF), vf0, O1, 0, 0, 0);
        O1 = __builtin_amdgcn_mfma_f32_32x32x16_bf16(*(const LAS bf16x8*)(bp + GSB_AF + 1024), vf1, O1, 0, 0, 0);
        const float a_last = (*(const LAS f32x4*)(bp + GSB_AL)).w;
#pragma unroll
        for (int tl = 0; tl < 4; ++tl) {
#pragma unroll
            for (int i = 0; i < 16; ++i) S[tl][i] *= a_last;
            S[tl] = __builtin_amdgcn_mfma_f32_32x32x16_bf16(*(const LAS bf16x8*)(bp + GSB_KF + (tl * 2) * 1024), vf0, S[tl], 0, 0, 0);
            S[tl] = __builtin_amdgcn_mfma_f32_32x32x16_bf16(*(const LAS bf16x8*)(bp + GSB_KF + (tl * 2 + 1) * 1024), vf1, S[tl], 0, 0, 0);
        }
        float* op = ORAW + (size_t)(row0 + 4 * h) * 1024 + hd * 128 + 32 * sl + r;
#pragma unroll
        for (int i = 0; i < 16; ++i) op[(size_t)((i & 3) + 8 * (i >> 2)) * 1024] = O1[i];
    }
#undef GS_DMA
#undef GS_FETCH
    float* Sout = F.out + O_PGDN + (size_t)((l * BATCH + b) * HA + hd) * 16384 + 32 * sl + r;
#pragma unroll
    for (int tl = 0; tl < 4; ++tl)
#pragma unroll
        for (int i = 0; i < 16; ++i) Sout[(size_t)(32 * tl + (i & 3) + 8 * (i >> 2) + 4 * h) * 128] = S[tl][i];
}

constexpr int VT_PITCH = 144, VT_WAVE_LDS = 64 * VT_PITCH, VT_ITEMS = BATCH * 3 * 4 * 2 * 32;
__device__ __forceinline__ void vt_item(Frame& F0, int item) {
    RELANE(F0);
    const int lane = F.lane; LAS unsigned char* T = F.lds + F.wave * VT_WAVE_LDS;
    const int ch = item & 31, dh = (item >> 5) & 1, hh = (item >> 6) & 3, bg = item >> 8, g = bg % 3, b = bg / 3;
    const int dil = 1 << (2 * g), Lc = SEQ >> (2 * g), pos0 = ch * 64, rho = pos0 / Lc, i0 = pos0 % Lc;
    const bf16* PROJ = (const bf16*)(F.ws + WS_PROJ); bf16* VT = (bf16*)(F.ws + WS_VT);
    const bf16* src = PROJ + ((size_t)b * SEQ + (size_t)(i0 + lane) * dil + rho) * NIN + PC_VB + g * 512 + hh * 128 + 64 * dh;
    v4u x[8];
#pragma unroll
    for (int c = 0; c < 8; ++c) x[c] = *(const v4u*)(src + 8 * c);
#pragma unroll
    for (int c = 0; c < 8; ++c) { const unsigned w[4] = {x[c].x, x[c].y, x[c].z, x[c].w};
#pragma unroll
        for (int e = 0; e < 4; ++e) { *(LAS unsigned short*)(T + (8 * c + 2 * e) * VT_PITCH + 2 * lane) = (unsigned short)(w[e] & 0xffffu); *(LAS unsigned short*)(T + (8 * c + 2 * e + 1) * VT_PITCH + 2 * lane) = (unsigned short)(w[e] >> 16); } }
    asm volatile("s_waitcnt lgkmcnt(0)" ::: "memory");
    bf16* dst = VT + ((size_t)((b * 3 + g) * 4 + hh) * 128 + 64 * dh) * 2048 + pos0;
#pragma unroll
    for (int it = 0; it < 8; ++it) { const int p = lane + 64 * it, row = p >> 3, cc = p & 7; const v4u v = *(const LAS v4u*)(T + row * VT_PITCH + 16 * cc); *(v4u*)(dst + (size_t)row * 2048 + 8 * cc) = v; }
    asm volatile("s_waitcnt lgkmcnt(0)" ::: "memory");
}

constexpr int ATT_UNITS = BATCH * 4 * 192;
__device__ __forceinline__ void attn_unit(Frame& F0, int unit) {
    RELANE(F0);
    const int lane = F.lane, r = lane & 31, h = lane >> 5;
    const int bh = unit / 192, b = bh >> 2, hh = bh & 3, u = unit % 192, g = u >> 6, v = u & 63;
    const int dil = 1 << (2 * g), ntpc = 64 >> (2 * g), rho = v / ntpc, i0 = (v % ntpc) * 32, Lc = SEQ >> (2 * g);
    const bf16* PROJ = (const bf16*)(F.ws + WS_PROJ);
    const bf16* cbase = PROJ + ((size_t)b * SEQ + rho) * NIN + g * 512 + hh * 128 + 8 * h;
    const bf16* qp = cbase + (size_t)(i0 + r) * dil * NIN + PC_QB;
    bf16x8 qf[8];
#pragma unroll
    for (int ks = 0; ks < 8; ++ks) qf[ks] = *(const bf16x8*)(qp + 16 * ks);
    f32x16 st[5]; float mx = -1e30f;
    bf16x8 kn[8];
    { const int k0 = i0 - 128; const bf16* kp = cbase + (size_t)((k0 >= 0 ? k0 : 0) + r) * dil * NIN + PC_KB;
#pragma unroll
      for (int ks = 0; ks < 8; ++ks) kn[ks] = *(const bf16x8*)(kp + 16 * ks); }
#pragma unroll
    for (int kt = 0; kt < 5; ++kt) {
        const int k0 = i0 - 128 + 32 * kt; const bool tv = k0 >= 0;
        bf16x8 kc[8];
#pragma unroll
        for (int ks = 0; ks < 8; ++ks) kc[ks] = kn[ks];
        if (kt < 4) { const int k1 = k0 + 32; const bf16* kp = cbase + (size_t)((k1 >= 0 ? k1 : 0) + r) * dil * NIN + PC_KB;
#pragma unroll
            for (int ks = 0; ks < 8; ++ks) kn[ks] = *(const bf16x8*)(kp + 16 * ks); }
        f32x16 acc;
#pragma unroll
        for (int i = 0; i < 16; ++i) acc[i] = 0.f;
#pragma unroll
        for (int ks = 0; ks < 8; ++ks) acc = __builtin_amdgcn_mfma_f32_32x32x16_bf16(kc[ks], qf[ks], acc, 0, 0, 0);
#pragma unroll
        for (int i = 0; i < 16; ++i) { const int row = (i & 3) + 8 * (i >> 2) + 4 * h; float sv = tv ? acc[i] : -1e30f;
            if (kt == 0 && row < r) sv = -1e30f;
            if (kt == 4 && row > r) sv = -1e30f;
            st[kt][i] = sv; mx = fmaxf(mx, sv); }
    }
    mx = fmaxf(mx, __shfl_xor(mx, 32));
    const float c = 0.08838834764831845f * 1.4426950408889634f, mc = mx * c; float ls = 0.f;
#pragma unroll
    for (int kt = 0; kt < 5; ++kt)
#pragma unroll
        for (int i = 0; i < 16; ++i) { const float p = __builtin_amdgcn_exp2f(st[kt][i] * c - mc); st[kt][i] = p; ls += p; }
    ls += __shfl_xor(ls, 32);
    f32x16 ot[4];
#pragma unroll
    for (int dt = 0; dt < 4; ++dt)
#pragma unroll
        for (int i = 0; i < 16; ++i) ot[dt][i] = 0.f;
    const bf16* vt = (const bf16*)(F.ws + WS_VT) + ((size_t)((b * 3 + g) * 4 + hh) * 128 + r) * 2048 + rho * Lc + 4 * h;
    v2u vn[2][4][2];
#define ATT_VLD(kt_) do { const int k0_ = i0 - 128 + 32 * (kt_), kc_ = k0_ >= 0 ? k0_ : 0; _Pragma("unroll") for (int sp = 0; sp < 2; ++sp) _Pragma("unroll") for (int dt = 0; dt < 4; ++dt) { \
            const bf16* vp = vt + (size_t)(32 * dt) * 2048 + kc_ + 16 * sp; vn[sp][dt][0] = *(const v2u*)vp; vn[sp][dt][1] = *(const v2u*)(vp + 8); } } while (0)
    ATT_VLD(0);
#pragma unroll
    for (int kt = 0; kt < 5; ++kt) {
        v2u vc[2][4][2];
#pragma unroll
        for (int sp = 0; sp < 2; ++sp)
#pragma unroll
            for (int dt = 0; dt < 4; ++dt) { vc[sp][dt][0] = vn[sp][dt][0]; vc[sp][dt][1] = vn[sp][dt][1]; }
        if (kt < 4) ATT_VLD(kt + 1);
#pragma unroll
        for (int sp = 0; sp < 2; ++sp) {
            v4u pu; pu.x = pk2(st[kt][8 * sp + 0], st[kt][8 * sp + 1]); pu.y = pk2(st[kt][8 * sp + 2], st[kt][8 * sp + 3]); pu.z = pk2(st[kt][8 * sp + 4], st[kt][8 * sp + 5]); pu.w = pk2(st[kt][8 * sp + 6], st[kt][8 * sp + 7]);
            const bf16x8 pf = __builtin_bit_cast(bf16x8, pu);
#pragma unroll
            for (int dt = 0; dt < 4; ++dt) {
                v4u vu; vu.x = vc[sp][dt][0].x; vu.y = vc[sp][dt][0].y; vu.z = vc[sp][dt][1].x; vu.w = vc[sp][dt][1].y;
                ot[dt] = __builtin_amdgcn_mfma_f32_32x32x16_bf16(__builtin_bit_cast(bf16x8, vu), pf, ot[dt], 0, 0, 0);
            }
        }
    }
#undef ATT_VLD
    const float inv = 1.f / ls; const size_t tok = (size_t)b * SEQ + (size_t)(i0 + r) * dil + rho;
    bf16* op = (bf16*)(F.ws + WS_OBG) + ((size_t)g * MV + tok) * 512 + hh * 128 + 4 * h;
#pragma unroll
    for (int dt = 0; dt < 4; ++dt)
#pragma unroll
        for (int g4 = 0; g4 < 4; ++g4) { v2u w; w.x = pk2(ot[dt][4 * g4] * inv, ot[dt][4 * g4 + 1] * inv); w.y = pk2(ot[dt][4 * g4 + 2] * inv, ot[dt][4 * g4 + 3] * inv); *(v2u*)(op + 32 * dt + 8 * g4) = w; }
    if (h == 0) *(f32x2*)((float*)(F.ws + WS_AST) + (((size_t)g * MV + tok) * 4 + hh) * 2) = (f32x2){mc, ls};
}


__device__ __forceinline__ void attn_sample_item(Frame& F0, int l, int item) {
    RELANE(F0);
    const int lane = F.lane, l16 = lane & 15;
    const int half = item & 1, it2 = item >> 1, g = it2 % 3, bt = it2 / 3, t = bt & 3, b = bt >> 2, dil = 1 << (2 * g), win = 128 * dil, jlo = half ? 65 : 0, part = g + 3 * half;
    const bf16* PROJ = (const bf16*)(F.ws + WS_PROJ);
    const int row = MP + DS * b + t;
    const float* cache = F.in[2 + g] + (size_t)(l * DB + b) * win * 1024 + 8 * lane;
    const bf16* newk = PROJ + (size_t)(MP + DS * b) * NIN + PC_KB + g * 512 + 8 * lane;
    float q[8]; unpack8(*(const v4u*)(PROJ + (size_t)row * NIN + PC_QB + g * 512 + 8 * lane), q);
    const int n_new = (g == 0) ? t + 1 : 1;
    const float c = 0.08838834764831845f * 1.4426950408889634f;
    float sc[5];
#pragma unroll
    for (int jr = 0; jr < 5; ++jr) {
        sc[jr] = -1e30f;
        const int jn = jr < 4 ? 16 : 1;
#pragma unroll 8
        for (int jl = 0; jl < jn; ++jl) {
            const int j = jlo + 16 * jr + jl, jc = j <= 128 ? j : 128; int idx = win + t - jc * dil; idx = idx < win ? idx : win - 1;
            const float* kp = cache + (size_t)idx * 1024; const f32x4 a = *(const f32x4*)kp, bq = *(const f32x4*)(kp + 4);
            float sv = (q[0] * a.x + q[1] * a.y) + (q[2] * a.z + q[3] * a.w) + (q[4] * bq.x + q[5] * bq.y) + (q[6] * bq.z + q[7] * bq.w);
            sv = j <= 128 ? row16_sum(sv) * c : -1e30f;
            sc[jr] = (l16 == jl) ? sv : sc[jr];
        }
    }
#pragma unroll
    for (int jj = 0; jj < 4; ++jj) {
        const int tk = t - jj >= 0 ? t - jj : 0; float k[8]; unpack8(*(const v4u*)(newk + (size_t)tk * NIN), k);
        float sv = (q[0] * k[0] + q[1] * k[1]) + (q[2] * k[2] + q[3] * k[3]) + (q[4] * k[4] + q[5] * k[5]) + (q[6] * k[6] + q[7] * k[7]);
        sv = row16_sum(sv) * c;
        sc[0] = (half == 0 && jj < n_new && l16 == jj) ? sv : sc[0];
    }
    float mx = -1e30f;
#pragma unroll
    for (int jr = 0; jr < 5; ++jr) mx = fmaxf(mx, sc[jr]);
    mx = fmaxf(mx, dpp_f<0xB1>(mx)); mx = fmaxf(mx, dpp_f<0x4E>(mx)); mx = fmaxf(mx, dpp_f<0x124>(mx)); mx = fmaxf(mx, dpp_f<0x128>(mx));
    float ls = 0.f;
#pragma unroll
    for (int jr = 0; jr < 5; ++jr) { sc[jr] = __builtin_amdgcn_exp2f(sc[jr] - mx); ls += sc[jr]; }
    ls = row16_sum(ls);
    float o[8];
#pragma unroll
    for (int e = 0; e < 8; ++e) o[e] = 0.f;
#pragma unroll
    for (int jj = 0; jj < 4; ++jj) {
        const int tk = t - jj >= 0 ? t - jj : 0; float vv[8]; unpack8(*(const v4u*)(newk + (size_t)tk * NIN + (PC_VB - PC_KB)), vv);
        const bool isnew = half == 0 && jj < n_new;
        const float p = isnew ? __shfl(sc[0], (lane & 48) | jj) : 0.f;
#pragma unroll
        for (int e = 0; e < 8; ++e) o[e] += p * vv[e];
        sc[0] = (isnew && l16 == jj) ? 0.f : sc[0];
    }
#pragma unroll
    for (int jr = 0; jr < 5; ++jr) {
        const int jn = jr < 4 ? 16 : 1;
#pragma unroll 8
        for (int jl = 0; jl < jn; ++jl) {
            const int j = jlo + 16 * jr + jl, jc = j <= 128 ? j : 128; int idx = win + t - jc * dil; idx = idx < win ? idx : win - 1;
            const float p = __shfl(sc[jr], (lane & 48) | jl);
            const float* vp = cache + (size_t)idx * 1024 + 512; const f32x4 a = *(const f32x4*)vp, bq = *(const f32x4*)(vp + 4);
            o[0] += p * a.x; o[1] += p * a.y; o[2] += p * a.z; o[3] += p * a.w; o[4] += p * bq.x; o[5] += p * bq.y; o[6] += p * bq.z; o[7] += p * bq.w;
        }
    }
    const float inv = 1.f / ls;
#pragma unroll
    for (int e = 0; e < 8; ++e) o[e] *= inv;
    *(v4u*)((bf16*)(F.ws + WS_OBG) + ((size_t)part * MV + row) * 512 + 8 * lane) = pack8(o);
    if (l16 == 0) *(f32x2*)((float*)(F.ws + WS_AST) + (((size_t)part * MV + row) * 4 + (lane >> 4)) * 2) = (f32x2){mx, ls};
}

__device__ __forceinline__ void gdn_gate_rows(Frame& F0, int l) {
    RELANE(F0);
    const int lane = F.lane, gw = F.vcu * NWAVES + F.wave, NGW = F.G * NWAVES;
    const float* ORAW = (const float*)(F.ws + WS_ORAW); const bf16* PROJ = (const bf16*)(F.ws + WS_PROJ); bf16* OUTA = (bf16*)(F.ws + WS_OUTA);
    const float* gain = F.in[12] + (size_t)l * 128;
    for (int r = gw; r < MV; r += NGW) {
#pragma unroll
        for (int j = 0; j < 4; ++j) {
            const int c0 = 256 * j + 4 * lane; const f32x4 o = *(const f32x4*)(ORAW + (size_t)r * 1024 + c0);
            float ss = (o.x * o.x + o.y * o.y) + (o.z * o.z + o.w * o.w);
            ss += __shfl_xor(ss, 1); ss += __shfl_xor(ss, 2); ss += __shfl_xor(ss, 4); ss += __shfl_xor(ss, 8); ss += __shfl_xor(ss, 16);
            const float rstd = rsqrtf(ss * (1.f / 128.f) + EPS);
            const f32x4 g = *(const f32x4*)(gain + (c0 & 127)); const v2u zu = *(const v2u*)(PROJ + (size_t)r * NIN + PC_ZA + c0);
            const float z0 = bf_lo(zu.x), z1 = bf_hi(zu.x), z2 = bf_lo(zu.y), z3 = bf_hi(zu.y);
            v2u w; w.x = pk2(o.x * rstd * g.x * silu(z0), o.y * rstd * g.y * silu(z1)); w.y = pk2(o.z * rstd * g.z * silu(z2), o.w * rstd * g.w * silu(z3));
            *(v2u*)(OUTA + (size_t)r * 1024 + c0) = w;
        }
        {
            const int c0 = 8 * lane, hh = lane >> 4; const float* ast = (const float*)(F.ws + WS_AST); const bf16* obg = (const bf16*)(F.ws + WS_OBG);
            const int np = r < MP ? 3 : 6;
            f32x2 sg[6]; v4u xo[6]; float M = -1e30f;
#pragma unroll
            for (int g = 0; g < 6; ++g) { const int gg = g < np ? g : 0; sg[g] = *(const f32x2*)(ast + (((size_t)gg * MV + r) * 4 + hh) * 2); xo[g] = *(const v4u*)(obg + ((size_t)gg * MV + r) * 512 + c0); }
#pragma unroll
            for (int g = 0; g < 6; ++g) { if (g >= np) sg[g] = (f32x2){-1e30f, 0.f}; M = fmaxf(M, sg[g].x); }
            float wg[6], den = 0.f;
#pragma unroll
            for (int g = 0; g < 6; ++g) { wg[g] = __builtin_amdgcn_exp2f(sg[g].x - M) * sg[g].y; den += wg[g]; }
            const float inv = 1.f / den; float o[8];
#pragma unroll
            for (int e = 0; e < 8; ++e) o[e] = 0.f;
#pragma unroll
            for (int g = 0; g < 6; ++g) { float x[8]; unpack8(xo[g], x); const float w = wg[g] * inv;
#pragma unroll
                for (int e = 0; e < 8; ++e) o[e] += w * x[e]; }
            *(v4u*)((bf16*)(F.ws + WS_OUTB) + (size_t)r * 512 + c0) = pack8(o);
        }
    }
}


constexpr int CP_PER_B = 31 + 127 + 511, CP_NSUB = DB * CP_PER_B;
constexpr int CP_TAIL_WG = 84, CP_TAIL_PER_WG = 64, CP_TAIL = CP_TAIL_WG * CP_TAIL_PER_WG;
__device__ __forceinline__ void copy_subchunk(Frame& F, int l, int c) {
    const int lane = F.lane, b = c / CP_PER_B, rc = c % CP_PER_B; const int gi = rc < 31 ? 0 : rc < 158 ? 1 : 2, k = rc - (gi == 0 ? 0 : gi == 1 ? 31 : 158), win = 128 << (2 * gi);
    const f32x4* src = (const f32x4*)(F.in[2 + gi] + ((size_t)(l * DB + b) * win + DS + 4 * k) * 1024) + lane;
    f32x4* dst = (f32x4*)(F.out + (gi == 0 ? O_SW1 : gi == 1 ? O_SW2 : O_SW3) + ((size_t)(l * DB + b) * win + 4 * k) * 1024) + lane;
    f32x4 v[16];
#pragma unroll
    for (int i = 0; i < 16; ++i) v[i] = __builtin_nontemporal_load(src + 64 * i);
#pragma unroll
    for (int i = 0; i < 16; ++i) __builtin_nontemporal_store(v[i], dst + 64 * i);
}
__device__ __forceinline__ void side_queue(Frame& F0, int l, volatile LAS unsigned* qctr) {
    RELANE(F0);
    const int lane = F.lane;
    const int nsub = CP_NSUB - (F.G == 256 ? CP_TAIL : 0);
    const int ncp = (nsub - (int)blockIdx.x + F.G - 1) / F.G;
    const int wper = 0,     w0 = (int)blockIdx.x * wper, nw = max(0, min(IT_LAYER, w0 + wper) - w0);
    LAS float* scr = (LAS float*)F.lds;
    for (;;) {
        unsigned q = 0; if (lane == 0) q = __hip_atomic_fetch_add((LAS unsigned*)qctr, 1u, __ATOMIC_RELAXED, __HIP_MEMORY_SCOPE_WORKGROUP);
        q = (unsigned)__builtin_amdgcn_readfirstlane((int)q);
        if ((int)q >= ncp + nw) break;
        if ((int)q < ncp) { copy_subchunk(F, l, (int)q * F.G + (int)blockIdx.x);
        } else weight_item(F, l + 1, w0 + (int)q - ncp, scr);
    }
}


__device__ __forceinline__ f32x16 skinny_kloop(const bf16* ap, const bf16* bp, int nks, f32x16 acc) {
    int ks = 0;
    for (; ks + 8 <= nks; ks += 8) { bf16x8 a[8], b[8];
#pragma unroll
        for (int u = 0; u < 8; ++u) { a[u] = *(const bf16x8*)(ap + 16 * (ks + u)); b[u] = *(const bf16x8*)(bp + 16 * (ks + u)); }
#pragma unroll
        for (int u = 0; u < 8; ++u) acc = __builtin_amdgcn_mfma_f32_32x32x16_bf16(a[u], b[u], acc, 0, 0, 0); }
    for (; ks < nks; ks += 4) { bf16x8 a[4], b[4];
#pragma unroll
        for (int u = 0; u < 4; ++u) { a[u] = *(const bf16x8*)(ap + 16 * (ks + u)); b[u] = *(const bf16x8*)(bp + 16 * (ks + u)); }
#pragma unroll
        for (int u = 0; u < 4; ++u) acc = __builtin_amdgcn_mfma_f32_32x32x16_bf16(a[u], b[u], acc, 0, 0, 0); }
    return acc;
}
__device__ __forceinline__ f32x2 skinny_reduce(Frame& F, const f32x16& acc) {
    LAS float* P = (LAS float*)F.lds; const int r = F.lane & 31, h = F.lane >> 5;
    __syncthreads();
#pragma unroll
    for (int i = 0; i < 16; ++i) P[(F.wave * 32 + (i & 3) + 8 * (i >> 2) + 4 * h) * 33 + r] = acc[i];
    __syncthreads();
    const int row = F.tid >> 4, col = 2 * (F.tid & 15); f32x2 o = {0.f, 0.f};
#pragma unroll
    for (int w = 0; w < 8; ++w) { o.x += P[(w * 32 + row) * 33 + col]; o.y += P[(w * 32 + row) * 33 + col + 1]; }
    return o;
}
__device__ __forceinline__ void skinny_store(Frame& F0, const bf16* A, int lda, const bf16* Bt, int K, bf16* O) {
    RELANE(F0);
    const int r = F.lane & 31, h = F.lane >> 5, kw = K / 8;
    for (int unit = launder_s((int)blockIdx.x); unit < 256; unit += F.G) {
        const int mt = unit >> 6, nt = unit & 63;
        f32x16 acc;
#pragma unroll
        for (int i = 0; i < 16; ++i) acc[i] = 0.f;
        acc = skinny_kloop(A + (size_t)(MP + 32 * mt + r) * lda + F.wave * kw + 8 * h, Bt + (size_t)(32 * nt + r) * K + F.wave * kw + 8 * h, kw / 16, acc);
        const f32x2 o = skinny_reduce(F, acc);
        *(unsigned*)(O + (size_t)(MP + 32 * mt + (F.tid >> 4)) * D + 32 * nt + 2 * (F.tid & 15)) = pk2(o.x, o.y);
    }
}
__device__ __forceinline__ void skinny_merge(Frame& F0, const unsigned char* wl) {
    RELANE(F0);
    const int r = F.lane & 31, h = F.lane >> 5; const bf16* PROJ = (const bf16*)(F.ws + WS_PROJ);
    for (int unit = launder_s((int)blockIdx.x); unit < 256; unit += F.G) {
        const int mt = unit >> 6, nt = unit & 63;
        f32x16 tot;
#pragma unroll
        for (int i = 0; i < 16; ++i) tot[i] = 0.f;
#pragma unroll
        for (int br = 0; br < 3; ++br) {
            const int K = br == 1 ? 512 : 1024, kw = K / 8;
            const bf16* A = (const bf16*)(F.ws + (br == 0 ? WS_OUTA : br == 1 ? WS_OUTB : WS_OC)); const bf16* Bt = (const bf16*)(wl + (br == 0 ? WO_BRA : br == 1 ? WO_BRB : WO_BRC));
            f32x16 acc;
#pragma unroll
            for (int i = 0; i < 16; ++i) acc[i] = 0.f;
            acc = skinny_kloop(A + (size_t)(MP + 32 * mt + r) * K + F.wave * kw + 8 * h, Bt + (size_t)(32 * nt + r) * K + F.wave * kw + 8 * h, kw / 16, acc);
            const bf16* gp = PROJ + (size_t)(MP + 32 * mt + 4 * h) * NIN + PC_GATE + br * 2048 + 32 * nt + r;
#pragma unroll
            for (int i = 0; i < 16; ++i) tot[i] += acc[i] * bf1(gp[(size_t)((i & 3) + 8 * (i >> 2)) * NIN]);
        }
        const f32x2 o = skinny_reduce(F, tot);
        *(unsigned*)((bf16*)(F.ws + WS_MERGED) + (size_t)(MP + 32 * mt + (F.tid >> 4)) * D + 32 * nt + 2 * (F.tid & 15)) = pk2(o.x, o.y);
    }
}

constexpr int N_PHASES = 1 + 11 * DEPTH;
__global__ void __launch_bounds__(NWAVES * 64, 2) fwd(Args args) {
    extern __shared__ __attribute__((aligned(16))) unsigned char lds_raw[];
    Frame F;
    F.lds = (LAS unsigned char*)lds_raw;
    F.tid = threadIdx.x; F.lane = F.tid & 63; F.wave = __builtin_amdgcn_readfirstlane(F.tid >> 6);
    F.G = gridDim.x; { const int bx = blockIdx.x; F.vcu = (F.G % 8 == 0) ? (bx % 8) * (F.G / 8) + bx / 8 : bx; }
    const CAS Args* const ap = (const CAS Args*)__builtin_amdgcn_kernarg_segment_ptr();
    F.in = ap->in; F.out = args.out; F.ws = args.ws;
    volatile LAS unsigned* MISC = (volatile LAS unsigned*)(F.lds + MISC_OFF);
    for (int u = F.tid; u < (LDS_BYTES - LDSCTL_OFF) / 4; u += NWAVES * 64) ((LAS unsigned*)(F.lds + LDSCTL_OFF))[u] = 0u;
    __syncthreads();
#if MK_ONE_LAUNCH
    XcdBarrier bar = xcd_barrier_post((unsigned*)(F.ws + WS_CTL) + CW_BAR, MISC + 8);
#define GRID_BAR() xcd_barrier(bar)
#else
#define GRID_BAR() do {} while (0)
#endif
    const int lo = args.ph_lo, hi = args.ph_hi;
#ifndef PHMASK
#define PHMASK 0xfff
#endif
#define IN(k) (lo <= (k) && (k) < hi)
#define EN(j) ((PHMASK >> (j)) & 1)
#ifndef REPMASK
#define REPMASK 0
#endif
#ifndef SUBREP
#define SUBREP 0
#endif
#define SUBR(j) for (int sr_ = 0; sr_ < 1 + ((SUBREP >> (j)) & 1); ++sr_)
#define REPEAT(j) for (int rep_ = 0; rep_ < 1 + ((REPMASK >> (j)) & 1); ++rep_)
#define REPBAR() do { if (rep_) GRID_BAR(); F.ws = launder_p(args.ws); F.out = launder_p(args.out); F.in = launder_k(ap->in); F.vcu = launder_s(vcu0); F.wave = launder_s(wave0); gw = F.vcu * NWAVES + F.wave; } while (0)
#define SEAM(k) do { if (IN(k) && IN((k) + 1)) GRID_BAR(); } while (0)
    const int vcu0 = F.vcu, wave0 = F.wave; int gw = F.vcu * NWAVES + F.wave; const int NGW = F.G * NWAVES;
    bf16* const H = (bf16*)(F.ws + WS_H); bf16* const PROJ = (bf16*)(F.ws + WS_PROJ);

    if (EN(0) && IN(0)) REPEAT(0) { REPBAR();
        LAS float* scr = (LAS float*)(F.lds + F.wave * 16384);
        for (int it = gw; it < 2 * IT_LAYER; it += NGW) { const int l = it >= IT_LAYER ? 1 : 0; weight_item(F, l, it - l * IT_LAYER, scr); }
        __syncthreads();
        stage_wba(F, 0);
        thin_rows<true>(F, F.in[0], F.in[1], nullptr, nullptr, nullptr, F.in[21], true, 0);
        __syncthreads();
    }
    SEAM(0);
#pragma unroll 1
    for (int l = 0; l < DEPTH; ++l) {
        const int pb = 1 + 11 * l;
        unsigned char* wl = F.ws + WS_W + (size_t)l * WL_BYTES;
        if (EN(1) && IN(pb + 0)) REPEAT(1) { REPBAR();
            pg8::Gemm g{H, (const bf16*)(wl + WO_IN), D, D, D, 0}; pg8::StaticOrder S; S.init(MT, NIN, launder_s(F.G), launder_s((int)blockIdx.x));
            EpiStore E{PROJ, NIN, PC_GATE / 256};
            pg8::gemm_phase<EpiStore, pg8::StaticOrder>(F.lds, g, S, E);
        }
        SEAM(pb + 0);
        if (EN(2) && IN(pb + 1)) REPEAT(2) { REPBAR(); for (int it = gw; it < PREP_ITEMS; it += NGW) prep_item(F, l, it); prep_out_rows(F, l); for (int it = gw; it < VT_ITEMS; it += NGW) vt_item(F, it); }
        SEAM(pb + 1);
        if (EN(3) && IN(pb + 2)) REPEAT(3) { REPBAR(); for (int it = gw; it < GCH; it += NGW) gdn_ga_item(F, it); }
        SEAM(pb + 2);
        if (EN(4) && IN(pb + 3)) REPEAT(4) { REPBAR();
            if (F.tid == 0) MISC[16] = 0u;
            { pg8::Gemm g{(const bf16*)(F.ws + WS_POOLED), (const bf16*)(wl + WO_POOL), 1024, 256, 256, 512}; pg8::StaticOrder S; S.init(MT, 1024, launder_s(F.G), launder_s((int)blockIdx.x));
              EpiStore E{(bf16*)(F.ws + WS_OC), 1024, 1 << 30};
              pg8::gemm_phase<EpiStore, pg8::StaticOrder>(F.lds, g, S, E); }
            SUBR(3) for (int it = gw; it < DB * HA * 8; it += NGW) { const int s = it & 7, bh = it >> 3, b = bh >> 3, h = bh & 7;
                gdn_scan_item(F, MP + DS * b, h, s, F.in[5] + (size_t)((l * DB + b) * HA + h) * 16384, F.out + O_SGDN + (size_t)((l * DB + b) * HA + h) * 16384); }
            {
                const bool scanw = (F.wave == 0) && (F.vcu < GSC_ITEMS);
                if (scanw) { SUBR(0) gdn_chunk_scan(F, l, F.vcu); }
                else {
                    const int aw = F.vcu < GSC_ITEMS ? F.vcu * 7 + F.wave - 1 : GSC_ITEMS * 7 + (F.vcu - GSC_ITEMS) * 8 + F.wave, naw = F.G * 8 - GSC_ITEMS;
                    SUBR(1) for (int it = aw; it < ATT_UNITS; it += naw) attn_unit(F, it);
                    SUBR(2) for (int it = aw; it < MS * 6; it += naw) attn_sample_item(F, l, it);
                }
            }
            side_queue(F, l, MISC + 16);
        }
        SEAM(pb + 3);
        if (EN(5) && IN(pb + 4)) REPEAT(5) { REPBAR(); gdn_gate_rows(F, l); }
        SEAM(pb + 4);
        if (EN(6) && IN(pb + 5)) REPEAT(6) { REPBAR();
            pg8::StaticOrder S; S.init(MP, D, launder_s(F.G), launder_s((int)blockIdx.x)); bf16* MG = (bf16*)(F.ws + WS_MERGED);
            { pg8::Gemm g{(const bf16*)(F.ws + WS_OUTA), (const bf16*)(wl + WO_BRA), 1024, 1024, 1024, 0}; EpiMerge<false> E{MG, PROJ + PC_GATE}; pg8::gemm_phase<EpiMerge<false>, pg8::StaticOrder>(F.lds, g, S, E); }
            { pg8::Gemm g{(const bf16*)(F.ws + WS_OUTB), (const bf16*)(wl + WO_BRB), 512, 512, 512, 0}; EpiMerge<true> E{MG, PROJ + PC_GATE + 2048}; pg8::gemm_phase<EpiMerge<true>, pg8::StaticOrder>(F.lds, g, S, E); }
            { pg8::Gemm g{(const bf16*)(F.ws + WS_OC), (const bf16*)(wl + WO_BRC), 1024, 1024, 1024, 0}; EpiMerge<true> E{MG, PROJ + PC_GATE + 4096}; pg8::gemm_phase<EpiMerge<true>, pg8::StaticOrder>(F.lds, g, S, E); }
            skinny_merge(F, wl);
        }
        SEAM(pb + 5);
        if (EN(7) && IN(pb + 6)) REPEAT(7) { REPBAR();
            pg8::Gemm g{(const bf16*)(F.ws + WS_MERGED), (const bf16*)(wl + WO_OUT), D, D, D, 0}; pg8::StaticOrder S; S.init(MP, D, launder_s(F.G), launder_s((int)blockIdx.x));
            EpiStore E{(bf16*)(F.ws + WS_Y), D, 1 << 30};
            pg8::gemm_phase<EpiStore, pg8::StaticOrder>(F.lds, g, S, E);
            skinny_store(F, (const bf16*)(F.ws + WS_MERGED), D, (const bf16*)(wl + WO_OUT), D, (bf16*)(F.ws + WS_Y));
        }
        SEAM(pb + 6);
        if (EN(8) && IN(pb + 7)) REPEAT(8) { REPBAR();
            thin_rows<false>(F, nullptr, nullptr, (const bf16*)(F.ws + WS_Y), F.in[22] + (size_t)l * D, nullptr, F.in[23] + (size_t)l * D, false, 0, 0);
        }
        SEAM(pb + 7);
        if (EN(9) && IN(pb + 8)) REPEAT(9) { REPBAR();
            pg8::Gemm g{H, (const bf16*)(wl + WO_GU), D, D, D, 0}; pg8::StaticOrder S; S.init(MT, 2 * DFF, launder_s(F.G), launder_s((int)blockIdx.x));
            EpiSwiglu E{(bf16*)(F.ws + WS_ACT)};
            pg8::gemm_phase<EpiSwiglu, pg8::StaticOrder>(F.lds, g, S, E);
            const int bxl = launder_s((int)blockIdx.x), Gl = launder_s(F.G);
            if (Gl == 256 && bxl >= 256 - CP_TAIL_WG) {
                Frame Fc = F; Fc.lane = launder(F.lane);
                const int base = CP_NSUB - CP_TAIL + (bxl - (256 - CP_TAIL_WG)) * CP_TAIL_PER_WG;
                for (int q = F.wave; q < CP_TAIL_PER_WG; q += NWAVES) copy_subchunk(Fc, 1 - l, base + q);
            }
        }
        SEAM(pb + 8);
        if (EN(10) && IN(pb + 9)) REPEAT(10) { REPBAR();
            pg8::Gemm g{(const bf16*)(F.ws + WS_ACT), (const bf16*)(wl + WO_DOWN), DFF, DFF, DFF, 0}; pg8::StaticOrder S; S.init(MP, D, launder_s(F.G), launder_s((int)blockIdx.x));
            EpiStore E{(bf16*)(F.ws + WS_Y), D, 1 << 30};
            pg8::gemm_phase<EpiStore, pg8::StaticOrder>(F.lds, g, S, E);
            skinny_store(F, (const bf16*)(F.ws + WS_ACT), DFF, (const bf16*)(wl + WO_DOWN), DFF, (bf16*)(F.ws + WS_Y));
        }
        SEAM(pb + 9);
        if (EN(11) && IN(pb + 10)) REPEAT(11) { REPBAR();
            if (l + 1 < DEPTH) { stage_wba(F, l + 1);
                thin_rows<false>(F, nullptr, nullptr, (const bf16*)(F.ws + WS_Y), F.in[24] + (size_t)l * D, nullptr, F.in[21] + (size_t)(l + 1) * D, true, l + 1, 0);
                __syncthreads(); }
            else thin_rows<false>(F, nullptr, nullptr, (const bf16*)(F.ws + WS_Y), F.in[24] + (size_t)l * D, F.out + O_YP, nullptr, false, 0, 0);
        }
        SEAM(pb + 10);
    }
#undef IN
#undef SEAM
}

extern "C" void kernel_launch(void* const* d_in, const int* in_sizes, int n_in, void* d_out, int out_size, void* d_ws, size_t ws_size, hipStream_t stream) {
    static int grid = 0;
    if (grid == 0) {
        if (n_in != 25 || (size_t)out_size != O_END || ws_size < WS_END) { fprintf(stderr, "kernel_launch: unexpected sizes n_in %d out %d ws %zu\n", n_in, out_size, ws_size); grid = -1; return; }
        int dev = 0, cus = 0, per_cu = 0;
        if (hipGetDevice(&dev) != hipSuccess || hipDeviceGetAttribute(&cus, hipDeviceAttributeMultiprocessorCount, dev) != hipSuccess) { grid = -1; return; }
        if (hipFuncSetAttribute((const void*)fwd, hipFuncAttributeMaxDynamicSharedMemorySize, LDS_BYTES) != hipSuccess) { fprintf(stderr, "kernel_launch: hipFuncSetAttribute failed\n"); grid = -1; return; }
        if (hipOccupancyMaxActiveBlocksPerMultiprocessor(&per_cu, (const void*)fwd, NWAVES * 64, LDS_BYTES) != hipSuccess || per_cu < 1) fprintf(stderr, "kernel_launch: occupancy query says %d\n", per_cu);
        (void)hipGetLastError();
        grid = cus;
    }
    if (grid < 0) return;
    if (hipMemsetAsync((char*)d_ws + WS_CTL, 0, CTL_BYTES, stream) != hipSuccess) return;
    Args a{};
    for (int i = 0; i < 25; ++i) a.in[i] = (const float*)d_in[i];
    a.out = (float*)d_out; a.ws = (unsigned char*)d_ws;
#if MK_ONE_LAUNCH
    a.ph_lo = 0; a.ph_hi = N_PHASES;
    hipLaunchKernelGGL(fwd, dim3(grid), dim3(NWAVES * 64), LDS_BYTES, stream, a);
#else
    for (int p = 0; p < N_PHASES; ++p) { a.ph_lo = p; a.ph_hi = p + 1; hipLaunchKernelGGL(fwd, dim3(grid), dim3(NWAVES * 64), LDS_BYTES, stream, a); }
#endif
}
```

```cpp
#include <hip/hip_runtime.h>
#include <cstdio>
#include <cstdint>

#ifndef MK_ONE_LAUNCH
#define MK_ONE_LAUNCH 1
#endif

#define GAS __attribute__((address_space(1)))
#define CAS __attribute__((address_space(4)))
typedef const float* cfp_t;
#define LAS __attribute__((address_space(3)))
typedef unsigned short bf16;
typedef unsigned v4u __attribute__((ext_vector_type(4)));
typedef unsigned v2u __attribute__((ext_vector_type(2)));
typedef float f32x4 __attribute__((ext_vector_type(4)));
typedef float f32x2 __attribute__((ext_vector_type(2)));
typedef short bf16x8 __attribute__((ext_vector_type(8)));
typedef float f32x16 __attribute__((ext_vector_type(16)));

constexpr int D = 2048, BATCH = 4, SEQ = 2048, DEPTH = 2, DB = 32, DS = 4;
constexpr int MP = BATCH * SEQ;
constexpr int MS = DB * DS;
constexpr int MV = MP + MS;
constexpr int MT = 8448;
constexpr int HA = 8, CONVCH = 3072;
constexpr int CPOOL = 1024, PHIST = 15;
constexpr int DFF = 5632;
constexpr int NIN_SRC = 15888, NIN = 15872;
constexpr int PC_ZA = 3072, PC_QB = 4096, PC_KB = 5632, PC_VB = 7168, PC_UC = 8704, PC_GATE = 9728;
constexpr float EPS = 1e-6f;
constexpr size_t O_YP = 0, O_YS = O_YP + (size_t)MP * D, O_PW1 = O_YS + (size_t)MS * D;
constexpr size_t O_PW2 = O_PW1 + (size_t)2 * 4 * 128 * 1024, O_PW3 = O_PW2 + (size_t)2 * 4 * 512 * 1024, O_PGDN = O_PW3 + (size_t)2 * 4 * 2048 * 1024;
constexpr size_t O_PCONV = O_PGDN + (size_t)2 * 4 * 8 * 16384, O_PPOOL = O_PCONV + (size_t)2 * 4 * 3 * 3072, O_SW1 = O_PPOOL + (size_t)2 * 4 * 15 * 1024;
constexpr size_t O_SW2 = O_SW1 + (size_t)2 * 32 * 128 * 1024, O_SW3 = O_SW2 + (size_t)2 * 32 * 512 * 1024, O_SGDN = O_SW3 + (size_t)2 * 32 * 2048 * 1024;
constexpr size_t O_SCONV = O_SGDN + (size_t)2 * 32 * 8 * 16384, O_SPOOL = O_SCONV + (size_t)2 * 32 * 3 * 3072, O_END = O_SPOOL + (size_t)2 * 32 * 15 * 1024;
static_assert(O_END == 226426880ull, "output size");

constexpr size_t WS_CTL = 0, CTL_BYTES = 1u << 20;
constexpr size_t SZ_WIN = (size_t)NIN * D * 2, SZ_WBRA = (size_t)D * 1024 * 2, SZ_WBRB = (size_t)D * 512 * 2, SZ_WBRC = (size_t)D * 1024 * 2, SZ_WPOOL = (size_t)4 * 256 * 256 * 2;
constexpr size_t SZ_WOUT = (size_t)D * D * 2, SZ_WGU = (size_t)2 * DFF * D * 2, SZ_WDOWN = (size_t)D * DFF * 2;
constexpr size_t WO_IN = 0, WO_BRA = WO_IN + SZ_WIN, WO_BRB = WO_BRA + SZ_WBRA, WO_BRC = WO_BRB + SZ_WBRB, WO_POOL = WO_BRC + SZ_WBRC, WO_OUT = WO_POOL + SZ_WPOOL;
constexpr size_t WO_GU = WO_OUT + SZ_WOUT, WO_DOWN = WO_GU + SZ_WGU, WL_BYTES = WO_DOWN + SZ_WDOWN;
constexpr size_t WS_W = CTL_BYTES;
constexpr size_t WS_H = WS_W + 2 * WL_BYTES;
constexpr size_t WS_PROJ = WS_H + (size_t)MT * D * 2;
constexpr size_t WS_GB = WS_PROJ + (size_t)MT * NIN * 2;
constexpr size_t WS_TOK = WS_GB + (size_t)MT * 16 * 4;
constexpr size_t WS_QN = WS_TOK + (size_t)MT * 8 * 16;
constexpr size_t WS_KN = WS_QN + (size_t)MT * 1024 * 2;
constexpr size_t WS_VV = WS_KN + (size_t)MT * 1024 * 2;
constexpr size_t WS_ORAW = WS_VV + (size_t)MT * 1024 * 2;
constexpr size_t WS_POOLED = WS_ORAW + (size_t)MT * 1024 * 4;
constexpr size_t WS_OUTA = WS_POOLED + (size_t)MT * 1024 * 2;
constexpr size_t WS_OUTB = WS_OUTA + (size_t)MT * 1024 * 2;
constexpr size_t WS_OC = WS_OUTB + (size_t)MT * 512 * 2;
constexpr size_t WS_MERGED = WS_OC + (size_t)MT * 1024 * 2;
constexpr size_t WS_Y = WS_MERGED + (size_t)MT * D * 2;
constexpr size_t WS_X1 = WS_Y + (size_t)MT * D * 2;
constexpr size_t WS_X2 = WS_X1 + (size_t)MT * D * 4;
constexpr size_t WS_ACT = WS_X2 + (size_t)MT * D * 4;
constexpr size_t WS_VT = WS_ACT + (size_t)MT * DFF * 2;
constexpr size_t WS_OBG = WS_VT + (size_t)BATCH * 3 * 4 * 128 * 2048 * 2;
constexpr size_t WS_AST = WS_OBG + (size_t)6 * MV * 512 * 2;
constexpr int GCH = BATCH * HA * (SEQ / 32);
constexpr size_t WS_WF = WS_AST + (size_t)6 * MV * 4 * 8;
constexpr size_t WS_KF = WS_WF + (size_t)GCH * 8192;
constexpr size_t WS_UF = WS_KF + (size_t)GCH * 8192;
constexpr size_t WS_AF = WS_UF + (size_t)GCH * 16384;
constexpr size_t WS_TB = WS_AF + (size_t)GCH * 2048;
constexpr size_t WS_QF = WS_TB + (size_t)GCH * 128;
constexpr size_t WS_XCH = WS_QF + (size_t)GCH * 8192;
constexpr size_t WS_END = WS_XCH + (size_t)4 * 32 * 256 * 8 * 16;
static_assert(WS_END < 2000000000ull, "workspace");

namespace pg8 {
#define PG8_LAS __attribute__((address_space(3)))
typedef unsigned short bf16_t;
typedef unsigned u32x4 __attribute__((ext_vector_type(4)));
constexpr int BM = 256, BK = 64, HALF = 128, HTB = HALF * BK * 2, STAGE_BYTES = 8 * HTB, NXCD = 8, WGM = 8;
__host__ __device__ __forceinline__ int lds_byte(int r, int c) { const int st = (r >> 4) * 2 + (c >> 5), rr = r & 15, cc = c & 31, ob = rr * 64 + cc * 2; return st * 1024 + (ob ^ (((ob >> 9) & 1) << 5)); }
__host__ __device__ __forceinline__ void stage_rc(int b, int& R, int& C) { const int st = b / 1024, sb = b % 1024, swz = sb ^ (((sb >> 9) & 1) << 5); R = (st >> 1) * 16 + swz / 64; C = (st & 1) * 32 + (swz % 64) / 2; }
__host__ __device__ __forceinline__ int perm32(int rho) { const int n = rho >> 4, i = rho & 15; return 8 * (i >> 2) + 4 * n + (i & 3); }
struct Unit { int pm, pn; };
struct Gemm { const bf16_t* A; const bf16_t* Bt; int lda, ldb, K; int a_pn_step; };
struct StaticOrder {
    int nM, nN, nwg, G, c;
    __host__ __device__ void init(int M, int N, int G_, int c_) { nM = M / BM; nN = N / BM; nwg = nM * nN; G = G_; c = c_; }
    __host__ __device__ bool next(int i, Unit& u) const {
        const long L = (long)i * G + c; if (L >= nwg) return false;
        int wgid = (int)L; { const int q = nwg / NXCD, r = nwg % NXCD, xcd = wgid % NXCD, off = wgid / NXCD; wgid = (xcd < r ? xcd * (q + 1) : r * (q + 1) + (xcd - r) * q) + off; }
        const int nig = WGM * nN, gid = wgid / nig, fm = gid * WGM, gsz = (nM - fm) < WGM ? (nM - fm) : WGM;
        u.pm = fm + ((wgid % nig) % gsz); u.pn = (wgid % nig) / gsz; return true;
    }
    __device__ __forceinline__ void a_ready(const Unit&) const {}
    __device__ __forceinline__ void done(const Unit&) const {}
};
__device__ __forceinline__ unsigned cvt_pk_bf16(float lo, float hi) { unsigned r; asm volatile("v_cvt_pk_bf16_f32 %0, %1, %2" : "=v"(r) : "v"(lo), "v"(hi)); return r; }

template <class Epi, class Sched, bool ALIGN_EPI = true>
__device__ __forceinline__ void gemm_phase(PG8_LAS unsigned char* lds, const Gemm g, const Sched& S, const Epi& E) {
    int tid = threadIdx.x; asm volatile("" : "+v"(tid));
    const int wid = __builtin_amdgcn_readfirstlane(tid >> 6), lane = tid & 63, wr = wid >> 2, wc = wid & 3, fr = lane & 15, fq = lane >> 4;
    int K = g.K; asm volatile("" : "+s"(K));
    const int nt = K / BK;
    unsigned voffA[2], voffB[2];
#pragma unroll
    for (int i = 0; i < 2; ++i) { int R, C; stage_rc(tid * 16 + i * 8192, R, C); const int Rb = ((R & ~31) + perm32(R & 31));
        voffA[i] = (unsigned)(R * g.lda + C) * 2u; voffB[i] = (unsigned)(Rb * g.ldb + C) * 2u; }
    const size_t kstep = (size_t)(BK * 2);
    const size_t hstepA = (size_t)HALF * g.lda * 2, hstepB = (size_t)HALF * g.ldb * 2;
    const size_t tstepA = 2 * hstepA, tstepB = 2 * hstepB;
    const unsigned ldsw = (unsigned)wid * 1024u;
    const int aoff = lds_byte(wr * 64 + fr, fq * 8), boff = lds_byte(wc * 32 + fr, fq * 8);
#define PG8_SA(b, h) (((b) * 2 + (h)) * HTB)
#define PG8_SB(b, h) ((4 + (b) * 2 + (h)) * HTB)
#define PG8_STAGE(bufoff, gbase, voff) do { _Pragma("unroll") for (int _i = 0; _i < 2; ++_i) \
        __builtin_amdgcn_global_load_lds((const unsigned*)((const char*)(gbase) + (voff)[_i]), (PG8_LAS unsigned*)(lds + (bufoff) + ldsw + _i * 8192), 16, 0, 0); } while (0)
#define PG8_LDA(dst, b, h) do { _Pragma("unroll") for (int m = 0; m < 4; ++m) _Pragma("unroll") for (int k = 0; k < 2; ++k) dst[m][k] = *(const PG8_LAS bf16x8*)(lds + PG8_SA(b, h) + aoff + m * 2048 + k * 1024); } while (0)
#define PG8_LDB(dst, b, h) do { _Pragma("unroll") for (int n = 0; n < 2; ++n) _Pragma("unroll") for (int k = 0; k < 2; ++k) dst[n][k] = *(const PG8_LAS bf16x8*)(lds + PG8_SB(b, h) + boff + n * 2048 + k * 1024); } while (0)
#define PG8_MMA(ai, bj, At, Bt) do { __builtin_amdgcn_s_setprio(1); _Pragma("unroll") for (int m = 0; m < 4; ++m) _Pragma("unroll") for (int n = 0; n < 2; ++n) _Pragma("unroll") for (int k = 0; k < 2; ++k) \
        acc[ai][bj][m][n] = __builtin_amdgcn_mfma_f32_16x16x32_bf16(Bt[n][k], At[m][k], acc[ai][bj][m][n], 0, 0, 0); __builtin_amdgcn_s_setprio(0); } while (0)
#define PG8_WAIT_V(n) asm volatile("s_waitcnt vmcnt(" #n ")" ::: "memory")
#define PG8_WAIT_L(n) asm volatile("s_waitcnt lgkmcnt(" #n ")" ::: "memory")
#define PG8_BAR __builtin_amdgcn_s_barrier()
#define PG8_SCHED __builtin_amdgcn_sched_barrier(0)
    Unit cur, nxt; int ui = 0;
    if (!S.next(0, cur)) return;
    f32x4 acc[2][2][4][2];
#pragma unroll
    for (int a = 0; a < 2; ++a)
#pragma unroll
        for (int b = 0; b < 2; ++b)
#pragma unroll
            for (int m = 0; m < 4; ++m)
#pragma unroll
                for (int n = 0; n < 2; ++n) acc[a][b][m][n] = (f32x4){0.f, 0.f, 0.f, 0.f};
    bf16x8 At[4][2], B0[2][2], B1[2][2];
    const char* cA = (const char*)g.A + (size_t)cur.pm * tstepA + (size_t)cur.pn * (size_t)g.a_pn_step; const char* cB = (const char*)g.Bt + (size_t)cur.pn * tstepB;
    S.a_ready(cur);
    PG8_STAGE(PG8_SB(0, 0), cB, voffB); PG8_STAGE(PG8_SB(0, 1), cB + hstepB, voffB); PG8_STAGE(PG8_SA(0, 0), cA, voffA); PG8_STAGE(PG8_SA(0, 1), cA + hstepA, voffA);
    if (wr == 1) PG8_BAR;
    PG8_WAIT_V(2); PG8_BAR;
    PG8_STAGE(PG8_SB(1, 0), cB + kstep, voffB); PG8_STAGE(PG8_SA(1, 0), cA + kstep, voffA); PG8_STAGE(PG8_SB(1, 1), cB + hstepB + kstep, voffB);
    PG8_WAIT_V(6); PG8_BAR;
    for (;;) {
        const bool has_next = S.next(ui + 1, nxt);
        const char* nA = has_next ? (const char*)g.A + (size_t)nxt.pm * tstepA + (size_t)nxt.pn * (size_t)g.a_pn_step : cA; const char* nB = has_next ? (const char*)g.Bt + (size_t)nxt.pn * tstepB : cB;
        for (int t = 0; t < nt; t += 2) {
            const bool last = (t == nt - 2);
            const char* a1 = cA + (size_t)(t + 1) * kstep;
            const char* a2 = last ? nA : cA + (size_t)(t + 2) * kstep; const char* b2 = last ? nB : cB + (size_t)(t + 2) * kstep;
            const char* a3 = a2 + kstep; const char* b3 = b2 + kstep;
            if (last && has_next) S.a_ready(nxt);
            PG8_LDB(B0, 0, 0); PG8_LDB(B1, 0, 1); PG8_SCHED; PG8_LDA(At, 0, 0); PG8_STAGE(PG8_SA(1, 1), a1 + hstepA, voffA);
            PG8_WAIT_V(8); PG8_WAIT_L(0); PG8_BAR; PG8_MMA(0, 0, At, B0); PG8_MMA(0, 1, At, B1); PG8_BAR; PG8_SCHED;
            PG8_LDA(At, 0, 1); PG8_STAGE(PG8_SB(0, 0), b2, voffB); PG8_STAGE(PG8_SB(0, 1), b2 + hstepB, voffB); PG8_STAGE(PG8_SA(0, 0), a2, voffA);
            PG8_WAIT_V(8); PG8_WAIT_L(0); PG8_BAR; PG8_MMA(1, 0, At, B0); PG8_MMA(1, 1, At, B1); PG8_BAR; PG8_SCHED;
            PG8_LDB(B0, 1, 0); PG8_LDB(B1, 1, 1); PG8_SCHED; PG8_LDA(At, 1, 0); PG8_STAGE(PG8_SA(0, 1), a2 + hstepA, voffA);
            PG8_WAIT_V(8); PG8_WAIT_L(0); PG8_BAR; PG8_MMA(0, 0, At, B0); PG8_MMA(0, 1, At, B1); PG8_BAR; PG8_SCHED;
            PG8_LDA(At, 1, 1); PG8_STAGE(PG8_SB(1, 0), b3, voffB); PG8_STAGE(PG8_SB(1, 1), b3 + hstepB, voffB); PG8_STAGE(PG8_SA(1, 0), a3, voffA);
            PG8_WAIT_V(8); PG8_WAIT_L(0); PG8_BAR; PG8_MMA(1, 0, At, B0); PG8_MMA(1, 1, At, B1); PG8_BAR; PG8_SCHED;
        }
        if constexpr (ALIGN_EPI) { if (wr == 0) PG8_BAR; }
        if constexpr (!Epi::AFTER_DRAIN) { E(acc, cur, wr, wc, fr, fq); S.done(cur); }
        if (!has_next) break;
#pragma unroll
        for (int a = 0; a < 2; ++a)
#pragma unroll
            for (int b = 0; b < 2; ++b)
#pragma unroll
                for (int m = 0; m < 4; ++m)
#pragma unroll
                    for (int n = 0; n < 2; ++n) acc[a][b][m][n] = (f32x4){0.f, 0.f, 0.f, 0.f};
        cur = nxt; cA = nA; cB = nB; ++ui;
        if constexpr (ALIGN_EPI) { if (wr == 1) PG8_BAR; }
    }
    PG8_WAIT_V(0);
    if constexpr (!ALIGN_EPI) { if (wr == 0) PG8_BAR; }
    PG8_BAR;
    if constexpr (Epi::AFTER_DRAIN) { E.fused(acc, cur, wr, wc, fr, fq, lds, wid, lane); S.done(cur); }
#undef PG8_SA
#undef PG8_SB
#undef PG8_STAGE
#undef PG8_LDA
#undef PG8_LDB
#undef PG8_MMA
#undef PG8_WAIT_V
#undef PG8_WAIT_L
#undef PG8_BAR
#undef PG8_SCHED
}
}

#define LDS_WAIT() asm volatile("s_waitcnt lgkmcnt(0)" ::: "memory")
#define VM_WAIT() asm volatile("s_waitcnt vmcnt(0)" ::: "memory")
__device__ __forceinline__ unsigned f2bf(float f) { unsigned u = __builtin_bit_cast(unsigned, f); return (u + 0x7fffu + ((u >> 16) & 1u)) >> 16; }
typedef __bf16 bf16v2 __attribute__((ext_vector_type(2)));
__device__ __forceinline__ unsigned pk2(float lo, float hi) { const f32x2 v = {lo, hi}; return __builtin_bit_cast(unsigned, __builtin_convertvector(v, bf16v2)); }
__device__ __forceinline__ float bf_lo(unsigned u) { return __builtin_bit_cast(float, u << 16); }
__device__ __forceinline__ float bf_hi(unsigned u) { return __builtin_bit_cast(float, u & 0xffff0000u); }
__device__ __forceinline__ float bf1(bf16 b) { return __builtin_bit_cast(float, ((unsigned)b) << 16); }
__device__ __forceinline__ void unpack8(const v4u u, float (&x)[8]) { x[0] = bf_lo(u.x); x[1] = bf_hi(u.x); x[2] = bf_lo(u.y); x[3] = bf_hi(u.y); x[4] = bf_lo(u.z); x[5] = bf_hi(u.z); x[6] = bf_lo(u.w); x[7] = bf_hi(u.w); }
__device__ __forceinline__ v4u pack8(const float (&x)[8]) { v4u o; o.x = pk2(x[0], x[1]); o.y = pk2(x[2], x[3]); o.z = pk2(x[4], x[5]); o.w = pk2(x[6], x[7]); return o; }
__device__ __forceinline__ float wave_max(float v) {
#pragma unroll
    for (int o = 1; o < 64; o <<= 1) v = fmaxf(v, __shfl_xor(v, o));
    return v;
}
template <int CTRL> __device__ __forceinline__ float dpp_f(float x) { return __builtin_bit_cast(float, __builtin_amdgcn_update_dpp(0, __builtin_bit_cast(int, x), CTRL, 0xf, 0xf, true)); }
__device__ __forceinline__ float row16_sum(float x) { x += dpp_f<0xB1>(x); x += dpp_f<0x4E>(x); x += dpp_f<0x124>(x); x += dpp_f<0x128>(x); return x; }
__device__ __forceinline__ float wave_sum(float v) { v = row16_sum(v); v += __shfl_xor(v, 16); v += __shfl_xor(v, 32); return v; }
__device__ __forceinline__ float sigm(float x) { return __builtin_amdgcn_rcpf(1.f + __expf(-x)); }
__device__ __forceinline__ float silu(float x) { return x * __builtin_amdgcn_rcpf(1.f + __expf(-x)); }

#define XB_TMO      128
#define XB_XCNT(j)  (256  + 64 * (j))
#define XB_XSUB(j)  (1280 + 64 * (j))
#define XB_XGEN(j)  (2304 + 64 * (j))
#define XB_TOP      3328
#define XB_TOPGEN   3392
#define XCD_BAR_WORDS 3456
#define XB_SPIN_CAP (1u << 18)
__device__ __forceinline__ unsigned xb_ld(unsigned* p)              { return __hip_atomic_load(p, __ATOMIC_RELAXED, __HIP_MEMORY_SCOPE_AGENT); }
__device__ __forceinline__ unsigned xb_add(unsigned* p, unsigned v) { return __hip_atomic_fetch_add(p, v, __ATOMIC_RELAXED, __HIP_MEMORY_SCOPE_AGENT); }
__device__ __forceinline__ unsigned xb_xcc_id() { return (unsigned)__builtin_amdgcn_s_getreg((3 << 11) | 20) & 0xFu; }
#define XB_SPIN(cond, bar) do { unsigned _sp = 0; while (cond) { __builtin_amdgcn_s_sleep(1); \
    if ((++_sp & 255u) == 0u) { if (xb_ld(&(bar)[XB_TMO])) break; if (_sp > XB_SPIN_CAP) { atomicAdd(&(bar)[XB_TMO], 1u); break; } } } } while (0)
struct XcdBarrier { unsigned* bar; unsigned x; volatile LAS unsigned* st; };
__device__ __forceinline__ XcdBarrier xcd_barrier_post(unsigned* bar, volatile LAS unsigned* st) {
    XcdBarrier b; b.bar = bar; b.x = xb_xcc_id(); b.st = st;
    if (threadIdx.x == 0) (void)xb_add(&bar[XB_XCNT(b.x)], 1u);
    return b;
}
__device__ __forceinline__ void xcd_barrier_complete(unsigned* bar, unsigned x, unsigned& nloc, unsigned& nx) {
    const unsigned G = gridDim.x * gridDim.y * gridDim.z;
    unsigned sum, cnt, mine, sp = 0u;
    for (;;) {
        sum = 0u; cnt = 0u; mine = 0u;
#pragma unroll
        for (unsigned j = 0; j < 16; ++j) { const unsigned c = xb_ld(&bar[XB_XCNT(j)]); sum += c; cnt += (c > 0u) ? 1u : 0u; mine = (j == x) ? c : mine; }
        if (sum == G) break;
        __builtin_amdgcn_s_sleep(1);
        if ((++sp & 255u) == 0u) { if (xb_ld(&bar[XB_TMO])) break; if (sp > XB_SPIN_CAP) { atomicAdd(&bar[XB_TMO], 1u); break; } }
    }
    nloc = mine > 0u ? mine : 1u; nx = cnt > 0u ? cnt : 1u;
}
__device__ __forceinline__ void xcd_barrier(const XcdBarrier& b) {
    asm volatile("s_waitcnt vmcnt(0)" ::: "memory");
    __syncthreads();
    if (threadIdx.x == 0) {
        unsigned* bar = b.bar;
        __builtin_amdgcn_s_waitcnt(0);
        unsigned nloc = b.st[0], nx = b.st[1];
        if (nloc == 0u) { xcd_barrier_complete(bar, b.x, nloc, nx); b.st[0] = nloc; b.st[1] = nx; }
        const unsigned old = xb_add(&bar[XB_XSUB(b.x)], 1u);
        const unsigned gen = old / nloc;
        if (old + 1u == (gen + 1u) * nloc) {
            __builtin_amdgcn_fence(__ATOMIC_RELEASE, "agent");
            asm volatile("s_waitcnt vmcnt(0)" ::: "memory");
            const unsigned og = xb_add(&bar[XB_TOP], 1u);
            const unsigned tg = og / nx;
            if (og + 1u == (tg + 1u) * nx) xb_add(&bar[XB_TOPGEN], 1u);
            else XB_SPIN(xb_ld(&bar[XB_TOPGEN]) == tg, bar);
            __builtin_amdgcn_fence(__ATOMIC_ACQUIRE, "agent");
            xb_add(&bar[XB_XGEN(b.x)], 1u);
            asm volatile("s_waitcnt vmcnt(0)" ::: "memory");
        } else {
            XB_SPIN(xb_ld(&bar[XB_XGEN(b.x)]) == gen, bar);
            __builtin_amdgcn_fence(__ATOMIC_ACQUIRE, "agent");
            asm volatile("s_waitcnt vmcnt(0)" ::: "memory");
        }
    }
    __syncthreads();
}

constexpr int NWAVES = 8;
constexpr int RING_BYTES = 131072, SCANTV_BYTES = 0, LDSCTL_OFF = RING_BYTES + SCANTV_BYTES, MISC_OFF = LDSCTL_OFF + 320, LDS_BYTES = 147456;
constexpr int CW_BAR = 4096;
constexpr int CW_TMO = 0, CW_RMS = 16384, RMS_BANK = 2048;

struct Args { const float* in[25]; float* out; unsigned char* ws; int ph_lo, ph_hi; };
struct Frame {
    LAS unsigned char* lds;
    int tid, lane, wave, vcu, G;
    const CAS cfp_t* in; float* out; unsigned char* ws;
};

__device__ __forceinline__ int launder(int x) { asm volatile("" : "+v"(x)); return x; }
__device__ __forceinline__ int launder_s(int x) { asm volatile("" : "+s"(x)); return x; }
template <class T> __device__ __forceinline__ T* launder_p(T* p) { asm volatile("" : "+s"(p)); return p; }
__device__ __forceinline__ const CAS cfp_t* launder_k(const CAS cfp_t* p) { asm volatile("" : "+s"(p)); return p; }
#define RELANE(F0) Frame F = F0; F.lane = launder(F0.lane); F.tid = launder(F0.tid)

struct EpiStore {
    static constexpr bool AFTER_DRAIN = false;
    bf16* O; int ldc; int sig_pn;
    __device__ __forceinline__ void operator()(const f32x4 (&acc)[2][2][4][2], const pg8::Unit& u, int wr, int wc, int fr, int fq) const {
        fr = launder(fr); fq = launder(fq);
        const int row0 = u.pm * 256 + wr * 64 + fr, col0 = u.pn * 256 + wc * 32 + 8 * fq; const bool sg = u.pn >= sig_pn;
#pragma unroll
        for (int ai = 0; ai < 2; ++ai)
#pragma unroll
            for (int m = 0; m < 4; ++m) { bf16* rowp = O + (size_t)(row0 + ai * 128 + m * 16) * ldc + col0;
#pragma unroll
                for (int bj = 0; bj < 2; ++bj) { f32x4 v0 = acc[ai][bj][m][0], v1 = acc[ai][bj][m][1];
                    if (sg) {
#pragma unroll
                        for (int j = 0; j < 4; ++j) { v0[j] = sigm(v0[j]); v1[j] = sigm(v1[j]); } }
                    v4u w; w.x = pg8::cvt_pk_bf16(v0[0], v0[1]); w.y = pg8::cvt_pk_bf16(v0[2], v0[3]); w.z = pg8::cvt_pk_bf16(v1[0], v1[1]); w.w = pg8::cvt_pk_bf16(v1[2], v1[3]);
                    *(v4u*)(rowp + bj * 128) = w; } }
    }
};
template <bool ACCUM> struct EpiMerge {
    static constexpr bool AFTER_DRAIN = false;
    bf16* O; const bf16* gate;
    __device__ __forceinline__ void operator()(const f32x4 (&acc)[2][2][4][2], const pg8::Unit& u, int wr, int wc, int fr, int fq) const {
        fr = launder(fr); fq = launder(fq);
        const int row0 = u.pm * 256 + wr * 64 + fr, col0 = u.pn * 256 + wc * 32 + 8 * fq;
#pragma unroll
        for (int ai = 0; ai < 2; ++ai)
#pragma unroll
            for (int m = 0; m < 4; ++m) { const int row = row0 + ai * 128 + m * 16; bf16* rowp = O + (size_t)row * D + col0; const bf16* gp = gate + (size_t)row * NIN + col0;
#pragma unroll
                for (int bj = 0; bj < 2; ++bj) {
                    float gv[8]; unpack8(*(const v4u*)(gp + bj * 128), gv);
                    float o[8];
#pragma unroll
                    for (int j = 0; j < 4; ++j) { o[j] = acc[ai][bj][m][0][j] * gv[j]; o[4 + j] = acc[ai][bj][m][1][j] * gv[4 + j]; }
                    if (ACCUM) { float p[8]; unpack8(*(const v4u*)(rowp + bj * 128), p);
#pragma unroll
                        for (int j = 0; j < 8; ++j) o[j] += p[j]; }
                    v4u w; w.x = pg8::cvt_pk_bf16(o[0], o[1]); w.y = pg8::cvt_pk_bf16(o[2], o[3]); w.z = pg8::cvt_pk_bf16(o[4], o[5]); w.w = pg8::cvt_pk_bf16(o[6], o[7]);
                    *(v4u*)(rowp + bj * 128) = w; }
                asm volatile("" ::: "memory"); }
    }
};

struct EpiRmsRes {
    static constexpr bool AFTER_DRAIN = true;
    unsigned char* ws; const CAS cfp_t* in; float* outp; int l, which;
    __device__ __forceinline__ void fused(const f32x4 (&acc)[2][2][4][2], const pg8::Unit& u, int wr, int wc, int fr, int fq, LAS unsigned char* lds, int wid, int lane) const {
        fr = launder(fr); fq = launder(fq);
        const bool lastl = which == 1 && l + 1 == DEPTH;
        bf16* const XB = (bf16*)(ws + WS_X1); bf16* const H = lastl ? nullptr : (bf16*)(ws + WS_H); float* const fout = lastl ? outp + O_YP : nullptr;
        const float* const gpost = (which ? in[24] : in[22]) + (size_t)l * D; const float* const gpre = lastl ? nullptr : (which ? in[21] + (size_t)(l + 1) * D : in[23] + (size_t)l * D);
        float* const slots = (float*)(ws + WS_XCH) + (size_t)(l * 2 + which) * 32 * 256 * 8 * 4;
        unsigned* const cnt = (unsigned*)(ws + WS_CTL) + CW_RMS + (l * 2 + which) * RMS_BANK; unsigned* const tmo = (unsigned*)(ws + WS_CTL) + CW_TMO;
        LAS f32x4* P = (LAS f32x4*)lds;
        LAS f32x2* SR = (LAS f32x2*)(lds + 16384);
        const int lr0 = wr * 64 + fr, col0 = u.pn * 256 + wc * 32 + 8 * fq;
        f32x4 gp[2][2];
#pragma unroll
        for (int bj = 0; bj < 2; ++bj) { gp[bj][0] = *(const f32x4*)(gpost + col0 + bj * 128); gp[bj][1] = *(const f32x4*)(gpost + col0 + bj * 128 + 4); }
#pragma unroll
        for (int ai = 0; ai < 2; ++ai)
#pragma unroll
            for (int m = 0; m < 4; ++m) {
                const int lr = lr0 + ai * 128 + m * 16; const bf16* xp = XB + (size_t)(u.pm * 256 + lr) * D + col0;
                float syy = 0.f, sxx = 0.f, sxy = 0.f, sgg = 0.f;
#pragma unroll
                for (int bj = 0; bj < 2; ++bj) { float xv[8]; unpack8(*(const v4u*)(xp + bj * 128), xv);
#pragma unroll
                    for (int n = 0; n < 2; ++n)
#pragma unroll
                        for (int j = 0; j < 4; ++j) { const float y = acc[ai][bj][m][n][j], yg = y * gp[bj][n][j], x = xv[4 * n + j]; syy += y * y; sxx += x * x; sxy += x * yg; sgg += yg * yg; } }
                syy += __shfl_xor(syy, 16); sxx += __shfl_xor(sxx, 16); sxy += __shfl_xor(sxy, 16); sgg += __shfl_xor(sgg, 16);
                syy += __shfl_xor(syy, 32); sxx += __shfl_xor(sxx, 32); sxy += __shfl_xor(sxy, 32); sgg += __shfl_xor(sgg, 32);
                if (fq == 0) P[lr * 4 + wc] = (f32x4){syy, sxx, sxy, sgg};
            }
        asm volatile("s_waitcnt lgkmcnt(0)" ::: "memory"); __builtin_amdgcn_s_barrier(); asm volatile("" ::: "memory");
        const int row = wid * 32 + (lane & 31);
        unsigned long long* slot = (unsigned long long*)slots + ((size_t)(u.pm * 256 + row) * 8 + u.pn) * 2;
        if (lane < 32) { const f32x4 a = P[row * 4 + 0], b = P[row * 4 + 1], c = P[row * 4 + 2], d = P[row * 4 + 3]; const f32x4 t = (a + b) + (c + d);
            __hip_atomic_store(slot, ((unsigned long long)__builtin_bit_cast(unsigned, t.y) << 32) | __builtin_bit_cast(unsigned, t.x), __ATOMIC_RELAXED, __HIP_MEMORY_SCOPE_AGENT);
            __hip_atomic_store(slot + 1, ((unsigned long long)__builtin_bit_cast(unsigned, t.w) << 32) | __builtin_bit_cast(unsigned, t.z), __ATOMIC_RELAXED, __HIP_MEMORY_SCOPE_AGENT); }
        asm volatile("s_waitcnt vmcnt(0)" ::: "memory");
        if (lane == 0) __hip_atomic_fetch_add(cnt + 64 * u.pm, 1u, __ATOMIC_RELAXED, __HIP_MEMORY_SCOPE_AGENT);
        if (wid == 0) {
            const unsigned long long t0 = __builtin_amdgcn_s_memrealtime();
            while ((unsigned)__builtin_amdgcn_readfirstlane((int)__hip_atomic_load(cnt + 64 * u.pm, __ATOMIC_RELAXED, __HIP_MEMORY_SCOPE_AGENT)) < 64u) {
                if (__builtin_amdgcn_s_memrealtime() - t0 > 2000000ull) { if (lane == 0) __hip_atomic_store(tmo, 1u, __ATOMIC_RELAXED, __HIP_MEMORY_SCOPE_AGENT); break; }
                __builtin_amdgcn_s_sleep(2); }
            __builtin_amdgcn_fence(__ATOMIC_ACQUIRE, "agent");
        }
        asm volatile("s_waitcnt vmcnt(0) lgkmcnt(0)" ::: "memory"); __builtin_amdgcn_s_barrier(); asm volatile("" ::: "memory");
        if (lane < 32) { const unsigned long long* sl = (const unsigned long long*)slots + (size_t)(u.pm * 256 + row) * 16; float syy = 0.f, sxx = 0.f, sxy = 0.f, sgg = 0.f;
#pragma unroll
            for (int t = 0; t < 8; ++t) { const unsigned long long w0 = __hip_atomic_load(sl + 2 * t, __ATOMIC_RELAXED, __HIP_MEMORY_SCOPE_AGENT), w1 = __hip_atomic_load(sl + 2 * t + 1, __ATOMIC_RELAXED, __HIP_MEMORY_SCOPE_AGENT);
                syy += __builtin_bit_cast(float, (unsigned)w0); sxx += __builtin_bit_cast(float, (unsigned)(w0 >> 32)); sxy += __builtin_bit_cast(float, (unsigned)w1); sgg += __builtin_bit_cast(float, (unsigned)(w1 >> 32)); }
            const float ry = rsqrtf(syy * (1.f / D) + EPS), s1 = sxx + 2.f * ry * sxy + ry * ry * sgg;
            SR[row] = (f32x2){ry, rsqrtf(fmaxf(s1, 0.f) * (1.f / D) + EPS)}; }
        asm volatile("s_waitcnt lgkmcnt(0)" ::: "memory"); __builtin_amdgcn_s_barrier(); asm volatile("" ::: "memory");
        f32x4 gq[2][2];
#pragma unroll
        for (int bj = 0; bj < 2; ++bj) { gq[bj][0] = gpre ? *(const f32x4*)(gpre + col0 + bj * 128) : (f32x4){0.f, 0.f, 0.f, 0.f}; gq[bj][1] = gpre ? *(const f32x4*)(gpre + col0 + bj * 128 + 4) : (f32x4){0.f, 0.f, 0.f, 0.f}; }
#pragma unroll
        for (int ai = 0; ai < 2; ++ai)
#pragma unroll
            for (int m = 0; m < 4; ++m) {
                const int lr = lr0 + ai * 128 + m * 16; const size_t off = (size_t)(u.pm * 256 + lr) * D + col0; const f32x2 sr = SR[lr];
#pragma unroll
                for (int bj = 0; bj < 2; ++bj) { float xv[8], x1[8]; unpack8(*(const v4u*)(XB + off + bj * 128), xv);
#pragma unroll
                    for (int n = 0; n < 2; ++n)
#pragma unroll
                        for (int j = 0; j < 4; ++j) x1[4 * n + j] = xv[4 * n + j] + acc[ai][bj][m][n][j] * sr.x * gp[bj][n][j];
                    if (fout) { *(f32x4*)(fout + off + bj * 128) = (f32x4){x1[0], x1[1], x1[2], x1[3]}; *(f32x4*)(fout + off + bj * 128 + 4) = (f32x4){x1[4], x1[5], x1[6], x1[7]}; }
                    else { *(v4u*)(XB + off + bj * 128) = pack8(x1);
                        if (H) { float hv[8];
#pragma unroll
                            for (int n = 0; n < 2; ++n)
#pragma unroll
                                for (int j = 0; j < 4; ++j) hv[4 * n + j] = x1[4 * n + j] * sr.y * gq[bj][n][j];
                            *(v4u*)(H + off + bj * 128) = pack8(hv); } } }
                asm volatile("" ::: "memory"); }
    }
};
struct EpiSwiglu {
    static constexpr bool AFTER_DRAIN = false;
    bf16* O;
    __device__ __forceinline__ void operator()(const f32x4 (&acc)[2][2][4][2], const pg8::Unit& u, int wr, int wc, int fr, int fq) const {
        fr = launder(fr); fq = launder(fq);
        const int row0 = u.pm * 256 + wr * 64 + fr, col0 = u.pn * 128 + wc * 32 + 8 * fq;
#pragma unroll
        for (int ai = 0; ai < 2; ++ai)
#pragma unroll
            for (int m = 0; m < 4; ++m) { bf16* rowp = O + (size_t)(row0 + ai * 128 + m * 16) * DFF + col0;
                float o[8];
#pragma unroll
                for (int j = 0; j < 4; ++j) { o[j] = silu(acc[ai][0][m][0][j]) * acc[ai][1][m][0][j]; o[4 + j] = silu(acc[ai][0][m][1][j]) * acc[ai][1][m][1][j]; }
                v4u w; w.x = pg8::cvt_pk_bf16(o[0], o[1]); w.y = pg8::cvt_pk_bf16(o[2], o[3]); w.z = pg8::cvt_pk_bf16(o[4], o[5]); w.w = pg8::cvt_pk_bf16(o[6], o[7]);
                *(v4u*)rowp = w; }
    }
};

__device__ __forceinline__ void transpose_item(const float* W, int ldw, int src_col0, int k0, bf16* WT, int ldt, int dst_row0, LAS float* scr, int lane, const float* rscale = nullptr) {
#pragma unroll 8
    for (int i = 0; i < 32; ++i) { const int kk = 2 * i + (lane >> 5); scr[kk * 33 + (lane & 31)] = W[(size_t)(k0 + kk) * ldw + src_col0 + (lane & 31)]; }
    LDS_WAIT(); asm volatile("" ::: "memory");
    const int c = lane & 7;
#pragma unroll
    for (int j = 0; j < 4; ++j) { const int n = (lane >> 3) + 8 * j; const LAS float* s = scr + (8 * c) * 33 + n; const float m = rscale ? rscale[n] : 1.f;
        v4u o; o.x = pk2(s[0 * 33] * m, s[1 * 33] * m); o.y = pk2(s[2 * 33] * m, s[3 * 33] * m); o.z = pk2(s[4 * 33] * m, s[5 * 33] * m); o.w = pk2(s[6 * 33] * m, s[7 * 33] * m);
        *(v4u*)(WT + (size_t)(dst_row0 + n) * ldt + k0 + 8 * c) = o; }
    LDS_WAIT(); asm volatile("" ::: "memory");
}
constexpr int IT_IN = 32 * 496, IT_BRA = 16 * 64, IT_BRB = 8 * 64, IT_BRC = 16 * 64, IT_POOL = 4 * 4 * 8, IT_OUT = 32 * 64, IT_GU = 32 * 352, IT_DOWN = 88 * 64;
constexpr int IT_LAYER = IT_IN + IT_BRA + IT_BRB + IT_BRC + IT_POOL + IT_OUT + IT_GU + IT_DOWN;
__device__ __forceinline__ void weight_item(Frame& F0, int l, int r, LAS float* scr) {
    RELANE(F0);
    unsigned char* wl = F.ws + WS_W + (size_t)l * WL_BYTES; const int lane = F.lane;
    if (r < IT_IN) { const int kb = r / 496, nb = r % 496, n0 = nb * 32; transpose_item(F.in[8] + (size_t)l * D * NIN_SRC, NIN_SRC, n0 + (n0 >= 4096 ? 16 : 0), kb * 64, (bf16*)(wl + WO_IN), D, n0, scr, lane); return; } r -= IT_IN;
    if (r < IT_BRA) { const int kb = r / 64, nb = r % 64; transpose_item(F.in[15] + (size_t)l * 1024 * D, D, nb * 32, kb * 64, (bf16*)(wl + WO_BRA), 1024, nb * 32, scr, lane); return; } r -= IT_BRA;
    if (r < IT_BRB) { const int kb = r / 64, nb = r % 64; transpose_item(F.in[16] + (size_t)l * 512 * D, D, nb * 32, kb * 64, (bf16*)(wl + WO_BRB), 512, nb * 32, scr, lane); return; } r -= IT_BRB;
    if (r < IT_BRC) { const int kb = r / 64, nb = r % 64; transpose_item(F.in[17] + (size_t)l * 1024 * D, D, nb * 32, kb * 64, (bf16*)(wl + WO_BRC), 1024, nb * 32, scr, lane); return; } r -= IT_BRC;
    if (r < IT_POOL) { const int g = r / 32, kb = (r % 32) / 8, nb = r % 8; transpose_item(F.in[13] + (size_t)(l * 4 + g) * 65536, 256, nb * 32, kb * 64, (bf16*)(wl + WO_POOL) + (size_t)g * 65536, 256, nb * 32, scr, lane, F.in[14] + (size_t)l * CPOOL + g * 256 + nb * 32); return; } r -= IT_POOL;
    if (r < IT_OUT) { const int kb = r / 64, nb = r % 64; transpose_item(F.in[18] + (size_t)l * D * D, D, nb * 32, kb * 64, (bf16*)(wl + WO_OUT), D, nb * 32, scr, lane); return; } r -= IT_OUT;
    if (r < IT_GU) { const int kb = r / 352, nb = r % 352, n0 = nb * 32, pn = n0 >> 8, bj = (n0 >> 7) & 1, rr = n0 & 127;
        transpose_item(F.in[19] + (size_t)l * D * 2 * DFF, 2 * DFF, bj * DFF + 128 * pn + rr, kb * 64, (bf16*)(wl + WO_GU), D, n0, scr, lane); return; } r -= IT_GU;
    { const int kb = r / 64, nb = r % 64; transpose_item(F.in[20] + (size_t)l * DFF * D, D, nb * 32, kb * 64, (bf16*)(wl + WO_DOWN), DFF, nb * 32, scr, lane); }
}

__device__ __forceinline__ void stage_wba(Frame& F0, int l) {
    RELANE(F0);
    LAS float* Wl = (LAS float*)F.lds; const float* w = F.in[8] + (size_t)l * D * NIN_SRC + 4096;
    for (int k = F.tid; k < D; k += NWAVES * 64) { const float* p = w + (size_t)k * NIN_SRC;
        const f32x4 a = *(const f32x4*)p, b = *(const f32x4*)(p + 4), c = *(const f32x4*)(p + 8), d = *(const f32x4*)(p + 12);
        Wl[0 * D + k] = a.x; Wl[1 * D + k] = a.y; Wl[2 * D + k] = a.z; Wl[3 * D + k] = a.w; Wl[4 * D + k] = b.x; Wl[5 * D + k] = b.y; Wl[6 * D + k] = b.z; Wl[7 * D + k] = b.w;
        Wl[8 * D + k] = c.x; Wl[9 * D + k] = c.y; Wl[10 * D + k] = c.z; Wl[11 * D + k] = c.w; Wl[12 * D + k] = d.x; Wl[13 * D + k] = d.y; Wl[14 * D + k] = d.z; Wl[15 * D + k] = d.w; }
    __syncthreads();
}
template <bool X32>
__device__ __forceinline__ void thin_rows(Frame& F0, const float* xa, const float* xb, const bf16* Y, const float* gpost, float* fout, const float* gpre, bool do_ba, int l_ba, int r_lo = 0) {
    RELANE(F0);
    const int lane = F.lane, gw = F.vcu * NWAVES + F.wave, NGW = F.G * NWAVES;
    bf16* H = (bf16*)(F.ws + WS_H); bf16* XB = (bf16*)(F.ws + WS_X1); float* GB = (float*)(F.ws + WS_GB);
    const LAS float* Wl = (const LAS float*)F.lds;
    f32x4 vn[8]; v2u xn[8], yn[8];
#define THIN_LOAD(rr) do { const int r_ = (rr); \
        if (X32) { const float* xr_ = (r_ < MP) ? xa + (size_t)r_ * D : xb + (size_t)(r_ - MP) * D; _Pragma("unroll") for (int j = 0; j < 8; ++j) vn[j] = *(const f32x4*)(xr_ + 4 * lane + 256 * j); } \
        else { _Pragma("unroll") for (int j = 0; j < 8; ++j) xn[j] = *(const v2u*)(XB + (size_t)r_ * D + 4 * lane + 256 * j); } \
        if (Y) { _Pragma("unroll") for (int j = 0; j < 8; ++j) yn[j] = *(const v2u*)(Y + (size_t)r_ * D + 4 * lane + 256 * j); } } while (0)
#pragma unroll
    for (int j = 0; j < 8; ++j) { yn[j] = (v2u){0u, 0u}; xn[j] = (v2u){0u, 0u}; vn[j] = (f32x4){0.f, 0.f, 0.f, 0.f}; }
    if (r_lo + gw < MV) THIN_LOAD(r_lo + gw);
    for (int r = r_lo + gw; r < MV; r += NGW) {
        f32x4 v[8]; v2u yu[8];
#pragma unroll
        for (int j = 0; j < 8; ++j) { v[j] = X32 ? vn[j] : (f32x4){bf_lo(xn[j].x), bf_hi(xn[j].x), bf_lo(xn[j].y), bf_hi(xn[j].y)}; yu[j] = yn[j]; }
        if (r + NGW < MV) THIN_LOAD(r + NGW);
        if (Y) {
            f32x4 y[8]; float ss = 0.f;
#pragma unroll
            for (int j = 0; j < 8; ++j) { const v2u u = yu[j]; y[j] = (f32x4){bf_lo(u.x), bf_hi(u.x), bf_lo(u.y), bf_hi(u.y)}; ss += (y[j].x * y[j].x + y[j].y * y[j].y) + (y[j].z * y[j].z + y[j].w * y[j].w); }
            const float rstd = rsqrtf(wave_sum(ss) * (1.f / D) + EPS);
#pragma unroll
            for (int j = 0; j < 8; ++j) { const f32x4 g = *(const f32x4*)(gpost + 4 * lane + 256 * j); v[j] = v[j] + y[j] * rstd * g; }
        }
        if (fout) {
#pragma unroll
            for (int j = 0; j < 8; ++j) *(f32x4*)(fout + (size_t)r * D + 4 * lane + 256 * j) = v[j];
        } else {
#pragma unroll
            for (int j = 0; j < 8; ++j) { v2u o; o.x = pk2(v[j].x, v[j].y); o.y = pk2(v[j].z, v[j].w); *(v2u*)(XB + (size_t)r * D + 4 * lane + 256 * j) = o; }
        }
        if (gpre) {
            float ss = 0.f;
#pragma unroll
            for (int j = 0; j < 8; ++j) ss += (v[j].x * v[j].x + v[j].y * v[j].y) + (v[j].z * v[j].z + v[j].w * v[j].w);
            const float rstd = rsqrtf(wave_sum(ss) * (1.f / D) + EPS);
#pragma unroll
            for (int j = 0; j < 8; ++j) { const f32x4 g = *(const f32x4*)(gpre + 4 * lane + 256 * j); v[j] = v[j] * rstd * g;
                v2u o; o.x = pk2(v[j].x, v[j].y); o.y = pk2(v[j].z, v[j].w); *(v2u*)(H + (size_t)r * D + 4 * lane + 256 * j) = o; }
            if (do_ba) {
                float pc[16], mine = 0.f;
#pragma unroll
                for (int c = 0; c < 16; ++c) { float p = 0.f;
#pragma unroll
                    for (int j = 0; j < 8; ++j) { const f32x4 w = *(const LAS f32x4*)(Wl + c * D + 256 * j + 4 * lane); p += (v[j].x * w.x + v[j].y * w.y) + (v[j].z * w.z + v[j].w * w.w); }
                    pc[c] = row16_sum(p); }
#pragma unroll
                for (int c = 0; c < 16; ++c) pc[c] += __shfl_xor(pc[c], 16);
#pragma unroll
                for (int c = 0; c < 16; ++c) { pc[c] += __shfl_xor(pc[c], 32); mine = (lane == c) ? pc[c] : mine; }
                if (lane < 16) { float o;
                    if (lane < 8) o = sigm(mine);
                    else { const float al = F.in[10][l_ba * HA + lane - 8], dtb = F.in[11][l_ba * HA + lane - 8]; const float z = mine + dtb; const float sp = fmaxf(z, 0.f) + log1pf(__expf(-fabsf(z))); o = -__expf(al) * sp; }
                    GB[(size_t)r * 16 + lane] = o; }
            }
        }
    }
}
#undef THIN_LOAD
__device__ __forceinline__ void ba_rows(Frame& F0, int l_ba) {
    RELANE(F0);
    const int lane = F.lane, gw = F.vcu * NWAVES + F.wave, NGW = F.G * NWAVES;
    const bf16* H = (const bf16*)(F.ws + WS_H); float* GB = (float*)(F.ws + WS_GB); const LAS float* Wl = (const LAS float*)F.lds;
    for (int r = gw; r < MP; r += NGW) {
        f32x4 v[8];
#pragma unroll
        for (int j = 0; j < 8; ++j) { const v2u u = *(const v2u*)(H + (size_t)r * D + 4 * lane + 256 * j); v[j] = (f32x4){bf_lo(u.x), bf_hi(u.x), bf_lo(u.y), bf_hi(u.y)}; }
        float mine = 0.f;
#pragma unroll 1
        for (int c = 0; c < 16; ++c) { float p = 0.f;
#pragma unroll
            for (int j = 0; j < 8; ++j) { const f32x4 w = *(const LAS f32x4*)(Wl + c * D + 256 * j + 4 * lane); p += (v[j].x * w.x + v[j].y * w.y) + (v[j].z * w.z + v[j].w * w.w); }
            p = wave_sum(p); if (lane == c) mine = p; }
        if (lane < 16) { float o;
            if (lane < 8) o = sigm(mine);
            else { const float al = F.in[10][l_ba * HA + lane - 8], dtb = F.in[11][l_ba * HA + lane - 8]; const float z = mine + dtb; const float sp = fmaxf(z, 0.f) + log1pf(__expf(-fabsf(z))); o = -__expf(al) * sp; }
            GB[(size_t)r * 16 + lane] = o; }
    }
}

__device__ __forceinline__ void ld8f(const float* p, float (&x)[8]) { const f32x4 a = *(const f32x4*)p, b = *(const f32x4*)(p + 4); x[0] = a.x; x[1] = a.y; x[2] = a.z; x[3] = a.w; x[4] = b.x; x[5] = b.y; x[6] = b.z; x[7] = b.w; }
template <bool QK> __device__ __forceinline__ void conv_item(Frame& F0, int l, int row0, int T, int hmode, int sb, int j) {
    RELANE(F0);
    const int lane = F.lane;
    const bf16* PROJ = (const bf16*)(F.ws + WS_PROJ); const float* convw = F.in[9] + (size_t)l * 4 * CONVCH;
    const int c0 = QK ? 512 * j + 8 * lane : 2048 + 512 * j + 8 * lane, c1 = 1024 + 512 * j + 8 * lane;
    float w0[4][8], w1[4][8], x0[4][8], x1[4][8];
#pragma unroll
    for (int tap = 0; tap < 4; ++tap) { ld8f(convw + tap * CONVCH + c0, w0[tap]); if (QK) ld8f(convw + tap * CONVCH + c1, w1[tap]); }
#pragma unroll
    for (int i = 0; i < 3; ++i) {
        if (hmode == 1) { unpack8(*(const v4u*)(PROJ + (size_t)(row0 - 3 + i) * NIN + c0), x0[i + 1]); if (QK) unpack8(*(const v4u*)(PROJ + (size_t)(row0 - 3 + i) * NIN + c1), x1[i + 1]); }
        else if (hmode == 2) { const float* hp = F.in[6] + ((size_t)(l * DB + sb) * 3 + i) * CONVCH; ld8f(hp + c0, x0[i + 1]); if (QK) ld8f(hp + c1, x1[i + 1]); }
        else {
#pragma unroll
            for (int e = 0; e < 8; ++e) { x0[i + 1][e] = 0.f; x1[i + 1][e] = 0.f; } }
    }
    bf16* O0 = (bf16*)(F.ws + (QK ? WS_QN : WS_VV)) + 512 * j + 8 * lane; bf16* O1 = (bf16*)(F.ws + WS_KN) + 512 * j + 8 * lane;
    const float* GB = (const float*)(F.ws + WS_GB); f32x4* TOK = (f32x4*)(F.ws + WS_TOK); const int hd = 4 * j + (lane >> 4);
    v4u n0[4], n1[4]; float ng[4], nb[4];
#pragma unroll
    for (int u = 0; u < 4; ++u) { n0[u] = *(const v4u*)(PROJ + (size_t)(row0 + u) * NIN + c0); n1[u] = n0[u]; ng[u] = 0.f; nb[u] = 0.f; if (QK) { n1[u] = *(const v4u*)(PROJ + (size_t)(row0 + u) * NIN + c1); ng[u] = GB[(size_t)(row0 + u) * 16 + 8 + hd]; nb[u] = GB[(size_t)(row0 + u) * 16 + hd]; } }
    for (int tb = 0; tb < T; tb += 4) {
        v4u m0[4], m1[4]; float mg[4], mb[4];
#pragma unroll
        for (int u = 0; u < 4; ++u) { m0[u] = n0[u]; m1[u] = n1[u]; mg[u] = ng[u]; mb[u] = nb[u]; }
        if (tb + 4 < T) {
#pragma unroll
            for (int u = 0; u < 4; ++u) { n0[u] = *(const v4u*)(PROJ + (size_t)(row0 + tb + 4 + u) * NIN + c0); if (QK) { n1[u] = *(const v4u*)(PROJ + (size_t)(row0 + tb + 4 + u) * NIN + c1); ng[u] = GB[(size_t)(row0 + tb + 4 + u) * 16 + 8 + hd]; nb[u] = GB[(size_t)(row0 + tb + 4 + u) * 16 + hd]; } } }
#pragma unroll
        for (int u = 0; u < 4; ++u) {
            const int t = tb + u; const size_t r = (size_t)(row0 + t);
            unpack8(m0[u], x0[u]); if (QK) unpack8(m1[u], x1[u]);
            float a0[8], a1[8]; float s0 = 0.f, s1 = 0.f;
#pragma unroll
            for (int e = 0; e < 8; ++e) {
                a0[e] = silu(w0[3][e] * x0[u][e] + w0[2][e] * x0[(u + 3) & 3][e] + w0[1][e] * x0[(u + 2) & 3][e] + w0[0][e] * x0[(u + 1) & 3][e]); s0 += a0[e] * a0[e];
                if (QK) { a1[e] = silu(w1[3][e] * x1[u][e] + w1[2][e] * x1[(u + 3) & 3][e] + w1[1][e] * x1[(u + 2) & 3][e] + w1[0][e] * x1[(u + 1) & 3][e]); s1 += a1[e] * a1[e]; } }
            if (QK) {
                const float q_sc = rsqrtf(row16_sum(s0) + 1e-6f) * 0.08838834764831845f, k_sc = rsqrtf(row16_sum(s1) + 1e-6f); float p = 0.f;
#pragma unroll
                for (int e = 0; e < 8; ++e) { a0[e] *= q_sc; a1[e] *= k_sc; p += a0[e] * a1[e]; }
                p = row16_sum(p);
                *(v4u*)(O1 + r * 1024) = pack8(a1);
                if ((lane & 15) == 0) TOK[r * 8 + hd] = (f32x4){__expf(mg[u]), mb[u], p, mg[u]};
            }
            *(v4u*)(O0 + r * 1024) = pack8(a0);
        }
    }
}
__device__ __forceinline__ void pool_item(Frame& F0, int l, int row0, int T, int pos0, int hmode, int sb, int j) {
    RELANE(F0);
    const int lane = F.lane, win = 2 << (2 * j + (lane >> 5)), cc = 512 * j + 8 * lane;
    const bf16* U = (const bf16*)(F.ws + WS_PROJ) + PC_UC + cc; const float* hist = F.in[7] + (size_t)(l * DB + sb) * PHIST * CPOOL + cc;
    bf16* PO = (bf16*)(F.ws + WS_POOLED) + cc;
    float S[8];
#pragma unroll
    for (int e = 0; e < 8; ++e) S[e] = 0.f;
    if (hmode == 2) {
        for (int i = 1; i < 16; ++i) if (i < win) { float x[8]; ld8f(hist + (size_t)(PHIST - i) * CPOOL, x);
#pragma unroll
            for (int e = 0; e < 8; ++e) S[e] += x[e]; }
        for (int t = 0; t < T; ++t) {
            float xn[8], xo[8]; unpack8(*(const v4u*)(U + (size_t)(row0 + t) * NIN), xn);
            const int to = t - win + 1;
            if (to >= 0) unpack8(*(const v4u*)(U + (size_t)(row0 + to) * NIN), xo); else ld8f(hist + (size_t)(PHIST + to) * CPOOL, xo);
            const float inv = 1.f / (float)win; float o[8];
#pragma unroll
            for (int e = 0; e < 8; ++e) { S[e] += xn[e]; o[e] = S[e] * inv - xn[e]; S[e] -= xo[e]; }
            *(v4u*)(PO + (size_t)(row0 + t) * 1024) = pack8(o);
        }
        return;
    }
    {
        v4u h[15];
#pragma unroll
        for (int i = 1; i < 16; ++i) { const int back = (pos0 - i >= 0) ? i : pos0; h[i - 1] = *(const v4u*)(U + (size_t)(row0 - back) * NIN); }
#pragma unroll
        for (int i = 1; i < 16; ++i) { float x[8]; unpack8(h[i - 1], x); const float wgt = (i < win && pos0 - i >= 0) ? 1.f : 0.f;
#pragma unroll
            for (int e = 0; e < 8; ++e) S[e] += wgt * x[e]; }
    }
    v4u nn[4], no[4];
#define POOL_LD(tb_) do { _Pragma("unroll") for (int u = 0; u < 4; ++u) { const int t_ = (tb_) + u, to_ = t_ - win + 1; nn[u] = *(const v4u*)(U + (size_t)(row0 + t_) * NIN); no[u] = *(const v4u*)(U + (size_t)(row0 + (pos0 + to_ >= 0 ? to_ : -pos0)) * NIN); } } while (0)
    POOL_LD(0);
    for (int tb = 0; tb < T; tb += 4) {
        v4u mn[4], mo[4];
#pragma unroll
        for (int u = 0; u < 4; ++u) { mn[u] = nn[u]; mo[u] = no[u]; }
        if (tb + 4 < T) POOL_LD(tb + 4);
#pragma unroll
        for (int u = 0; u < 4; ++u) {
            const int t = tb + u, to = t - win + 1; const float wo = (pos0 + to >= 0) ? 1.f : 0.f;
            float xn[8], xo[8]; unpack8(mn[u], xn); unpack8(mo[u], xo);
            const float cnt = (float)(win < pos0 + t + 1 ? win : pos0 + t + 1), inv = __builtin_amdgcn_rcpf(cnt); float o[8];
#pragma unroll
            for (int e = 0; e < 8; ++e) { S[e] += xn[e]; o[e] = S[e] * inv - xn[e]; S[e] -= wo * xo[e]; }
            *(v4u*)(PO + (size_t)(row0 + t) * 1024) = pack8(o);
        }
    }
#undef POOL_LD
}
constexpr int CV_BLK = 16, CV_NB = SEQ / CV_BLK;
constexpr int CV_P_ITEMS = BATCH * CV_NB * 2, CV_S_ITEMS = DB * 2;
constexpr int PREP_ITEMS = 2 * (CV_P_ITEMS + CV_S_ITEMS) + CV_P_ITEMS + CV_S_ITEMS;
__device__ __forceinline__ void prep_item(Frame& F, int l, int it) {
    int kind = 0;
    if (it >= CV_P_ITEMS + CV_S_ITEMS) { it -= CV_P_ITEMS + CV_S_ITEMS; kind = 1; if (it >= CV_P_ITEMS + CV_S_ITEMS) { it -= CV_P_ITEMS + CV_S_ITEMS; kind = 2; } }
    int row0, T, hmode, sb = 0, pos0; const int j = it & 1;
    if (it < CV_P_ITEMS) { const int blk = (it >> 1) % CV_NB, b = (it >> 1) / CV_NB; row0 = b * SEQ + blk * CV_BLK; T = CV_BLK; hmode = blk ? 1 : 0; pos0 = blk * CV_BLK; }
    else { sb = (it - CV_P_ITEMS) >> 1; row0 = MP + DS * sb; T = DS; hmode = 2; pos0 = 0; }
    if (kind == 0) conv_item<true>(F, l, row0, T, hmode, sb, j); else if (kind == 1) conv_item<false>(F, l, row0, T, hmode, sb, j); else pool_item(F, l, row0, T, pos0, hmode, sb, j);
}

__device__ __forceinline__ void st8f(float* p, const v4u u) { float x[8]; unpack8(u, x); *(f32x4*)p = (f32x4){x[0], x[1], x[2], x[3]}; *(f32x4*)(p + 4) = (f32x4){x[4], x[5], x[6], x[7]}; }
__device__ __forceinline__ void prep_out_rows(Frame& F0, int l) {
    RELANE(F0);
    const int lane = F.lane, gw = F.vcu * NWAVES + F.wave, NGW = F.G * NWAVES;
    const bf16* PROJ = (const bf16*)(F.ws + WS_PROJ);
    float* out = F.out;
    for (int r = gw; r < MV; r += NGW) {
        const bool samp = r >= MP; const int b = samp ? (r - MP) / DS : r / SEQ, t = samp ? (r - MP) % DS : r % SEQ;
        const bf16* prow = PROJ + (size_t)r * NIN;
        const int ci = samp ? t - 1 : t - (SEQ - 3), pi = samp ? 11 + t : t - (SEQ - PHIST);
        v4u kvr[3][2], cv[6], pv[2];
#pragma unroll
        for (int gi = 0; gi < 3; ++gi) { kvr[gi][0] = *(const v4u*)(prow + PC_KB + gi * 512 + 8 * lane); kvr[gi][1] = *(const v4u*)(prow + PC_VB + gi * 512 + 8 * lane); }
        const bool needc = (ci >= 0) || (pi >= 0);
        if (needc) {
#pragma unroll
            for (int j = 0; j < 6; ++j) cv[j] = *(const v4u*)(prow + 512 * j + 8 * lane);
#pragma unroll
            for (int j = 0; j < 2; ++j) pv[j] = *(const v4u*)(prow + PC_UC + 512 * j + 8 * lane);
        }
#pragma unroll
        for (int gi = 0; gi < 3; ++gi) {
            const int win = 128 << (2 * gi); const int w = samp ? win - DS + t : t - (SEQ - win);
            if (w >= 0) {
                const size_t obase = samp ? (gi == 0 ? O_SW1 : gi == 1 ? O_SW2 : O_SW3) : (gi == 0 ? O_PW1 : gi == 1 ? O_PW2 : O_PW3);
                float* dst = out + obase + ((size_t)(l * (samp ? DB : BATCH) + b) * win + w) * 1024 + 8 * lane;
                st8f(dst, kvr[gi][0]); st8f(dst + 512, kvr[gi][1]);
            }
        }
        if (needc) {
            if (ci >= 0) { float* dst = out + (samp ? O_SCONV + ((size_t)(l * DB + b) * 3 + ci) * CONVCH : O_PCONV + ((size_t)(l * BATCH + b) * 3 + ci) * CONVCH) + 8 * lane;
#pragma unroll
                for (int j = 0; j < 6; ++j) st8f(dst + 512 * j, cv[j]); }
            if (pi >= 0) { float* dst = out + (samp ? O_SPOOL + ((size_t)(l * DB + b) * PHIST + pi) * CPOOL : O_PPOOL + ((size_t)(l * BATCH + b) * PHIST + pi) * CPOOL) + 8 * lane;
#pragma unroll
                for (int j = 0; j < 2; ++j) st8f(dst + 512 * j, pv[j]); }
            if (samp && t == 0) {
                const float* phist = F.in[7] + (size_t)(l * DB + b) * PHIST * CPOOL;
                float* dst = out + O_SPOOL + (size_t)(l * DB + b) * PHIST * CPOOL; const float* src = phist + 4 * CPOOL;
                for (int i = lane; i < 11 * CPOOL / 4; i += 64) *(f32x4*)(dst + 4 * i) = *(const f32x4*)(src + 4 * i);
            }
        }
    }
}

__device__ __forceinline__ void gdn_scan_item(Frame& F0, int row0, int h, int s, const float* S0, float* Sout) {
    RELANE(F0);
    const int lane = F.lane, dvl = lane & 15, kg = lane >> 4;
    const bf16* QN = (const bf16*)(F.ws + WS_QN); const bf16* KN = (const bf16*)(F.ws + WS_KN); const bf16* VV = (const bf16*)(F.ws + WS_VV);
    const f32x4* TOK = (const f32x4*)(F.ws + WS_TOK); float* ORAW = (float*)(F.ws + WS_ORAW);
    float S[32]; v4u ku[DS][4], qu[DS][4]; float vv[DS]; f32x4 tk[DS];
    const float* sp = S0 + (size_t)(32 * kg) * 128 + 16 * s + dvl;
#pragma unroll
    for (int i = 0; i < 32; ++i) S[i] = sp[(size_t)i * 128];
#pragma unroll
    for (int t = 0; t < DS; ++t) { const size_t r = (size_t)(row0 + t);
#pragma unroll
        for (int c = 0; c < 4; ++c) { ku[t][c] = *(const v4u*)(KN + r * 1024 + h * 128 + 32 * kg + 8 * c); qu[t][c] = *(const v4u*)(QN + r * 1024 + h * 128 + 32 * kg + 8 * c); }
        vv[t] = bf1(VV[r * 1024 + h * 128 + 16 * s + dvl]); tk[t] = TOK[r * 8 + h]; }
#pragma unroll
    for (int t = 0; t < DS; ++t) {
        float rk = 0.f, rq = 0.f; float kf[32];
#pragma unroll
        for (int c = 0; c < 4; ++c) { float k8[8], q8[8]; unpack8(ku[t][c], k8); unpack8(qu[t][c], q8);
#pragma unroll
            for (int e = 0; e < 8; ++e) { kf[8 * c + e] = k8[e]; rk += k8[e] * S[8 * c + e]; rq += q8[e] * S[8 * c + e]; } }
        rk += __shfl_xor(rk, 16); rq += __shfl_xor(rq, 16); rk += __shfl_xor(rk, 32); rq += __shfl_xor(rq, 32);
        const float a = tk[t].x, d = tk[t].y * (vv[t] - a * rk), o = a * rq + tk[t].z * d;
#pragma unroll
        for (int i = 0; i < 32; ++i) S[i] = a * S[i] + kf[i] * d;
        if (kg == 0) ORAW[(size_t)(row0 + t) * 1024 + h * 128 + 16 * s + dvl] = o;
    }
    float* op = Sout + (size_t)(32 * kg) * 128 + 16 * s + dvl;
#pragma unroll
    for (int i = 0; i < 32; ++i) op[(size_t)i * 128] = S[i];
}

__device__ __forceinline__ bf16x8 pack_acc(const f32x16& x, int sp) {
    v4u p; p.x = pk2(x[8 * sp + 0], x[8 * sp + 1]); p.y = pk2(x[8 * sp + 2], x[8 * sp + 3]); p.z = pk2(x[8 * sp + 4], x[8 * sp + 5]); p.w = pk2(x[8 * sp + 6], x[8 * sp + 7]);
    return __builtin_bit_cast(bf16x8, p);
}
constexpr int GA_PITCH = 272, GA_LT_PITCH = 36, GA_WAVE_LDS = 32 * GA_PITCH + 32 * GA_LT_PITCH * 4 + 384;
__device__ __forceinline__ void gdn_ga_item(Frame& F0, int ch) {
    RELANE(F0);
    const int lane = F.lane, r = lane & 31, h = lane >> 5;
    const int c = ch & 63, bh = ch >> 6, hd = bh & 7, b = bh >> 3, row0 = b * SEQ + 32 * c;
    LAS unsigned char* TL = F.lds + F.wave * GA_WAVE_LDS; LAS float* LT = (LAS float*)(TL + 32 * GA_PITCH); LAS float* GS = (LAS float*)(TL + 32 * GA_PITCH + 32 * GA_LT_PITCH * 4);
    const bf16* QN = (const bf16*)(F.ws + WS_QN); const bf16* KN = (const bf16*)(F.ws + WS_KN); const bf16* VV = (const bf16*)(F.ws + WS_VV); const f32x4* TOK = (const f32x4*)(F.ws + WS_TOK);
    { const f32x4 tk = TOK[(size_t)(row0 + r) * 8 + hd]; if (h == 0) { GS[r] = tk.w; GS[32 + r] = tk.y; } }
#pragma unroll
    for (int i = 0; i < 8; ++i) { const int p = lane + 64 * i, rw = p >> 4, c16 = p & 15; *(LAS v4u*)(TL + rw * GA_PITCH + 16 * c16) = *(const v4u*)(KN + (size_t)(row0 + rw) * 1024 + hd * 128 + 8 * c16); }
    asm volatile("s_waitcnt lgkmcnt(0)" ::: "memory");
    float gcv[32], bev[32];
#pragma unroll
    for (int i = 0; i < 8; ++i) { const f32x4 a = *(const LAS f32x4*)(GS + 4 * i), bq = *(const LAS f32x4*)(GS + 32 + 4 * i);
        gcv[4 * i] = a.x; gcv[4 * i + 1] = a.y; gcv[4 * i + 2] = a.z; gcv[4 * i + 3] = a.w; bev[4 * i] = bq.x; bev[4 * i + 1] = bq.y; bev[4 * i + 2] = bq.z; bev[4 * i + 3] = bq.w; }
#pragma unroll
    for (int i = 1; i < 32; ++i) gcv[i] += gcv[i - 1];
    if (lane == 0) {
#pragma unroll
        for (int i = 0; i < 8; ++i) *(LAS f32x4*)(GS + 64 + 4 * i) = (f32x4){gcv[4 * i], gcv[4 * i + 1], gcv[4 * i + 2], gcv[4 * i + 3]}; }
    asm volatile("s_waitcnt lgkmcnt(0)" ::: "memory");
    const float gc_own = GS[64 + r], fr = (float)r;
    const bf16* kp = KN + (size_t)(row0 + r) * 1024 + hd * 128 + 8 * h; const bf16* qp = QN + (size_t)(row0 + r) * 1024 + hd * 128 + 8 * h;
    f32x16 akk, aqk;
#pragma unroll
    for (int i = 0; i < 16; ++i) { akk[i] = 0.f; aqk[i] = 0.f; }
#pragma unroll
    for (int ks = 0; ks < 8; ++ks) { const bf16x8 kf = *(const bf16x8*)(kp + 16 * ks), qf = *(const bf16x8*)(qp + 16 * ks);
        akk = __builtin_amdgcn_mfma_f32_32x32x16_bf16(kf, kf, akk, 0, 0, 0); aqk = __builtin_amdgcn_mfma_f32_32x32x16_bf16(kf, qf, aqk, 0, 0, 0); }
#pragma unroll
    for (int g4 = 0; g4 < 4; ++g4) { f32x4 w;
#pragma unroll
        for (int e = 0; e < 4; ++e) { const int k0 = 8 * g4 + e, k1 = k0 + 4; const float gk = h ? gcv[k1] : gcv[k0], bk = h ? bev[k1] : bev[k0]; const int kk = h ? k1 : k0;
            const float lo = fminf(fmaxf((float)kk - fr, 0.f), 1.f);
            w[e] = lo * bk * akk[4 * g4 + e] * __expf(fminf(gk - gc_own, 0.f));
            aqk[4 * g4 + e] = (1.f - lo) * aqk[4 * g4 + e] * __expf(fminf(gc_own - gk, 0.f)); }
        *(LAS f32x4*)(LT + r * GA_LT_PITCH + 8 * g4 + 4 * h) = w; }
    bf16x8* AF = (bf16x8*)(F.ws + WS_AF) + (size_t)ch * 128;
    AF[lane] = pack_acc(aqk, 0); AF[64 + lane] = pack_acc(aqk, 1);
    asm volatile("s_waitcnt lgkmcnt(0)" ::: "memory");
    float t[32];
#pragma unroll
    for (int j = 31; j >= 0; --j) {
        float acc = 1.f - fminf(fabsf(fr - (float)j), 1.f);
#pragma unroll
        for (int gq = (j + 1) >> 2; gq < 8; ++gq) { const f32x4 lv = *(const LAS f32x4*)(LT + j * GA_LT_PITCH + 4 * gq);
#pragma unroll
            for (int e = 0; e < 4; ++e) if (4 * gq + e > j) acc -= t[4 * gq + e] * lv[e]; }
        t[j] = acc;
    }
    bf16x8 t1f[2], t2f[2];
#pragma unroll
    for (int sp = 0; sp < 2; ++sp) { float x1[8], x2[8];
#pragma unroll
        for (int e = 0; e < 8; ++e) { const int j0 = 16 * sp + e, j1 = j0 + 8; const float tv = h ? t[j1] : t[j0], bj = h ? bev[j1] : bev[j0], gj = h ? gcv[j1] : gcv[j0]; x1[e] = tv * bj; x2[e] = x1[e] * __expf(gj); }
        t1f[sp] = __builtin_bit_cast(bf16x8, pack8(x1)); t2f[sp] = __builtin_bit_cast(bf16x8, pack8(x2)); }
    { bf16x8* QFo = (bf16x8*)(F.ws + WS_QF) + (size_t)ch * 512; const bf16* qrow = QN + (size_t)(row0 + r) * 1024 + hd * 128 + 4 * h;
#pragma unroll
      for (int tl = 0; tl < 4; ++tl)
#pragma unroll
          for (int sp = 0; sp < 2; ++sp) { const v2u qlo = *(const v2u*)(qrow + 32 * tl + 16 * sp), qhi = *(const v2u*)(qrow + 32 * tl + 16 * sp + 8); v4u qu; qu.x = qlo.x; qu.y = qlo.y; qu.z = qhi.x; qu.w = qhi.y; QFo[(tl * 2 + sp) * 64 + lane] = __builtin_bit_cast(bf16x8, qu); } }
    const float g_last = gcv[31];
    bf16x8* WF = (bf16x8*)(F.ws + WS_WF) + (size_t)ch * 512; bf16x8* KF = (bf16x8*)(F.ws + WS_KF) + (size_t)ch * 512;
#pragma unroll
    for (int tl = 0; tl < 4; ++tl) {
        f32x16 acc;
#pragma unroll
        for (int i = 0; i < 16; ++i) acc[i] = 0.f;
        const LAS unsigned char* col = TL + (32 * tl + r) * 2;
#pragma unroll
        for (int sp = 0; sp < 2; ++sp) { unsigned w[4];
#pragma unroll
            for (int e = 0; e < 4; ++e) { const unsigned lo = *(const LAS unsigned short*)(col + (16 * sp + 8 * h + 2 * e) * GA_PITCH), hi = *(const LAS unsigned short*)(col + (16 * sp + 8 * h + 2 * e + 1) * GA_PITCH); w[e] = lo | (hi << 16); }
            v4u wu; wu.x = w[0]; wu.y = w[1]; wu.z = w[2]; wu.w = w[3];
            acc = __builtin_amdgcn_mfma_f32_32x32x16_bf16(__builtin_bit_cast(bf16x8, wu), t2f[sp], acc, 0, 0, 0); }
#pragma unroll
        for (int i = 0; i < 16; ++i) acc[i] = -acc[i];
#pragma unroll
        for (int sp = 0; sp < 2; ++sp) { WF[(tl * 2 + sp) * 64 + lane] = pack_acc(acc, sp);
            float x[8];
#pragma unroll
            for (int e = 0; e < 8; ++e) { const int j0 = 16 * sp + 8 * (e >> 2) + (e & 3), j1 = j0 + 4; const float gj = h ? gcv[j1] : gcv[j0];
                const unsigned kv = *(const LAS unsigned short*)(col + (j0 + 4 * h) * GA_PITCH); x[e] = __builtin_bit_cast(float, kv << 16) * __expf(g_last - gj); }
            KF[(tl * 2 + sp) * 64 + lane] = __builtin_bit_cast(bf16x8, pack8(x)); }
    }
    asm volatile("s_waitcnt lgkmcnt(0)" ::: "memory");
#pragma unroll
    for (int i = 0; i < 8; ++i) { const int p = lane + 64 * i, rw = p >> 4, c16 = p & 15; *(LAS v4u*)(TL + rw * GA_PITCH + 16 * c16) = *(const v4u*)(VV + (size_t)(row0 + rw) * 1024 + hd * 128 + 8 * c16); }
    asm volatile("s_waitcnt lgkmcnt(0)" ::: "memory");
    f32x4* UF = (f32x4*)(F.ws + WS_UF) + (size_t)ch * 1024;
#pragma unroll
    for (int tl = 0; tl < 4; ++tl) {
        f32x16 acc;
#pragma unroll
        for (int i = 0; i < 16; ++i) acc[i] = 0.f;
        const LAS unsigned char* col = TL + (32 * tl + r) * 2;
#pragma unroll
        for (int sp = 0; sp < 2; ++sp) { unsigned w[4];
#pragma unroll
            for (int e = 0; e < 4; ++e) { const unsigned lo = *(const LAS unsigned short*)(col + (16 * sp + 8 * h + 2 * e) * GA_PITCH), hi = *(const LAS unsigned short*)(col + (16 * sp + 8 * h + 2 * e + 1) * GA_PITCH); w[e] = lo | (hi << 16); }
            v4u wu; wu.x = w[0]; wu.y = w[1]; wu.z = w[2]; wu.w = w[3];
            acc = __builtin_amdgcn_mfma_f32_32x32x16_bf16(t1f[sp], __builtin_bit_cast(bf16x8, wu), acc, 0, 0, 0); }
#pragma unroll
        for (int g4 = 0; g4 < 4; ++g4) UF[(tl * 4 + g4) * 64 + lane] = (f32x4){acc[4 * g4], acc[4 * g4 + 1], acc[4 * g4 + 2], acc[4 * g4 + 3]};
    }
    if (h == 0) ((float*)(F.ws + WS_TB))[(size_t)ch * 32 + r] = __expf(gc_own);
    asm volatile("s_waitcnt lgkmcnt(0)" ::: "memory");
}

constexpr int GSC_ITEMS = BATCH * HA * 4;
constexpr int GSB_WF = 0, GSB_KF = 8192, GSB_QF = 16384, GSB_UF = 24576, GSB_AF = 28672, GSB_TB = 30720, GSB_AL = 34816, GSB_STRIDE = 36864;
__device__ __forceinline__ void gdn_chunk_scan(Frame& F0, int l, int item) {
    RELANE(F0);
    const int lane = F.lane, r = lane & 31, h = lane >> 5;
    const int sl = item & 3, bh = item >> 2, hd = bh & 7, b = bh >> 3;
    float* ORAW = (float*)(F.ws + WS_ORAW);
    LAS unsigned char* buf = F.lds;
#define GS_DMA(src, off) __builtin_amdgcn_global_load_lds((const unsigned*)(src), (LAS unsigned*)(bp + (off)), 16, 0, 0)
#define GS_FETCH(cc, bsel) do { const size_t ch_ = (size_t)bh * 64 + (cc); LAS unsigned char* bp = buf + (bsel) * GSB_STRIDE; \
        const bf16x8* wf_ = (const bf16x8*)(F.ws + WS_WF) + ch_ * 512 + lane; const bf16x8* kf_ = (const bf16x8*)(F.ws + WS_KF) + ch_ * 512 + lane; const bf16x8* qf_ = (const bf16x8*)(F.ws + WS_QF) + ch_ * 512 + lane; \
        const f32x4* uf_ = (const f32x4*)(F.ws + WS_UF) + ch_ * 1024 + (size_t)sl * 256 + lane; const bf16x8* af_ = (const bf16x8*)(F.ws + WS_AF) + ch_ * 128 + lane; const float* tb_ = (const float*)(F.ws + WS_TB) + ch_ * 32; \
        _Pragma("unroll") for (int i_ = 0; i_ < 8; ++i_) { GS_DMA(wf_ + i_ * 64, GSB_WF + i_ * 1024); GS_DMA(qf_ + i_ * 64, GSB_QF + i_ * 1024); } \
        _Pragma("unroll") for (int i_ = 0; i_ < 4; ++i_) { GS_DMA(uf_ + i_ * 64, GSB_UF + i_ * 1024); GS_DMA(tb_ + 8 * i_ + 4 * h, GSB_TB + i_ * 1024); } \
        GS_DMA(af_, GSB_AF); GS_DMA(af_ + 64, GSB_AF + 1024); GS_DMA(tb_ + 28, GSB_AL); \
        _Pragma("unroll") for (int i_ = 0; i_ < 8; ++i_) GS_DMA(kf_ + i_ * 64, GSB_KF + i_ * 1024); } while (0)
    f32x16 S[4];
#pragma unroll
    for (int tl = 0; tl < 4; ++tl)
#pragma unroll
        for (int i = 0; i < 16; ++i) S[tl][i] = 0.f;
    GS_FETCH(0, 0);
#pragma unroll 1
    for (int c = 0; c < SEQ / 32; ++c) {
        const int row0 = b * SEQ + 32 * c;
        asm volatile("s_waitcnt vmcnt(0)" ::: "memory");
        if (c + 1 < SEQ / 32) GS_FETCH(c + 1, (c + 1) & 1);
        const LAS unsigned char* bp = buf + (c & 1) * GSB_STRIDE + lane * 16;
        f32x16 P, O1;
#pragma unroll
        for (int g4 = 0; g4 < 4; ++g4) { const f32x4 u = *(const LAS f32x4*)(bp + GSB_UF + g4 * 1024); P[4 * g4] = u.x; P[4 * g4 + 1] = u.y; P[4 * g4 + 2] = u.z; P[4 * g4 + 3] = u.w; }
#pragma unroll
        for (int i = 0; i < 16; ++i) O1[i] = 0.f;
#pragma unroll
        for (int tl = 0; tl < 4; ++tl)
#pragma unroll
            for (int sp = 0; sp < 2; ++sp) {
                const bf16x8 sf = pack_acc(S[tl], sp);
                P = __builtin_amdgcn_mfma_f32_32x32x16_bf16(*(const LAS bf16x8*)(bp + GSB_WF + (tl * 2 + sp) * 1024), sf, P, 0, 0, 0);
                O1 = __builtin_amdgcn_mfma_f32_32x32x16_bf16(*(const LAS bf16x8*)(bp + GSB_QF + (tl * 2 + sp) * 1024), sf, O1, 0, 0, 0);
            }
#pragma unroll
        for (int g4 = 0; g4 < 4; ++g4) { const f32x4 eg = *(const LAS f32x4*)(bp + GSB_TB + g4 * 1024); O1[4 * g4] *= eg.x; O1[4 * g4 + 1] *= eg.y; O1[4 * g4 + 2] *= eg.z; O1[4 * g4 + 3] *= eg.w; }
        const bf16x8 vf0 = pack_acc(P, 0), vf1 = pack_acc(P, 1);
        O1 = __builtin_amdgcn_mfma_f32_32x32x16_bf16(*(const LAS bf16x8*)(bp + GSB_AF), vf0, O1, 0, 0, 0);
        O1 = __builtin_amdgcn_mfma_f32_32x32x16_bf16(*(const LAS bf16x8*)(bp + GSB_AF + 1024), vf1, O1, 0, 0, 0);
        const float a_last = (*(const LAS f32x4*)(bp + GSB_AL)).w;
#pragma unroll
        for (int tl = 0; tl < 4; ++tl) {
#pragma unroll
            for (int i = 0; i < 16; ++i) S[tl][i] *= a_last;
            S[tl] = __builtin_amdgcn_mfma_f32_32x32x16_bf16(*(const LAS bf16x8*)(bp + GSB_KF + (tl * 2) * 1024), vf0, S[tl], 0, 0, 0);
            S[tl] = __builtin_amdgcn_mfma_f32_32x32x16_bf16(*(const LAS bf16x8*)(bp + GSB_KF + (tl * 2 + 1) * 1024), vf1, S[tl], 0, 0, 0);
        }
        float* op = ORAW + (size_t)(row0 + 4 * h) * 1024 + hd * 128 + 32 * sl + r;
#pragma unroll
        for (int i = 0; i < 16; ++i) op[(size_t)((i & 3) + 8 * (i >> 2)) * 1024] = O1[i];
    }
#undef GS_DMA
#undef GS_FETCH
    float* Sout = F.out + O_PGDN + (size_t)((l * BATCH + b) * HA + hd) * 16384 + 32 * sl + r;
#pragma unroll
    for (int tl = 0; tl < 4; ++tl)
#pragma unroll
        for (int i = 0; i < 16; ++i) Sout[(size_t)(32 * tl + (i & 3) + 8 * (i >> 2) + 4 * h) * 128] = S[tl][i];
}

constexpr int VT_PITCH = 144, VT_WAVE_LDS = 64 * VT_PITCH, VT_ITEMS = BATCH * 3 * 4 * 2 * 32;
__device__ __forceinline__ void vt_item(Frame& F0, int item) {
    RELANE(F0);
    const int lane = F.lane; LAS unsigned char* T = F.lds + F.wave * VT_WAVE_LDS;
    const int ch = item & 31, dh = (item >> 5) & 1, hh = (item >> 6) & 3, bg = item >> 8, g = bg % 3, b = bg / 3;
    const int dil = 1 << (2 * g), Lc = SEQ >> (2 * g), pos0 = ch * 64, rho = pos0 / Lc, i0 = pos0 % Lc;
    const bf16* PROJ = (const bf16*)(F.ws + WS_PROJ); bf16* VT = (bf16*)(F.ws + WS_VT);
    const bf16* src = PROJ + ((size_t)b * SEQ + (size_t)(i0 + lane) * dil + rho) * NIN + PC_VB + g * 512 + hh * 128 + 64 * dh;
    v4u x[8];
#pragma unroll
    for (int c = 0; c < 8; ++c) x[c] = *(const v4u*)(src + 8 * c);
#pragma unroll
    for (int c = 0; c < 8; ++c) { const unsigned w[4] = {x[c].x, x[c].y, x[c].z, x[c].w};
#pragma unroll
        for (int e = 0; e < 4; ++e) { *(LAS unsigned short*)(T + (8 * c + 2 * e) * VT_PITCH + 2 * lane) = (unsigned short)(w[e] & 0xffffu); *(LAS unsigned short*)(T + (8 * c + 2 * e + 1) * VT_PITCH + 2 * lane) = (unsigned short)(w[e] >> 16); } }
    asm volatile("s_waitcnt lgkmcnt(0)" ::: "memory");
    bf16* dst = VT + ((size_t)((b * 3 + g) * 4 + hh) * 128 + 64 * dh) * 2048 + pos0;
#pragma unroll
    for (int it = 0; it < 8; ++it) { const int p = lane + 64 * it, row = p >> 3, cc = p & 7; const v4u v = *(const LAS v4u*)(T + row * VT_PITCH + 16 * cc); *(v4u*)(dst + (size_t)row * 2048 + 8 * cc) = v; }
    asm volatile("s_waitcnt lgkmcnt(0)" ::: "memory");
}

constexpr int ATT_UNITS = BATCH * 4 * 192;
__device__ __forceinline__ void attn_unit(Frame& F0, int unit) {
    RELANE(F0);
    const int lane = F.lane, r = lane & 31, h = lane >> 5;
    const int bh = unit / 192, b = bh >> 2, hh = bh & 3, u = unit % 192, g = u >> 6, v = u & 63;
    const int dil = 1 << (2 * g), ntpc = 64 >> (2 * g), rho = v / ntpc, i0 = (v % ntpc) * 32, Lc = SEQ >> (2 * g);
    const bf16* PROJ = (const bf16*)(F.ws + WS_PROJ);
    const bf16* cbase = PROJ + ((size_t)b * SEQ + rho) * NIN + g * 512 + hh * 128 + 8 * h;
    const bf16* qp = cbase + (size_t)(i0 + r) * dil * NIN + PC_QB;
    bf16x8 qf[8];
#pragma unroll
    for (int ks = 0; ks < 8; ++ks) qf[ks] = *(const bf16x8*)(qp + 16 * ks);
    f32x16 st[5]; float mx = -1e30f;
    bf16x8 kn[8];
    { const int k0 = i0 - 128; const bf16* kp = cbase + (size_t)((k0 >= 0 ? k0 : 0) + r) * dil * NIN + PC_KB;
#pragma unroll
      for (int ks = 0; ks < 8; ++ks) kn[ks] = *(const bf16x8*)(kp + 16 * ks); }
#pragma unroll
    for (int kt = 0; kt < 5; ++kt) {
        const int k0 = i0 - 128 + 32 * kt; const bool tv = k0 >= 0;
        bf16x8 kc[8];
#pragma unroll
        for (int ks = 0; ks < 8; ++ks) kc[ks] = kn[ks];
        if (kt < 4) { const int k1 = k0 + 32; const bf16* kp = cbase + (size_t)((k1 >= 0 ? k1 : 0) + r) * dil * NIN + PC_KB;
#pragma unroll
            for (int ks = 0; ks < 8; ++ks) kn[ks] = *(const bf16x8*)(kp + 16 * ks); }
        f32x16 acc;
#pragma unroll
        for (int i = 0; i < 16; ++i) acc[i] = 0.f;
#pragma unroll
        for (int ks = 0; ks < 8; ++ks) acc = __builtin_amdgcn_mfma_f32_32x32x16_bf16(kc[ks], qf[ks], acc, 0, 0, 0);
#pragma unroll
        for (int i = 0; i < 16; ++i) { const int row = (i & 3) + 8 * (i >> 2) + 4 * h; float sv = tv ? acc[i] : -1e30f;
            if (kt == 0 && row < r) sv = -1e30f;
            if (kt == 4 && row > r) sv = -1e30f;
            st[kt][i] = sv; mx = fmaxf(mx, sv); }
    }
    mx = fmaxf(mx, __shfl_xor(mx, 32));
    const float c = 0.08838834764831845f * 1.4426950408889634f, mc = mx * c; float ls = 0.f;
#pragma unroll
    for (int kt = 0; kt < 5; ++kt)
#pragma unroll
        for (int i = 0; i < 16; ++i) { const float p = __builtin_amdgcn_exp2f(st[kt][i] * c - mc); st[kt][i] = p; ls += p; }
    ls += __shfl_xor(ls, 32);
    f32x16 ot[4];
#pragma unroll
    for (int dt = 0; dt < 4; ++dt)
#pragma unroll
        for (int i = 0; i < 16; ++i) ot[dt][i] = 0.f;
    const bf16* vt = (const bf16*)(F.ws + WS_VT) + ((size_t)((b * 3 + g) * 4 + hh) * 128 + r) * 2048 + rho * Lc + 4 * h;
    v2u vn[2][4][2];
#define ATT_VLD(kt_) do { const int k0_ = i0 - 128 + 32 * (kt_), kc_ = k0_ >= 0 ? k0_ : 0; _Pragma("unroll") for (int sp = 0; sp < 2; ++sp) _Pragma("unroll") for (int dt = 0; dt < 4; ++dt) { \
            const bf16* vp = vt + (size_t)(32 * dt) * 2048 + kc_ + 16 * sp; vn[sp][dt][0] = *(const v2u*)vp; vn[sp][dt][1] = *(const v2u*)(vp + 8); } } while (0)
    ATT_VLD(0);
#pragma unroll
    for (int kt = 0; kt < 5; ++kt) {
        v2u vc[2][4][2];
#pragma unroll
        for (int sp = 0; sp < 2; ++sp)
#pragma unroll
            for (int dt = 0; dt < 4; ++dt) { vc[sp][dt][0] = vn[sp][dt][0]; vc[sp][dt][1] = vn[sp][dt][1]; }
        if (kt < 4) ATT_VLD(kt + 1);
#pragma unroll
        for (int sp = 0; sp < 2; ++sp) {
            v4u pu; pu.x = pk2(st[kt][8 * sp + 0], st[kt][8 * sp + 1]); pu.y = pk2(st[kt][8 * sp + 2], st[kt][8 * sp + 3]); pu.z = pk2(st[kt][8 * sp + 4], st[kt][8 * sp + 5]); pu.w = pk2(st[kt][8 * sp + 6], st[kt][8 * sp + 7]);
            const bf16x8 pf = __builtin_bit_cast(bf16x8, pu);
#pragma unroll
            for (int dt = 0; dt < 4; ++dt) {
                v4u vu; vu.x = vc[sp][dt][0].x; vu.y = vc[sp][dt][0].y; vu.z = vc[sp][dt][1].x; vu.w = vc[sp][dt][1].y;
                ot[dt] = __builtin_amdgcn_mfma_f32_32x32x16_bf16(__builtin_bit_cast(bf16x8, vu), pf, ot[dt], 0, 0, 0);
            }
        }
    }
#undef ATT_VLD
    const float inv = 1.f / ls; const size_t tok = (size_t)b * SEQ + (size_t)(i0 + r) * dil + rho;
    bf16* op = (bf16*)(F.ws + WS_OBG) + ((size_t)g * MV + tok) * 512 + hh * 128 + 4 * h;
#pragma unroll
    for (int dt = 0; dt < 4; ++dt)
#pragma unroll
        for (int g4 = 0; g4 < 4; ++g4) { v2u w; w.x = pk2(ot[dt][4 * g4] * inv, ot[dt][4 * g4 + 1] * inv); w.y = pk2(ot[dt][4 * g4 + 2] * inv, ot[dt][4 * g4 + 3] * inv); *(v2u*)(op + 32 * dt + 8 * g4) = w; }
    if (h == 0) *(f32x2*)((float*)(F.ws + WS_AST) + (((size_t)g * MV + tok) * 4 + hh) * 2) = (f32x2){mc, ls};
}


__device__ __forceinline__ void attn_sample_item(Frame& F0, int l, int item) {
    RELANE(F0);
    const int lane = F.lane, l16 = lane & 15;
    const int half = item & 1, it2 = item >> 1, g = it2 % 3, bt = it2 / 3, t = bt & 3, b = bt >> 2, dil = 1 << (2 * g), win = 128 * dil, jlo = half ? 65 : 0, part = g + 3 * half;
    const bf16* PROJ = (const bf16*)(F.ws + WS_PROJ);
    const int row = MP + DS * b + t;
    const float* cache = F.in[2 + g] + (size_t)(l * DB + b) * win * 1024 + 8 * lane;
    const bf16* newk = PROJ + (size_t)(MP + DS * b) * NIN + PC_KB + g * 512 + 8 * lane;
    float q[8]; unpack8(*(const v4u*)(PROJ + (size_t)row * NIN + PC_QB + g * 512 + 8 * lane), q);
    const int n_new = (g == 0) ? t + 1 : 1;
    const float c = 0.08838834764831845f * 1.4426950408889634f;
    float sc[5];
#pragma unroll
    for (int jr = 0; jr < 5; ++jr) {
        sc[jr] = -1e30f;
        const int jn = jr < 4 ? 16 : 1;
#pragma unroll 8
        for (int jl = 0; jl < jn; ++jl) {
            const int j = jlo + 16 * jr + jl, jc = j <= 128 ? j : 128; int idx = win + t - jc * dil; idx = idx < win ? idx : win - 1;
            const float* kp = cache + (size_t)idx * 1024; const f32x4 a = *(const f32x4*)kp, bq = *(const f32x4*)(kp + 4);
            float sv = (q[0] * a.x + q[1] * a.y) + (q[2] * a.z + q[3] * a.w) + (q[4] * bq.x + q[5] * bq.y) + (q[6] * bq.z + q[7] * bq.w);
            sv = j <= 128 ? row16_sum(sv) * c : -1e30f;
            sc[jr] = (l16 == jl) ? sv : sc[jr];
        }
    }
#pragma unroll
    for (int jj = 0; jj < 4; ++jj) {
        const int tk = t - jj >= 0 ? t - jj : 0; float k[8]; unpack8(*(const v4u*)(newk + (size_t)tk * NIN), k);
        float sv = (q[0] * k[0] + q[1] * k[1]) + (q[2] * k[2] + q[3] * k[3]) + (q[4] * k[4] + q[5] * k[5]) + (q[6] * k[6] + q[7] * k[7]);
        sv = row16_sum(sv) * c;
        sc[0] = (half == 0 && jj < n_new && l16 == jj) ? sv : sc[0];
    }
    float mx = -1e30f;
#pragma unroll
    for (int jr = 0; jr < 5; ++jr) mx = fmaxf(mx, sc[jr]);
    mx = fmaxf(mx, dpp_f<0xB1>(mx)); mx = fmaxf(mx, dpp_f<0x4E>(mx)); mx = fmaxf(mx, dpp_f<0x124>(mx)); mx = fmaxf(mx, dpp_f<0x128>(mx));
    float ls = 0.f;
#pragma unroll
    for (int jr = 0; jr < 5; ++jr) { sc[jr] = __builtin_amdgcn_exp2f(sc[jr] - mx); ls += sc[jr]; }
    ls = row16_sum(ls);
    float o[8];
#pragma unroll
    for (int e = 0; e < 8; ++e) o[e] = 0.f;
#pragma unroll
    for (int jj = 0; jj < 4; ++jj) {
        const int tk = t - jj >= 0 ? t - jj : 0; float vv[8]; unpack8(*(const v4u*)(newk + (size_t)tk * NIN + (PC_VB - PC_KB)), vv);
        const bool isnew = half == 0 && jj < n_new;
        const float p = isnew ? __shfl(sc[0], (lane & 48) | jj) : 0.f;
#pragma unroll
        for (int e = 0; e < 8; ++e) o[e] += p * vv[e];
        sc[0] = (isnew && l16 == jj) ? 0.f : sc[0];
    }
#pragma unroll
    for (int jr = 0; jr < 5; ++jr) {
        const int jn = jr < 4 ? 16 : 1;
#pragma unroll 8
        for (int jl = 0; jl < jn; ++jl) {
            const int j = jlo + 16 * jr + jl, jc = j <= 128 ? j : 128; int idx = win + t - jc * dil; idx = idx < win ? idx : win - 1;
            const float p = __shfl(sc[jr], (lane & 48) | jl);
            const float* vp = cache + (size_t)idx * 1024 + 512; const f32x4 a = *(const f32x4*)vp, bq = *(const f32x4*)(vp + 4);
            o[0] += p * a.x; o[1] += p * a.y; o[2] += p * a.z; o[3] += p * a.w; o[4] += p * bq.x; o[5] += p * bq.y; o[6] += p * bq.z; o[7] += p * bq.w;
        }
    }
    const float inv = 1.f / ls;
#pragma unroll
    for (int e = 0; e < 8; ++e) o[e] *= inv;
    *(v4u*)((bf16*)(F.ws + WS_OBG) + ((size_t)part * MV + row) * 512 + 8 * lane) = pack8(o);
    if (l16 == 0) *(f32x2*)((float*)(F.ws + WS_AST) + (((size_t)part * MV + row) * 4 + (lane >> 4)) * 2) = (f32x2){mx, ls};
}

__device__ __forceinline__ void gdn_gate_rows(Frame& F0, int l) {
    RELANE(F0);
    const int lane = F.lane, gw = F.vcu * NWAVES + F.wave, NGW = F.G * NWAVES;
    const float* ORAW = (const float*)(F.ws + WS_ORAW); const bf16* PROJ = (const bf16*)(F.ws + WS_PROJ); bf16* OUTA = (bf16*)(F.ws + WS_OUTA);
    const float* gain = F.in[12] + (size_t)l * 128;
    for (int r = gw; r < MV; r += NGW) {
#pragma unroll
        for (int j = 0; j < 4; ++j) {
            const int c0 = 256 * j + 4 * lane; const f32x4 o = *(const f32x4*)(ORAW + (size_t)r * 1024 + c0);
            float ss = (o.x * o.x + o.y * o.y) + (o.z * o.z + o.w * o.w);
            ss += __shfl_xor(ss, 1); ss += __shfl_xor(ss, 2); ss += __shfl_xor(ss, 4); ss += __shfl_xor(ss, 8); ss += __shfl_xor(ss, 16);
            const float rstd = rsqrtf(ss * (1.f / 128.f) + EPS);
            const f32x4 g = *(const f32x4*)(gain + (c0 & 127)); const v2u zu = *(const v2u*)(PROJ + (size_t)r * NIN + PC_ZA + c0);
            const float z0 = bf_lo(zu.x), z1 = bf_hi(zu.x), z2 = bf_lo(zu.y), z3 = bf_hi(zu.y);
            v2u w; w.x = pk2(o.x * rstd * g.x * silu(z0), o.y * rstd * g.y * silu(z1)); w.y = pk2(o.z * rstd * g.z * silu(z2), o.w * rstd * g.w * silu(z3));
            *(v2u*)(OUTA + (size_t)r * 1024 + c0) = w;
        }
        {
            const int c0 = 8 * lane, hh = lane >> 4; const float* ast = (const float*)(F.ws + WS_AST); const bf16* obg = (const bf16*)(F.ws + WS_OBG);
            const int np = r < MP ? 3 : 6;
            f32x2 sg[6]; v4u xo[6]; float M = -1e30f;
#pragma unroll
            for (int g = 0; g < 6; ++g) { const int gg = g < np ? g : 0; sg[g] = *(const f32x2*)(ast + (((size_t)gg * MV + r) * 4 + hh) * 2); xo[g] = *(const v4u*)(obg + ((size_t)gg * MV + r) * 512 + c0); }
#pragma unroll
            for (int g = 0; g < 6; ++g) { if (g >= np) sg[g] = (f32x2){-1e30f, 0.f}; M = fmaxf(M, sg[g].x); }
            float wg[6], den = 0.f;
#pragma unroll
            for (int g = 0; g < 6; ++g) { wg[g] = __builtin_amdgcn_exp2f(sg[g].x - M) * sg[g].y; den += wg[g]; }
            const float inv = 1.f / den; float o[8];
#pragma unroll
            for (int e = 0; e < 8; ++e) o[e] = 0.f;
#pragma unroll
            for (int g = 0; g < 6; ++g) { float x[8]; unpack8(xo[g], x); const float w = wg[g] * inv;
#pragma unroll
                for (int e = 0; e < 8; ++e) o[e] += w * x[e]; }
            *(v4u*)((bf16*)(F.ws + WS_OUTB) + (size_t)r * 512 + c0) = pack8(o);
        }
    }
}


constexpr int CP_PER_B = 31 + 127 + 511, CP_NSUB = DB * CP_PER_B;
constexpr int CP_TAIL_WG = 84, CP_TAIL_PER_WG = 64, CP_TAIL = CP_TAIL_WG * CP_TAIL_PER_WG;
__device__ __forceinline__ void copy_subchunk(Frame& F, int l, int c) {
    const int lane = F.lane, b = c / CP_PER_B, rc = c % CP_PER_B; const int gi = rc < 31 ? 0 : rc < 158 ? 1 : 2, k = rc - (gi == 0 ? 0 : gi == 1 ? 31 : 158), win = 128 << (2 * gi);
    const f32x4* src = (const f32x4*)(F.in[2 + gi] + ((size_t)(l * DB + b) * win + DS + 4 * k) * 1024) + lane;
    f32x4* dst = (f32x4*)(F.out + (gi == 0 ? O_SW1 : gi == 1 ? O_SW2 : O_SW3) + ((size_t)(l * DB + b) * win + 4 * k) * 1024) + lane;
    f32x4 v[16];
#pragma unroll
    for (int i = 0; i < 16; ++i) v[i] = __builtin_nontemporal_load(src + 64 * i);
#pragma unroll
    for (int i = 0; i < 16; ++i) __builtin_nontemporal_store(v[i], dst + 64 * i);
}
__device__ __forceinline__ void side_queue(Frame& F0, int l, volatile LAS unsigned* qctr) {
    RELANE(F0);
    const int lane = F.lane;
    const int nsub = CP_NSUB - (F.G == 256 ? CP_TAIL : 0);
    const int ncp = (nsub - (int)blockIdx.x + F.G - 1) / F.G;
    const int wper = 0,     w0 = (int)blockIdx.x * wper, nw = max(0, min(IT_LAYER, w0 + wper) - w0);
    LAS float* scr = (LAS float*)F.lds;
    for (;;) {
        unsigned q = 0; if (lane == 0) q = __hip_atomic_fetch_add((LAS unsigned*)qctr, 1u, __ATOMIC_RELAXED, __HIP_MEMORY_SCOPE_WORKGROUP);
        q = (unsigned)__builtin_amdgcn_readfirstlane((int)q);
        if ((int)q >= ncp + nw) break;
        if ((int)q < ncp) { copy_subchunk(F, l, (int)q * F.G + (int)blockIdx.x);
        } else weight_item(F, l + 1, w0 + (int)q - ncp, scr);
    }
}


__device__ __forceinline__ f32x16 skinny_kloop(const bf16* ap, const bf16* bp, int nks, f32x16 acc) {
    int ks = 0;
    for (; ks + 8 <= nks; ks += 8) { bf16x8 a[8], b[8];
#pragma unroll
        for (int u = 0; u < 8; ++u) { a[u] = *(const bf16x8*)(ap + 16 * (ks + u)); b[u] = *(const bf16x8*)(bp + 16 * (ks + u)); }
#pragma unroll
        for (int u = 0; u < 8; ++u) acc = __builtin_amdgcn_mfma_f32_32x32x16_bf16(a[u], b[u], acc, 0, 0, 0); }
    for (; ks < nks; ks += 4) { bf16x8 a[4], b[4];
#pragma unroll
        for (int u = 0; u < 4; ++u) { a[u] = *(const bf16x8*)(ap + 16 * (ks + u)); b[u] = *(const bf16x8*)(bp + 16 * (ks + u)); }
#pragma unroll
        for (int u = 0; u < 4; ++u) acc = __builtin_amdgcn_mfma_f32_32x32x16_bf16(a[u], b[u], acc, 0, 0, 0); }
    return acc;
}
__device__ __forceinline__ f32x2 skinny_reduce(Frame& F, const f32x16& acc) {
    LAS float* P = (LAS float*)F.lds; const int r = F.lane & 31, h = F.lane >> 5;
    __syncthreads();
#pragma unroll
    for (int i = 0; i < 16; ++i) P[(F.wave * 32 + (i & 3) + 8 * (i >> 2) + 4 * h) * 33 + r] = acc[i];
    __syncthreads();
    const int row = F.tid >> 4, col = 2 * (F.tid & 15); f32x2 o = {0.f, 0.f};
#pragma unroll
    for (int w = 0; w < 8; ++w) { o.x += P[(w * 32 + row) * 33 + col]; o.y += P[(w * 32 + row) * 33 + col + 1]; }
    return o;
}
__device__ __forceinline__ void skinny_store(Frame& F0, const bf16* A, int lda, const bf16* Bt, int K, bf16* O) {
    RELANE(F0);
    const int r = F.lane & 31, h = F.lane >> 5, kw = K / 8;
    for (int unit = launder_s((int)blockIdx.x); unit < 256; unit += F.G) {
        const int mt = unit >> 6, nt = unit & 63;
        f32x16 acc;
#pragma unroll
        for (int i = 0; i < 16; ++i) acc[i] = 0.f;
        acc = skinny_kloop(A + (size_t)(MP + 32 * mt + r) * lda + F.wave * kw + 8 * h, Bt + (size_t)(32 * nt + r) * K + F.wave * kw + 8 * h, kw / 16, acc);
        const f32x2 o = skinny_reduce(F, acc);
        *(unsigned*)(O + (size_t)(MP + 32 * mt + (F.tid >> 4)) * D + 32 * nt + 2 * (F.tid & 15)) = pk2(o.x, o.y);
    }
}
__device__ __forceinline__ void skinny_merge(Frame& F0, const unsigned char* wl) {
    RELANE(F0);
    const int r = F.lane & 31, h = F.lane >> 5; const bf16* PROJ = (const bf16*)(F.ws + WS_PROJ);
    for (int unit = launder_s((int)blockIdx.x); unit < 256; unit += F.G) {
        const int mt = unit >> 6, nt = unit & 63;
        f32x16 tot;
#pragma unroll
        for (int i = 0; i < 16; ++i) tot[i] = 0.f;
#pragma unroll
        for (int br = 0; br < 3; ++br) {
            const int K = br == 1 ? 512 : 1024, kw = K / 8;
            const bf16* A = (const bf16*)(F.ws + (br == 0 ? WS_OUTA : br == 1 ? WS_OUTB : WS_OC)); const bf16* Bt = (const bf16*)(wl + (br == 0 ? WO_BRA : br == 1 ? WO_BRB : WO_BRC));
            f32x16 acc;
#pragma unroll
            for (int i = 0; i < 16; ++i) acc[i] = 0.f;
            acc = skinny_kloop(A + (size_t)(MP + 32 * mt + r) * K + F.wave * kw + 8 * h, Bt + (size_t)(32 * nt + r) * K + F.wave * kw + 8 * h, kw / 16, acc);
            const bf16* gp = PROJ + (size_t)(MP + 32 * mt + 4 * h) * NIN + PC_GATE + br * 2048 + 32 * nt + r;
#pragma unroll
            for (int i = 0; i < 16; ++i) tot[i] += acc[i] * bf1(gp[(size_t)((i & 3) + 8 * (i >> 2)) * NIN]);
        }
        const f32x2 o = skinny_reduce(F, tot);
        *(unsigned*)((bf16*)(F.ws + WS_MERGED) + (size_t)(MP + 32 * mt + (F.tid >> 4)) * D + 32 * nt + 2 * (F.tid & 15)) = pk2(o.x, o.y);
    }
}

constexpr int N_PHASES = 1 + 11 * DEPTH;
__global__ void __launch_bounds__(NWAVES * 64, 2) fwd(Args args) {
    extern __shared__ __attribute__((aligned(16))) unsigned char lds_raw[];
    Frame F;
    F.lds = (LAS unsigned char*)lds_raw;
    F.tid = threadIdx.x; F.lane = F.tid & 63; F.wave = __builtin_amdgcn_readfirstlane(F.tid >> 6);
    F.G = gridDim.x; { const int bx = blockIdx.x; F.vcu = (F.G % 8 == 0) ? (bx % 8) * (F.G / 8) + bx / 8 : bx; }
    const CAS Args* const ap = (const CAS Args*)__builtin_amdgcn_kernarg_segment_ptr();
    F.in = ap->in; F.out = args.out; F.ws = args.ws;
    volatile LAS unsigned* MISC = (volatile LAS unsigned*)(F.lds + MISC_OFF);
    for (int u = F.tid; u < (LDS_BYTES - LDSCTL_OFF) / 4; u += NWAVES * 64) ((LAS unsigned*)(F.lds + LDSCTL_OFF))[u] = 0u;
    __syncthreads();
#if MK_ONE_LAUNCH
    XcdBarrier bar = xcd_barrier_post((unsigned*)(F.ws + WS_CTL) + CW_BAR, MISC + 8);
#define GRID_BAR() xcd_barrier(bar)
#else
#define GRID_BAR() do {} while (0)
#endif
    const int lo = args.ph_lo, hi = args.ph_hi;
#ifndef PHMASK
#define PHMASK 0xfff
#endif
#define IN(k) (lo <= (k) && (k) < hi)
#define EN(j) ((PHMASK >> (j)) & 1)
#ifndef REPMASK
#define REPMASK 0
#endif
#ifndef SUBREP
#define SUBREP 0
#endif
#define SUBR(j) for (int sr_ = 0; sr_ < 1 + ((SUBREP >> (j)) & 1); ++sr_)
#define REPEAT(j) for (int rep_ = 0; rep_ < 1 + ((REPMASK >> (j)) & 1); ++rep_)
#define REPBAR() do { if (rep_) GRID_BAR(); F.ws = launder_p(args.ws); F.out = launder_p(args.out); F.in = launder_k(ap->in); F.vcu = launder_s(vcu0); F.wave = launder_s(wave0); gw = F.vcu * NWAVES + F.wave; } while (0)
#define SEAM(k) do { if (IN(k) && IN((k) + 1)) GRID_BAR(); } while (0)
    const int vcu0 = F.vcu, wave0 = F.wave; int gw = F.vcu * NWAVES + F.wave; const int NGW = F.G * NWAVES;
    bf16* const H = (bf16*)(F.ws + WS_H); bf16* const PROJ = (bf16*)(F.ws + WS_PROJ);

    if (EN(0) && IN(0)) REPEAT(0) { REPBAR();
        LAS float* scr = (LAS float*)(F.lds + F.wave * 16384);
        for (int it = gw; it < 2 * IT_LAYER; it += NGW) { const int l = it >= IT_LAYER ? 1 : 0; weight_item(F, l, it - l * IT_LAYER, scr); }
        __syncthreads();
        stage_wba(F, 0);
        thin_rows<true>(F, F.in[0], F.in[1], nullptr, nullptr, nullptr, F.in[21], true, 0);
        __syncthreads();
    }
    SEAM(0);
#pragma unroll 1
    for (int l = 0; l < DEPTH; ++l) {
        const int pb = 1 + 11 * l;
        unsigned char* wl = F.ws + WS_W + (size_t)l * WL_BYTES;
        if (EN(1) && IN(pb + 0)) REPEAT(1) { REPBAR();
            pg8::Gemm g{H, (const bf16*)(wl + WO_IN), D, D, D, 0}; pg8::StaticOrder S; S.init(MT, NIN, launder_s(F.G), launder_s((int)blockIdx.x));
            EpiStore E{PROJ, NIN, PC_GATE / 256};
            pg8::gemm_phase<EpiStore, pg8::StaticOrder>(F.lds, g, S, E);
        }
        SEAM(pb + 0);
        if (EN(2) && IN(pb + 1)) REPEAT(2) { REPBAR(); for (int it = gw; it < PREP_ITEMS; it += NGW) prep_item(F, l, it); prep_out_rows(F, l); for (int it = gw; it < VT_ITEMS; it += NGW) vt_item(F, it); }
        SEAM(pb + 1);
        if (EN(3) && IN(pb + 2)) REPEAT(3) { REPBAR(); for (int it = gw; it < GCH; it += NGW) gdn_ga_item(F, it); }
        SEAM(pb + 2);
        if (EN(4) && IN(pb + 3)) REPEAT(4) { REPBAR();
            if (F.tid == 0) MISC[16] = 0u;
            { pg8::Gemm g{(const bf16*)(F.ws + WS_POOLED), (const bf16*)(wl + WO_POOL), 1024, 256, 256, 512}; pg8::StaticOrder S; S.init(MT, 1024, launder_s(F.G), launder_s((int)blockIdx.x));
              EpiStore E{(bf16*)(F.ws + WS_OC), 1024, 1 << 30};
              pg8::gemm_phase<EpiStore, pg8::StaticOrder>(F.lds, g, S, E); }
            SUBR(3) for (int it = gw; it < DB * HA * 8; it += NGW) { const int s = it & 7, bh = it >> 3, b = bh >> 3, h = bh & 7;
                gdn_scan_item(F, MP + DS * b, h, s, F.in[5] + (size_t)((l * DB + b) * HA + h) * 16384, F.out + O_SGDN + (size_t)((l * DB + b) * HA + h) * 16384); }
            {
                const bool scanw = (F.wave == 0) && (F.vcu < GSC_ITEMS);
                if (scanw) { SUBR(0) gdn_chunk_scan(F, l, F.vcu); }
                else {
                    const int aw = F.vcu < GSC_ITEMS ? F.vcu * 7 + F.wave - 1 : GSC_ITEMS * 7 + (F.vcu - GSC_ITEMS) * 8 + F.wave, naw = F.G * 8 - GSC_ITEMS;
                    SUBR(1) for (int it = aw; it < ATT_UNITS; it += naw) attn_unit(F, it);
                    SUBR(2) for (int it = (aw + naw - ATT_UNITS % naw) % naw; it < MS * 6; it += naw) attn_sample_item(F, l, it);
                }
            }
            side_queue(F, l, MISC + 16);
        }
        SEAM(pb + 3);
        if (EN(5) && IN(pb + 4)) REPEAT(5) { REPBAR(); gdn_gate_rows(F, l); }
        SEAM(pb + 4);
        if (EN(6) && IN(pb + 5)) REPEAT(6) { REPBAR();
            pg8::StaticOrder S; S.init(MP, D, launder_s(F.G), launder_s((int)blockIdx.x)); bf16* MG = (bf16*)(F.ws + WS_MERGED);
            { pg8::Gemm g{(const bf16*)(F.ws + WS_OUTA), (const bf16*)(wl + WO_BRA), 1024, 1024, 1024, 0}; EpiMerge<false> E{MG, PROJ + PC_GATE}; pg8::gemm_phase<EpiMerge<false>, pg8::StaticOrder>(F.lds, g, S, E); }
            { pg8::Gemm g{(const bf16*)(F.ws + WS_OUTB), (const bf16*)(wl + WO_BRB), 512, 512, 512, 0}; EpiMerge<true> E{MG, PROJ + PC_GATE + 2048}; pg8::gemm_phase<EpiMerge<true>, pg8::StaticOrder>(F.lds, g, S, E); }
            { pg8::Gemm g{(const bf16*)(F.ws + WS_OC), (const bf16*)(wl + WO_BRC), 1024, 1024, 1024, 0}; EpiMerge<true> E{MG, PROJ + PC_GATE + 4096}; pg8::gemm_phase<EpiMerge<true>, pg8::StaticOrder>(F.lds, g, S, E); }
            skinny_merge(F, wl);
        }
        SEAM(pb + 5);
        if (EN(7) && IN(pb + 6)) REPEAT(7) { REPBAR();
            pg8::Gemm g{(const bf16*)(F.ws + WS_MERGED), (const bf16*)(wl + WO_OUT), D, D, D, 0}; pg8::StaticOrder S; S.init(MP, D, launder_s(F.G), launder_s((int)blockIdx.x));
            EpiStore E{(bf16*)(F.ws + WS_Y), D, 1 << 30};
            pg8::gemm_phase<EpiStore, pg8::StaticOrder>(F.lds, g, S, E);
            skinny_store(F, (const bf16*)(F.ws + WS_MERGED), D, (const bf16*)(wl + WO_OUT), D, (bf16*)(F.ws + WS_Y));
        }
        SEAM(pb + 6);
        if (EN(8) && IN(pb + 7)) REPEAT(8) { REPBAR();
            thin_rows<false>(F, nullptr, nullptr, (const bf16*)(F.ws + WS_Y), F.in[22] + (size_t)l * D, nullptr, F.in[23] + (size_t)l * D, false, 0, 0);
        }
        SEAM(pb + 7);
        if (EN(9) && IN(pb + 8)) REPEAT(9) { REPBAR();
            pg8::Gemm g{H, (const bf16*)(wl + WO_GU), D, D, D, 0}; pg8::StaticOrder S; S.init(MT, 2 * DFF, launder_s(F.G), launder_s((int)blockIdx.x));
            EpiSwiglu E{(bf16*)(F.ws + WS_ACT)};
            pg8::gemm_phase<EpiSwiglu, pg8::StaticOrder>(F.lds, g, S, E);
            const int bxl = launder_s((int)blockIdx.x), Gl = launder_s(F.G);
            if (Gl == 256 && bxl >= 256 - CP_TAIL_WG) {
                Frame Fc = F; Fc.lane = launder(F.lane);
                const int base = CP_NSUB - CP_TAIL + (bxl - (256 - CP_TAIL_WG)) * CP_TAIL_PER_WG;
                for (int q = F.wave; q < CP_TAIL_PER_WG; q += NWAVES) copy_subchunk(Fc, 1 - l, base + q);
            }
        }
        SEAM(pb + 8);
        if (EN(10) && IN(pb + 9)) REPEAT(10) { REPBAR();
            pg8::Gemm g{(const bf16*)(F.ws + WS_ACT), (const bf16*)(wl + WO_DOWN), DFF, DFF, DFF, 0}; pg8::StaticOrder S; S.init(MP, D, launder_s(F.G), launder_s((int)blockIdx.x));
            EpiStore E{(bf16*)(F.ws + WS_Y), D, 1 << 30};
            pg8::gemm_phase<EpiStore, pg8::StaticOrder>(F.lds, g, S, E);
            skinny_store(F, (const bf16*)(F.ws + WS_ACT), DFF, (const bf16*)(wl + WO_DOWN), DFF, (bf16*)(F.ws + WS_Y));
        }
        SEAM(pb + 9);
        if (EN(11) && IN(pb + 10)) REPEAT(11) { REPBAR();
            if (l + 1 < DEPTH) { stage_wba(F, l + 1);
                thin_rows<false>(F, nullptr, nullptr, (const bf16*)(F.ws + WS_Y), F.in[24] + (size_t)l * D, nullptr, F.in[21] + (size_t)(l + 1) * D, true, l + 1, 0);
                __syncthreads(); }
            else thin_rows<false>(F, nullptr, nullptr, (const bf16*)(F.ws + WS_Y), F.in[24] + (size_t)l * D, F.out + O_YP, nullptr, false, 0, 0);
        }
        SEAM(pb + 10);
    }
#undef IN
#undef SEAM
}

extern "C" void kernel_launch(void* const* d_in, const int* in_sizes, int n_in, void* d_out, int out_size, void* d_ws, size_t ws_size, hipStream_t stream) {
    static int grid = 0;
    if (grid == 0) {
        if (n_in != 25 || (size_t)out_size != O_END || ws_size < WS_END) { fprintf(stderr, "kernel_launch: unexpected sizes n_in %d out %d ws %zu\n", n_in, out_size, ws_size); grid = -1; return; }
        int dev = 0, cus = 0, per_cu = 0;
        if (hipGetDevice(&dev) != hipSuccess || hipDeviceGetAttribute(&cus, hipDeviceAttributeMultiprocessorCount, dev) != hipSuccess) { grid = -1; return; }
        if (hipFuncSetAttribute((const void*)fwd, hipFuncAttributeMaxDynamicSharedMemorySize, LDS_BYTES) != hipSuccess) { fprintf(stderr, "kernel_launch: hipFuncSetAttribute failed\n"); grid = -1; return; }
        if (hipOccupancyMaxActiveBlocksPerMultiprocessor(&per_cu, (const void*)fwd, NWAVES * 64, LDS_BYTES) != hipSuccess || per_cu < 1) fprintf(stderr, "kernel_launch: occupancy query says %d\n", per_cu);
        (void)hipGetLastError();
        grid = cus;
    }
    if (grid < 0) return;
    if (hipMemsetAsync((char*)d_ws + WS_CTL, 0, CTL_BYTES, stream) != hipSuccess) return;
    Args a{};
    for (int i = 0; i < 25; ++i) a.in[i] = (const float*)d_in[i];
    a.out = (float*)d_out; a.ws = (unsigned char*)d_ws;
#if MK_ONE_LAUNCH
    a.ph_lo = 0; a.ph_hi = N_PHASES;
    hipLaunchKernelGGL(fwd, dim3(grid), dim3(NWAVES * 64), LDS_BYTES, stream, a);
#else
    for (int p = 0; p < N_PHASES; ++p) { a.ph_lo = p; a.ph_hi = p + 1; hipLaunchKernelGGL(fwd, dim3(grid), dim3(NWAVES * 64), LDS_BYTES, stream, a); }
#endif
}
```

```cpp
#include <hip/hip_runtime.h>
#include <cstdio>
#include <cstdint>

#ifndef MK_ONE_LAUNCH
#define MK_ONE_LAUNCH 1
#endif

#define GAS __attribute__((address_space(1)))
#define CAS __attribute__((address_space(4)))
typedef const float* cfp_t;
#define LAS __attribute__((address_space(3)))
typedef unsigned short bf16;
typedef unsigned v4u __attribute__((ext_vector_type(4)));
typedef unsigned v2u __attribute__((ext_vector_type(2)));
typedef float f32x4 __attribute__((ext_vector_type(4)));
typedef float f32x2 __attribute__((ext_vector_type(2)));
typedef short bf16x8 __attribute__((ext_vector_type(8)));
typedef float f32x16 __attribute__((ext_vector_type(16)));

constexpr int D = 2048, BATCH = 4, SEQ = 2048, DEPTH = 2, DB = 32, DS = 4;
constexpr int MP = BATCH * SEQ;
constexpr int MS = DB * DS;
constexpr int MV = MP + MS;
constexpr int MT = 8448;
constexpr int HA = 8, CONVCH = 3072;
constexpr int CPOOL = 1024, PHIST = 15;
constexpr int DFF = 5632;
constexpr int NIN_SRC = 15888, NIN = 15872;
constexpr int PC_ZA = 3072, PC_QB = 4096, PC_KB = 5632, PC_VB = 7168, PC_UC = 8704, PC_GATE = 9728;
constexpr float EPS = 1e-6f;
constexpr size_t O_YP = 0, O_YS = O_YP + (size_t)MP * D, O_PW1 = O_YS + (size_t)MS * D;
constexpr size_t O_PW2 = O_PW1 + (size_t)2 * 4 * 128 * 1024, O_PW3 = O_PW2 + (size_t)2 * 4 * 512 * 1024, O_PGDN = O_PW3 + (size_t)2 * 4 * 2048 * 1024;
constexpr size_t O_PCONV = O_PGDN + (size_t)2 * 4 * 8 * 16384, O_PPOOL = O_PCONV + (size_t)2 * 4 * 3 * 3072, O_SW1 = O_PPOOL + (size_t)2 * 4 * 15 * 1024;
constexpr size_t O_SW2 = O_SW1 + (size_t)2 * 32 * 128 * 1024, O_SW3 = O_SW2 + (size_t)2 * 32 * 512 * 1024, O_SGDN = O_SW3 + (size_t)2 * 32 * 2048 * 1024;
constexpr size_t O_SCONV = O_SGDN + (size_t)2 * 32 * 8 * 16384, O_SPOOL = O_SCONV + (size_t)2 * 32 * 3 * 3072, O_END = O_SPOOL + (size_t)2 * 32 * 15 * 1024;
static_assert(O_END == 226426880ull, "output size");

constexpr size_t WS_CTL = 0, CTL_BYTES = 1u << 20;
constexpr size_t SZ_WIN = (size_t)NIN * D * 2, SZ_WBRA = (size_t)D * 1024 * 2, SZ_WBRB = (size_t)D * 512 * 2, SZ_WBRC = (size_t)D * 1024 * 2, SZ_WPOOL = (size_t)4 * 256 * 256 * 2;
constexpr size_t SZ_WOUT = (size_t)D * D * 2, SZ_WGU = (size_t)2 * DFF * D * 2, SZ_WDOWN = (size_t)D * DFF * 2;
constexpr size_t WO_IN = 0, WO_BRA = WO_IN + SZ_WIN, WO_BRB = WO_BRA + SZ_WBRA, WO_BRC = WO_BRB + SZ_WBRB, WO_POOL = WO_BRC + SZ_WBRC, WO_OUT = WO_POOL + SZ_WPOOL;
constexpr size_t WO_GU = WO_OUT + SZ_WOUT, WO_DOWN = WO_GU + SZ_WGU, WL_BYTES = WO_DOWN + SZ_WDOWN;
constexpr size_t WS_W = CTL_BYTES;
constexpr size_t WS_H = WS_W + 2 * WL_BYTES;
constexpr size_t WS_PROJ = WS_H + (size_t)MT * D * 2;
constexpr size_t WS_GB = WS_PROJ + (size_t)MT * NIN * 2;
constexpr size_t WS_TOK = WS_GB + (size_t)MT * 16 * 4;
constexpr size_t WS_QN = WS_TOK + (size_t)MT * 8 * 16;
constexpr size_t WS_KN = WS_QN + (size_t)MT * 1024 * 2;
constexpr size_t WS_VV = WS_KN + (size_t)MT * 1024 * 2;
constexpr size_t WS_ORAW = WS_VV + (size_t)MT * 1024 * 2;
constexpr size_t WS_POOLED = WS_ORAW + (size_t)MT * 1024 * 4;
constexpr size_t WS_OUTA = WS_POOLED + (size_t)MT * 1024 * 2;
constexpr size_t WS_OUTB = WS_OUTA + (size_t)MT * 1024 * 2;
constexpr size_t WS_OC = WS_OUTB + (size_t)MT * 512 * 2;
constexpr size_t WS_MERGED = WS_OC + (size_t)MT * 1024 * 2;
constexpr size_t WS_Y = WS_MERGED + (size_t)MT * D * 2;
constexpr size_t WS_X1 = WS_Y + (size_t)MT * D * 2;
constexpr size_t WS_X2 = WS_X1 + (size_t)MT * D * 4;
constexpr size_t WS_ACT = WS_X2 + (size_t)MT * D * 4;
constexpr size_t WS_VT = WS_ACT + (size_t)MT * DFF * 2;
constexpr size_t WS_OBG = WS_VT + (size_t)BATCH * 3 * 4 * 128 * 2048 * 2;
constexpr size_t WS_AST = WS_OBG + (size_t)6 * MV * 512 * 2;
constexpr int GCH = BATCH * HA * (SEQ / 32);
constexpr size_t WS_WF = WS_AST + (size_t)6 * MV * 4 * 8;
constexpr size_t WS_KF = WS_WF + (size_t)GCH * 8192;
constexpr size_t WS_UF = WS_KF + (size_t)GCH * 8192;
constexpr size_t WS_AF = WS_UF + (size_t)GCH * 16384;
constexpr size_t WS_TB = WS_AF + (size_t)GCH * 2048;
constexpr size_t WS_QF = WS_TB + (size_t)GCH * 128;
constexpr size_t WS_XCH = WS_QF + (size_t)GCH * 8192;
constexpr size_t WS_END = WS_XCH + (size_t)4 * 32 * 256 * 8 * 16;
static_assert(WS_END < 2000000000ull, "workspace");

__device__ __forceinline__ int lane_id() { return (int)__builtin_amdgcn_mbcnt_hi(~0u, __builtin_amdgcn_mbcnt_lo(~0u, 0u)); }
namespace pg8 {
#define PG8_LAS __attribute__((address_space(3)))
typedef unsigned short bf16_t;
typedef unsigned u32x4 __attribute__((ext_vector_type(4)));
constexpr int BM = 256, BK = 64, HALF = 128, HTB = HALF * BK * 2, STAGE_BYTES = 8 * HTB, NXCD = 8, WGM = 8;
__host__ __device__ __forceinline__ int lds_byte(int r, int c) { const int st = (r >> 4) * 2 + (c >> 5), rr = r & 15, cc = c & 31, ob = rr * 64 + cc * 2; return st * 1024 + (ob ^ (((ob >> 9) & 1) << 5)); }
__host__ __device__ __forceinline__ void stage_rc(int b, int& R, int& C) { const int st = b / 1024, sb = b % 1024, swz = sb ^ (((sb >> 9) & 1) << 5); R = (st >> 1) * 16 + swz / 64; C = (st & 1) * 32 + (swz % 64) / 2; }
__host__ __device__ __forceinline__ int perm32(int rho) { const int n = rho >> 4, i = rho & 15; return 8 * (i >> 2) + 4 * n + (i & 3); }
struct Unit { int pm, pn; };
struct Gemm { const bf16_t* A; const bf16_t* Bt; int lda, ldb, K; int a_pn_step; };
struct StaticOrder {
    int nM, nN, nwg, G, c;
    __host__ __device__ void init(int M, int N, int G_, int c_) { nM = M / BM; nN = N / BM; nwg = nM * nN; G = G_; c = c_; }
    __host__ __device__ bool next(int i, Unit& u) const {
        const long L = (long)i * G + c; if (L >= nwg) return false;
        int wgid = (int)L; { const int q = nwg / NXCD, r = nwg % NXCD, xcd = wgid % NXCD, off = wgid / NXCD; wgid = (xcd < r ? xcd * (q + 1) : r * (q + 1) + (xcd - r) * q) + off; }
        const int nig = WGM * nN, gid = wgid / nig, fm = gid * WGM, gsz = (nM - fm) < WGM ? (nM - fm) : WGM;
        u.pm = fm + ((wgid % nig) % gsz); u.pn = (wgid % nig) / gsz; return true;
    }
    __device__ __forceinline__ void a_ready(const Unit&) const {}
    __device__ __forceinline__ void done(const Unit&) const {}
};
__device__ __forceinline__ unsigned cvt_pk_bf16(float lo, float hi) { unsigned r; asm volatile("v_cvt_pk_bf16_f32 %0, %1, %2" : "=v"(r) : "v"(lo), "v"(hi)); return r; }

template <class Epi, class Sched, bool ALIGN_EPI = true>
__device__ __forceinline__ void gemm_phase(PG8_LAS unsigned char* lds, const Gemm g, const Sched& S, const Epi& E) {
    int tid = threadIdx.x; asm volatile("" : "+v"(tid));
    const int wid = __builtin_amdgcn_readfirstlane(tid >> 6), lane = tid & 63, wr = wid >> 2, wc = wid & 3, fr = lane & 15, fq = lane >> 4;
    int K = g.K; asm volatile("" : "+s"(K));
    const int nt = K / BK;
    unsigned voffA[2], voffB[2];
#pragma unroll
    for (int i = 0; i < 2; ++i) { int R, C; stage_rc(tid * 16 + i * 8192, R, C); const int Rb = ((R & ~31) + perm32(R & 31));
        voffA[i] = (unsigned)(R * g.lda + C) * 2u; voffB[i] = (unsigned)(Rb * g.ldb + C) * 2u; }
    const size_t kstep = (size_t)(BK * 2);
    const size_t hstepA = (size_t)HALF * g.lda * 2, hstepB = (size_t)HALF * g.ldb * 2;
    const size_t tstepA = 2 * hstepA, tstepB = 2 * hstepB;
    const unsigned ldsw = (unsigned)wid * 1024u;
    const int aoff = lds_byte(wr * 64 + fr, fq * 8), boff = lds_byte(wc * 32 + fr, fq * 8);
#define PG8_SA(b, h) (((b) * 2 + (h)) * HTB)
#define PG8_SB(b, h) ((4 + (b) * 2 + (h)) * HTB)
#define PG8_STAGE(bufoff, gbase, voff) do { const char* _gb = (const char*)(gbase); asm volatile("" : "+s"(_gb));     \
        _Pragma("unroll") for (int _i = 0; _i < 2; ++_i) { unsigned _vo = (voff)[_i]; asm volatile("" : "+v"(_vo));     \
        __builtin_amdgcn_global_load_lds((const unsigned*)(_gb + _vo), (PG8_LAS unsigned*)(lds + (bufoff) + ldsw + _i * 8192), 16, 0, 0); } } while (0)
#define PG8_LDA(dst, b, h) do { _Pragma("unroll") for (int m = 0; m < 4; ++m) _Pragma("unroll") for (int k = 0; k < 2; ++k) dst[m][k] = *(const PG8_LAS bf16x8*)(lds + PG8_SA(b, h) + aoff + m * 2048 + k * 1024); } while (0)
#define PG8_LDB(dst, b, h) do { _Pragma("unroll") for (int n = 0; n < 2; ++n) _Pragma("unroll") for (int k = 0; k < 2; ++k) dst[n][k] = *(const PG8_LAS bf16x8*)(lds + PG8_SB(b, h) + boff + n * 2048 + k * 1024); } while (0)
#define PG8_MMA(ai, bj, At, Bt) do { __builtin_amdgcn_s_setprio(1); _Pragma("unroll") for (int m = 0; m < 4; ++m) _Pragma("unroll") for (int n = 0; n < 2; ++n) _Pragma("unroll") for (int k = 0; k < 2; ++k) \
        acc[ai][bj][m][n] = __builtin_amdgcn_mfma_f32_16x16x32_bf16(Bt[n][k], At[m][k], acc[ai][bj][m][n], 0, 0, 0); __builtin_amdgcn_s_setprio(0); } while (0)
#define PG8_WAIT_V(n) asm volatile("s_waitcnt vmcnt(" #n ")" ::: "memory")
#define PG8_WAIT_L(n) asm volatile("s_waitcnt lgkmcnt(" #n ")" ::: "memory")
#define PG8_BAR __builtin_amdgcn_s_barrier()
#define PG8_SCHED __builtin_amdgcn_sched_barrier(0)
    Unit cur, nxt; int ui = 0;
    if (!S.next(0, cur)) return;
    f32x4 acc[2][2][4][2];
#pragma unroll
    for (int a = 0; a < 2; ++a)
#pragma unroll
        for (int b = 0; b < 2; ++b)
#pragma unroll
            for (int m = 0; m < 4; ++m)
#pragma unroll
                for (int n = 0; n < 2; ++n) acc[a][b][m][n] = (f32x4){0.f, 0.f, 0.f, 0.f};
    bf16x8 At[4][2], B0[2][2], B1[2][2];
    const char* cA = (const char*)g.A + (size_t)cur.pm * tstepA + (size_t)cur.pn * (size_t)g.a_pn_step; const char* cB = (const char*)g.Bt + (size_t)cur.pn * tstepB;
    S.a_ready(cur);
    PG8_STAGE(PG8_SB(0, 0), cB, voffB); PG8_STAGE(PG8_SB(0, 1), cB + hstepB, voffB); PG8_STAGE(PG8_SA(0, 0), cA, voffA); PG8_STAGE(PG8_SA(0, 1), cA + hstepA, voffA);
    if (wr == 1) PG8_BAR;
    PG8_WAIT_V(2); PG8_BAR;
    PG8_STAGE(PG8_SB(1, 0), cB + kstep, voffB); PG8_STAGE(PG8_SA(1, 0), cA + kstep, voffA); PG8_STAGE(PG8_SB(1, 1), cB + hstepB + kstep, voffB);
    PG8_WAIT_V(6); PG8_BAR;
    for (;;) {
        const bool has_next = S.next(ui + 1, nxt);
        const char* nA = has_next ? (const char*)g.A + (size_t)nxt.pm * tstepA + (size_t)nxt.pn * (size_t)g.a_pn_step : cA; const char* nB = has_next ? (const char*)g.Bt + (size_t)nxt.pn * tstepB : cB;
        for (int t = 0; t < nt; t += 2) {
            const bool last = (t == nt - 2);
            const char* a1 = cA + (size_t)(t + 1) * kstep;
            const char* a2 = last ? nA : cA + (size_t)(t + 2) * kstep; const char* b2 = last ? nB : cB + (size_t)(t + 2) * kstep;
            const char* a3 = a2 + kstep; const char* b3 = b2 + kstep;
            if (last && has_next) S.a_ready(nxt);
            PG8_LDB(B0, 0, 0); PG8_LDB(B1, 0, 1); PG8_SCHED; PG8_LDA(At, 0, 0); PG8_STAGE(PG8_SA(1, 1), a1 + hstepA, voffA);
            PG8_WAIT_V(8); PG8_WAIT_L(0); PG8_BAR; PG8_MMA(0, 0, At, B0); PG8_MMA(0, 1, At, B1); PG8_BAR; PG8_SCHED;
            PG8_LDA(At, 0, 1); PG8_STAGE(PG8_SB(0, 0), b2, voffB); PG8_STAGE(PG8_SB(0, 1), b2 + hstepB, voffB); PG8_STAGE(PG8_SA(0, 0), a2, voffA);
            PG8_WAIT_V(8); PG8_WAIT_L(0); PG8_BAR; PG8_MMA(1, 0, At, B0); PG8_MMA(1, 1, At, B1); PG8_BAR; PG8_SCHED;
            PG8_LDB(B0, 1, 0); PG8_LDB(B1, 1, 1); PG8_SCHED; PG8_LDA(At, 1, 0); PG8_STAGE(PG8_SA(0, 1), a2 + hstepA, voffA);
            PG8_WAIT_V(8); PG8_WAIT_L(0); PG8_BAR; PG8_MMA(0, 0, At, B0); PG8_MMA(0, 1, At, B1); PG8_BAR; PG8_SCHED;
            PG8_LDA(At, 1, 1); PG8_STAGE(PG8_SB(1, 0), b3, voffB); PG8_STAGE(PG8_SB(1, 1), b3 + hstepB, voffB); PG8_STAGE(PG8_SA(1, 0), a3, voffA);
            PG8_WAIT_V(8); PG8_WAIT_L(0); PG8_BAR; PG8_MMA(1, 0, At, B0); PG8_MMA(1, 1, At, B1); PG8_BAR; PG8_SCHED;
        }
        if constexpr (ALIGN_EPI) { if (wr == 0) PG8_BAR; }
        if constexpr (!Epi::AFTER_DRAIN) { E(acc, cur, wr, wc, fr, fq); S.done(cur); }
        if (!has_next) break;
#pragma unroll
        for (int a = 0; a < 2; ++a)
#pragma unroll
            for (int b = 0; b < 2; ++b)
#pragma unroll
                for (int m = 0; m < 4; ++m)
#pragma unroll
                    for (int n = 0; n < 2; ++n) acc[a][b][m][n] = (f32x4){0.f, 0.f, 0.f, 0.f};
        cur = nxt; cA = nA; cB = nB; ++ui;
        if constexpr (ALIGN_EPI) { if (wr == 1) PG8_BAR; }
    }
    PG8_WAIT_V(0);
    if constexpr (!ALIGN_EPI) { if (wr == 0) PG8_BAR; }
    PG8_BAR;
    if constexpr (Epi::AFTER_DRAIN) { E.fused(acc, cur, wr, wc, fr, fq, lds, wid, lane); S.done(cur); }
#undef PG8_SA
#undef PG8_SB
#undef PG8_STAGE
#undef PG8_LDA
#undef PG8_LDB
#undef PG8_MMA
#undef PG8_WAIT_V
#undef PG8_WAIT_L
#undef PG8_BAR
#undef PG8_SCHED
}
}

#define LDS_WAIT() asm volatile("s_waitcnt lgkmcnt(0)" ::: "memory")
#define VM_WAIT() asm volatile("s_waitcnt vmcnt(0)" ::: "memory")
__device__ __forceinline__ unsigned f2bf(float f) { unsigned u = __builtin_bit_cast(unsigned, f); return (u + 0x7fffu + ((u >> 16) & 1u)) >> 16; }
typedef __bf16 bf16v2 __attribute__((ext_vector_type(2)));
__device__ __forceinline__ unsigned pk2(float lo, float hi) { const f32x2 v = {lo, hi}; return __builtin_bit_cast(unsigned, __builtin_convertvector(v, bf16v2)); }
__device__ __forceinline__ float bf_lo(unsigned u) { return __builtin_bit_cast(float, u << 16); }
__device__ __forceinline__ float bf_hi(unsigned u) { return __builtin_bit_cast(float, u & 0xffff0000u); }
__device__ __forceinline__ float bf1(bf16 b) { return __builtin_bit_cast(float, ((unsigned)b) << 16); }
__device__ __forceinline__ void unpack8(const v4u u, float (&x)[8]) { x[0] = bf_lo(u.x); x[1] = bf_hi(u.x); x[2] = bf_lo(u.y); x[3] = bf_hi(u.y); x[4] = bf_lo(u.z); x[5] = bf_hi(u.z); x[6] = bf_lo(u.w); x[7] = bf_hi(u.w); }
__device__ __forceinline__ v4u pack8(const float (&x)[8]) { v4u o; o.x = pk2(x[0], x[1]); o.y = pk2(x[2], x[3]); o.z = pk2(x[4], x[5]); o.w = pk2(x[6], x[7]); return o; }
__device__ __forceinline__ float wave_max(float v) {
#pragma unroll
    for (int o = 1; o < 64; o <<= 1) v = fmaxf(v, __shfl_xor(v, o));
    return v;
}
template <int CTRL> __device__ __forceinline__ float dpp_f(float x) { return __builtin_bit_cast(float, __builtin_amdgcn_update_dpp(0, __builtin_bit_cast(int, x), CTRL, 0xf, 0xf, true)); }
__device__ __forceinline__ float row16_sum(float x) { x += dpp_f<0xB1>(x); x += dpp_f<0x4E>(x); x += dpp_f<0x124>(x); x += dpp_f<0x128>(x); return x; }
__device__ __forceinline__ float wave_sum(float v) { v = row16_sum(v); v += __shfl_xor(v, 16); v += __shfl_xor(v, 32); return v; }
__device__ __forceinline__ float sigm(float x) { return __builtin_amdgcn_rcpf(1.f + __expf(-x)); }
__device__ __forceinline__ float silu(float x) { return x * __builtin_amdgcn_rcpf(1.f + __expf(-x)); }

#define XB_TMO      128
#define XB_XCNT(j)  (256  + 64 * (j))
#define XB_XSUB(j)  (1280 + 64 * (j))
#define XB_XGEN(j)  (2304 + 64 * (j))
#define XB_TOP      3328
#define XB_TOPGEN   3392
#define XCD_BAR_WORDS 3456
#define XB_SPIN_CAP (1u << 18)
__device__ __forceinline__ unsigned xb_ld(unsigned* p)              { return __hip_atomic_load(p, __ATOMIC_RELAXED, __HIP_MEMORY_SCOPE_AGENT); }
__device__ __forceinline__ unsigned xb_add(unsigned* p, unsigned v) { return __hip_atomic_fetch_add(p, v, __ATOMIC_RELAXED, __HIP_MEMORY_SCOPE_AGENT); }
__device__ __forceinline__ unsigned xb_xcc_id() { return (unsigned)__builtin_amdgcn_s_getreg((3 << 11) | 20) & 0xFu; }
#define XB_SPIN(cond, bar) do { unsigned _sp = 0; while (cond) { __builtin_amdgcn_s_sleep(1); \
    if ((++_sp & 255u) == 0u) { if (xb_ld(&(bar)[XB_TMO])) break; if (_sp > XB_SPIN_CAP) { atomicAdd(&(bar)[XB_TMO], 1u); break; } } } } while (0)
struct XcdBarrier { unsigned* bar; unsigned x; volatile LAS unsigned* st; };
__device__ __forceinline__ XcdBarrier xcd_barrier_post(unsigned* bar, volatile LAS unsigned* st) {
    XcdBarrier b; b.bar = bar; b.x = xb_xcc_id(); b.st = st;
    if (threadIdx.x == 0) (void)xb_add(&bar[XB_XCNT(b.x)], 1u);
    return b;
}
__device__ __forceinline__ void xcd_barrier_complete(unsigned* bar, unsigned x, unsigned& nloc, unsigned& nx) {
    const unsigned G = gridDim.x * gridDim.y * gridDim.z;
    unsigned sum, cnt, mine, sp = 0u;
    for (;;) {
        sum = 0u; cnt = 0u; mine = 0u;
#pragma unroll
        for (unsigned j = 0; j < 16; ++j) { const unsigned c = xb_ld(&bar[XB_XCNT(j)]); sum += c; cnt += (c > 0u) ? 1u : 0u; mine = (j == x) ? c : mine; }
        if (sum == G) break;
        __builtin_amdgcn_s_sleep(1);
        if ((++sp & 255u) == 0u) { if (xb_ld(&bar[XB_TMO])) break; if (sp > XB_SPIN_CAP) { atomicAdd(&bar[XB_TMO], 1u); break; } }
    }
    nloc = mine > 0u ? mine : 1u; nx = cnt > 0u ? cnt : 1u;
}
__device__ __forceinline__ void xcd_barrier(const XcdBarrier& b) {
    asm volatile("s_waitcnt vmcnt(0)" ::: "memory");
    __syncthreads();
    if (threadIdx.x == 0) {
        unsigned* bar = b.bar;
        __builtin_amdgcn_s_waitcnt(0);
        unsigned nloc = b.st[0], nx = b.st[1];
        if (nloc == 0u) { xcd_barrier_complete(bar, b.x, nloc, nx); b.st[0] = nloc; b.st[1] = nx; }
        const unsigned old = xb_add(&bar[XB_XSUB(b.x)], 1u);
        const unsigned gen = old / nloc;
        if (old + 1u == (gen + 1u) * nloc) {
            __builtin_amdgcn_fence(__ATOMIC_RELEASE, "agent");
            asm volatile("s_waitcnt vmcnt(0)" ::: "memory");
            const unsigned og = xb_add(&bar[XB_TOP], 1u);
            const unsigned tg = og / nx;
            if (og + 1u == (tg + 1u) * nx) xb_add(&bar[XB_TOPGEN], 1u);
            else XB_SPIN(xb_ld(&bar[XB_TOPGEN]) == tg, bar);
            __builtin_amdgcn_fence(__ATOMIC_ACQUIRE, "agent");
            xb_add(&bar[XB_XGEN(b.x)], 1u);
            asm volatile("s_waitcnt vmcnt(0)" ::: "memory");
        } else {
            XB_SPIN(xb_ld(&bar[XB_XGEN(b.x)]) == gen, bar);
            __builtin_amdgcn_fence(__ATOMIC_ACQUIRE, "agent");
            asm volatile("s_waitcnt vmcnt(0)" ::: "memory");
        }
    }
    __syncthreads();
}

constexpr int NWAVES = 8;
constexpr int RING_BYTES = 131072, SCANTV_BYTES = 0, LDSCTL_OFF = RING_BYTES + SCANTV_BYTES, MISC_OFF = LDSCTL_OFF + 320, LDS_BYTES = 147456;
constexpr int CW_BAR = 4096;
constexpr int CW_TMO = 0, CW_RMS = 16384, RMS_BANK = 2048;

struct Args { const float* in[25]; float* out; unsigned char* ws; int ph_lo, ph_hi; };
struct Frame {
    LAS unsigned char* lds;
    int tid, lane, wave, vcu, G;
    const CAS cfp_t* in; float* out; unsigned char* ws;
};

__device__ __forceinline__ int launder(int x) { asm volatile("" : "+v"(x)); return x; }
__device__ __forceinline__ int launder_s(int x) { asm volatile("" : "+s"(x)); return x; }
template <class T> __device__ __forceinline__ T* launder_p(T* p) { asm volatile("" : "+s"(p)); return p; }
__device__ __forceinline__ const CAS cfp_t* launder_k(const CAS cfp_t* p) { asm volatile("" : "+s"(p)); return p; }
#define RELANE(F0) Frame F = F0; F.lane = launder(F0.lane); F.tid = launder(F0.tid)

struct EpiStore {
    static constexpr bool AFTER_DRAIN = false;
    bf16* O; int ldc; int sig_pn;
    __device__ __forceinline__ void operator()(const f32x4 (&acc)[2][2][4][2], const pg8::Unit& u, int wr, int wc, int fr, int fq) const {
        { const int l_ = launder(lane_id()); fr = l_ & 15; fq = l_ >> 4; }
        const int row0 = u.pm * 256 + wr * 64 + fr, col0 = u.pn * 256 + wc * 32 + 8 * fq; const bool sg = u.pn >= sig_pn;
#pragma unroll
        for (int ai = 0; ai < 2; ++ai)
#pragma unroll
            for (int m = 0; m < 4; ++m) { bf16* rowp = O + (size_t)(row0 + ai * 128 + m * 16) * ldc + col0;
#pragma unroll
                for (int bj = 0; bj < 2; ++bj) { f32x4 v0 = acc[ai][bj][m][0], v1 = acc[ai][bj][m][1];
                    if (sg) {
#pragma unroll
                        for (int j = 0; j < 4; ++j) { v0[j] = sigm(v0[j]); v1[j] = sigm(v1[j]); } }
                    v4u w; w.x = pg8::cvt_pk_bf16(v0[0], v0[1]); w.y = pg8::cvt_pk_bf16(v0[2], v0[3]); w.z = pg8::cvt_pk_bf16(v1[0], v1[1]); w.w = pg8::cvt_pk_bf16(v1[2], v1[3]);
                    *(v4u*)(rowp + bj * 128) = w; } }
    }
};
template <bool ACCUM> struct EpiMerge {
    static constexpr bool AFTER_DRAIN = false;
    bf16* O; const bf16* gate;
    __device__ __forceinline__ void operator()(const f32x4 (&acc)[2][2][4][2], const pg8::Unit& u, int wr, int wc, int fr, int fq) const {
        { const int l_ = launder(lane_id()); fr = l_ & 15; fq = l_ >> 4; }
        const int row0 = u.pm * 256 + wr * 64 + fr, col0 = u.pn * 256 + wc * 32 + 8 * fq;
#pragma unroll
        for (int ai = 0; ai < 2; ++ai)
#pragma unroll
            for (int m = 0; m < 4; ++m) { const int row = row0 + ai * 128 + m * 16; bf16* rowp = O + (size_t)row * D + col0; const bf16* gp = gate + (size_t)row * NIN + col0;
#pragma unroll
                for (int bj = 0; bj < 2; ++bj) {
                    float gv[8]; unpack8(*(const v4u*)(gp + bj * 128), gv);
                    float o[8];
#pragma unroll
                    for (int j = 0; j < 4; ++j) { o[j] = acc[ai][bj][m][0][j] * gv[j]; o[4 + j] = acc[ai][bj][m][1][j] * gv[4 + j]; }
                    if (ACCUM) { float p[8]; unpack8(*(const v4u*)(rowp + bj * 128), p);
#pragma unroll
                        for (int j = 0; j < 8; ++j) o[j] += p[j]; }
                    v4u w; w.x = pg8::cvt_pk_bf16(o[0], o[1]); w.y = pg8::cvt_pk_bf16(o[2], o[3]); w.z = pg8::cvt_pk_bf16(o[4], o[5]); w.w = pg8::cvt_pk_bf16(o[6], o[7]);
                    *(v4u*)(rowp + bj * 128) = w; }
                asm volatile("" ::: "memory"); }
    }
};

struct EpiRmsRes {
    static constexpr bool AFTER_DRAIN = true;
    unsigned char* ws; const CAS cfp_t* in; float* outp; int l, which;
    __device__ __forceinline__ void fused(const f32x4 (&acc)[2][2][4][2], const pg8::Unit& u, int wr, int wc, int fr, int fq, LAS unsigned char* lds, int wid, int lane) const {
        { const int l_ = launder(lane_id()); fr = l_ & 15; fq = l_ >> 4; }
        const bool lastl = which == 1 && l + 1 == DEPTH;
        bf16* const XB = (bf16*)(ws + WS_X1); bf16* const H = lastl ? nullptr : (bf16*)(ws + WS_H); float* const fout = lastl ? outp + O_YP : nullptr;
        const float* const gpost = (which ? in[24] : in[22]) + (size_t)l * D; const float* const gpre = lastl ? nullptr : (which ? in[21] + (size_t)(l + 1) * D : in[23] + (size_t)l * D);
        float* const slots = (float*)(ws + WS_XCH) + (size_t)(l * 2 + which) * 32 * 256 * 8 * 4;
        unsigned* const cnt = (unsigned*)(ws + WS_CTL) + CW_RMS + (l * 2 + which) * RMS_BANK; unsigned* const tmo = (unsigned*)(ws + WS_CTL) + CW_TMO;
        LAS f32x4* P = (LAS f32x4*)lds;
        LAS f32x2* SR = (LAS f32x2*)(lds + 16384);
        const int lr0 = wr * 64 + fr, col0 = u.pn * 256 + wc * 32 + 8 * fq;
        f32x4 gp[2][2];
#pragma unroll
        for (int bj = 0; bj < 2; ++bj) { gp[bj][0] = *(const f32x4*)(gpost + col0 + bj * 128); gp[bj][1] = *(const f32x4*)(gpost + col0 + bj * 128 + 4); }
#pragma unroll
        for (int ai = 0; ai < 2; ++ai)
#pragma unroll
            for (int m = 0; m < 4; ++m) {
                const int lr = lr0 + ai * 128 + m * 16; const bf16* xp = XB + (size_t)(u.pm * 256 + lr) * D + col0;
                float syy = 0.f, sxx = 0.f, sxy = 0.f, sgg = 0.f;
#pragma unroll
                for (int bj = 0; bj < 2; ++bj) { float xv[8]; unpack8(*(const v4u*)(xp + bj * 128), xv);
#pragma unroll
                    for (int n = 0; n < 2; ++n)
#pragma unroll
                        for (int j = 0; j < 4; ++j) { const float y = acc[ai][bj][m][n][j], yg = y * gp[bj][n][j], x = xv[4 * n + j]; syy += y * y; sxx += x * x; sxy += x * yg; sgg += yg * yg; } }
                syy += __shfl_xor(syy, 16); sxx += __shfl_xor(sxx, 16); sxy += __shfl_xor(sxy, 16); sgg += __shfl_xor(sgg, 16);
                syy += __shfl_xor(syy, 32); sxx += __shfl_xor(sxx, 32); sxy += __shfl_xor(sxy, 32); sgg += __shfl_xor(sgg, 32);
                if (fq == 0) P[lr * 4 + wc] = (f32x4){syy, sxx, sxy, sgg};
            }
        asm volatile("s_waitcnt lgkmcnt(0)" ::: "memory"); __builtin_amdgcn_s_barrier(); asm volatile("" ::: "memory");
        const int row = wid * 32 + (lane & 31);
        unsigned long long* slot = (unsigned long long*)slots + ((size_t)(u.pm * 256 + row) * 8 + u.pn) * 2;
        if (lane < 32) { const f32x4 a = P[row * 4 + 0], b = P[row * 4 + 1], c = P[row * 4 + 2], d = P[row * 4 + 3]; const f32x4 t = (a + b) + (c + d);
            __hip_atomic_store(slot, ((unsigned long long)__builtin_bit_cast(unsigned, t.y) << 32) | __builtin_bit_cast(unsigned, t.x), __ATOMIC_RELAXED, __HIP_MEMORY_SCOPE_AGENT);
            __hip_atomic_store(slot + 1, ((unsigned long long)__builtin_bit_cast(unsigned, t.w) << 32) | __builtin_bit_cast(unsigned, t.z), __ATOMIC_RELAXED, __HIP_MEMORY_SCOPE_AGENT); }
        asm volatile("s_waitcnt vmcnt(0)" ::: "memory");
        if (lane == 0) __hip_atomic_fetch_add(cnt + 64 * u.pm, 1u, __ATOMIC_RELAXED, __HIP_MEMORY_SCOPE_AGENT);
        if (wid == 0) {
            const unsigned long long t0 = __builtin_amdgcn_s_memrealtime();
            while ((unsigned)__builtin_amdgcn_readfirstlane((int)__hip_atomic_load(cnt + 64 * u.pm, __ATOMIC_RELAXED, __HIP_MEMORY_SCOPE_AGENT)) < 64u) {
                if (__builtin_amdgcn_s_memrealtime() - t0 > 2000000ull) { if (lane == 0) __hip_atomic_store(tmo, 1u, __ATOMIC_RELAXED, __HIP_MEMORY_SCOPE_AGENT); break; }
                __builtin_amdgcn_s_sleep(2); }
            __builtin_amdgcn_fence(__ATOMIC_ACQUIRE, "agent");
        }
        asm volatile("s_waitcnt vmcnt(0) lgkmcnt(0)" ::: "memory"); __builtin_amdgcn_s_barrier(); asm volatile("" ::: "memory");
        if (lane < 32) { const unsigned long long* sl = (const unsigned long long*)slots + (size_t)(u.pm * 256 + row) * 16; float syy = 0.f, sxx = 0.f, sxy = 0.f, sgg = 0.f;
#pragma unroll
            for (int t = 0; t < 8; ++t) { const unsigned long long w0 = __hip_atomic_load(sl + 2 * t, __ATOMIC_RELAXED, __HIP_MEMORY_SCOPE_AGENT), w1 = __hip_atomic_load(sl + 2 * t + 1, __ATOMIC_RELAXED, __HIP_MEMORY_SCOPE_AGENT);
                syy += __builtin_bit_cast(float, (unsigned)w0); sxx += __builtin_bit_cast(float, (unsigned)(w0 >> 32)); sxy += __builtin_bit_cast(float, (unsigned)w1); sgg += __builtin_bit_cast(float, (unsigned)(w1 >> 32)); }
            const float ry = rsqrtf(syy * (1.f / D) + EPS), s1 = sxx + 2.f * ry * sxy + ry * ry * sgg;
            SR[row] = (f32x2){ry, rsqrtf(fmaxf(s1, 0.f) * (1.f / D) + EPS)}; }
        asm volatile("s_waitcnt lgkmcnt(0)" ::: "memory"); __builtin_amdgcn_s_barrier(); asm volatile("" ::: "memory");
        f32x4 gq[2][2];
#pragma unroll
        for (int bj = 0; bj < 2; ++bj) { gq[bj][0] = gpre ? *(const f32x4*)(gpre + col0 + bj * 128) : (f32x4){0.f, 0.f, 0.f, 0.f}; gq[bj][1] = gpre ? *(const f32x4*)(gpre + col0 + bj * 128 + 4) : (f32x4){0.f, 0.f, 0.f, 0.f}; }
#pragma unroll
        for (int ai = 0; ai < 2; ++ai)
#pragma unroll
            for (int m = 0; m < 4; ++m) {
                const int lr = lr0 + ai * 128 + m * 16; const size_t off = (size_t)(u.pm * 256 + lr) * D + col0; const f32x2 sr = SR[lr];
#pragma unroll
                for (int bj = 0; bj < 2; ++bj) { float xv[8], x1[8]; unpack8(*(const v4u*)(XB + off + bj * 128), xv);
#pragma unroll
                    for (int n = 0; n < 2; ++n)
#pragma unroll
                        for (int j = 0; j < 4; ++j) x1[4 * n + j] = xv[4 * n + j] + acc[ai][bj][m][n][j] * sr.x * gp[bj][n][j];
                    if (fout) { *(f32x4*)(fout + off + bj * 128) = (f32x4){x1[0], x1[1], x1[2], x1[3]}; *(f32x4*)(fout + off + bj * 128 + 4) = (f32x4){x1[4], x1[5], x1[6], x1[7]}; }
                    else { *(v4u*)(XB + off + bj * 128) = pack8(x1);
                        if (H) { float hv[8];
#pragma unroll
                            for (int n = 0; n < 2; ++n)
#pragma unroll
                                for (int j = 0; j < 4; ++j) hv[4 * n + j] = x1[4 * n + j] * sr.y * gq[bj][n][j];
                            *(v4u*)(H + off + bj * 128) = pack8(hv); } } }
                asm volatile("" ::: "memory"); }
    }
};
struct EpiSwiglu {
    static constexpr bool AFTER_DRAIN = false;
    bf16* O;
    __device__ __forceinline__ void operator()(const f32x4 (&acc)[2][2][4][2], const pg8::Unit& u, int wr, int wc, int fr, int fq) const {
        { const int l_ = launder(lane_id()); fr = l_ & 15; fq = l_ >> 4; }
        const int row0 = u.pm * 256 + wr * 64 + fr, col0 = u.pn * 128 + wc * 32 + 8 * fq;
#pragma unroll
        for (int ai = 0; ai < 2; ++ai)
#pragma unroll
            for (int m = 0; m < 4; ++m) { bf16* rowp = O + (size_t)(row0 + ai * 128 + m * 16) * DFF + col0;
                float o[8];
#pragma unroll
                for (int j = 0; j < 4; ++j) { o[j] = silu(acc[ai][0][m][0][j]) * acc[ai][1][m][0][j]; o[4 + j] = silu(acc[ai][0][m][1][j]) * acc[ai][1][m][1][j]; }
                v4u w; w.x = pg8::cvt_pk_bf16(o[0], o[1]); w.y = pg8::cvt_pk_bf16(o[2], o[3]); w.z = pg8::cvt_pk_bf16(o[4], o[5]); w.w = pg8::cvt_pk_bf16(o[6], o[7]);
                *(v4u*)rowp = w; }
    }
};

__device__ __forceinline__ void transpose_item(const float* W, int ldw, int src_col0, int k0, bf16* WT, int ldt, int dst_row0, LAS float* scr, int lane, const float* rscale = nullptr) {
#pragma unroll 8
    for (int i = 0; i < 32; ++i) { const int kk = 2 * i + (lane >> 5); scr[kk * 33 + (lane & 31)] = W[(size_t)(k0 + kk) * ldw + src_col0 + (lane & 31)]; }
    LDS_WAIT(); asm volatile("" ::: "memory");
    const int c = lane & 7;
#pragma unroll
    for (int j = 0; j < 4; ++j) { const int n = (lane >> 3) + 8 * j; const LAS float* s = scr + (8 * c) * 33 + n; const float m = rscale ? rscale[n] : 1.f;
        v4u o; o.x = pk2(s[0 * 33] * m, s[1 * 33] * m); o.y = pk2(s[2 * 33] * m, s[3 * 33] * m); o.z = pk2(s[4 * 33] * m, s[5 * 33] * m); o.w = pk2(s[6 * 33] * m, s[7 * 33] * m);
        *(v4u*)(WT + (size_t)(dst_row0 + n) * ldt + k0 + 8 * c) = o; }
    LDS_WAIT(); asm volatile("" ::: "memory");
}
constexpr int IT_IN = 32 * 496, IT_BRA = 16 * 64, IT_BRB = 8 * 64, IT_BRC = 16 * 64, IT_POOL = 4 * 4 * 8, IT_OUT = 32 * 64, IT_GU = 32 * 352, IT_DOWN = 88 * 64;
constexpr int IT_LAYER = IT_IN + IT_BRA + IT_BRB + IT_BRC + IT_POOL + IT_OUT + IT_GU + IT_DOWN;
__device__ __forceinline__ void weight_item(Frame& F0, int l, int r, LAS float* scr) {
    RELANE(F0);
    unsigned char* wl = F.ws + WS_W + (size_t)l * WL_BYTES; const int lane = F.lane;
    if (r < IT_IN) { const int kb = r / 496, nb = r % 496, n0 = nb * 32; transpose_item(F.in[8] + (size_t)l * D * NIN_SRC, NIN_SRC, n0 + (n0 >= 4096 ? 16 : 0), kb * 64, (bf16*)(wl + WO_IN), D, n0, scr, lane); return; } r -= IT_IN;
    if (r < IT_BRA) { const int kb = r / 64, nb = r % 64; transpose_item(F.in[15] + (size_t)l * 1024 * D, D, nb * 32, kb * 64, (bf16*)(wl + WO_BRA), 1024, nb * 32, scr, lane); return; } r -= IT_BRA;
    if (r < IT_BRB) { const int kb = r / 64, nb = r % 64; transpose_item(F.in[16] + (size_t)l * 512 * D, D, nb * 32, kb * 64, (bf16*)(wl + WO_BRB), 512, nb * 32, scr, lane); return; } r -= IT_BRB;
    if (r < IT_BRC) { const int kb = r / 64, nb = r % 64; transpose_item(F.in[17] + (size_t)l * 1024 * D, D, nb * 32, kb * 64, (bf16*)(wl + WO_BRC), 1024, nb * 32, scr, lane); return; } r -= IT_BRC;
    if (r < IT_POOL) { const int g = r / 32, kb = (r % 32) / 8, nb = r % 8; transpose_item(F.in[13] + (size_t)(l * 4 + g) * 65536, 256, nb * 32, kb * 64, (bf16*)(wl + WO_POOL) + (size_t)g * 65536, 256, nb * 32, scr, lane, F.in[14] + (size_t)l * CPOOL + g * 256 + nb * 32); return; } r -= IT_POOL;
    if (r < IT_OUT) { const int kb = r / 64, nb = r % 64; transpose_item(F.in[18] + (size_t)l * D * D, D, nb * 32, kb * 64, (bf16*)(wl + WO_OUT), D, nb * 32, scr, lane); return; } r -= IT_OUT;
    if (r < IT_GU) { const int kb = r / 352, nb = r % 352, n0 = nb * 32, pn = n0 >> 8, bj = (n0 >> 7) & 1, rr = n0 & 127;
        transpose_item(F.in[19] + (size_t)l * D * 2 * DFF, 2 * DFF, bj * DFF + 128 * pn + rr, kb * 64, (bf16*)(wl + WO_GU), D, n0, scr, lane); return; } r -= IT_GU;
    { const int kb = r / 64, nb = r % 64; transpose_item(F.in[20] + (size_t)l * DFF * D, D, nb * 32, kb * 64, (bf16*)(wl + WO_DOWN), DFF, nb * 32, scr, lane); }
}

__device__ __forceinline__ void stage_wba(Frame& F0, int l) {
    RELANE(F0);
    LAS float* Wl = (LAS float*)F.lds; const float* w = F.in[8] + (size_t)l * D * NIN_SRC + 4096;
    for (int k = F.tid; k < D; k += NWAVES * 64) { const float* p = w + (size_t)k * NIN_SRC;
        const f32x4 a = *(const f32x4*)p, b = *(const f32x4*)(p + 4), c = *(const f32x4*)(p + 8), d = *(const f32x4*)(p + 12);
        Wl[0 * D + k] = a.x; Wl[1 * D + k] = a.y; Wl[2 * D + k] = a.z; Wl[3 * D + k] = a.w; Wl[4 * D + k] = b.x; Wl[5 * D + k] = b.y; Wl[6 * D + k] = b.z; Wl[7 * D + k] = b.w;
        Wl[8 * D + k] = c.x; Wl[9 * D + k] = c.y; Wl[10 * D + k] = c.z; Wl[11 * D + k] = c.w; Wl[12 * D + k] = d.x; Wl[13 * D + k] = d.y; Wl[14 * D + k] = d.z; Wl[15 * D + k] = d.w; }
    __syncthreads();
}
template <bool X32>
__device__ __forceinline__ void thin_rows(Frame& F0, const float* xa, const float* xb, const bf16* Y, const float* gpost, float* fout, const float* gpre, bool do_ba, int l_ba, int r_lo = 0) {
    RELANE(F0);
    const int lane = F.lane, gw = F.vcu * NWAVES + F.wave, NGW = F.G * NWAVES;
    bf16* H = (bf16*)(F.ws + WS_H); bf16* XB = (bf16*)(F.ws + WS_X1); float* GB = (float*)(F.ws + WS_GB);
    const LAS float* Wl = (const LAS float*)F.lds;
    f32x4 vn[8]; v2u xn[8], yn[8];
#define THIN_LOAD(rr) do { const int r_ = (rr); \
        if (X32) { const float* xr_ = (r_ < MP) ? xa + (size_t)r_ * D : xb + (size_t)(r_ - MP) * D; _Pragma("unroll") for (int j = 0; j < 8; ++j) vn[j] = *(const f32x4*)(xr_ + 4 * lane + 256 * j); } \
        else { _Pragma("unroll") for (int j = 0; j < 8; ++j) xn[j] = *(const v2u*)(XB + (size_t)r_ * D + 4 * lane + 256 * j); } \
        if (Y) { _Pragma("unroll") for (int j = 0; j < 8; ++j) yn[j] = *(const v2u*)(Y + (size_t)r_ * D + 4 * lane + 256 * j); } } while (0)
#pragma unroll
    for (int j = 0; j < 8; ++j) { yn[j] = (v2u){0u, 0u}; xn[j] = (v2u){0u, 0u}; vn[j] = (f32x4){0.f, 0.f, 0.f, 0.f}; }
    if (r_lo + gw < MV) THIN_LOAD(r_lo + gw);
    for (int r = r_lo + gw; r < MV; r += NGW) {
        f32x4 v[8]; v2u yu[8];
#pragma unroll
        for (int j = 0; j < 8; ++j) { v[j] = X32 ? vn[j] : (f32x4){bf_lo(xn[j].x), bf_hi(xn[j].x), bf_lo(xn[j].y), bf_hi(xn[j].y)}; yu[j] = yn[j]; }
        if (r + NGW < MV) THIN_LOAD(r + NGW);
        if (Y) {
            f32x4 y[8]; float ss = 0.f;
#pragma unroll
            for (int j = 0; j < 8; ++j) { const v2u u = yu[j]; y[j] = (f32x4){bf_lo(u.x), bf_hi(u.x), bf_lo(u.y), bf_hi(u.y)}; ss += (y[j].x * y[j].x + y[j].y * y[j].y) + (y[j].z * y[j].z + y[j].w * y[j].w); }
            const float rstd = rsqrtf(wave_sum(ss) * (1.f / D) + EPS);
#pragma unroll
            for (int j = 0; j < 8; ++j) { const f32x4 g = *(const f32x4*)(gpost + 4 * lane + 256 * j); v[j] = v[j] + y[j] * rstd * g; }
        }
        if (fout) {
#pragma unroll
            for (int j = 0; j < 8; ++j) *(f32x4*)(fout + (size_t)r * D + 4 * lane + 256 * j) = v[j];
        } else {
#pragma unroll
            for (int j = 0; j < 8; ++j) { v2u o; o.x = pk2(v[j].x, v[j].y); o.y = pk2(v[j].z, v[j].w); *(v2u*)(XB + (size_t)r * D + 4 * lane + 256 * j) = o; }
        }
        if (gpre) {
            float ss = 0.f;
#pragma unroll
            for (int j = 0; j < 8; ++j) ss += (v[j].x * v[j].x + v[j].y * v[j].y) + (v[j].z * v[j].z + v[j].w * v[j].w);
            const float rstd = rsqrtf(wave_sum(ss) * (1.f / D) + EPS);
#pragma unroll
            for (int j = 0; j < 8; ++j) { const f32x4 g = *(const f32x4*)(gpre + 4 * lane + 256 * j); v[j] = v[j] * rstd * g;
                v2u o; o.x = pk2(v[j].x, v[j].y); o.y = pk2(v[j].z, v[j].w); *(v2u*)(H + (size_t)r * D + 4 * lane + 256 * j) = o; }
            if (do_ba) {
                float pc[16], mine = 0.f;
#pragma unroll
                for (int c = 0; c < 16; ++c) { float p = 0.f;
#pragma unroll
                    for (int j = 0; j < 8; ++j) { const f32x4 w = *(const LAS f32x4*)(Wl + c * D + 256 * j + 4 * lane); p += (v[j].x * w.x + v[j].y * w.y) + (v[j].z * w.z + v[j].w * w.w); }
                    pc[c] = row16_sum(p); }
#pragma unroll
                for (int c = 0; c < 16; ++c) pc[c] += __shfl_xor(pc[c], 16);
#pragma unroll
                for (int c = 0; c < 16; ++c) { pc[c] += __shfl_xor(pc[c], 32); mine = (lane == c) ? pc[c] : mine; }
                if (lane < 16) { float o;
                    if (lane < 8) o = sigm(mine);
                    else { const float al = F.in[10][l_ba * HA + lane - 8], dtb = F.in[11][l_ba * HA + lane - 8]; const float z = mine + dtb; const float sp = fmaxf(z, 0.f) + __logf(1.f + __expf(-fabsf(z))); o = -__expf(al) * sp; }
                    GB[(size_t)r * 16 + lane] = o; }
            }
        }
    }
}
#undef THIN_LOAD
__device__ __forceinline__ void ba_rows(Frame& F0, int l_ba) {
    RELANE(F0);
    const int lane = F.lane, gw = F.vcu * NWAVES + F.wave, NGW = F.G * NWAVES;
    const bf16* H = (const bf16*)(F.ws + WS_H); float* GB = (float*)(F.ws + WS_GB); const LAS float* Wl = (const LAS float*)F.lds;
    for (int r = gw; r < MP; r += NGW) {
        f32x4 v[8];
#pragma unroll
        for (int j = 0; j < 8; ++j) { const v2u u = *(const v2u*)(H + (size_t)r * D + 4 * lane + 256 * j); v[j] = (f32x4){bf_lo(u.x), bf_hi(u.x), bf_lo(u.y), bf_hi(u.y)}; }
        float mine = 0.f;
#pragma unroll 1
        for (int c = 0; c < 16; ++c) { float p = 0.f;
#pragma unroll
            for (int j = 0; j < 8; ++j) { const f32x4 w = *(const LAS f32x4*)(Wl + c * D + 256 * j + 4 * lane); p += (v[j].x * w.x + v[j].y * w.y) + (v[j].z * w.z + v[j].w * w.w); }
            p = wave_sum(p); if (lane == c) mine = p; }
        if (lane < 16) { float o;
            if (lane < 8) o = sigm(mine);
            else { const float al = F.in[10][l_ba * HA + lane - 8], dtb = F.in[11][l_ba * HA + lane - 8]; const float z = mine + dtb; const float sp = fmaxf(z, 0.f) + __logf(1.f + __expf(-fabsf(z))); o = -__expf(al) * sp; }
            GB[(size_t)r * 16 + lane] = o; }
    }
}

__device__ __forceinline__ void ld8f(const float* p, float (&x)[8]) { const f32x4 a = *(const f32x4*)p, b = *(const f32x4*)(p + 4); x[0] = a.x; x[1] = a.y; x[2] = a.z; x[3] = a.w; x[4] = b.x; x[5] = b.y; x[6] = b.z; x[7] = b.w; }
template <bool QK> __device__ __forceinline__ void conv_item(Frame& F0, int l, int row0, int T, int hmode, int sb, int j) {
    RELANE(F0);
    const int lane = F.lane;
    const bf16* PROJ = (const bf16*)(F.ws + WS_PROJ); const float* convw = F.in[9] + (size_t)l * 4 * CONVCH;
    const int c0 = QK ? 512 * j + 8 * lane : 2048 + 512 * j + 8 * lane, c1 = 1024 + 512 * j + 8 * lane;
    float w0[4][8], w1[4][8], x0[4][8], x1[4][8];
#pragma unroll
    for (int tap = 0; tap < 4; ++tap) { ld8f(convw + tap * CONVCH + c0, w0[tap]); if (QK) ld8f(convw + tap * CONVCH + c1, w1[tap]); }
#pragma unroll
    for (int i = 0; i < 3; ++i) {
        if (hmode == 1) { unpack8(*(const v4u*)(PROJ + (size_t)(row0 - 3 + i) * NIN + c0), x0[i + 1]); if (QK) unpack8(*(const v4u*)(PROJ + (size_t)(row0 - 3 + i) * NIN + c1), x1[i + 1]); }
        else if (hmode == 2) { const float* hp = F.in[6] + ((size_t)(l * DB + sb) * 3 + i) * CONVCH; ld8f(hp + c0, x0[i + 1]); if (QK) ld8f(hp + c1, x1[i + 1]); }
        else {
#pragma unroll
            for (int e = 0; e < 8; ++e) { x0[i + 1][e] = 0.f; x1[i + 1][e] = 0.f; } }
    }
    bf16* O0 = (bf16*)(F.ws + (QK ? WS_QN : WS_VV)) + 512 * j + 8 * lane; bf16* O1 = (bf16*)(F.ws + WS_KN) + 512 * j + 8 * lane;
    const float* GB = (const float*)(F.ws + WS_GB); f32x4* TOK = (f32x4*)(F.ws + WS_TOK); const int hd = 4 * j + (lane >> 4);
    v4u n0[4], n1[4]; float ng[4], nb[4];
#pragma unroll
    for (int u = 0; u < 4; ++u) { n0[u] = *(const v4u*)(PROJ + (size_t)(row0 + u) * NIN + c0); n1[u] = n0[u]; ng[u] = 0.f; nb[u] = 0.f; if (QK) { n1[u] = *(const v4u*)(PROJ + (size_t)(row0 + u) * NIN + c1); ng[u] = GB[(size_t)(row0 + u) * 16 + 8 + hd]; nb[u] = GB[(size_t)(row0 + u) * 16 + hd]; } }
    for (int tb = 0; tb < T; tb += 4) {
        v4u m0[4], m1[4]; float mg[4], mb[4];
#pragma unroll
        for (int u = 0; u < 4; ++u) { m0[u] = n0[u]; m1[u] = n1[u]; mg[u] = ng[u]; mb[u] = nb[u]; }
        if (tb + 4 < T) {
#pragma unroll
            for (int u = 0; u < 4; ++u) { n0[u] = *(const v4u*)(PROJ + (size_t)(row0 + tb + 4 + u) * NIN + c0); if (QK) { n1[u] = *(const v4u*)(PROJ + (size_t)(row0 + tb + 4 + u) * NIN + c1); ng[u] = GB[(size_t)(row0 + tb + 4 + u) * 16 + 8 + hd]; nb[u] = GB[(size_t)(row0 + tb + 4 + u) * 16 + hd]; } } }
#pragma unroll
        for (int u = 0; u < 4; ++u) {
            const int t = tb + u; const size_t r = (size_t)(row0 + t);
            unpack8(m0[u], x0[u]); if (QK) unpack8(m1[u], x1[u]);
            float a0[8], a1[8]; float s0 = 0.f, s1 = 0.f;
#pragma unroll
            for (int e = 0; e < 8; ++e) {
                a0[e] = silu(w0[3][e] * x0[u][e] + w0[2][e] * x0[(u + 3) & 3][e] + w0[1][e] * x0[(u + 2) & 3][e] + w0[0][e] * x0[(u + 1) & 3][e]); s0 += a0[e] * a0[e];
                if (QK) { a1[e] = silu(w1[3][e] * x1[u][e] + w1[2][e] * x1[(u + 3) & 3][e] + w1[1][e] * x1[(u + 2) & 3][e] + w1[0][e] * x1[(u + 1) & 3][e]); s1 += a1[e] * a1[e]; } }
            if (QK) {
                const float q_sc = rsqrtf(row16_sum(s0) + 1e-6f) * 0.08838834764831845f, k_sc = rsqrtf(row16_sum(s1) + 1e-6f); float p = 0.f;
#pragma unroll
                for (int e = 0; e < 8; ++e) { a0[e] *= q_sc; a1[e] *= k_sc; p += a0[e] * a1[e]; }
                p = row16_sum(p);
                *(v4u*)(O1 + r * 1024) = pack8(a1);
                if ((lane & 15) == 0) TOK[r * 8 + hd] = (f32x4){__expf(mg[u]), mb[u], p, mg[u]};
            }
            *(v4u*)(O0 + r * 1024) = pack8(a0);
        }
    }
}
__device__ __forceinline__ void pool_item(Frame& F0, int l, int row0, int T, int pos0, int hmode, int sb, int j) {
    RELANE(F0);
    const int lane = F.lane, win = 2 << (2 * j + (lane >> 5)), cc = 512 * j + 8 * lane;
    const bf16* U = (const bf16*)(F.ws + WS_PROJ) + PC_UC + cc; const float* hist = F.in[7] + (size_t)(l * DB + sb) * PHIST * CPOOL + cc;
    bf16* PO = (bf16*)(F.ws + WS_POOLED) + cc;
    float S[8];
#pragma unroll
    for (int e = 0; e < 8; ++e) S[e] = 0.f;
    if (hmode == 2) {
        for (int i = 1; i < 16; ++i) if (i < win) { float x[8]; ld8f(hist + (size_t)(PHIST - i) * CPOOL, x);
#pragma unroll
            for (int e = 0; e < 8; ++e) S[e] += x[e]; }
        for (int t = 0; t < T; ++t) {
            float xn[8], xo[8]; unpack8(*(const v4u*)(U + (size_t)(row0 + t) * NIN), xn);
            const int to = t - win + 1;
            if (to >= 0) unpack8(*(const v4u*)(U + (size_t)(row0 + to) * NIN), xo); else ld8f(hist + (size_t)(PHIST + to) * CPOOL, xo);
            const float inv = 1.f / (float)win; float o[8];
#pragma unroll
            for (int e = 0; e < 8; ++e) { S[e] += xn[e]; o[e] = S[e] * inv - xn[e]; S[e] -= xo[e]; }
            *(v4u*)(PO + (size_t)(row0 + t) * 1024) = pack8(o);
        }
        return;
    }
    {
        v4u h[15];
#pragma unroll
        for (int i = 1; i < 16; ++i) { const int back = (pos0 - i >= 0) ? i : pos0; h[i - 1] = *(const v4u*)(U + (size_t)(row0 - back) * NIN); }
#pragma unroll
        for (int i = 1; i < 16; ++i) { float x[8]; unpack8(h[i - 1], x); const float wgt = (i < win && pos0 - i >= 0) ? 1.f : 0.f;
#pragma unroll
            for (int e = 0; e < 8; ++e) S[e] += wgt * x[e]; }
    }
    v4u nn[4], no[4];
#define POOL_LD(tb_) do { _Pragma("unroll") for (int u = 0; u < 4; ++u) { const int t_ = (tb_) + u, to_ = t_ - win + 1; nn[u] = *(const v4u*)(U + (size_t)(row0 + t_) * NIN); no[u] = *(const v4u*)(U + (size_t)(row0 + (pos0 + to_ >= 0 ? to_ : -pos0)) * NIN); } } while (0)
    POOL_LD(0);
    for (int tb = 0; tb < T; tb += 4) {
        v4u mn[4], mo[4];
#pragma unroll
        for (int u = 0; u < 4; ++u) { mn[u] = nn[u]; mo[u] = no[u]; }
        if (tb + 4 < T) POOL_LD(tb + 4);
#pragma unroll
        for (int u = 0; u < 4; ++u) {
            const int t = tb + u, to = t - win + 1; const float wo = (pos0 + to >= 0) ? 1.f : 0.f;
            float xn[8], xo[8]; unpack8(mn[u], xn); unpack8(mo[u], xo);
            const float cnt = (float)(win < pos0 + t + 1 ? win : pos0 + t + 1), inv = __builtin_amdgcn_rcpf(cnt); float o[8];
#pragma unroll
            for (int e = 0; e < 8; ++e) { S[e] += xn[e]; o[e] = S[e] * inv - xn[e]; S[e] -= wo * xo[e]; }
            *(v4u*)(PO + (size_t)(row0 + t) * 1024) = pack8(o);
        }
    }
#undef POOL_LD
}
constexpr int CV_BLK = 16, CV_NB = SEQ / CV_BLK;
constexpr int CV_P_ITEMS = BATCH * CV_NB * 2, CV_S_ITEMS = DB * 2;
constexpr int PREP_ITEMS = 2 * (CV_P_ITEMS + CV_S_ITEMS) + CV_P_ITEMS + CV_S_ITEMS;
__device__ __forceinline__ void prep_item(Frame& F, int l, int it) {
    int kind = 0;
    if (it >= CV_P_ITEMS + CV_S_ITEMS) { it -= CV_P_ITEMS + CV_S_ITEMS; kind = 1; if (it >= CV_P_ITEMS + CV_S_ITEMS) { it -= CV_P_ITEMS + CV_S_ITEMS; kind = 2; } }
    int row0, T, hmode, sb = 0, pos0; const int j = it & 1;
    if (it < CV_P_ITEMS) { const int blk = (it >> 1) % CV_NB, b = (it >> 1) / CV_NB; row0 = b * SEQ + blk * CV_BLK; T = CV_BLK; hmode = blk ? 1 : 0; pos0 = blk * CV_BLK; }
    else { sb = (it - CV_P_ITEMS) >> 1; row0 = MP + DS * sb; T = DS; hmode = 2; pos0 = 0; }
    if (kind == 0) conv_item<true>(F, l, row0, T, hmode, sb, j); else if (kind == 1) conv_item<false>(F, l, row0, T, hmode, sb, j); else pool_item(F, l, row0, T, pos0, hmode, sb, j);
}

__device__ __forceinline__ void st8f(float* p, const v4u u) { float x[8]; unpack8(u, x); *(f32x4*)p = (f32x4){x[0], x[1], x[2], x[3]}; *(f32x4*)(p + 4) = (f32x4){x[4], x[5], x[6], x[7]}; }
__device__ __forceinline__ void prep_out_rows(Frame& F0, int l) {
    RELANE(F0);
    const int lane = F.lane, gw = F.vcu * NWAVES + F.wave, NGW = F.G * NWAVES;
    const bf16* PROJ = (const bf16*)(F.ws + WS_PROJ);
    float* out = F.out;
    for (int r = gw; r < MV; r += NGW) {
        const bool samp = r >= MP; const int b = samp ? (r - MP) / DS : r / SEQ, t = samp ? (r - MP) % DS : r % SEQ;
        const bf16* prow = PROJ + (size_t)r * NIN;
        const int ci = samp ? t - 1 : t - (SEQ - 3), pi = samp ? 11 + t : t - (SEQ - PHIST);
        v4u kvr[3][2], cv[6], pv[2];
#pragma unroll
        for (int gi = 0; gi < 3; ++gi) { kvr[gi][0] = *(const v4u*)(prow + PC_KB + gi * 512 + 8 * lane); kvr[gi][1] = *(const v4u*)(prow + PC_VB + gi * 512 + 8 * lane); }
        const bool needc = (ci >= 0) || (pi >= 0);
        if (needc) {
#pragma unroll
            for (int j = 0; j < 6; ++j) cv[j] = *(const v4u*)(prow + 512 * j + 8 * lane);
#pragma unroll
            for (int j = 0; j < 2; ++j) pv[j] = *(const v4u*)(prow + PC_UC + 512 * j + 8 * lane);
        }
#pragma unroll
        for (int gi = 0; gi < 3; ++gi) {
            const int win = 128 << (2 * gi); const int w = samp ? win - DS + t : t - (SEQ - win);
            if (w >= 0) {
                const size_t obase = samp ? (gi == 0 ? O_SW1 : gi == 1 ? O_SW2 : O_SW3) : (gi == 0 ? O_PW1 : gi == 1 ? O_PW2 : O_PW3);
                float* dst = out + obase + ((size_t)(l * (samp ? DB : BATCH) + b) * win + w) * 1024 + 8 * lane;
                st8f(dst, kvr[gi][0]); st8f(dst + 512, kvr[gi][1]);
            }
        }
        if (needc) {
            if (ci >= 0) { float* dst = out + (samp ? O_SCONV + ((size_t)(l * DB + b) * 3 + ci) * CONVCH : O_PCONV + ((size_t)(l * BATCH + b) * 3 + ci) * CONVCH) + 8 * lane;
#pragma unroll
                for (int j = 0; j < 6; ++j) st8f(dst + 512 * j, cv[j]); }
            if (pi >= 0) { float* dst = out + (samp ? O_SPOOL + ((size_t)(l * DB + b) * PHIST + pi) * CPOOL : O_PPOOL + ((size_t)(l * BATCH + b) * PHIST + pi) * CPOOL) + 8 * lane;
#pragma unroll
                for (int j = 0; j < 2; ++j) st8f(dst + 512 * j, pv[j]); }
            if (samp && t == 0) {
                const float* phist = F.in[7] + (size_t)(l * DB + b) * PHIST * CPOOL;
                float* dst = out + O_SPOOL + (size_t)(l * DB + b) * PHIST * CPOOL; const float* src = phist + 4 * CPOOL;
                for (int i = lane; i < 11 * CPOOL / 4; i += 64) *(f32x4*)(dst + 4 * i) = *(const f32x4*)(src + 4 * i);
            }
        }
    }
}

__device__ __forceinline__ void gdn_scan_item(Frame& F0, int row0, int h, int s, const float* S0, float* Sout) {
    RELANE(F0);
    const int lane = F.lane, dvl = lane & 15, kg = lane >> 4;
    const bf16* QN = (const bf16*)(F.ws + WS_QN); const bf16* KN = (const bf16*)(F.ws + WS_KN); const bf16* VV = (const bf16*)(F.ws + WS_VV);
    const f32x4* TOK = (const f32x4*)(F.ws + WS_TOK); float* ORAW = (float*)(F.ws + WS_ORAW);
    float S[32]; v4u ku[DS][4], qu[DS][4]; float vv[DS]; f32x4 tk[DS];
    const float* sp = S0 + (size_t)(32 * kg) * 128 + 16 * s + dvl;
#pragma unroll
    for (int i = 0; i < 32; ++i) S[i] = sp[(size_t)i * 128];
#pragma unroll
    for (int t = 0; t < DS; ++t) { const size_t r = (size_t)(row0 + t);
#pragma unroll
        for (int c = 0; c < 4; ++c) { ku[t][c] = *(const v4u*)(KN + r * 1024 + h * 128 + 32 * kg + 8 * c); qu[t][c] = *(const v4u*)(QN + r * 1024 + h * 128 + 32 * kg + 8 * c); }
        vv[t] = bf1(VV[r * 1024 + h * 128 + 16 * s + dvl]); tk[t] = TOK[r * 8 + h]; }
#pragma unroll
    for (int t = 0; t < DS; ++t) {
        float rk = 0.f, rq = 0.f; float kf[32];
#pragma unroll
        for (int c = 0; c < 4; ++c) { float k8[8], q8[8]; unpack8(ku[t][c], k8); unpack8(qu[t][c], q8);
#pragma unroll
            for (int e = 0; e < 8; ++e) { kf[8 * c + e] = k8[e]; rk += k8[e] * S[8 * c + e]; rq += q8[e] * S[8 * c + e]; } }
        rk += __shfl_xor(rk, 16); rq += __shfl_xor(rq, 16); rk += __shfl_xor(rk, 32); rq += __shfl_xor(rq, 32);
        const float a = tk[t].x, d = tk[t].y * (vv[t] - a * rk), o = a * rq + tk[t].z * d;
#pragma unroll
        for (int i = 0; i < 32; ++i) S[i] = a * S[i] + kf[i] * d;
        if (kg == 0) ORAW[(size_t)(row0 + t) * 1024 + h * 128 + 16 * s + dvl] = o;
    }
    float* op = Sout + (size_t)(32 * kg) * 128 + 16 * s + dvl;
#pragma unroll
    for (int i = 0; i < 32; ++i) op[(size_t)i * 128] = S[i];
}

__device__ __forceinline__ bf16x8 pack_acc(const f32x16& x, int sp) {
    v4u p; p.x = pk2(x[8 * sp + 0], x[8 * sp + 1]); p.y = pk2(x[8 * sp + 2], x[8 * sp + 3]); p.z = pk2(x[8 * sp + 4], x[8 * sp + 5]); p.w = pk2(x[8 * sp + 6], x[8 * sp + 7]);
    return __builtin_bit_cast(bf16x8, p);
}
constexpr int GA_PITCH = 272, GA_LT_PITCH = 36, GA_WAVE_LDS = 32 * GA_PITCH + 32 * GA_LT_PITCH * 4 + 384;
__device__ __forceinline__ void gdn_ga_item(Frame& F0, int ch) {
    RELANE(F0);
    const int lane = F.lane, r = lane & 31, h = lane >> 5;
    const int c = ch & 63, bh = ch >> 6, hd = bh & 7, b = bh >> 3, row0 = b * SEQ + 32 * c;
    LAS unsigned char* TL = F.lds + F.wave * GA_WAVE_LDS; LAS float* LT = (LAS float*)(TL + 32 * GA_PITCH); LAS float* GS = (LAS float*)(TL + 32 * GA_PITCH + 32 * GA_LT_PITCH * 4);
    const bf16* QN = (const bf16*)(F.ws + WS_QN); const bf16* KN = (const bf16*)(F.ws + WS_KN); const bf16* VV = (const bf16*)(F.ws + WS_VV); const f32x4* TOK = (const f32x4*)(F.ws + WS_TOK);
    { const f32x4 tk = TOK[(size_t)(row0 + r) * 8 + hd]; if (h == 0) { GS[r] = tk.w; GS[32 + r] = tk.y; } }
#pragma unroll
    for (int i = 0; i < 8; ++i) { const int p = lane + 64 * i, rw = p >> 4, c16 = p & 15; *(LAS v4u*)(TL + rw * GA_PITCH + 16 * c16) = *(const v4u*)(KN + (size_t)(row0 + rw) * 1024 + hd * 128 + 8 * c16); }
    asm volatile("s_waitcnt lgkmcnt(0)" ::: "memory");
    float gcv[32], bev[32];
#pragma unroll
    for (int i = 0; i < 8; ++i) { const f32x4 a = *(const LAS f32x4*)(GS + 4 * i), bq = *(const LAS f32x4*)(GS + 32 + 4 * i);
        gcv[4 * i] = a.x; gcv[4 * i + 1] = a.y; gcv[4 * i + 2] = a.z; gcv[4 * i + 3] = a.w; bev[4 * i] = bq.x; bev[4 * i + 1] = bq.y; bev[4 * i + 2] = bq.z; bev[4 * i + 3] = bq.w; }
#pragma unroll
    for (int i = 1; i < 32; ++i) gcv[i] += gcv[i - 1];
    if (lane == 0) {
#pragma unroll
        for (int i = 0; i < 8; ++i) *(LAS f32x4*)(GS + 64 + 4 * i) = (f32x4){gcv[4 * i], gcv[4 * i + 1], gcv[4 * i + 2], gcv[4 * i + 3]}; }
    asm volatile("s_waitcnt lgkmcnt(0)" ::: "memory");
    const float gc_own = GS[64 + r], fr = (float)r;
    const bf16* kp = KN + (size_t)(row0 + r) * 1024 + hd * 128 + 8 * h; const bf16* qp = QN + (size_t)(row0 + r) * 1024 + hd * 128 + 8 * h;
    f32x16 akk, aqk;
#pragma unroll
    for (int i = 0; i < 16; ++i) { akk[i] = 0.f; aqk[i] = 0.f; }
#pragma unroll
    for (int ks = 0; ks < 8; ++ks) { const bf16x8 kf = *(const bf16x8*)(kp + 16 * ks), qf = *(const bf16x8*)(qp + 16 * ks);
        akk = __builtin_amdgcn_mfma_f32_32x32x16_bf16(kf, kf, akk, 0, 0, 0); aqk = __builtin_amdgcn_mfma_f32_32x32x16_bf16(kf, qf, aqk, 0, 0, 0); }
#pragma unroll
    for (int g4 = 0; g4 < 4; ++g4) { f32x4 w;
#pragma unroll
        for (int e = 0; e < 4; ++e) { const int k0 = 8 * g4 + e, k1 = k0 + 4; const float gk = h ? gcv[k1] : gcv[k0], bk = h ? bev[k1] : bev[k0]; const int kk = h ? k1 : k0;
            const float lo = fminf(fmaxf((float)kk - fr, 0.f), 1.f);
            w[e] = lo * bk * akk[4 * g4 + e] * __expf(fminf(gk - gc_own, 0.f));
            aqk[4 * g4 + e] = (1.f - lo) * aqk[4 * g4 + e] * __expf(fminf(gc_own - gk, 0.f)); }
        *(LAS f32x4*)(LT + r * GA_LT_PITCH + 8 * g4 + 4 * h) = w; }
    bf16x8* AF = (bf16x8*)(F.ws + WS_AF) + (size_t)ch * 128;
    AF[lane] = pack_acc(aqk, 0); AF[64 + lane] = pack_acc(aqk, 1);
    asm volatile("s_waitcnt lgkmcnt(0)" ::: "memory");
    float t[32];
#pragma unroll
    for (int j = 31; j >= 0; --j) {
        float acc = 1.f - fminf(fabsf(fr - (float)j), 1.f);
#pragma unroll
        for (int gq = (j + 1) >> 2; gq < 8; ++gq) { const f32x4 lv = *(const LAS f32x4*)(LT + j * GA_LT_PITCH + 4 * gq);
#pragma unroll
            for (int e = 0; e < 4; ++e) if (4 * gq + e > j) acc -= t[4 * gq + e] * lv[e]; }
        t[j] = acc;
    }
    bf16x8 t1f[2], t2f[2];
#pragma unroll
    for (int sp = 0; sp < 2; ++sp) { float x1[8], x2[8];
#pragma unroll
        for (int e = 0; e < 8; ++e) { const int j0 = 16 * sp + e, j1 = j0 + 8; const float tv = h ? t[j1] : t[j0], bj = h ? bev[j1] : bev[j0], gj = h ? gcv[j1] : gcv[j0]; x1[e] = tv * bj; x2[e] = x1[e] * __expf(gj); }
        t1f[sp] = __builtin_bit_cast(bf16x8, pack8(x1)); t2f[sp] = __builtin_bit_cast(bf16x8, pack8(x2)); }
    { bf16x8* QFo = (bf16x8*)(F.ws + WS_QF) + (size_t)ch * 512; const bf16* qrow = QN + (size_t)(row0 + r) * 1024 + hd * 128 + 4 * h;
#pragma unroll
      for (int tl = 0; tl < 4; ++tl)
#pragma unroll
          for (int sp = 0; sp < 2; ++sp) { const v2u qlo = *(const v2u*)(qrow + 32 * tl + 16 * sp), qhi = *(const v2u*)(qrow + 32 * tl + 16 * sp + 8); v4u qu; qu.x = qlo.x; qu.y = qlo.y; qu.z = qhi.x; qu.w = qhi.y; QFo[(tl * 2 + sp) * 64 + lane] = __builtin_bit_cast(bf16x8, qu); } }
    const float g_last = gcv[31];
    bf16x8* WF = (bf16x8*)(F.ws + WS_WF) + (size_t)ch * 512; bf16x8* KF = (bf16x8*)(F.ws + WS_KF) + (size_t)ch * 512;
#pragma unroll
    for (int tl = 0; tl < 4; ++tl) {
        f32x16 acc;
#pragma unroll
        for (int i = 0; i < 16; ++i) acc[i] = 0.f;
        const LAS unsigned char* col = TL + (32 * tl + r) * 2;
#pragma unroll
        for (int sp = 0; sp < 2; ++sp) { unsigned w[4];
#pragma unroll
            for (int e = 0; e < 4; ++e) { const unsigned lo = *(const LAS unsigned short*)(col + (16 * sp + 8 * h + 2 * e) * GA_PITCH), hi = *(const LAS unsigned short*)(col + (16 * sp + 8 * h + 2 * e + 1) * GA_PITCH); w[e] = lo | (hi << 16); }
            v4u wu; wu.x = w[0]; wu.y = w[1]; wu.z = w[2]; wu.w = w[3];
            acc = __builtin_amdgcn_mfma_f32_32x32x16_bf16(__builtin_bit_cast(bf16x8, wu), t2f[sp], acc, 0, 0, 0); }
#pragma unroll
        for (int i = 0; i < 16; ++i) acc[i] = -acc[i];
#pragma unroll
        for (int sp = 0; sp < 2; ++sp) { WF[(tl * 2 + sp) * 64 + lane] = pack_acc(acc, sp);
            float x[8];
#pragma unroll
            for (int e = 0; e < 8; ++e) { const int j0 = 16 * sp + 8 * (e >> 2) + (e & 3), j1 = j0 + 4; const float gj = h ? gcv[j1] : gcv[j0];
                const unsigned kv = *(const LAS unsigned short*)(col + (j0 + 4 * h) * GA_PITCH); x[e] = __builtin_bit_cast(float, kv << 16) * __expf(g_last - gj); }
            KF[(tl * 2 + sp) * 64 + lane] = __builtin_bit_cast(bf16x8, pack8(x)); }
    }
    asm volatile("s_waitcnt lgkmcnt(0)" ::: "memory");
#pragma unroll
    for (int i = 0; i < 8; ++i) { const int p = lane + 64 * i, rw = p >> 4, c16 = p & 15; *(LAS v4u*)(TL + rw * GA_PITCH + 16 * c16) = *(const v4u*)(VV + (size_t)(row0 + rw) * 1024 + hd * 128 + 8 * c16); }
    asm volatile("s_waitcnt lgkmcnt(0)" ::: "memory");
    f32x4* UF = (f32x4*)(F.ws + WS_UF) + (size_t)ch * 1024;
#pragma unroll
    for (int tl = 0; tl < 4; ++tl) {
        f32x16 acc;
#pragma unroll
        for (int i = 0; i < 16; ++i) acc[i] = 0.f;
        const LAS unsigned char* col = TL + (32 * tl + r) * 2;
#pragma unroll
        for (int sp = 0; sp < 2; ++sp) { unsigned w[4];
#pragma unroll
            for (int e = 0; e < 4; ++e) { const unsigned lo = *(const LAS unsigned short*)(col + (16 * sp + 8 * h + 2 * e) * GA_PITCH), hi = *(const LAS unsigned short*)(col + (16 * sp + 8 * h + 2 * e + 1) * GA_PITCH); w[e] = lo | (hi << 16); }
            v4u wu; wu.x = w[0]; wu.y = w[1]; wu.z = w[2]; wu.w = w[3];
            acc = __builtin_amdgcn_mfma_f32_32x32x16_bf16(t1f[sp], __builtin_bit_cast(bf16x8, wu), acc, 0, 0, 0); }
#pragma unroll
        for (int g4 = 0; g4 < 4; ++g4) UF[(tl * 4 + g4) * 64 + lane] = (f32x4){acc[4 * g4], acc[4 * g4 + 1], acc[4 * g4 + 2], acc[4 * g4 + 3]};
    }
    if (h == 0) ((float*)(F.ws + WS_TB))[(size_t)ch * 32 + r] = __expf(gc_own);
    asm volatile("s_waitcnt lgkmcnt(0)" ::: "memory");
}

constexpr int GSC_ITEMS = BATCH * HA * 4;
constexpr int GSB_WF = 0, GSB_KF = 8192, GSB_QF = 16384, GSB_UF = 24576, GSB_AF = 28672, GSB_TB = 30720, GSB_AL = 34816, GSB_STRIDE = 36864;
__device__ __forceinline__ void gdn_chunk_scan(Frame& F0, int l, int item) {
    RELANE(F0);
    const int lane = F.lane, r = lane & 31, h = lane >> 5;
    const int sl = item & 3, bh = item >> 2, hd = bh & 7, b = bh >> 3;
    float* ORAW = (float*)(F.ws + WS_ORAW);
    LAS unsigned char* buf = F.lds;
#define GS_DMA(src, off) __builtin_amdgcn_global_load_lds((const unsigned*)(src), (LAS unsigned*)(bp + (off)), 16, 0, 0)
#define GS_FETCH(cc, bsel) do { const size_t ch_ = (size_t)bh * 64 + (cc); LAS unsigned char* bp = buf + (bsel) * GSB_STRIDE; \
        const bf16x8* wf_ = (const bf16x8*)(F.ws + WS_WF) + ch_ * 512 + lane; const bf16x8* kf_ = (const bf16x8*)(F.ws + WS_KF) + ch_ * 512 + lane; const bf16x8* qf_ = (const bf16x8*)(F.ws + WS_QF) + ch_ * 512 + lane; \
        const f32x4* uf_ = (const f32x4*)(F.ws + WS_UF) + ch_ * 1024 + (size_t)sl * 256 + lane; const bf16x8* af_ = (const bf16x8*)(F.ws + WS_AF) + ch_ * 128 + lane; const float* tb_ = (const float*)(F.ws + WS_TB) + ch_ * 32; \
        _Pragma("unroll") for (int i_ = 0; i_ < 8; ++i_) { GS_DMA(wf_ + i_ * 64, GSB_WF + i_ * 1024); GS_DMA(qf_ + i_ * 64, GSB_QF + i_ * 1024); } \
        _Pragma("unroll") for (int i_ = 0; i_ < 4; ++i_) { GS_DMA(uf_ + i_ * 64, GSB_UF + i_ * 1024); GS_DMA(tb_ + 8 * i_ + 4 * h, GSB_TB + i_ * 1024); } \
        GS_DMA(af_, GSB_AF); GS_DMA(af_ + 64, GSB_AF + 1024); GS_DMA(tb_ + 28, GSB_AL); \
        _Pragma("unroll") for (int i_ = 0; i_ < 8; ++i_) GS_DMA(kf_ + i_ * 64, GSB_KF + i_ * 1024); } while (0)
    f32x16 S[4];
#pragma unroll
    for (int tl = 0; tl < 4; ++tl)
#pragma unroll
        for (int i = 0; i < 16; ++i) S[tl][i] = 0.f;
    GS_FETCH(0, 0);
#pragma unroll 1
    for (int c = 0; c < SEQ / 32; ++c) {
        const int row0 = b * SEQ + 32 * c;
        asm volatile("s_waitcnt vmcnt(0)" ::: "memory");
        if (c + 1 < SEQ / 32) GS_FETCH(c + 1, (c + 1) & 1);
        const LAS unsigned char* bp = buf + (c & 1) * GSB_STRIDE + lane * 16;
        f32x16 P, O1;
#pragma unroll
        for (int g4 = 0; g4 < 4; ++g4) { const f32x4 u = *(const LAS f32x4*)(bp + GSB_UF + g4 * 1024); P[4 * g4] = u.x; P[4 * g4 + 1] = u.y; P[4 * g4 + 2] = u.z; P[4 * g4 + 3] = u.w; }
#pragma unroll
        for (int i = 0; i < 16; ++i) O1[i] = 0.f;
#pragma unroll
        for (int tl = 0; tl < 4; ++tl)
#pragma unroll
            for (int sp = 0; sp < 2; ++sp) {
                const bf16x8 sf = pack_acc(S[tl], sp);
                P = __builtin_amdgcn_mfma_f32_32x32x16_bf16(*(const LAS bf16x8*)(bp + GSB_WF + (tl * 2 + sp) * 1024), sf, P, 0, 0, 0);
                O1 = __builtin_amdgcn_mfma_f32_32x32x16_bf16(*(const LAS bf16x8*)(bp + GSB_QF + (tl * 2 + sp) * 1024), sf, O1, 0, 0, 0);
            }
#pragma unroll
        for (int g4 = 0; g4 < 4; ++g4) { const f32x4 eg = *(const LAS f32x4*)(bp + GSB_TB + g4 * 1024); O1[4 * g4] *= eg.x; O1[4 * g4 + 1] *= eg.y; O1[4 * g4 + 2] *= eg.z; O1[4 * g4 + 3] *= eg.w; }
        const bf16x8 vf0 = pack_acc(P, 0), vf1 = pack_acc(P, 1);
        O1 = __builtin_amdgcn_mfma_f32_32x32x16_bf16(*(const LAS bf16x8*)(bp + GSB_AF), vf0, O1, 0, 0, 0);
        O1 = __builtin_amdgcn_mfma_f32_32x32x16_bf16(*(const LAS bf16x8*)(bp + GSB_AF + 1024), vf1, O1, 0, 0, 0);
        const float a_last = (*(const LAS f32x4*)(bp + GSB_AL)).w;
#pragma unroll
        for (int tl = 0; tl < 4; ++tl) {
#pragma unroll
            for (int i = 0; i < 16; ++i) S[tl][i] *= a_last;
            S[tl] = __builtin_amdgcn_mfma_f32_32x32x16_bf16(*(const LAS bf16x8*)(bp + GSB_KF + (tl * 2) * 1024), vf0, S[tl], 0, 0, 0);
            S[tl] = __builtin_amdgcn_mfma_f32_32x32x16_bf16(*(const LAS bf16x8*)(bp + GSB_KF + (tl * 2 + 1) * 1024), vf1, S[tl], 0, 0, 0);
        }
        float* op = ORAW + (size_t)(row0 + 4 * h) * 1024 + hd * 128 + 32 * sl + r;
#pragma unroll
        for (int i = 0; i < 16; ++i) op[(size_t)((i & 3) + 8 * (i >> 2)) * 1024] = O1[i];
    }
#undef GS_DMA
#undef GS_FETCH
    float* Sout = F.out + O_PGDN + (size_t)((l * BATCH + b) * HA + hd) * 16384 + 32 * sl + r;
#pragma unroll
    for (int tl = 0; tl < 4; ++tl)
#pragma unroll
        for (int i = 0; i < 16; ++i) Sout[(size_t)(32 * tl + (i & 3) + 8 * (i >> 2) + 4 * h) * 128] = S[tl][i];
}

constexpr int VT_PITCH = 144, VT_WAVE_LDS = 64 * VT_PITCH, VT_ITEMS = BATCH * 3 * 4 * 2 * 32;
__device__ __forceinline__ void vt_item(Frame& F0, int item) {
    RELANE(F0);
    const int lane = F.lane; LAS unsigned char* T = F.lds + F.wave * VT_WAVE_LDS;
    const int ch = item & 31, dh = (item >> 5) & 1, hh = (item >> 6) & 3, bg = item >> 8, g = bg % 3, b = bg / 3;
    const int dil = 1 << (2 * g), Lc = SEQ >> (2 * g), pos0 = ch * 64, rho = pos0 / Lc, i0 = pos0 % Lc;
    const bf16* PROJ = (const bf16*)(F.ws + WS_PROJ); bf16* VT = (bf16*)(F.ws + WS_VT);
    const bf16* src = PROJ + ((size_t)b * SEQ + (size_t)(i0 + lane) * dil + rho) * NIN + PC_VB + g * 512 + hh * 128 + 64 * dh;
    v4u x[8];
#pragma unroll
    for (int c = 0; c < 8; ++c) x[c] = *(const v4u*)(src + 8 * c);
#pragma unroll
    for (int c = 0; c < 8; ++c) { const unsigned w[4] = {x[c].x, x[c].y, x[c].z, x[c].w};
#pragma unroll
        for (int e = 0; e < 4; ++e) { *(LAS unsigned short*)(T + (8 * c + 2 * e) * VT_PITCH + 2 * lane) = (unsigned short)(w[e] & 0xffffu); *(LAS unsigned short*)(T + (8 * c + 2 * e + 1) * VT_PITCH + 2 * lane) = (unsigned short)(w[e] >> 16); } }
    asm volatile("s_waitcnt lgkmcnt(0)" ::: "memory");
    bf16* dst = VT + ((size_t)((b * 3 + g) * 4 + hh) * 128 + 64 * dh) * 2048 + pos0;
#pragma unroll
    for (int it = 0; it < 8; ++it) { const int p = lane + 64 * it, row = p >> 3, cc = p & 7; const v4u v = *(const LAS v4u*)(T + row * VT_PITCH + 16 * cc); *(v4u*)(dst + (size_t)row * 2048 + 8 * cc) = v; }
    asm volatile("s_waitcnt lgkmcnt(0)" ::: "memory");
}

constexpr int ATT_UNITS = BATCH * 4 * 192;
__device__ __forceinline__ void attn_unit(Frame& F0, int unit) {
    RELANE(F0);
    const int lane = F.lane, r = lane & 31, h = lane >> 5;
    const int bh = unit / 192, b = bh >> 2, hh = bh & 3, u = unit % 192, g = u >> 6, v = u & 63;
    const int dil = 1 << (2 * g), ntpc = 64 >> (2 * g), rho = v / ntpc, i0 = (v % ntpc) * 32, Lc = SEQ >> (2 * g);
    const bf16* PROJ = (const bf16*)(F.ws + WS_PROJ);
    const bf16* cbase = PROJ + ((size_t)b * SEQ + rho) * NIN + g * 512 + hh * 128 + 8 * h;
    const bf16* qp = cbase + (size_t)(i0 + r) * dil * NIN + PC_QB;
    bf16x8 qf[8];
#pragma unroll
    for (int ks = 0; ks < 8; ++ks) qf[ks] = *(const bf16x8*)(qp + 16 * ks);
    f32x16 st[5]; float mx = -1e30f;
    bf16x8 kn[8];
    { const int k0 = i0 - 128; const bf16* kp = cbase + (size_t)((k0 >= 0 ? k0 : 0) + r) * dil * NIN + PC_KB;
#pragma unroll
      for (int ks = 0; ks < 8; ++ks) kn[ks] = *(const bf16x8*)(kp + 16 * ks); }
#pragma unroll
    for (int kt = 0; kt < 5; ++kt) {
        const int k0 = i0 - 128 + 32 * kt; const bool tv = k0 >= 0;
        bf16x8 kc[8];
#pragma unroll
        for (int ks = 0; ks < 8; ++ks) kc[ks] = kn[ks];
        if (kt < 4) { const int k1 = k0 + 32; const bf16* kp = cbase + (size_t)((k1 >= 0 ? k1 : 0) + r) * dil * NIN + PC_KB;
#pragma unroll
            for (int ks = 0; ks < 8; ++ks) kn[ks] = *(const bf16x8*)(kp + 16 * ks); }
        f32x16 acc;
#pragma unroll
        for (int i = 0; i < 16; ++i) acc[i] = 0.f;
#pragma unroll
        for (int ks = 0; ks < 8; ++ks) acc = __builtin_amdgcn_mfma_f32_32x32x16_bf16(kc[ks], qf[ks], acc, 0, 0, 0);
#pragma unroll
        for (int i = 0; i < 16; ++i) { const int row = (i & 3) + 8 * (i >> 2) + 4 * h; float sv = tv ? acc[i] : -1e30f;
            if (kt == 0 && row < r) sv = -1e30f;
            if (kt == 4 && row > r) sv = -1e30f;
            st[kt][i] = sv; mx = fmaxf(mx, sv); }
    }
    mx = fmaxf(mx, __shfl_xor(mx, 32));
    const float c = 0.08838834764831845f * 1.4426950408889634f, mc = mx * c; float ls = 0.f;
#pragma unroll
    for (int kt = 0; kt < 5; ++kt)
#pragma unroll
        for (int i = 0; i < 16; ++i) { const float p = __builtin_amdgcn_exp2f(st[kt][i] * c - mc); st[kt][i] = p; ls += p; }
    ls += __shfl_xor(ls, 32);
    f32x16 ot[4];
#pragma unroll
    for (int dt = 0; dt < 4; ++dt)
#pragma unroll
        for (int i = 0; i < 16; ++i) ot[dt][i] = 0.f;
    const bf16* vt = (const bf16*)(F.ws + WS_VT) + ((size_t)((b * 3 + g) * 4 + hh) * 128 + r) * 2048 + rho * Lc + 4 * h;
    v2u vn[2][4][2];
#define ATT_VLD(kt_) do { const int k0_ = i0 - 128 + 32 * (kt_), kc_ = k0_ >= 0 ? k0_ : 0; _Pragma("unroll") for (int sp = 0; sp < 2; ++sp) _Pragma("unroll") for (int dt = 0; dt < 4; ++dt) { \
            const bf16* vp = vt + (size_t)(32 * dt) * 2048 + kc_ + 16 * sp; vn[sp][dt][0] = *(const v2u*)vp; vn[sp][dt][1] = *(const v2u*)(vp + 8); } } while (0)
    ATT_VLD(0);
#pragma unroll
    for (int kt = 0; kt < 5; ++kt) {
        v2u vc[2][4][2];
#pragma unroll
        for (int sp = 0; sp < 2; ++sp)
#pragma unroll
            for (int dt = 0; dt < 4; ++dt) { vc[sp][dt][0] = vn[sp][dt][0]; vc[sp][dt][1] = vn[sp][dt][1]; }
        if (kt < 4) ATT_VLD(kt + 1);
#pragma unroll
        for (int sp = 0; sp < 2; ++sp) {
            v4u pu; pu.x = pk2(st[kt][8 * sp + 0], st[kt][8 * sp + 1]); pu.y = pk2(st[kt][8 * sp + 2], st[kt][8 * sp + 3]); pu.z = pk2(st[kt][8 * sp + 4], st[kt][8 * sp + 5]); pu.w = pk2(st[kt][8 * sp + 6], st[kt][8 * sp + 7]);
            const bf16x8 pf = __builtin_bit_cast(bf16x8, pu);
#pragma unroll
            for (int dt = 0; dt < 4; ++dt) {
                v4u vu; vu.x = vc[sp][dt][0].x; vu.y = vc[sp][dt][0].y; vu.z = vc[sp][dt][1].x; vu.w = vc[sp][dt][1].y;
                ot[dt] = __builtin_amdgcn_mfma_f32_32x32x16_bf16(__builtin_bit_cast(bf16x8, vu), pf, ot[dt], 0, 0, 0);
            }
        }
    }
#undef ATT_VLD
    const float inv = 1.f / ls; const size_t tok = (size_t)b * SEQ + (size_t)(i0 + r) * dil + rho;
    bf16* op = (bf16*)(F.ws + WS_OBG) + ((size_t)g * MV + tok) * 512 + hh * 128 + 4 * h;
#pragma unroll
    for (int dt = 0; dt < 4; ++dt)
#pragma unroll
        for (int g4 = 0; g4 < 4; ++g4) { v2u w; w.x = pk2(ot[dt][4 * g4] * inv, ot[dt][4 * g4 + 1] * inv); w.y = pk2(ot[dt][4 * g4 + 2] * inv, ot[dt][4 * g4 + 3] * inv); *(v2u*)(op + 32 * dt + 8 * g4) = w; }
    if (h == 0) *(f32x2*)((float*)(F.ws + WS_AST) + (((size_t)g * MV + tok) * 4 + hh) * 2) = (f32x2){mc, ls};
}


__device__ __forceinline__ void attn_sample_item(Frame& F0, int l, int item) {
    RELANE(F0);
    const int lane = F.lane, l16 = lane & 15;
    const int half = item & 1, it2 = item >> 1, g = it2 % 3, bt = it2 / 3, t = bt & 3, b = bt >> 2, dil = 1 << (2 * g), win = 128 * dil, jlo = half ? 65 : 0, part = g + 3 * half;
    const bf16* PROJ = (const bf16*)(F.ws + WS_PROJ);
    const int row = MP + DS * b + t;
    const float* cache = F.in[2 + g] + (size_t)(l * DB + b) * win * 1024 + 8 * lane;
    const bf16* newk = PROJ + (size_t)(MP + DS * b) * NIN + PC_KB + g * 512 + 8 * lane;
    float q[8]; unpack8(*(const v4u*)(PROJ + (size_t)row * NIN + PC_QB + g * 512 + 8 * lane), q);
    const int n_new = (g == 0) ? t + 1 : 1;
    const float c = 0.08838834764831845f * 1.4426950408889634f;
    float sc[5];
#pragma unroll
    for (int jr = 0; jr < 5; ++jr) {
        sc[jr] = -1e30f;
        const int jn = jr < 4 ? 16 : 1;
#pragma unroll 8
        for (int jl = 0; jl < jn; ++jl) {
            const int j = jlo + 16 * jr + jl, jc = j <= 128 ? j : 128; int idx = win + t - jc * dil; idx = idx < win ? idx : win - 1;
            const float* kp = cache + (size_t)idx * 1024; const f32x4 a = *(const f32x4*)kp, bq = *(const f32x4*)(kp + 4);
            float sv = (q[0] * a.x + q[1] * a.y) + (q[2] * a.z + q[3] * a.w) + (q[4] * bq.x + q[5] * bq.y) + (q[6] * bq.z + q[7] * bq.w);
            sv = j <= 128 ? row16_sum(sv) * c : -1e30f;
            sc[jr] = (l16 == jl) ? sv : sc[jr];
        }
    }
#pragma unroll
    for (int jj = 0; jj < 4; ++jj) {
        const int tk = t - jj >= 0 ? t - jj : 0; float k[8]; unpack8(*(const v4u*)(newk + (size_t)tk * NIN), k);
        float sv = (q[0] * k[0] + q[1] * k[1]) + (q[2] * k[2] + q[3] * k[3]) + (q[4] * k[4] + q[5] * k[5]) + (q[6] * k[6] + q[7] * k[7]);
        sv = row16_sum(sv) * c;
        sc[0] = (half == 0 && jj < n_new && l16 == jj) ? sv : sc[0];
    }
    float mx = -1e30f;
#pragma unroll
    for (int jr = 0; jr < 5; ++jr) mx = fmaxf(mx, sc[jr]);
    mx = fmaxf(mx, dpp_f<0xB1>(mx)); mx = fmaxf(mx, dpp_f<0x4E>(mx)); mx = fmaxf(mx, dpp_f<0x124>(mx)); mx = fmaxf(mx, dpp_f<0x128>(mx));
    float ls = 0.f;
#pragma unroll
    for (int jr = 0; jr < 5; ++jr) { sc[jr] = __builtin_amdgcn_exp2f(sc[jr] - mx); ls += sc[jr]; }
    ls = row16_sum(ls);
    float o[8];
#pragma unroll
    for (int e = 0; e < 8; ++e) o[e] = 0.f;
#pragma unroll
    for (int jj = 0; jj < 4; ++jj) {
        const int tk = t - jj >= 0 ? t - jj : 0; float vv[8]; unpack8(*(const v4u*)(newk + (size_t)tk * NIN + (PC_VB - PC_KB)), vv);
        const bool isnew = half == 0 && jj < n_new;
        const float p = isnew ? __shfl(sc[0], (lane & 48) | jj) : 0.f;
#pragma unroll
        for (int e = 0; e < 8; ++e) o[e] += p * vv[e];
        sc[0] = (isnew && l16 == jj) ? 0.f : sc[0];
    }
#pragma unroll
    for (int jr = 0; jr < 5; ++jr) {
        const int jn = jr < 4 ? 16 : 1;
#pragma unroll 8
        for (int jl = 0; jl < jn; ++jl) {
            const int j = jlo + 16 * jr + jl, jc = j <= 128 ? j : 128; int idx = win + t - jc * dil; idx = idx < win ? idx : win - 1;
            const float p = __shfl(sc[jr], (lane & 48) | jl);
            const float* vp = cache + (size_t)idx * 1024 + 512; const f32x4 a = *(const f32x4*)vp, bq = *(const f32x4*)(vp + 4);
            o[0] += p * a.x; o[1] += p * a.y; o[2] += p * a.z; o[3] += p * a.w; o[4] += p * bq.x; o[5] += p * bq.y; o[6] += p * bq.z; o[7] += p * bq.w;
        }
    }
    const float inv = 1.f / ls;
#pragma unroll
    for (int e = 0; e < 8; ++e) o[e] *= inv;
    *(v4u*)((bf16*)(F.ws + WS_OBG) + ((size_t)part * MV + row) * 512 + 8 * lane) = pack8(o);
    if (l16 == 0) *(f32x2*)((float*)(F.ws + WS_AST) + (((size_t)part * MV + row) * 4 + (lane >> 4)) * 2) = (f32x2){mx, ls};
}

__device__ __forceinline__ void gdn_gate_rows(Frame& F0, int l) {
    RELANE(F0);
    const int lane = F.lane, gw = F.vcu * NWAVES + F.wave, NGW = F.G * NWAVES;
    const float* ORAW = (const float*)(F.ws + WS_ORAW); const bf16* PROJ = (const bf16*)(F.ws + WS_PROJ); bf16* OUTA = (bf16*)(F.ws + WS_OUTA);
    const float* gain = F.in[12] + (size_t)l * 128;
    for (int r = gw; r < MV; r += NGW) {
#pragma unroll
        for (int j = 0; j < 4; ++j) {
            const int c0 = 256 * j + 4 * lane; const f32x4 o = *(const f32x4*)(ORAW + (size_t)r * 1024 + c0);
            float ss = (o.x * o.x + o.y * o.y) + (o.z * o.z + o.w * o.w);
            ss += __shfl_xor(ss, 1); ss += __shfl_xor(ss, 2); ss += __shfl_xor(ss, 4); ss += __shfl_xor(ss, 8); ss += __shfl_xor(ss, 16);
            const float rstd = rsqrtf(ss * (1.f / 128.f) + EPS);
            const f32x4 g = *(const f32x4*)(gain + (c0 & 127)); const v2u zu = *(const v2u*)(PROJ + (size_t)r * NIN + PC_ZA + c0);
            const float z0 = bf_lo(zu.x), z1 = bf_hi(zu.x), z2 = bf_lo(zu.y), z3 = bf_hi(zu.y);
            v2u w; w.x = pk2(o.x * rstd * g.x * silu(z0), o.y * rstd * g.y * silu(z1)); w.y = pk2(o.z * rstd * g.z * silu(z2), o.w * rstd * g.w * silu(z3));
            *(v2u*)(OUTA + (size_t)r * 1024 + c0) = w;
        }
        {
            const int c0 = 8 * lane, hh = lane >> 4; const float* ast = (const float*)(F.ws + WS_AST); const bf16* obg = (const bf16*)(F.ws + WS_OBG);
            const int np = r < MP ? 3 : 6;
            f32x2 sg[6]; v4u xo[6]; float M = -1e30f;
#pragma unroll
            for (int g = 0; g < 6; ++g) { const int gg = g < np ? g : 0; sg[g] = *(const f32x2*)(ast + (((size_t)gg * MV + r) * 4 + hh) * 2); xo[g] = *(const v4u*)(obg + ((size_t)gg * MV + r) * 512 + c0); }
#pragma unroll
            for (int g = 0; g < 6; ++g) { if (g >= np) sg[g] = (f32x2){-1e30f, 0.f}; M = fmaxf(M, sg[g].x); }
            float wg[6], den = 0.f;
#pragma unroll
            for (int g = 0; g < 6; ++g) { wg[g] = __builtin_amdgcn_exp2f(sg[g].x - M) * sg[g].y; den += wg[g]; }
            const float inv = 1.f / den; float o[8];
#pragma unroll
            for (int e = 0; e < 8; ++e) o[e] = 0.f;
#pragma unroll
            for (int g = 0; g < 6; ++g) { float x[8]; unpack8(xo[g], x); const float w = wg[g] * inv;
#pragma unroll
                for (int e = 0; e < 8; ++e) o[e] += w * x[e]; }
            *(v4u*)((bf16*)(F.ws + WS_OUTB) + (size_t)r * 512 + c0) = pack8(o);
        }
    }
}


constexpr int CP_PER_B = 31 + 127 + 511, CP_NSUB = DB * CP_PER_B;
constexpr int CP_TAIL_WG = 84, CP_TAIL_PER_WG = 64, CP_TAIL = CP_TAIL_WG * CP_TAIL_PER_WG;
__device__ __forceinline__ void copy_subchunk(Frame& F, int l, int c) {
    const int lane = F.lane, b = c / CP_PER_B, rc = c % CP_PER_B; const int gi = rc < 31 ? 0 : rc < 158 ? 1 : 2, k = rc - (gi == 0 ? 0 : gi == 1 ? 31 : 158), win = 128 << (2 * gi);
    const f32x4* src = (const f32x4*)(F.in[2 + gi] + ((size_t)(l * DB + b) * win + DS + 4 * k) * 1024) + lane;
    f32x4* dst = (f32x4*)(F.out + (gi == 0 ? O_SW1 : gi == 1 ? O_SW2 : O_SW3) + ((size_t)(l * DB + b) * win + 4 * k) * 1024) + lane;
    f32x4 v[16];
#pragma unroll
    for (int i = 0; i < 16; ++i) v[i] = __builtin_nontemporal_load(src + 64 * i);
#pragma unroll
    for (int i = 0; i < 16; ++i) __builtin_nontemporal_store(v[i], dst + 64 * i);
}
__device__ __forceinline__ void side_queue(Frame& F0, int l, volatile LAS unsigned* qctr) {
    RELANE(F0);
    const int lane = F.lane;
    const int nsub = CP_NSUB - (F.G == 256 ? CP_TAIL : 0);
    const int ncp = (nsub - (int)blockIdx.x + F.G - 1) / F.G;
    const int wper = 0,     w0 = (int)blockIdx.x * wper, nw = max(0, min(IT_LAYER, w0 + wper) - w0);
    LAS float* scr = (LAS float*)F.lds;
    for (;;) {
        unsigned q = 0; if (lane == 0) q = __hip_atomic_fetch_add((LAS unsigned*)qctr, 1u, __ATOMIC_RELAXED, __HIP_MEMORY_SCOPE_WORKGROUP);
        q = (unsigned)__builtin_amdgcn_readfirstlane((int)q);
        if ((int)q >= ncp + nw) break;
        if ((int)q < ncp) { copy_subchunk(F, l, (int)q * F.G + (int)blockIdx.x);
        } else weight_item(F, l + 1, w0 + (int)q - ncp, scr);
    }
}


__device__ __forceinline__ f32x16 skinny_kloop(const bf16* ap, const bf16* bp, int nks, f32x16 acc) {
    int ks = 0;
    for (; ks + 8 <= nks; ks += 8) { bf16x8 a[8], b[8];
#pragma unroll
        for (int u = 0; u < 8; ++u) { a[u] = *(const bf16x8*)(ap + 16 * (ks + u)); b[u] = *(const bf16x8*)(bp + 16 * (ks + u)); }
#pragma unroll
        for (int u = 0; u < 8; ++u) acc = __builtin_amdgcn_mfma_f32_32x32x16_bf16(a[u], b[u], acc, 0, 0, 0); }
    for (; ks < nks; ks += 4) { bf16x8 a[4], b[4];
#pragma unroll
        for (int u = 0; u < 4; ++u) { a[u] = *(const bf16x8*)(ap + 16 * (ks + u)); b[u] = *(const bf16x8*)(bp + 16 * (ks + u)); }
#pragma unroll
        for (int u = 0; u < 4; ++u) acc = __builtin_amdgcn_mfma_f32_32x32x16_bf16(a[u], b[u], acc, 0, 0, 0); }
    return acc;
}
__device__ __forceinline__ f32x2 skinny_reduce(Frame& F, const f32x16& acc) {
    LAS float* P = (LAS float*)F.lds; const int r = F.lane & 31, h = F.lane >> 5;
    __syncthreads();
#pragma unroll
    for (int i = 0; i < 16; ++i) P[(F.wave * 32 + (i & 3) + 8 * (i >> 2) + 4 * h) * 33 + r] = acc[i];
    __syncthreads();
    const int row = F.tid >> 4, col = 2 * (F.tid & 15); f32x2 o = {0.f, 0.f};
#pragma unroll
    for (int w = 0; w < 8; ++w) { o.x += P[(w * 32 + row) * 33 + col]; o.y += P[(w * 32 + row) * 33 + col + 1]; }
    return o;
}
__device__ __forceinline__ void skinny_store(Frame& F0, const bf16* A, int lda, const bf16* Bt, int K, bf16* O) {
    RELANE(F0);
    const int r = F.lane & 31, h = F.lane >> 5, kw = K / 8;
    for (int unit = launder_s((int)blockIdx.x); unit < 256; unit += F.G) {
        const int mt = unit >> 6, nt = unit & 63;
        f32x16 acc;
#pragma unroll
        for (int i = 0; i < 16; ++i) acc[i] = 0.f;
        acc = skinny_kloop(A + (size_t)(MP + 32 * mt + r) * lda + F.wave * kw + 8 * h, Bt + (size_t)(32 * nt + r) * K + F.wave * kw + 8 * h, kw / 16, acc);
        const f32x2 o = skinny_reduce(F, acc);
        *(unsigned*)(O + (size_t)(MP + 32 * mt + (F.tid >> 4)) * D + 32 * nt + 2 * (F.tid & 15)) = pk2(o.x, o.y);
    }
}
__device__ __forceinline__ void skinny_merge(Frame& F0, const unsigned char* wl) {
    RELANE(F0);
    const int r = F.lane & 31, h = F.lane >> 5; const bf16* PROJ = (const bf16*)(F.ws + WS_PROJ);
    for (int unit = launder_s((int)blockIdx.x); unit < 256; unit += F.G) {
        const int mt = unit >> 6, nt = unit & 63;
        f32x16 tot;
#pragma unroll
        for (int i = 0; i < 16; ++i) tot[i] = 0.f;
#pragma unroll
        for (int br = 0; br < 3; ++br) {
            const int K = br == 1 ? 512 : 1024, kw = K / 8;
            const bf16* A = (const bf16*)(F.ws + (br == 0 ? WS_OUTA : br == 1 ? WS_OUTB : WS_OC)); const bf16* Bt = (const bf16*)(wl + (br == 0 ? WO_BRA : br == 1 ? WO_BRB : WO_BRC));
            f32x16 acc;
#pragma unroll
            for (int i = 0; i < 16; ++i) acc[i] = 0.f;
            acc = skinny_kloop(A + (size_t)(MP + 32 * mt + r) * K + F.wave * kw + 8 * h, Bt + (size_t)(32 * nt + r) * K + F.wave * kw + 8 * h, kw / 16, acc);
            const bf16* gp = PROJ + (size_t)(MP + 32 * mt + 4 * h) * NIN + PC_GATE + br * 2048 + 32 * nt + r;
#pragma unroll
            for (int i = 0; i < 16; ++i) tot[i] += acc[i] * bf1(gp[(size_t)((i & 3) + 8 * (i >> 2)) * NIN]);
        }
        const f32x2 o = skinny_reduce(F, tot);
        *(unsigned*)((bf16*)(F.ws + WS_MERGED) + (size_t)(MP + 32 * mt + (F.tid >> 4)) * D + 32 * nt + 2 * (F.tid & 15)) = pk2(o.x, o.y);
    }
}

constexpr int N_PHASES = 1 + 11 * DEPTH;
__global__ void __launch_bounds__(NWAVES * 64, 2) fwd(Args args) {
    extern __shared__ __attribute__((aligned(16))) unsigned char lds_raw[];
    Frame F;
    F.lds = (LAS unsigned char*)lds_raw;
    F.tid = threadIdx.x; F.lane = F.tid & 63; F.wave = __builtin_amdgcn_readfirstlane(F.tid >> 6);
    F.G = gridDim.x; { const int bx = blockIdx.x; F.vcu = (F.G % 8 == 0) ? (bx % 8) * (F.G / 8) + bx / 8 : bx; }
    const CAS Args* const ap = (const CAS Args*)__builtin_amdgcn_kernarg_segment_ptr();
    F.in = ap->in; F.out = args.out; F.ws = args.ws;
    volatile LAS unsigned* MISC = (volatile LAS unsigned*)(F.lds + MISC_OFF);
    for (int u = F.tid; u < (LDS_BYTES - LDSCTL_OFF) / 4; u += NWAVES * 64) ((LAS unsigned*)(F.lds + LDSCTL_OFF))[u] = 0u;
    __syncthreads();
#if MK_ONE_LAUNCH
    XcdBarrier bar = xcd_barrier_post((unsigned*)(F.ws + WS_CTL) + CW_BAR, MISC + 8);
#define GRID_BAR() xcd_barrier(bar)
#else
#define GRID_BAR() do {} while (0)
#endif
    const int lo = args.ph_lo, hi = args.ph_hi;
#ifndef PHMASK
#define PHMASK 0xfff
#endif
#define IN(k) (lo <= (k) && (k) < hi)
#define EN(j) ((PHMASK >> (j)) & 1)
#ifndef REPMASK
#define REPMASK 0
#endif
#ifndef SUBREP
#define SUBREP 0
#endif
#define SUBR(j) for (int sr_ = 0; sr_ < 1 + ((SUBREP >> (j)) & 1); ++sr_)
#define REPEAT(j) for (int rep_ = 0; rep_ < 1 + ((REPMASK >> (j)) & 1); ++rep_)
#define REPBAR() do { if (rep_) GRID_BAR(); F.ws = launder_p(args.ws); F.out = launder_p(args.out); F.in = launder_k(ap->in); F.vcu = launder_s(vcu0); F.wave = launder_s(wave0); gw = F.vcu * NWAVES + F.wave; } while (0)
#define SEAM(k) do { if (IN(k) && IN((k) + 1)) GRID_BAR(); } while (0)
    const int vcu0 = F.vcu, wave0 = F.wave; int gw = F.vcu * NWAVES + F.wave; const int NGW = F.G * NWAVES;
    bf16* const H = (bf16*)(F.ws + WS_H); bf16* const PROJ = (bf16*)(F.ws + WS_PROJ);

    if (EN(0) && IN(0)) REPEAT(0) { REPBAR();
        LAS float* scr = (LAS float*)(F.lds + F.wave * 16384);
        for (int it = gw; it < 2 * IT_LAYER; it += NGW) { const int l = it >= IT_LAYER ? 1 : 0; weight_item(F, l, it - l * IT_LAYER, scr); }
        __syncthreads();
        stage_wba(F, 0);
        thin_rows<true>(F, F.in[0], F.in[1], nullptr, nullptr, nullptr, F.in[21], true, 0);
        __syncthreads();
    }
    SEAM(0);
#pragma unroll 1
    for (int l = 0; l < DEPTH; ++l) {
        const int pb = 1 + 11 * l;
        unsigned char* wl = F.ws + WS_W + (size_t)l * WL_BYTES;
        if (EN(1) && IN(pb + 0)) REPEAT(1) { REPBAR();
            pg8::Gemm g{H, (const bf16*)(wl + WO_IN), D, D, D, 0}; pg8::StaticOrder S; S.init(MT, NIN, launder_s(F.G), launder_s((int)blockIdx.x));
            EpiStore E{PROJ, NIN, PC_GATE / 256};
            pg8::gemm_phase<EpiStore, pg8::StaticOrder>(F.lds, g, S, E);
        }
        SEAM(pb + 0);
        if (EN(2) && IN(pb + 1)) REPEAT(2) { REPBAR(); for (int it = gw; it < PREP_ITEMS; it += NGW) prep_item(F, l, it); prep_out_rows(F, l); for (int it = gw; it < VT_ITEMS; it += NGW) vt_item(F, it); }
        SEAM(pb + 1);
        if (EN(3) && IN(pb + 2)) REPEAT(3) { REPBAR(); for (int it = gw; it < GCH; it += NGW) gdn_ga_item(F, it); }
        SEAM(pb + 2);
        if (EN(4) && IN(pb + 3)) REPEAT(4) { REPBAR();
            if (F.tid == 0) MISC[16] = 0u;
            { pg8::Gemm g{(const bf16*)(F.ws + WS_POOLED), (const bf16*)(wl + WO_POOL), 1024, 256, 256, 512}; pg8::StaticOrder S; S.init(MT, 1024, launder_s(F.G), launder_s((int)blockIdx.x));
              EpiStore E{(bf16*)(F.ws + WS_OC), 1024, 1 << 30};
              pg8::gemm_phase<EpiStore, pg8::StaticOrder>(F.lds, g, S, E); }
            SUBR(3) for (int it = gw; it < DB * HA * 8; it += NGW) { const int s = it & 7, bh = it >> 3, b = bh >> 3, h = bh & 7;
                gdn_scan_item(F, MP + DS * b, h, s, F.in[5] + (size_t)((l * DB + b) * HA + h) * 16384, F.out + O_SGDN + (size_t)((l * DB + b) * HA + h) * 16384); }
            {
                const bool scanw = (F.wave == 0) && (F.vcu < GSC_ITEMS);
                if (scanw) { SUBR(0) gdn_chunk_scan(F, l, F.vcu); }
                else {
                    const int aw = F.vcu < GSC_ITEMS ? F.vcu * 7 + F.wave - 1 : GSC_ITEMS * 7 + (F.vcu - GSC_ITEMS) * 8 + F.wave, naw = F.G * 8 - GSC_ITEMS;
                    SUBR(1) for (int it = aw; it < ATT_UNITS; it += naw) attn_unit(F, it);
                    SUBR(2) for (int it = (aw + naw - ATT_UNITS % naw) % naw; it < MS * 6; it += naw) attn_sample_item(F, l, it);
                }
            }
            side_queue(F, l, MISC + 16);
        }
        SEAM(pb + 3);
        if (EN(5) && IN(pb + 4)) REPEAT(5) { REPBAR(); gdn_gate_rows(F, l); }
        SEAM(pb + 4);
        if (EN(6) && IN(pb + 5)) REPEAT(6) { REPBAR();
            pg8::StaticOrder S; S.init(MP, D, launder_s(F.G), launder_s((int)blockIdx.x)); bf16* MG = (bf16*)(F.ws + WS_MERGED);
            { pg8::Gemm g{(const bf16*)(F.ws + WS_OUTA), (const bf16*)(wl + WO_BRA), 1024, 1024, 1024, 0}; EpiMerge<false> E{MG, PROJ + PC_GATE}; pg8::gemm_phase<EpiMerge<false>, pg8::StaticOrder>(F.lds, g, S, E); }
            { pg8::Gemm g{(const bf16*)(F.ws + WS_OUTB), (const bf16*)(wl + WO_BRB), 512, 512, 512, 0}; EpiMerge<true> E{MG, PROJ + PC_GATE + 2048}; pg8::gemm_phase<EpiMerge<true>, pg8::StaticOrder>(F.lds, g, S, E); }
            { pg8::Gemm g{(const bf16*)(F.ws + WS_OC), (const bf16*)(wl + WO_BRC), 1024, 1024, 1024, 0}; EpiMerge<true> E{MG, PROJ + PC_GATE + 4096}; pg8::gemm_phase<EpiMerge<true>, pg8::StaticOrder>(F.lds, g, S, E); }
            skinny_merge(F, wl);
        }
        SEAM(pb + 5);
        if (EN(7) && IN(pb + 6)) REPEAT(7) { REPBAR();
            pg8::Gemm g{(const bf16*)(F.ws + WS_MERGED), (const bf16*)(wl + WO_OUT), D, D, D, 0}; pg8::StaticOrder S; S.init(MP, D, launder_s(F.G), launder_s((int)blockIdx.x));
            EpiStore E{(bf16*)(F.ws + WS_Y), D, 1 << 30};
            pg8::gemm_phase<EpiStore, pg8::StaticOrder>(F.lds, g, S, E);
            skinny_store(F, (const bf16*)(F.ws + WS_MERGED), D, (const bf16*)(wl + WO_OUT), D, (bf16*)(F.ws + WS_Y));
        }
        SEAM(pb + 6);
        if (EN(8) && IN(pb + 7)) REPEAT(8) { REPBAR();
            thin_rows<false>(F, nullptr, nullptr, (const bf16*)(F.ws + WS_Y), F.in[22] + (size_t)l * D, nullptr, F.in[23] + (size_t)l * D, false, 0, 0);
        }
        SEAM(pb + 7);
        if (EN(9) && IN(pb + 8)) REPEAT(9) { REPBAR();
            pg8::Gemm g{H, (const bf16*)(wl + WO_GU), D, D, D, 0}; pg8::StaticOrder S; S.init(MT, 2 * DFF, launder_s(F.G), launder_s((int)blockIdx.x));
            EpiSwiglu E{(bf16*)(F.ws + WS_ACT)};
            pg8::gemm_phase<EpiSwiglu, pg8::StaticOrder>(F.lds, g, S, E);
            const int bxl = launder_s((int)blockIdx.x), Gl = launder_s(F.G);
            if (Gl == 256 && bxl >= 256 - CP_TAIL_WG) {
                Frame Fc = F; Fc.lane = launder(F.lane);
                const int base = CP_NSUB - CP_TAIL + (bxl - (256 - CP_TAIL_WG)) * CP_TAIL_PER_WG;
                for (int q = F.wave; q < CP_TAIL_PER_WG; q += NWAVES) copy_subchunk(Fc, 1 - l, base + q);
            }
        }
        SEAM(pb + 8);
        if (EN(10) && IN(pb + 9)) REPEAT(10) { REPBAR();
            pg8::Gemm g{(const bf16*)(F.ws + WS_ACT), (const bf16*)(wl + WO_DOWN), DFF, DFF, DFF, 0}; pg8::StaticOrder S; S.init(MP, D, launder_s(F.G), launder_s((int)blockIdx.x));
            EpiStore E{(bf16*)(F.ws + WS_Y), D, 1 << 30};
            pg8::gemm_phase<EpiStore, pg8::StaticOrder>(F.lds, g, S, E);
            skinny_store(F, (const bf16*)(F.ws + WS_ACT), DFF, (const bf16*)(wl + WO_DOWN), DFF, (bf16*)(F.ws + WS_Y));
        }
        SEAM(pb + 9);
        if (EN(11) && IN(pb + 10)) REPEAT(11) { REPBAR();
            if (l + 1 < DEPTH) { stage_wba(F, l + 1);
                thin_rows<false>(F, nullptr, nullptr, (const bf16*)(F.ws + WS_Y), F.in[24] + (size_t)l * D, nullptr, F.in[21] + (size_t)(l + 1) * D, true, l + 1, 0);
                __syncthreads(); }
            else thin_rows<false>(F, nullptr, nullptr, (const bf16*)(F.ws + WS_Y), F.in[24] + (size_t)l * D, F.out + O_YP, nullptr, false, 0, 0);
        }
        SEAM(pb + 10);
    }
#undef IN
#undef SEAM
}

extern "C" void kernel_launch(void* const* d_in, const int* in_sizes, int n_in, void* d_out, int out_size, void* d_ws, size_t ws_size, hipStream_t stream) {
    static int grid = 0;
    if (grid == 0) {
        if (n_in != 25 || (size_t)out_size != O_END || ws_size < WS_END) { fprintf(stderr, "kernel_launch: unexpected sizes n_in %d out %d ws %zu\n", n_in, out_size, ws_size); grid = -1; return; }
        int dev = 0, cus = 0, per_cu = 0;
        if (hipGetDevice(&dev) != hipSuccess || hipDeviceGetAttribute(&cus, hipDeviceAttributeMultiprocessorCount, dev) != hipSuccess) { grid = -1; return; }
        if (hipFuncSetAttribute((const void*)fwd, hipFuncAttributeMaxDynamicSharedMemorySize, LDS_BYTES) != hipSuccess) { fprintf(stderr, "kernel_launch: hipFuncSetAttribute failed\n"); grid = -1; return; }
        if (hipOccupancyMaxActiveBlocksPerMultiprocessor(&per_cu, (const void*)fwd, NWAVES * 64, LDS_BYTES) != hipSuccess || per_cu < 1) fprintf(stderr, "kernel_launch: occupancy query says %d\n", per_cu);
        (void)hipGetLastError();
        grid = cus;
    }
    if (grid < 0) return;
    if (hipMemsetAsync((char*)d_ws + WS_CTL, 0, CTL_BYTES, stream) != hipSuccess) return;
    Args a{};
    for (int i = 0; i < 25; ++i) a.in[i] = (const float*)d_in[i];
    a.out = (float*)d_out; a.ws = (unsigned char*)d_ws;
#if MK_ONE_LAUNCH
    a.ph_lo = 0; a.ph_hi = N_PHASES;
    hipLaunchKernelGGL(fwd, dim3(grid), dim3(NWAVES * 64), LDS_BYTES, stream, a);
#else
    for (int p = 0; p < N_PHASES; ++p) { a.ph_lo = p; a.ph_hi = p + 1; hipLaunchKernelGGL(fwd, dim3(grid), dim3(NWAVES * 64), LDS_BYTES, stream, a); }
#endif
}
```

```cpp
#include <hip/hip_runtime.h>
#include <cstdio>
#include <cstdint>

#ifndef MK_ONE_LAUNCH
#define MK_ONE_LAUNCH 1
#endif

#define GAS __attribute__((address_space(1)))
#define CAS __attribute__((address_space(4)))
typedef const float* cfp_t;
#define LAS __attribute__((address_space(3)))
typedef unsigned short bf16;
typedef unsigned v4u __attribute__((ext_vector_type(4)));
typedef unsigned v2u __attribute__((ext_vector_type(2)));
typedef float f32x4 __attribute__((ext_vector_type(4)));
typedef float f32x2 __attribute__((ext_vector_type(2)));
typedef short bf16x8 __attribute__((ext_vector_type(8)));
typedef float f32x16 __attribute__((ext_vector_type(16)));

constexpr int D = 2048, BATCH = 4, SEQ = 2048, DEPTH = 2, DB = 32, DS = 4;
constexpr int MP = BATCH * SEQ;
constexpr int MS = DB * DS;
constexpr int MV = MP + MS;
constexpr int MT = 8448;
constexpr int HA = 8, CONVCH = 3072;
constexpr int CPOOL = 1024, PHIST = 15;
constexpr int DFF = 5632;
constexpr int NIN_SRC = 15888, NIN = 15872;
constexpr int PC_ZA = 3072, PC_QB = 4096, PC_KB = 5632, PC_VB = 7168, PC_UC = 8704, PC_GATE = 9728;
constexpr float EPS = 1e-6f;
constexpr size_t O_YP = 0, O_YS = O_YP + (size_t)MP * D, O_PW1 = O_YS + (size_t)MS * D;
constexpr size_t O_PW2 = O_PW1 + (size_t)2 * 4 * 128 * 1024, O_PW3 = O_PW2 + (size_t)2 * 4 * 512 * 1024, O_PGDN = O_PW3 + (size_t)2 * 4 * 2048 * 1024;
constexpr size_t O_PCONV = O_PGDN + (size_t)2 * 4 * 8 * 16384, O_PPOOL = O_PCONV + (size_t)2 * 4 * 3 * 3072, O_SW1 = O_PPOOL + (size_t)2 * 4 * 15 * 1024;
constexpr size_t O_SW2 = O_SW1 + (size_t)2 * 32 * 128 * 1024, O_SW3 = O_SW2 + (size_t)2 * 32 * 512 * 1024, O_SGDN = O_SW3 + (size_t)2 * 32 * 2048 * 1024;
constexpr size_t O_SCONV = O_SGDN + (size_t)2 * 32 * 8 * 16384, O_SPOOL = O_SCONV + (size_t)2 * 32 * 3 * 3072, O_END = O_SPOOL + (size_t)2 * 32 * 15 * 1024;
static_assert(O_END == 226426880ull, "output size");

constexpr size_t WS_CTL = 0, CTL_BYTES = 1u << 20;
constexpr size_t SZ_WIN = (size_t)NIN * D * 2, SZ_WBRA = (size_t)D * 1024 * 2, SZ_WBRB = (size_t)D * 512 * 2, SZ_WBRC = (size_t)D * 1024 * 2, SZ_WPOOL = (size_t)4 * 256 * 256 * 2;
constexpr size_t SZ_WOUT = (size_t)D * D * 2, SZ_WGU = (size_t)2 * DFF * D * 2, SZ_WDOWN = (size_t)D * DFF * 2;
constexpr size_t WO_IN = 0, WO_BRA = WO_IN + SZ_WIN, WO_BRB = WO_BRA + SZ_WBRA, WO_BRC = WO_BRB + SZ_WBRB, WO_POOL = WO_BRC + SZ_WBRC, WO_OUT = WO_POOL + SZ_WPOOL;
constexpr size_t WO_GU = WO_OUT + SZ_WOUT, WO_DOWN = WO_GU + SZ_WGU, WL_BYTES = WO_DOWN + SZ_WDOWN;
constexpr size_t WS_W = CTL_BYTES;
constexpr size_t WS_H = WS_W + 2 * WL_BYTES;
constexpr size_t WS_PROJ = WS_H + (size_t)MT * D * 2;
constexpr size_t WS_GB = WS_PROJ + (size_t)MT * NIN * 2;
constexpr size_t WS_TOK = WS_GB + (size_t)MT * 16 * 4;
constexpr size_t WS_QN = WS_TOK + (size_t)MT * 8 * 16;
constexpr size_t WS_KN = WS_QN + (size_t)MT * 1024 * 2;
constexpr size_t WS_VV = WS_KN + (size_t)MT * 1024 * 2;
constexpr size_t WS_ORAW = WS_VV + (size_t)MT * 1024 * 2;
constexpr size_t WS_POOLED = WS_ORAW + (size_t)MT * 1024 * 4;
constexpr size_t WS_OUTA = WS_POOLED + (size_t)MT * 1024 * 2;
constexpr size_t WS_OUTB = WS_OUTA + (size_t)MT * 1024 * 2;
constexpr size_t WS_OC = WS_OUTB + (size_t)MT * 512 * 2;
constexpr size_t WS_MERGED = WS_OC + (size_t)MT * 1024 * 2;
constexpr size_t WS_Y = WS_MERGED + (size_t)MT * D * 2;
constexpr size_t WS_X1 = WS_Y + (size_t)MT * D * 2;
constexpr size_t WS_X2 = WS_X1 + (size_t)MT * D * 4;
constexpr size_t WS_ACT = WS_X2 + (size_t)MT * D * 4;
constexpr size_t WS_VT = WS_ACT + (size_t)MT * DFF * 2;
constexpr size_t WS_OBG = WS_VT + (size_t)BATCH * 3 * 4 * 128 * 2048 * 2;
constexpr size_t WS_AST = WS_OBG + (size_t)6 * MV * 512 * 2;
constexpr int GCH = BATCH * HA * (SEQ / 32);
constexpr size_t WS_WF = WS_AST + (size_t)6 * MV * 4 * 8;
constexpr size_t WS_KF = WS_WF + (size_t)GCH * 8192;
constexpr size_t WS_UF = WS_KF + (size_t)GCH * 8192;
constexpr size_t WS_AF = WS_UF + (size_t)GCH * 16384;
constexpr size_t WS_TB = WS_AF + (size_t)GCH * 2048;
constexpr size_t WS_QF = WS_TB + (size_t)GCH * 128;
constexpr size_t WS_XCH = WS_QF + (size_t)GCH * 8192;
constexpr size_t WS_PAD = WS_XCH + (size_t)4 * 32 * 256 * 8 * 16;
constexpr size_t WS_END = WS_PAD + (size_t)1024 * 16 * 512 * 4;
static_assert(WS_END < 2000000000ull, "workspace");

__device__ __forceinline__ int lane_id() { return (int)__builtin_amdgcn_mbcnt_hi(~0u, __builtin_amdgcn_mbcnt_lo(~0u, 0u)); }
namespace pg8 {
#define PG8_LAS __attribute__((address_space(3)))
typedef unsigned short bf16_t;
typedef unsigned u32x4 __attribute__((ext_vector_type(4)));
constexpr int BM = 256, BK = 64, HALF = 128, HTB = HALF * BK * 2, STAGE_BYTES = 8 * HTB, NXCD = 8, WGM = 8;
__host__ __device__ __forceinline__ int lds_byte(int r, int c) { const int st = (r >> 4) * 2 + (c >> 5), rr = r & 15, cc = c & 31, ob = rr * 64 + cc * 2; return st * 1024 + (ob ^ (((ob >> 9) & 1) << 5)); }
__host__ __device__ __forceinline__ void stage_rc(int b, int& R, int& C) { const int st = b / 1024, sb = b % 1024, swz = sb ^ (((sb >> 9) & 1) << 5); R = (st >> 1) * 16 + swz / 64; C = (st & 1) * 32 + (swz % 64) / 2; }
__host__ __device__ __forceinline__ int perm32(int rho) { const int n = rho >> 4, i = rho & 15; return 8 * (i >> 2) + 4 * n + (i & 3); }
struct Unit { int pm, pn; };
struct Gemm { const bf16_t* A; const bf16_t* Bt; int lda, ldb, K; int a_pn_step; unsigned* pad = nullptr; };
struct StaticOrder {
    int nM, nN, nwg, G, c;
    __host__ __device__ void init(int M, int N, int G_, int c_) { nM = M / BM; nN = N / BM; nwg = nM * nN; G = G_; c = c_; }
    __host__ __device__ bool next(int i, Unit& u) const {
        const long L = (long)i * G + c; if (L >= nwg) return false;
        int wgid = (int)L; { const int q = nwg / NXCD, r = nwg % NXCD, xcd = wgid % NXCD, off = wgid / NXCD; wgid = (xcd < r ? xcd * (q + 1) : r * (q + 1) + (xcd - r) * q) + off; }
        const int nig = WGM * nN, gid = wgid / nig, fm = gid * WGM, gsz = (nM - fm) < WGM ? (nM - fm) : WGM;
        u.pm = fm + ((wgid % nig) % gsz); u.pn = (wgid % nig) / gsz; return true;
    }
    __device__ __forceinline__ void a_ready(const Unit&) const {}
    __device__ __forceinline__ void done(const Unit&) const {}
};
__device__ __forceinline__ unsigned cvt_pk_bf16(float lo, float hi) { unsigned r; asm volatile("v_cvt_pk_bf16_f32 %0, %1, %2" : "=v"(r) : "v"(lo), "v"(hi)); return r; }

template <class Epi, class Sched, bool ALIGN_EPI = true, bool RELAX = false>
__device__ __forceinline__ void gemm_phase(PG8_LAS unsigned char* lds, const Gemm g, const Sched& S, const Epi& E) {
    int tid = threadIdx.x; asm volatile("" : "+v"(tid));
    const int wid = __builtin_amdgcn_readfirstlane(tid >> 6), lane = tid & 63, wr = wid >> 2, wc = wid & 3, fr = lane & 15, fq = lane >> 4;
    int K = g.K; asm volatile("" : "+s"(K));
    const int nt = K / BK;
    unsigned voffA[2], voffB[2];
#pragma unroll
    for (int i = 0; i < 2; ++i) { int R, C; stage_rc(tid * 16 + i * 8192, R, C); const int Rb = ((R & ~31) + perm32(R & 31));
        voffA[i] = (unsigned)(R * g.lda + C) * 2u; voffB[i] = (unsigned)(Rb * g.ldb + C) * 2u; }
    const size_t kstep = (size_t)(BK * 2);
    const size_t hstepA = (size_t)HALF * g.lda * 2, hstepB = (size_t)HALF * g.ldb * 2;
    const size_t tstepA = 2 * hstepA, tstepB = 2 * hstepB;
    const unsigned ldsw = (unsigned)wid * 1024u;
    const int aoff = lds_byte(wr * 64 + fr, fq * 8), boff = lds_byte(wc * 32 + fr, fq * 8);
#define PG8_SA(b, h) (((b) * 2 + (h)) * HTB)
#define PG8_SB(b, h) ((4 + (b) * 2 + (h)) * HTB)
#define PG8_STAGE(bufoff, gbase, voff) do { const char* _gb = (const char*)(gbase); asm volatile("" : "+s"(_gb));     \
        _Pragma("unroll") for (int _i = 0; _i < 2; ++_i) { unsigned _vo = (voff)[_i]; asm volatile("" : "+v"(_vo));     \
        __builtin_amdgcn_global_load_lds((const unsigned*)(_gb + _vo), (PG8_LAS unsigned*)(lds + (bufoff) + ldsw + _i * 8192), 16, 0, 0); } } while (0)
#define PG8_LDA(dst, b, h) do { _Pragma("unroll") for (int m = 0; m < 4; ++m) _Pragma("unroll") for (int k = 0; k < 2; ++k) dst[m][k] = *(const PG8_LAS bf16x8*)(lds + PG8_SA(b, h) + aoff + m * 2048 + k * 1024); } while (0)
#define PG8_LDB(dst, b, h) do { _Pragma("unroll") for (int n = 0; n < 2; ++n) _Pragma("unroll") for (int k = 0; k < 2; ++k) dst[n][k] = *(const PG8_LAS bf16x8*)(lds + PG8_SB(b, h) + boff + n * 2048 + k * 1024); } while (0)
#define PG8_MMA(ai, bj, At, Bt) do { __builtin_amdgcn_s_setprio(1); _Pragma("unroll") for (int m = 0; m < 4; ++m) _Pragma("unroll") for (int n = 0; n < 2; ++n) _Pragma("unroll") for (int k = 0; k < 2; ++k) \
        acc[ai][bj][m][n] = __builtin_amdgcn_mfma_f32_16x16x32_bf16(Bt[n][k], At[m][k], acc[ai][bj][m][n], 0, 0, 0); __builtin_amdgcn_s_setprio(0); } while (0)
#define PG8_WAIT_V(n) asm volatile("s_waitcnt vmcnt(" #n ")" ::: "memory")
#define PG8_WAIT_L(n) asm volatile("s_waitcnt lgkmcnt(" #n ")" ::: "memory")
#define PG8_BAR __builtin_amdgcn_s_barrier()
#define PG8_SCHED __builtin_amdgcn_sched_barrier(0)
    Unit cur, nxt; int ui = 0;
    if (!S.next(0, cur)) return;
    f32x4 acc[2][2][4][2];
#pragma unroll
    for (int a = 0; a < 2; ++a)
#pragma unroll
        for (int b = 0; b < 2; ++b)
#pragma unroll
            for (int m = 0; m < 4; ++m)
#pragma unroll
                for (int n = 0; n < 2; ++n) acc[a][b][m][n] = (f32x4){0.f, 0.f, 0.f, 0.f};
    bf16x8 At[4][2], B0[2][2], B1[2][2];
    const char* cA = (const char*)g.A + (size_t)cur.pm * tstepA + (size_t)cur.pn * (size_t)g.a_pn_step; const char* cB = (const char*)g.Bt + (size_t)cur.pn * tstepB;
    S.a_ready(cur);
    PG8_STAGE(PG8_SB(0, 0), cB, voffB); PG8_STAGE(PG8_SB(0, 1), cB + hstepB, voffB); PG8_STAGE(PG8_SA(0, 0), cA, voffA); PG8_STAGE(PG8_SA(0, 1), cA + hstepA, voffA);
    if (wr == 1) PG8_BAR;
    PG8_WAIT_V(2); PG8_BAR;
    PG8_STAGE(PG8_SB(1, 0), cB + kstep, voffB); PG8_STAGE(PG8_SA(1, 0), cA + kstep, voffA); PG8_STAGE(PG8_SB(1, 1), cB + hstepB + kstep, voffB);
    PG8_WAIT_V(6); PG8_BAR;
    if constexpr (RELAX && Epi::NSTORE > 0) {
#pragma unroll
        for (int i = 0; i < Epi::NSTORE; ++i) __builtin_nontemporal_store((unsigned)tid, (__attribute__((address_space(1))) unsigned*)g.pad + ((size_t)blockIdx.x * 16 + i) * 512 + tid);
    }
    for (;;) {
        const bool has_next = S.next(ui + 1, nxt);
        const char* nA = has_next ? (const char*)g.A + (size_t)nxt.pm * tstepA + (size_t)nxt.pn * (size_t)g.a_pn_step : cA; const char* nB = has_next ? (const char*)g.Bt + (size_t)nxt.pn * tstepB : cB;
#define PG8_TRIP(W1, W2) do { \
            const bool last = (t == nt - 2); \
            const char* a1 = cA + (size_t)(t + 1) * kstep; \
            const char* a2 = last ? nA : cA + (size_t)(t + 2) * kstep; const char* b2 = last ? nB : cB + (size_t)(t + 2) * kstep; \
            const char* a3 = a2 + kstep; const char* b3 = b2 + kstep; \
            if (last && has_next) S.a_ready(nxt); \
            PG8_LDB(B0, 0, 0); PG8_LDB(B1, 0, 1); PG8_SCHED; PG8_LDA(At, 0, 0); PG8_STAGE(PG8_SA(1, 1), a1 + hstepA, voffA); \
            W1; PG8_WAIT_L(0); PG8_BAR; PG8_MMA(0, 0, At, B0); PG8_MMA(0, 1, At, B1); PG8_BAR; PG8_SCHED; \
            PG8_LDA(At, 0, 1); PG8_STAGE(PG8_SB(0, 0), b2, voffB); PG8_STAGE(PG8_SB(0, 1), b2 + hstepB, voffB); PG8_STAGE(PG8_SA(0, 0), a2, voffA); \
            W2; PG8_WAIT_L(0); PG8_BAR; PG8_MMA(1, 0, At, B0); PG8_MMA(1, 1, At, B1); PG8_BAR; PG8_SCHED; \
            PG8_LDB(B0, 1, 0); PG8_LDB(B1, 1, 1); PG8_SCHED; PG8_LDA(At, 1, 0); PG8_STAGE(PG8_SA(0, 1), a2 + hstepA, voffA); \
            PG8_WAIT_V(8); PG8_WAIT_L(0); PG8_BAR; PG8_MMA(0, 0, At, B0); PG8_MMA(0, 1, At, B1); PG8_BAR; PG8_SCHED; \
            PG8_LDA(At, 1, 1); PG8_STAGE(PG8_SB(1, 0), b3, voffB); PG8_STAGE(PG8_SB(1, 1), b3 + hstepB, voffB); PG8_STAGE(PG8_SA(1, 0), a3, voffA); \
            PG8_WAIT_V(8); PG8_WAIT_L(0); PG8_BAR; PG8_MMA(1, 0, At, B0); PG8_MMA(1, 1, At, B1); PG8_BAR; PG8_SCHED; } while (0)
        int t = 0;
        if constexpr (RELAX && Epi::NSTORE == 16) { PG8_TRIP(PG8_WAIT_V(24), PG8_WAIT_V(24)); t = 2; }
        if constexpr (RELAX && Epi::NSTORE == 8) { PG8_TRIP(PG8_WAIT_V(16), PG8_WAIT_V(16)); t = 2; }
        for (; t < nt; t += 2) PG8_TRIP(PG8_WAIT_V(8), PG8_WAIT_V(8));
#undef PG8_TRIP
        if constexpr (ALIGN_EPI) { if (wr == 0) PG8_BAR; }
        if constexpr (!Epi::AFTER_DRAIN) { E(acc, cur, wr, wc, fr, fq); S.done(cur); }
        if (!has_next) break;
#pragma unroll
        for (int a = 0; a < 2; ++a)
#pragma unroll
            for (int b = 0; b < 2; ++b)
#pragma unroll
                for (int m = 0; m < 4; ++m)
#pragma unroll
                    for (int n = 0; n < 2; ++n) acc[a][b][m][n] = (f32x4){0.f, 0.f, 0.f, 0.f};
        cur = nxt; cA = nA; cB = nB; ++ui;
        if constexpr (ALIGN_EPI) { if (wr == 1) PG8_BAR; }
    }
    PG8_WAIT_V(0);
    if constexpr (!ALIGN_EPI) { if (wr == 0) PG8_BAR; }
    PG8_BAR;
    if constexpr (Epi::AFTER_DRAIN) { E.fused(acc, cur, wr, wc, fr, fq, lds, wid, lane); S.done(cur); }
#undef PG8_SA
#undef PG8_SB
#undef PG8_STAGE
#undef PG8_LDA
#undef PG8_LDB
#undef PG8_MMA
#undef PG8_WAIT_V
#undef PG8_WAIT_L
#undef PG8_BAR
#undef PG8_SCHED
}
}

#define LDS_WAIT() asm volatile("s_waitcnt lgkmcnt(0)" ::: "memory")
#define VM_WAIT() asm volatile("s_waitcnt vmcnt(0)" ::: "memory")
__device__ __forceinline__ unsigned f2bf(float f) { unsigned u = __builtin_bit_cast(unsigned, f); return (u + 0x7fffu + ((u >> 16) & 1u)) >> 16; }
typedef __bf16 bf16v2 __attribute__((ext_vector_type(2)));
__device__ __forceinline__ unsigned pk2(float lo, float hi) { const f32x2 v = {lo, hi}; return __builtin_bit_cast(unsigned, __builtin_convertvector(v, bf16v2)); }
__device__ __forceinline__ float bf_lo(unsigned u) { return __builtin_bit_cast(float, u << 16); }
__device__ __forceinline__ float bf_hi(unsigned u) { return __builtin_bit_cast(float, u & 0xffff0000u); }
__device__ __forceinline__ float bf1(bf16 b) { return __builtin_bit_cast(float, ((unsigned)b) << 16); }
__device__ __forceinline__ void unpack8(const v4u u, float (&x)[8]) { x[0] = bf_lo(u.x); x[1] = bf_hi(u.x); x[2] = bf_lo(u.y); x[3] = bf_hi(u.y); x[4] = bf_lo(u.z); x[5] = bf_hi(u.z); x[6] = bf_lo(u.w); x[7] = bf_hi(u.w); }
__device__ __forceinline__ v4u pack8(const float (&x)[8]) { v4u o; o.x = pk2(x[0], x[1]); o.y = pk2(x[2], x[3]); o.z = pk2(x[4], x[5]); o.w = pk2(x[6], x[7]); return o; }
__device__ __forceinline__ float wave_max(float v) {
#pragma unroll
    for (int o = 1; o < 64; o <<= 1) v = fmaxf(v, __shfl_xor(v, o));
    return v;
}
template <int CTRL> __device__ __forceinline__ float dpp_f(float x) { return __builtin_bit_cast(float, __builtin_amdgcn_update_dpp(0, __builtin_bit_cast(int, x), CTRL, 0xf, 0xf, true)); }
__device__ __forceinline__ float row16_sum(float x) { x += dpp_f<0xB1>(x); x += dpp_f<0x4E>(x); x += dpp_f<0x124>(x); x += dpp_f<0x128>(x); return x; }
__device__ __forceinline__ float wave_sum(float v) { v = row16_sum(v); v += __shfl_xor(v, 16); v += __shfl_xor(v, 32); return v; }
__device__ __forceinline__ float sigm(float x) { return __builtin_amdgcn_rcpf(1.f + __expf(-x)); }
__device__ __forceinline__ float silu(float x) { return x * __builtin_amdgcn_rcpf(1.f + __expf(-x)); }

#define XB_TMO      128
#define XB_XCNT(j)  (256  + 64 * (j))
#define XB_XSUB(j)  (1280 + 64 * (j))
#define XB_XGEN(j)  (2304 + 64 * (j))
#define XB_TOP      3328
#define XB_TOPGEN   3392
#define XCD_BAR_WORDS 3456
#define XB_SPIN_CAP (1u << 18)
__device__ __forceinline__ unsigned xb_ld(unsigned* p)              { return __hip_atomic_load(p, __ATOMIC_RELAXED, __HIP_MEMORY_SCOPE_AGENT); }
__device__ __forceinline__ unsigned xb_add(unsigned* p, unsigned v) { return __hip_atomic_fetch_add(p, v, __ATOMIC_RELAXED, __HIP_MEMORY_SCOPE_AGENT); }
__device__ __forceinline__ unsigned xb_xcc_id() { return (unsigned)__builtin_amdgcn_s_getreg((3 << 11) | 20) & 0xFu; }
#define XB_SPIN(cond, bar) do { unsigned _sp = 0; while (cond) { __builtin_amdgcn_s_sleep(1); \
    if ((++_sp & 255u) == 0u) { if (xb_ld(&(bar)[XB_TMO])) break; if (_sp > XB_SPIN_CAP) { atomicAdd(&(bar)[XB_TMO], 1u); break; } } } } while (0)
struct XcdBarrier { unsigned* bar; unsigned x; volatile LAS unsigned* st; };
__device__ __forceinline__ XcdBarrier xcd_barrier_post(unsigned* bar, volatile LAS unsigned* st) {
    XcdBarrier b; b.bar = bar; b.x = xb_xcc_id(); b.st = st;
    if (threadIdx.x == 0) (void)xb_add(&bar[XB_XCNT(b.x)], 1u);
    return b;
}
__device__ __forceinline__ void xcd_barrier_complete(unsigned* bar, unsigned x, unsigned& nloc, unsigned& nx) {
    const unsigned G = gridDim.x * gridDim.y * gridDim.z;
    unsigned sum, cnt, mine, sp = 0u;
    for (;;) {
        sum = 0u; cnt = 0u; mine = 0u;
#pragma unroll
        for (unsigned j = 0; j < 16; ++j) { const unsigned c = xb_ld(&bar[XB_XCNT(j)]); sum += c; cnt += (c > 0u) ? 1u : 0u; mine = (j == x) ? c : mine; }
        if (sum == G) break;
        __builtin_amdgcn_s_sleep(1);
        if ((++sp & 255u) == 0u) { if (xb_ld(&bar[XB_TMO])) break; if (sp > XB_SPIN_CAP) { atomicAdd(&bar[XB_TMO], 1u); break; } }
    }
    nloc = mine > 0u ? mine : 1u; nx = cnt > 0u ? cnt : 1u;
}
__device__ __forceinline__ void xcd_barrier(const XcdBarrier& b) {
    asm volatile("s_waitcnt vmcnt(0)" ::: "memory");
    __syncthreads();
    if (threadIdx.x == 0) {
        unsigned* bar = b.bar;
        __builtin_amdgcn_s_waitcnt(0);
        unsigned nloc = b.st[0], nx = b.st[1];
        if (nloc == 0u) { xcd_barrier_complete(bar, b.x, nloc, nx); b.st[0] = nloc; b.st[1] = nx; }
        const unsigned old = xb_add(&bar[XB_XSUB(b.x)], 1u);
        const unsigned gen = old / nloc;
        if (old + 1u == (gen + 1u) * nloc) {
            __builtin_amdgcn_fence(__ATOMIC_RELEASE, "agent");
            asm volatile("s_waitcnt vmcnt(0)" ::: "memory");
            const unsigned og = xb_add(&bar[XB_TOP], 1u);
            const unsigned tg = og / nx;
            if (og + 1u == (tg + 1u) * nx) xb_add(&bar[XB_TOPGEN], 1u);
            else XB_SPIN(xb_ld(&bar[XB_TOPGEN]) == tg, bar);
            __builtin_amdgcn_fence(__ATOMIC_ACQUIRE, "agent");
            xb_add(&bar[XB_XGEN(b.x)], 1u);
            asm volatile("s_waitcnt vmcnt(0)" ::: "memory");
        } else {
            XB_SPIN(xb_ld(&bar[XB_XGEN(b.x)]) == gen, bar);
            __builtin_amdgcn_fence(__ATOMIC_ACQUIRE, "agent");
            asm volatile("s_waitcnt vmcnt(0)" ::: "memory");
        }
    }
    __syncthreads();
}

constexpr int NWAVES = 8;
constexpr int RING_BYTES = 131072, SCANTV_BYTES = 0, LDSCTL_OFF = RING_BYTES + SCANTV_BYTES, MISC_OFF = LDSCTL_OFF + 320, LDS_BYTES = 147456;
constexpr int CW_BAR = 4096;
constexpr int CW_TMO = 0, CW_RMS = 16384, RMS_BANK = 2048;

struct Args { const float* in[25]; float* out; unsigned char* ws; int ph_lo, ph_hi; };
struct Frame {
    LAS unsigned char* lds;
    int tid, lane, wave, vcu, G;
    const CAS cfp_t* in; float* out; unsigned char* ws;
};

__device__ __forceinline__ int launder(int x) { asm volatile("" : "+v"(x)); return x; }
__device__ __forceinline__ int launder_s(int x) { asm volatile("" : "+s"(x)); return x; }
template <class T> __device__ __forceinline__ T* launder_p(T* p) { asm volatile("" : "+s"(p)); return p; }
__device__ __forceinline__ const CAS cfp_t* launder_k(const CAS cfp_t* p) { asm volatile("" : "+s"(p)); return p; }
#define RELANE(F0) Frame F = F0; F.lane = launder(F0.lane); F.tid = launder(F0.tid)

struct EpiStore {
    static constexpr bool AFTER_DRAIN = false; static constexpr int NSTORE = 16;
    bf16* O; int ldc; int sig_pn;
    __device__ __forceinline__ void operator()(const f32x4 (&acc)[2][2][4][2], const pg8::Unit& u, int wr, int wc, int fr, int fq) const {
        { const int l_ = launder(lane_id()); fr = l_ & 15; fq = l_ >> 4; }
        const int row0 = u.pm * 256 + wr * 64 + fr, col0 = u.pn * 256 + wc * 32 + 8 * fq; const bool sg = u.pn >= sig_pn;
#pragma unroll
        for (int ai = 0; ai < 2; ++ai)
#pragma unroll
            for (int m = 0; m < 4; ++m) { bf16* rowp = O + (size_t)(row0 + ai * 128 + m * 16) * ldc + col0;
#pragma unroll
                for (int bj = 0; bj < 2; ++bj) { f32x4 v0 = acc[ai][bj][m][0], v1 = acc[ai][bj][m][1];
                    if (sg) {
#pragma unroll
                        for (int j = 0; j < 4; ++j) { v0[j] = sigm(v0[j]); v1[j] = sigm(v1[j]); } }
                    v4u w; w.x = pg8::cvt_pk_bf16(v0[0], v0[1]); w.y = pg8::cvt_pk_bf16(v0[2], v0[3]); w.z = pg8::cvt_pk_bf16(v1[0], v1[1]); w.w = pg8::cvt_pk_bf16(v1[2], v1[3]);
                    *(v4u*)(rowp + bj * 128) = w; } }
    }
};
template <bool ACCUM> struct EpiMerge {
    static constexpr bool AFTER_DRAIN = false; static constexpr int NSTORE = 0;
    bf16* O; const bf16* gate;
    __device__ __forceinline__ void operator()(const f32x4 (&acc)[2][2][4][2], const pg8::Unit& u, int wr, int wc, int fr, int fq) const {
        { const int l_ = launder(lane_id()); fr = l_ & 15; fq = l_ >> 4; }
        const int row0 = u.pm * 256 + wr * 64 + fr, col0 = u.pn * 256 + wc * 32 + 8 * fq;
#pragma unroll
        for (int ai = 0; ai < 2; ++ai)
#pragma unroll
            for (int m = 0; m < 4; ++m) { const int row = row0 + ai * 128 + m * 16; bf16* rowp = O + (size_t)row * D + col0; const bf16* gp = gate + (size_t)row * NIN + col0;
#pragma unroll
                for (int bj = 0; bj < 2; ++bj) {
                    float gv[8]; unpack8(*(const v4u*)(gp + bj * 128), gv);
                    float o[8];
#pragma unroll
                    for (int j = 0; j < 4; ++j) { o[j] = acc[ai][bj][m][0][j] * gv[j]; o[4 + j] = acc[ai][bj][m][1][j] * gv[4 + j]; }
                    if (ACCUM) { float p[8]; unpack8(*(const v4u*)(rowp + bj * 128), p);
#pragma unroll
                        for (int j = 0; j < 8; ++j) o[j] += p[j]; }
                    v4u w; w.x = pg8::cvt_pk_bf16(o[0], o[1]); w.y = pg8::cvt_pk_bf16(o[2], o[3]); w.z = pg8::cvt_pk_bf16(o[4], o[5]); w.w = pg8::cvt_pk_bf16(o[6], o[7]);
                    *(v4u*)(rowp + bj * 128) = w; }
                asm volatile("" ::: "memory"); }
    }
};

struct EpiRmsRes {
    static constexpr bool AFTER_DRAIN = true; static constexpr int NSTORE = 0;
    unsigned char* ws; const CAS cfp_t* in; float* outp; int l, which;
    __device__ __forceinline__ void fused(const f32x4 (&acc)[2][2][4][2], const pg8::Unit& u, int wr, int wc, int fr, int fq, LAS unsigned char* lds, int wid, int lane) const {
        { const int l_ = launder(lane_id()); fr = l_ & 15; fq = l_ >> 4; }
        const bool lastl = which == 1 && l + 1 == DEPTH;
        bf16* const XB = (bf16*)(ws + WS_X1); bf16* const H = lastl ? nullptr : (bf16*)(ws + WS_H); float* const fout = lastl ? outp + O_YP : nullptr;
        const float* const gpost = (which ? in[24] : in[22]) + (size_t)l * D; const float* const gpre = lastl ? nullptr : (which ? in[21] + (size_t)(l + 1) * D : in[23] + (size_t)l * D);
        float* const slots = (float*)(ws + WS_XCH) + (size_t)(l * 2 + which) * 32 * 256 * 8 * 4;
        unsigned* const cnt = (unsigned*)(ws + WS_CTL) + CW_RMS + (l * 2 + which) * RMS_BANK; unsigned* const tmo = (unsigned*)(ws + WS_CTL) + CW_TMO;
        LAS f32x4* P = (LAS f32x4*)lds;
        LAS f32x2* SR = (LAS f32x2*)(lds + 16384);
        const int lr0 = wr * 64 + fr, col0 = u.pn * 256 + wc * 32 + 8 * fq;
        f32x4 gp[2][2];
#pragma unroll
        for (int bj = 0; bj < 2; ++bj) { gp[bj][0] = *(const f32x4*)(gpost + col0 + bj * 128); gp[bj][1] = *(const f32x4*)(gpost + col0 + bj * 128 + 4); }
#pragma unroll
        for (int ai = 0; ai < 2; ++ai)
#pragma unroll
            for (int m = 0; m < 4; ++m) {
                const int lr = lr0 + ai * 128 + m * 16; const bf16* xp = XB + (size_t)(u.pm * 256 + lr) * D + col0;
                float syy = 0.f, sxx = 0.f, sxy = 0.f, sgg = 0.f;
#pragma unroll
                for (int bj = 0; bj < 2; ++bj) { float xv[8]; unpack8(*(const v4u*)(xp + bj * 128), xv);
#pragma unroll
                    for (int n = 0; n < 2; ++n)
#pragma unroll
                        for (int j = 0; j < 4; ++j) { const float y = acc[ai][bj][m][n][j], yg = y * gp[bj][n][j], x = xv[4 * n + j]; syy += y * y; sxx += x * x; sxy += x * yg; sgg += yg * yg; } }
                syy += __shfl_xor(syy, 16); sxx += __shfl_xor(sxx, 16); sxy += __shfl_xor(sxy, 16); sgg += __shfl_xor(sgg, 16);
                syy += __shfl_xor(syy, 32); sxx += __shfl_xor(sxx, 32); sxy += __shfl_xor(sxy, 32); sgg += __shfl_xor(sgg, 32);
                if (fq == 0) P[lr * 4 + wc] = (f32x4){syy, sxx, sxy, sgg};
            }
        asm volatile("s_waitcnt lgkmcnt(0)" ::: "memory"); __builtin_amdgcn_s_barrier(); asm volatile("" ::: "memory");
        const int row = wid * 32 + (lane & 31);
        unsigned long long* slot = (unsigned long long*)slots + ((size_t)(u.pm * 256 + row) * 8 + u.pn) * 2;
        if (lane < 32) { const f32x4 a = P[row * 4 + 0], b = P[row * 4 + 1], c = P[row * 4 + 2], d = P[row * 4 + 3]; const f32x4 t = (a + b) + (c + d);
            __hip_atomic_store(slot, ((unsigned long long)__builtin_bit_cast(unsigned, t.y) << 32) | __builtin_bit_cast(unsigned, t.x), __ATOMIC_RELAXED, __HIP_MEMORY_SCOPE_AGENT);
            __hip_atomic_store(slot + 1, ((unsigned long long)__builtin_bit_cast(unsigned, t.w) << 32) | __builtin_bit_cast(unsigned, t.z), __ATOMIC_RELAXED, __HIP_MEMORY_SCOPE_AGENT); }
        asm volatile("s_waitcnt vmcnt(0)" ::: "memory");
        if (lane == 0) __hip_atomic_fetch_add(cnt + 64 * u.pm, 1u, __ATOMIC_RELAXED, __HIP_MEMORY_SCOPE_AGENT);
        if (wid == 0) {
            const unsigned long long t0 = __builtin_amdgcn_s_memrealtime();
            while ((unsigned)__builtin_amdgcn_readfirstlane((int)__hip_atomic_load(cnt + 64 * u.pm, __ATOMIC_RELAXED, __HIP_MEMORY_SCOPE_AGENT)) < 64u) {
                if (__builtin_amdgcn_s_memrealtime() - t0 > 2000000ull) { if (lane == 0) __hip_atomic_store(tmo, 1u, __ATOMIC_RELAXED, __HIP_MEMORY_SCOPE_AGENT); break; }
                __builtin_amdgcn_s_sleep(2); }
            __builtin_amdgcn_fence(__ATOMIC_ACQUIRE, "agent");
        }
        asm volatile("s_waitcnt vmcnt(0) lgkmcnt(0)" ::: "memory"); __builtin_amdgcn_s_barrier(); asm volatile("" ::: "memory");
        if (lane < 32) { const unsigned long long* sl = (const unsigned long long*)slots + (size_t)(u.pm * 256 + row) * 16; float syy = 0.f, sxx = 0.f, sxy = 0.f, sgg = 0.f;
#pragma unroll
            for (int t = 0; t < 8; ++t) { const unsigned long long w0 = __hip_atomic_load(sl + 2 * t, __ATOMIC_RELAXED, __HIP_MEMORY_SCOPE_AGENT), w1 = __hip_atomic_load(sl + 2 * t + 1, __ATOMIC_RELAXED, __HIP_MEMORY_SCOPE_AGENT);
                syy += __builtin_bit_cast(float, (unsigned)w0); sxx += __builtin_bit_cast(float, (unsigned)(w0 >> 32)); sxy += __builtin_bit_cast(float, (unsigned)w1); sgg += __builtin_bit_cast(float, (unsigned)(w1 >> 32)); }
            const float ry = rsqrtf(syy * (1.f / D) + EPS), s1 = sxx + 2.f * ry * sxy + ry * ry * sgg;
            SR[row] = (f32x2){ry, rsqrtf(fmaxf(s1, 0.f) * (1.f / D) + EPS)}; }
        asm volatile("s_waitcnt lgkmcnt(0)" ::: "memory"); __builtin_amdgcn_s_barrier(); asm volatile("" ::: "memory");
        f32x4 gq[2][2];
#pragma unroll
        for (int bj = 0; bj < 2; ++bj) { gq[bj][0] = gpre ? *(const f32x4*)(gpre + col0 + bj * 128) : (f32x4){0.f, 0.f, 0.f, 0.f}; gq[bj][1] = gpre ? *(const f32x4*)(gpre + col0 + bj * 128 + 4) : (f32x4){0.f, 0.f, 0.f, 0.f}; }
#pragma unroll
        for (int ai = 0; ai < 2; ++ai)
#pragma unroll
            for (int m = 0; m < 4; ++m) {
                const int lr = lr0 + ai * 128 + m * 16; const size_t off = (size_t)(u.pm * 256 + lr) * D + col0; const f32x2 sr = SR[lr];
#pragma unroll
                for (int bj = 0; bj < 2; ++bj) { float xv[8], x1[8]; unpack8(*(const v4u*)(XB + off + bj * 128), xv);
#pragma unroll
                    for (int n = 0; n < 2; ++n)
#pragma unroll
                        for (int j = 0; j < 4; ++j) x1[4 * n + j] = xv[4 * n + j] + acc[ai][bj][m][n][j] * sr.x * gp[bj][n][j];
                    if (fout) { *(f32x4*)(fout + off + bj * 128) = (f32x4){x1[0], x1[1], x1[2], x1[3]}; *(f32x4*)(fout + off + bj * 128 + 4) = (f32x4){x1[4], x1[5], x1[6], x1[7]}; }
                    else { *(v4u*)(XB + off + bj * 128) = pack8(x1);
                        if (H) { float hv[8];
#pragma unroll
                            for (int n = 0; n < 2; ++n)
#pragma unroll
                                for (int j = 0; j < 4; ++j) hv[4 * n + j] = x1[4 * n + j] * sr.y * gq[bj][n][j];
                            *(v4u*)(H + off + bj * 128) = pack8(hv); } } }
                asm volatile("" ::: "memory"); }
    }
};
struct EpiSwiglu {
    static constexpr bool AFTER_DRAIN = false; static constexpr int NSTORE = 8;
    bf16* O;
    __device__ __forceinline__ void operator()(const f32x4 (&acc)[2][2][4][2], const pg8::Unit& u, int wr, int wc, int fr, int fq) const {
        { const int l_ = launder(lane_id()); fr = l_ & 15; fq = l_ >> 4; }
        const int row0 = u.pm * 256 + wr * 64 + fr, col0 = u.pn * 128 + wc * 32 + 8 * fq;
#pragma unroll
        for (int ai = 0; ai < 2; ++ai)
#pragma unroll
            for (int m = 0; m < 4; ++m) { bf16* rowp = O + (size_t)(row0 + ai * 128 + m * 16) * DFF + col0;
                float o[8];
#pragma unroll
                for (int j = 0; j < 4; ++j) { o[j] = silu(acc[ai][0][m][0][j]) * acc[ai][1][m][0][j]; o[4 + j] = silu(acc[ai][0][m][1][j]) * acc[ai][1][m][1][j]; }
                v4u w; w.x = pg8::cvt_pk_bf16(o[0], o[1]); w.y = pg8::cvt_pk_bf16(o[2], o[3]); w.z = pg8::cvt_pk_bf16(o[4], o[5]); w.w = pg8::cvt_pk_bf16(o[6], o[7]);
                *(v4u*)rowp = w; }
    }
};

__device__ __forceinline__ void transpose_item(const float* W, int ldw, int src_col0, int k0, bf16* WT, int ldt, int dst_row0, LAS float* scr, int lane, const float* rscale = nullptr) {
#pragma unroll 8
    for (int i = 0; i < 32; ++i) { const int kk = 2 * i + (lane >> 5); scr[kk * 33 + (lane & 31)] = W[(size_t)(k0 + kk) * ldw + src_col0 + (lane & 31)]; }
    LDS_WAIT(); asm volatile("" ::: "memory");
    const int c = lane & 7;
#pragma unroll
    for (int j = 0; j < 4; ++j) { const int n = (lane >> 3) + 8 * j; const LAS float* s = scr + (8 * c) * 33 + n; const float m = rscale ? rscale[n] : 1.f;
        v4u o; o.x = pk2(s[0 * 33] * m, s[1 * 33] * m); o.y = pk2(s[2 * 33] * m, s[3 * 33] * m); o.z = pk2(s[4 * 33] * m, s[5 * 33] * m); o.w = pk2(s[6 * 33] * m, s[7 * 33] * m);
        *(v4u*)(WT + (size_t)(dst_row0 + n) * ldt + k0 + 8 * c) = o; }
    LDS_WAIT(); asm volatile("" ::: "memory");
}
constexpr int IT_IN = 32 * 496, IT_BRA = 16 * 64, IT_BRB = 8 * 64, IT_BRC = 16 * 64, IT_POOL = 4 * 4 * 8, IT_OUT = 32 * 64, IT_GU = 32 * 352, IT_DOWN = 88 * 64;
constexpr int IT_LAYER = IT_IN + IT_BRA + IT_BRB + IT_BRC + IT_POOL + IT_OUT + IT_GU + IT_DOWN;
__device__ __forceinline__ void weight_item(Frame& F0, int l, int r, LAS float* scr) {
    RELANE(F0);
    unsigned char* wl = F.ws + WS_W + (size_t)l * WL_BYTES; const int lane = F.lane;
    if (r < IT_IN) { const int kb = r / 496, nb = r % 496, n0 = nb * 32; transpose_item(F.in[8] + (size_t)l * D * NIN_SRC, NIN_SRC, n0 + (n0 >= 4096 ? 16 : 0), kb * 64, (bf16*)(wl + WO_IN), D, n0, scr, lane); return; } r -= IT_IN;
    if (r < IT_BRA) { const int kb = r / 64, nb = r % 64; transpose_item(F.in[15] + (size_t)l * 1024 * D, D, nb * 32, kb * 64, (bf16*)(wl + WO_BRA), 1024, nb * 32, scr, lane); return; } r -= IT_BRA;
    if (r < IT_BRB) { const int kb = r / 64, nb = r % 64; transpose_item(F.in[16] + (size_t)l * 512 * D, D, nb * 32, kb * 64, (bf16*)(wl + WO_BRB), 512, nb * 32, scr, lane); return; } r -= IT_BRB;
    if (r < IT_BRC) { const int kb = r / 64, nb = r % 64; transpose_item(F.in[17] + (size_t)l * 1024 * D, D, nb * 32, kb * 64, (bf16*)(wl + WO_BRC), 1024, nb * 32, scr, lane); return; } r -= IT_BRC;
    if (r < IT_POOL) { const int g = r / 32, kb = (r % 32) / 8, nb = r % 8; transpose_item(F.in[13] + (size_t)(l * 4 + g) * 65536, 256, nb * 32, kb * 64, (bf16*)(wl + WO_POOL) + (size_t)g * 65536, 256, nb * 32, scr, lane, F.in[14] + (size_t)l * CPOOL + g * 256 + nb * 32); return; } r -= IT_POOL;
    if (r < IT_OUT) { const int kb = r / 64, nb = r % 64; transpose_item(F.in[18] + (size_t)l * D * D, D, nb * 32, kb * 64, (bf16*)(wl + WO_OUT), D, nb * 32, scr, lane); return; } r -= IT_OUT;
    if (r < IT_GU) { const int kb = r / 352, nb = r % 352, n0 = nb * 32, pn = n0 >> 8, bj = (n0 >> 7) & 1, rr = n0 & 127;
        transpose_item(F.in[19] + (size_t)l * D * 2 * DFF, 2 * DFF, bj * DFF + 128 * pn + rr, kb * 64, (bf16*)(wl + WO_GU), D, n0, scr, lane); return; } r -= IT_GU;
    { const int kb = r / 64, nb = r % 64; transpose_item(F.in[20] + (size_t)l * DFF * D, D, nb * 32, kb * 64, (bf16*)(wl + WO_DOWN), DFF, nb * 32, scr, lane); }
}

__device__ __forceinline__ void stage_wba(Frame& F0, int l) {
    RELANE(F0);
    LAS float* Wl = (LAS float*)F.lds; const float* w = F.in[8] + (size_t)l * D * NIN_SRC + 4096;
    for (int k = F.tid; k < D; k += NWAVES * 64) { const float* p = w + (size_t)k * NIN_SRC;
        const f32x4 a = *(const f32x4*)p, b = *(const f32x4*)(p + 4), c = *(const f32x4*)(p + 8), d = *(const f32x4*)(p + 12);
        Wl[0 * D + k] = a.x; Wl[1 * D + k] = a.y; Wl[2 * D + k] = a.z; Wl[3 * D + k] = a.w; Wl[4 * D + k] = b.x; Wl[5 * D + k] = b.y; Wl[6 * D + k] = b.z; Wl[7 * D + k] = b.w;
        Wl[8 * D + k] = c.x; Wl[9 * D + k] = c.y; Wl[10 * D + k] = c.z; Wl[11 * D + k] = c.w; Wl[12 * D + k] = d.x; Wl[13 * D + k] = d.y; Wl[14 * D + k] = d.z; Wl[15 * D + k] = d.w; }
    __syncthreads();
}
template <bool X32>
__device__ __forceinline__ void thin_rows(Frame& F0, const float* xa, const float* xb, const bf16* Y, const float* gpost, float* fout, const float* gpre, bool do_ba, int l_ba, int r_lo = 0) {
    RELANE(F0);
    const int lane = F.lane, gw = F.vcu * NWAVES + F.wave, NGW = F.G * NWAVES;
    bf16* H = (bf16*)(F.ws + WS_H); bf16* XB = (bf16*)(F.ws + WS_X1); float* GB = (float*)(F.ws + WS_GB);
    const LAS float* Wl = (const LAS float*)F.lds;
    f32x4 vn[8]; v2u xn[8], yn[8];
#define THIN_LOAD(rr) do { const int r_ = (rr); \
        if (X32) { const float* xr_ = (r_ < MP) ? xa + (size_t)r_ * D : xb + (size_t)(r_ - MP) * D; _Pragma("unroll") for (int j = 0; j < 8; ++j) vn[j] = *(const f32x4*)(xr_ + 4 * lane + 256 * j); } \
        else { _Pragma("unroll") for (int j = 0; j < 8; ++j) xn[j] = *(const v2u*)(XB + (size_t)r_ * D + 4 * lane + 256 * j); } \
        if (Y) { _Pragma("unroll") for (int j = 0; j < 8; ++j) yn[j] = *(const v2u*)(Y + (size_t)r_ * D + 4 * lane + 256 * j); } } while (0)
#pragma unroll
    for (int j = 0; j < 8; ++j) { yn[j] = (v2u){0u, 0u}; xn[j] = (v2u){0u, 0u}; vn[j] = (f32x4){0.f, 0.f, 0.f, 0.f}; }
    if (r_lo + gw < MV) THIN_LOAD(r_lo + gw);
    for (int r = r_lo + gw; r < MV; r += NGW) {
        f32x4 v[8]; v2u yu[8];
#pragma unroll
        for (int j = 0; j < 8; ++j) { v[j] = X32 ? vn[j] : (f32x4){bf_lo(xn[j].x), bf_hi(xn[j].x), bf_lo(xn[j].y), bf_hi(xn[j].y)}; yu[j] = yn[j]; }
        if (r + NGW < MV) THIN_LOAD(r + NGW);
        if (Y) {
            f32x4 y[8]; float ss = 0.f;
#pragma unroll
            for (int j = 0; j < 8; ++j) { const v2u u = yu[j]; y[j] = (f32x4){bf_lo(u.x), bf_hi(u.x), bf_lo(u.y), bf_hi(u.y)}; ss += (y[j].x * y[j].x + y[j].y * y[j].y) + (y[j].z * y[j].z + y[j].w * y[j].w); }
            const float rstd = rsqrtf(wave_sum(ss) * (1.f / D) + EPS);
#pragma unroll
            for (int j = 0; j < 8; ++j) { const f32x4 g = *(const f32x4*)(gpost + 4 * lane + 256 * j); v[j] = v[j] + y[j] * rstd * g; }
        }
        if (fout) {
#pragma unroll
            for (int j = 0; j < 8; ++j) *(f32x4*)(fout + (size_t)r * D + 4 * lane + 256 * j) = v[j];
        } else {
#pragma unroll
            for (int j = 0; j < 8; ++j) { v2u o; o.x = pk2(v[j].x, v[j].y); o.y = pk2(v[j].z, v[j].w); *(v2u*)(XB + (size_t)r * D + 4 * lane + 256 * j) = o; }
        }
        if (gpre) {
            float ss = 0.f;
#pragma unroll
            for (int j = 0; j < 8; ++j) ss += (v[j].x * v[j].x + v[j].y * v[j].y) + (v[j].z * v[j].z + v[j].w * v[j].w);
            const float rstd = rsqrtf(wave_sum(ss) * (1.f / D) + EPS);
#pragma unroll
            for (int j = 0; j < 8; ++j) { const f32x4 g = *(const f32x4*)(gpre + 4 * lane + 256 * j); v[j] = v[j] * rstd * g;
                v2u o; o.x = pk2(v[j].x, v[j].y); o.y = pk2(v[j].z, v[j].w); *(v2u*)(H + (size_t)r * D + 4 * lane + 256 * j) = o; }
            if (do_ba) {
                float pc[16], mine = 0.f;
#pragma unroll
                for (int c = 0; c < 16; ++c) { float p = 0.f;
#pragma unroll
                    for (int j = 0; j < 8; ++j) { const f32x4 w = *(const LAS f32x4*)(Wl + c * D + 256 * j + 4 * lane); p += (v[j].x * w.x + v[j].y * w.y) + (v[j].z * w.z + v[j].w * w.w); }
                    pc[c] = row16_sum(p); }
#pragma unroll
                for (int c = 0; c < 16; ++c) pc[c] += __shfl_xor(pc[c], 16);
#pragma unroll
                for (int c = 0; c < 16; ++c) { pc[c] += __shfl_xor(pc[c], 32); mine = (lane == c) ? pc[c] : mine; }
                if (lane < 16) { float o;
                    if (lane < 8) o = sigm(mine);
                    else { const float al = F.in[10][l_ba * HA + lane - 8], dtb = F.in[11][l_ba * HA + lane - 8]; const float z = mine + dtb; const float sp = fmaxf(z, 0.f) + __logf(1.f + __expf(-fabsf(z))); o = -__expf(al) * sp; }
                    GB[(size_t)r * 16 + lane] = o; }
            }
        }
    }
}
#undef THIN_LOAD
__device__ __forceinline__ void ba_rows(Frame& F0, int l_ba) {
    RELANE(F0);
    const int lane = F.lane, gw = F.vcu * NWAVES + F.wave, NGW = F.G * NWAVES;
    const bf16* H = (const bf16*)(F.ws + WS_H); float* GB = (float*)(F.ws + WS_GB); const LAS float* Wl = (const LAS float*)F.lds;
    for (int r = gw; r < MP; r += NGW) {
        f32x4 v[8];
#pragma unroll
        for (int j = 0; j < 8; ++j) { const v2u u = *(const v2u*)(H + (size_t)r * D + 4 * lane + 256 * j); v[j] = (f32x4){bf_lo(u.x), bf_hi(u.x), bf_lo(u.y), bf_hi(u.y)}; }
        float mine = 0.f;
#pragma unroll 1
        for (int c = 0; c < 16; ++c) { float p = 0.f;
#pragma unroll
            for (int j = 0; j < 8; ++j) { const f32x4 w = *(const LAS f32x4*)(Wl + c * D + 256 * j + 4 * lane); p += (v[j].x * w.x + v[j].y * w.y) + (v[j].z * w.z + v[j].w * w.w); }
            p = wave_sum(p); if (lane == c) mine = p; }
        if (lane < 16) { float o;
            if (lane < 8) o = sigm(mine);
            else { const float al = F.in[10][l_ba * HA + lane - 8], dtb = F.in[11][l_ba * HA + lane - 8]; const float z = mine + dtb; const float sp = fmaxf(z, 0.f) + __logf(1.f + __expf(-fabsf(z))); o = -__expf(al) * sp; }
            GB[(size_t)r * 16 + lane] = o; }
    }
}

__device__ __forceinline__ void ld8f(const float* p, float (&x)[8]) { const f32x4 a = *(const f32x4*)p, b = *(const f32x4*)(p + 4); x[0] = a.x; x[1] = a.y; x[2] = a.z; x[3] = a.w; x[4] = b.x; x[5] = b.y; x[6] = b.z; x[7] = b.w; }
template <bool QK> __device__ __forceinline__ void conv_item(Frame& F0, int l, int row0, int T, int hmode, int sb, int j) {
    RELANE(F0);
    const int lane = F.lane;
    const bf16* PROJ = (const bf16*)(F.ws + WS_PROJ); const float* convw = F.in[9] + (size_t)l * 4 * CONVCH;
    const int c0 = QK ? 512 * j + 8 * lane : 2048 + 512 * j + 8 * lane, c1 = 1024 + 512 * j + 8 * lane;
    float w0[4][8], w1[4][8], x0[4][8], x1[4][8];
#pragma unroll
    for (int tap = 0; tap < 4; ++tap) { ld8f(convw + tap * CONVCH + c0, w0[tap]); if (QK) ld8f(convw + tap * CONVCH + c1, w1[tap]); }
#pragma unroll
    for (int i = 0; i < 3; ++i) {
        if (hmode == 1) { unpack8(*(const v4u*)(PROJ + (size_t)(row0 - 3 + i) * NIN + c0), x0[i + 1]); if (QK) unpack8(*(const v4u*)(PROJ + (size_t)(row0 - 3 + i) * NIN + c1), x1[i + 1]); }
        else if (hmode == 2) { const float* hp = F.in[6] + ((size_t)(l * DB + sb) * 3 + i) * CONVCH; ld8f(hp + c0, x0[i + 1]); if (QK) ld8f(hp + c1, x1[i + 1]); }
        else {
#pragma unroll
            for (int e = 0; e < 8; ++e) { x0[i + 1][e] = 0.f; x1[i + 1][e] = 0.f; } }
    }
    bf16* O0 = (bf16*)(F.ws + (QK ? WS_QN : WS_VV)) + 512 * j + 8 * lane; bf16* O1 = (bf16*)(F.ws + WS_KN) + 512 * j + 8 * lane;
    const float* GB = (const float*)(F.ws + WS_GB); f32x4* TOK = (f32x4*)(F.ws + WS_TOK); const int hd = 4 * j + (lane >> 4);
    v4u n0[4], n1[4]; float ng[4], nb[4];
#pragma unroll
    for (int u = 0; u < 4; ++u) { n0[u] = *(const v4u*)(PROJ + (size_t)(row0 + u) * NIN + c0); n1[u] = n0[u]; ng[u] = 0.f; nb[u] = 0.f; if (QK) { n1[u] = *(const v4u*)(PROJ + (size_t)(row0 + u) * NIN + c1); ng[u] = GB[(size_t)(row0 + u) * 16 + 8 + hd]; nb[u] = GB[(size_t)(row0 + u) * 16 + hd]; } }
    for (int tb = 0; tb < T; tb += 4) {
        v4u m0[4], m1[4]; float mg[4], mb[4];
#pragma unroll
        for (int u = 0; u < 4; ++u) { m0[u] = n0[u]; m1[u] = n1[u]; mg[u] = ng[u]; mb[u] = nb[u]; }
        if (tb + 4 < T) {
#pragma unroll
            for (int u = 0; u < 4; ++u) { n0[u] = *(const v4u*)(PROJ + (size_t)(row0 + tb + 4 + u) * NIN + c0); if (QK) { n1[u] = *(const v4u*)(PROJ + (size_t)(row0 + tb + 4 + u) * NIN + c1); ng[u] = GB[(size_t)(row0 + tb + 4 + u) * 16 + 8 + hd]; nb[u] = GB[(size_t)(row0 + tb + 4 + u) * 16 + hd]; } } }
#pragma unroll
        for (int u = 0; u < 4; ++u) {
            const int t = tb + u; const size_t r = (size_t)(row0 + t);
            unpack8(m0[u], x0[u]); if (QK) unpack8(m1[u], x1[u]);
            float a0[8], a1[8]; float s0 = 0.f, s1 = 0.f;
#pragma unroll
            for (int e = 0; e < 8; ++e) {
                a0[e] = silu(w0[3][e] * x0[u][e] + w0[2][e] * x0[(u + 3) & 3][e] + w0[1][e] * x0[(u + 2) & 3][e] + w0[0][e] * x0[(u + 1) & 3][e]); s0 += a0[e] * a0[e];
                if (QK) { a1[e] = silu(w1[3][e] * x1[u][e] + w1[2][e] * x1[(u + 3) & 3][e] + w1[1][e] * x1[(u + 2) & 3][e] + w1[0][e] * x1[(u + 1) & 3][e]); s1 += a1[e] * a1[e]; } }
            if (QK) {
                const float q_sc = rsqrtf(row16_sum(s0) + 1e-6f) * 0.08838834764831845f, k_sc = rsqrtf(row16_sum(s1) + 1e-6f); float p = 0.f;
#pragma unroll
                for (int e = 0; e < 8; ++e) { a0[e] *= q_sc; a1[e] *= k_sc; p += a0[e] * a1[e]; }
                p = row16_sum(p);
                *(v4u*)(O1 + r * 1024) = pack8(a1);
                if ((lane & 15) == 0) TOK[r * 8 + hd] = (f32x4){__expf(mg[u]), mb[u], p, mg[u]};
            }
            *(v4u*)(O0 + r * 1024) = pack8(a0);
        }
    }
}
__device__ __forceinline__ void pool_item(Frame& F0, int l, int row0, int T, int pos0, int hmode, int sb, int j) {
    RELANE(F0);
    const int lane = F.lane, win = 2 << (2 * j + (lane >> 5)), cc = 512 * j + 8 * lane;
    const bf16* U = (const bf16*)(F.ws + WS_PROJ) + PC_UC + cc; const float* hist = F.in[7] + (size_t)(l * DB + sb) * PHIST * CPOOL + cc;
    bf16* PO = (bf16*)(F.ws + WS_POOLED) + cc;
    float S[8];
#pragma unroll
    for (int e = 0; e < 8; ++e) S[e] = 0.f;
    if (hmode == 2) {
        for (int i = 1; i < 16; ++i) if (i < win) { float x[8]; ld8f(hist + (size_t)(PHIST - i) * CPOOL, x);
#pragma unroll
            for (int e = 0; e < 8; ++e) S[e] += x[e]; }
        for (int t = 0; t < T; ++t) {
            float xn[8], xo[8]; unpack8(*(const v4u*)(U + (size_t)(row0 + t) * NIN), xn);
            const int to = t - win + 1;
            if (to >= 0) unpack8(*(const v4u*)(U + (size_t)(row0 + to) * NIN), xo); else ld8f(hist + (size_t)(PHIST + to) * CPOOL, xo);
            const float inv = 1.f / (float)win; float o[8];
#pragma unroll
            for (int e = 0; e < 8; ++e) { S[e] += xn[e]; o[e] = S[e] * inv - xn[e]; S[e] -= xo[e]; }
            *(v4u*)(PO + (size_t)(row0 + t) * 1024) = pack8(o);
        }
        return;
    }
    {
        v4u h[15];
#pragma unroll
        for (int i = 1; i < 16; ++i) { const int back = (pos0 - i >= 0) ? i : pos0; h[i - 1] = *(const v4u*)(U + (size_t)(row0 - back) * NIN); }
#pragma unroll
        for (int i = 1; i < 16; ++i) { float x[8]; unpack8(h[i - 1], x); const float wgt = (i < win && pos0 - i >= 0) ? 1.f : 0.f;
#pragma unroll
            for (int e = 0; e < 8; ++e) S[e] += wgt * x[e]; }
    }
    v4u nn[4], no[4];
#define POOL_LD(tb_) do { _Pragma("unroll") for (int u = 0; u < 4; ++u) { const int t_ = (tb_) + u, to_ = t_ - win + 1; nn[u] = *(const v4u*)(U + (size_t)(row0 + t_) * NIN); no[u] = *(const v4u*)(U + (size_t)(row0 + (pos0 + to_ >= 0 ? to_ : -pos0)) * NIN); } } while (0)
    POOL_LD(0);
    for (int tb = 0; tb < T; tb += 4) {
        v4u mn[4], mo[4];
#pragma unroll
        for (int u = 0; u < 4; ++u) { mn[u] = nn[u]; mo[u] = no[u]; }
        if (tb + 4 < T) POOL_LD(tb + 4);
#pragma unroll
        for (int u = 0; u < 4; ++u) {
            const int t = tb + u, to = t - win + 1; const float wo = (pos0 + to >= 0) ? 1.f : 0.f;
            float xn[8], xo[8]; unpack8(mn[u], xn); unpack8(mo[u], xo);
            const float cnt = (float)(win < pos0 + t + 1 ? win : pos0 + t + 1), inv = __builtin_amdgcn_rcpf(cnt); float o[8];
#pragma unroll
            for (int e = 0; e < 8; ++e) { S[e] += xn[e]; o[e] = S[e] * inv - xn[e]; S[e] -= wo * xo[e]; }
            *(v4u*)(PO + (size_t)(row0 + t) * 1024) = pack8(o);
        }
    }
#undef POOL_LD
}
constexpr int CV_BLK = 16, CV_NB = SEQ / CV_BLK;
constexpr int CV_P_ITEMS = BATCH * CV_NB * 2, CV_S_ITEMS = DB * 2;
constexpr int PREP_ITEMS = 2 * (CV_P_ITEMS + CV_S_ITEMS) + CV_P_ITEMS + CV_S_ITEMS;
__device__ __forceinline__ void prep_item(Frame& F, int l, int it) {
    int kind = 0;
    if (it >= CV_P_ITEMS + CV_S_ITEMS) { it -= CV_P_ITEMS + CV_S_ITEMS; kind = 1; if (it >= CV_P_ITEMS + CV_S_ITEMS) { it -= CV_P_ITEMS + CV_S_ITEMS; kind = 2; } }
    int row0, T, hmode, sb = 0, pos0; const int j = it & 1;
    if (it < CV_P_ITEMS) { const int blk = (it >> 1) % CV_NB, b = (it >> 1) / CV_NB; row0 = b * SEQ + blk * CV_BLK; T = CV_BLK; hmode = blk ? 1 : 0; pos0 = blk * CV_BLK; }
    else { sb = (it - CV_P_ITEMS) >> 1; row0 = MP + DS * sb; T = DS; hmode = 2; pos0 = 0; }
    if (kind == 0) conv_item<true>(F, l, row0, T, hmode, sb, j); else if (kind == 1) conv_item<false>(F, l, row0, T, hmode, sb, j); else pool_item(F, l, row0, T, pos0, hmode, sb, j);
}

__device__ __forceinline__ void st8f(float* p, const v4u u) { float x[8]; unpack8(u, x); *(f32x4*)p = (f32x4){x[0], x[1], x[2], x[3]}; *(f32x4*)(p + 4) = (f32x4){x[4], x[5], x[6], x[7]}; }
__device__ __forceinline__ void prep_out_rows(Frame& F0, int l) {
    RELANE(F0);
    const int lane = F.lane, gw = F.vcu * NWAVES + F.wave, NGW = F.G * NWAVES;
    const bf16* PROJ = (const bf16*)(F.ws + WS_PROJ);
    float* out = F.out;
    for (int r = gw; r < MV; r += NGW) {
        const bool samp = r >= MP; const int b = samp ? (r - MP) / DS : r / SEQ, t = samp ? (r - MP) % DS : r % SEQ;
        const bf16* prow = PROJ + (size_t)r * NIN;
        const int ci = samp ? t - 1 : t - (SEQ - 3), pi = samp ? 11 + t : t - (SEQ - PHIST);
        v4u kvr[3][2], cv[6], pv[2];
#pragma unroll
        for (int gi = 0; gi < 3; ++gi) { kvr[gi][0] = *(const v4u*)(prow + PC_KB + gi * 512 + 8 * lane); kvr[gi][1] = *(const v4u*)(prow + PC_VB + gi * 512 + 8 * lane); }
        const bool needc = (ci >= 0) || (pi >= 0);
        if (needc) {
#pragma unroll
            for (int j = 0; j < 6; ++j) cv[j] = *(const v4u*)(prow + 512 * j + 8 * lane);
#pragma unroll
            for (int j = 0; j < 2; ++j) pv[j] = *(const v4u*)(prow + PC_UC + 512 * j + 8 * lane);
        }
#pragma unroll
        for (int gi = 0; gi < 3; ++gi) {
            const int win = 128 << (2 * gi); const int w = samp ? win - DS + t : t - (SEQ - win);
            if (w >= 0) {
                const size_t obase = samp ? (gi == 0 ? O_SW1 : gi == 1 ? O_SW2 : O_SW3) : (gi == 0 ? O_PW1 : gi == 1 ? O_PW2 : O_PW3);
                float* dst = out + obase + ((size_t)(l * (samp ? DB : BATCH) + b) * win + w) * 1024 + 8 * lane;
                st8f(dst, kvr[gi][0]); st8f(dst + 512, kvr[gi][1]);
            }
        }
        if (needc) {
            if (ci >= 0) { float* dst = out + (samp ? O_SCONV + ((size_t)(l * DB + b) * 3 + ci) * CONVCH : O_PCONV + ((size_t)(l * BATCH + b) * 3 + ci) * CONVCH) + 8 * lane;
#pragma unroll
                for (int j = 0; j < 6; ++j) st8f(dst + 512 * j, cv[j]); }
            if (pi >= 0) { float* dst = out + (samp ? O_SPOOL + ((size_t)(l * DB + b) * PHIST + pi) * CPOOL : O_PPOOL + ((size_t)(l * BATCH + b) * PHIST + pi) * CPOOL) + 8 * lane;
#pragma unroll
                for (int j = 0; j < 2; ++j) st8f(dst + 512 * j, pv[j]); }
            if (samp && t == 0) {
                const float* phist = F.in[7] + (size_t)(l * DB + b) * PHIST * CPOOL;
                float* dst = out + O_SPOOL + (size_t)(l * DB + b) * PHIST * CPOOL; const float* src = phist + 4 * CPOOL;
                for (int i = lane; i < 11 * CPOOL / 4; i += 64) *(f32x4*)(dst + 4 * i) = *(const f32x4*)(src + 4 * i);
            }
        }
    }
}

__device__ __forceinline__ void gdn_scan_item(Frame& F0, int row0, int h, int s, const float* S0, float* Sout) {
    RELANE(F0);
    const int lane = F.lane, dvl = lane & 15, kg = lane >> 4;
    const bf16* QN = (const bf16*)(F.ws + WS_QN); const bf16* KN = (const bf16*)(F.ws + WS_KN); const bf16* VV = (const bf16*)(F.ws + WS_VV);
    const f32x4* TOK = (const f32x4*)(F.ws + WS_TOK); float* ORAW = (float*)(F.ws + WS_ORAW);
    float S[32]; v4u ku[DS][4], qu[DS][4]; float vv[DS]; f32x4 tk[DS];
    const float* sp = S0 + (size_t)(32 * kg) * 128 + 16 * s + dvl;
#pragma unroll
    for (int i = 0; i < 32; ++i) S[i] = sp[(size_t)i * 128];
#pragma unroll
    for (int t = 0; t < DS; ++t) { const size_t r = (size_t)(row0 + t);
#pragma unroll
        for (int c = 0; c < 4; ++c) { ku[t][c] = *(const v4u*)(KN + r * 1024 + h * 128 + 32 * kg + 8 * c); qu[t][c] = *(const v4u*)(QN + r * 1024 + h * 128 + 32 * kg + 8 * c); }
        vv[t] = bf1(VV[r * 1024 + h * 128 + 16 * s + dvl]); tk[t] = TOK[r * 8 + h]; }
#pragma unroll
    for (int t = 0; t < DS; ++t) {
        float rk = 0.f, rq = 0.f; float kf[32];
#pragma unroll
        for (int c = 0; c < 4; ++c) { float k8[8], q8[8]; unpack8(ku[t][c], k8); unpack8(qu[t][c], q8);
#pragma unroll
            for (int e = 0; e < 8; ++e) { kf[8 * c + e] = k8[e]; rk += k8[e] * S[8 * c + e]; rq += q8[e] * S[8 * c + e]; } }
        rk += __shfl_xor(rk, 16); rq += __shfl_xor(rq, 16); rk += __shfl_xor(rk, 32); rq += __shfl_xor(rq, 32);
        const float a = tk[t].x, d = tk[t].y * (vv[t] - a * rk), o = a * rq + tk[t].z * d;
#pragma unroll
        for (int i = 0; i < 32; ++i) S[i] = a * S[i] + kf[i] * d;
        if (kg == 0) ORAW[(size_t)(row0 + t) * 1024 + h * 128 + 16 * s + dvl] = o;
    }
    float* op = Sout + (size_t)(32 * kg) * 128 + 16 * s + dvl;
#pragma unroll
    for (int i = 0; i < 32; ++i) op[(size_t)i * 128] = S[i];
}

__device__ __forceinline__ bf16x8 pack_acc(const f32x16& x, int sp) {
    v4u p; p.x = pk2(x[8 * sp + 0], x[8 * sp + 1]); p.y = pk2(x[8 * sp + 2], x[8 * sp + 3]); p.z = pk2(x[8 * sp + 4], x[8 * sp + 5]); p.w = pk2(x[8 * sp + 6], x[8 * sp + 7]);
    return __builtin_bit_cast(bf16x8, p);
}
constexpr int GA_PITCH = 272, GA_LT_PITCH = 36, GA_WAVE_LDS = 32 * GA_PITCH + 32 * GA_LT_PITCH * 4 + 384;
__device__ __forceinline__ void gdn_ga_item(Frame& F0, int ch) {
    RELANE(F0);
    const int lane = F.lane, r = lane & 31, h = lane >> 5;
    const int c = ch & 63, bh = ch >> 6, hd = bh & 7, b = bh >> 3, row0 = b * SEQ + 32 * c;
    LAS unsigned char* TL = F.lds + F.wave * GA_WAVE_LDS; LAS float* LT = (LAS float*)(TL + 32 * GA_PITCH); LAS float* GS = (LAS float*)(TL + 32 * GA_PITCH + 32 * GA_LT_PITCH * 4);
    const bf16* QN = (const bf16*)(F.ws + WS_QN); const bf16* KN = (const bf16*)(F.ws + WS_KN); const bf16* VV = (const bf16*)(F.ws + WS_VV); const f32x4* TOK = (const f32x4*)(F.ws + WS_TOK);
    { const f32x4 tk = TOK[(size_t)(row0 + r) * 8 + hd]; if (h == 0) { GS[r] = tk.w; GS[32 + r] = tk.y; } }
#pragma unroll
    for (int i = 0; i < 8; ++i) { const int p = lane + 64 * i, rw = p >> 4, c16 = p & 15; *(LAS v4u*)(TL + rw * GA_PITCH + 16 * c16) = *(const v4u*)(KN + (size_t)(row0 + rw) * 1024 + hd * 128 + 8 * c16); }
    asm volatile("s_waitcnt lgkmcnt(0)" ::: "memory");
    float gcv[32], bev[32];
#pragma unroll
    for (int i = 0; i < 8; ++i) { const f32x4 a = *(const LAS f32x4*)(GS + 4 * i), bq = *(const LAS f32x4*)(GS + 32 + 4 * i);
        gcv[4 * i] = a.x; gcv[4 * i + 1] = a.y; gcv[4 * i + 2] = a.z; gcv[4 * i + 3] = a.w; bev[4 * i] = bq.x; bev[4 * i + 1] = bq.y; bev[4 * i + 2] = bq.z; bev[4 * i + 3] = bq.w; }
#pragma unroll
    for (int i = 1; i < 32; ++i) gcv[i] += gcv[i - 1];
    if (lane == 0) {
#pragma unroll
        for (int i = 0; i < 8; ++i) *(LAS f32x4*)(GS + 64 + 4 * i) = (f32x4){gcv[4 * i], gcv[4 * i + 1], gcv[4 * i + 2], gcv[4 * i + 3]}; }
    asm volatile("s_waitcnt lgkmcnt(0)" ::: "memory");
    const float gc_own = GS[64 + r], fr = (float)r;
    const bf16* kp = KN + (size_t)(row0 + r) * 1024 + hd * 128 + 8 * h; const bf16* qp = QN + (size_t)(row0 + r) * 1024 + hd * 128 + 8 * h;
    f32x16 akk, aqk;
#pragma unroll
    for (int i = 0; i < 16; ++i) { akk[i] = 0.f; aqk[i] = 0.f; }
#pragma unroll
    for (int ks = 0; ks < 8; ++ks) { const bf16x8 kf = *(const bf16x8*)(kp + 16 * ks), qf = *(const bf16x8*)(qp + 16 * ks);
        akk = __builtin_amdgcn_mfma_f32_32x32x16_bf16(kf, kf, akk, 0, 0, 0); aqk = __builtin_amdgcn_mfma_f32_32x32x16_bf16(kf, qf, aqk, 0, 0, 0); }
#pragma unroll
    for (int g4 = 0; g4 < 4; ++g4) { f32x4 w;
#pragma unroll
        for (int e = 0; e < 4; ++e) { const int k0 = 8 * g4 + e, k1 = k0 + 4; const float gk = h ? gcv[k1] : gcv[k0], bk = h ? bev[k1] : bev[k0]; const int kk = h ? k1 : k0;
            const float lo = fminf(fmaxf((float)kk - fr, 0.f), 1.f);
            w[e] = lo * bk * akk[4 * g4 + e] * __expf(fminf(gk - gc_own, 0.f));
            aqk[4 * g4 + e] = (1.f - lo) * aqk[4 * g4 + e] * __expf(fminf(gc_own - gk, 0.f)); }
        *(LAS f32x4*)(LT + r * GA_LT_PITCH + 8 * g4 + 4 * h) = w; }
    bf16x8* AF = (bf16x8*)(F.ws + WS_AF) + (size_t)ch * 128;
    AF[lane] = pack_acc(aqk, 0); AF[64 + lane] = pack_acc(aqk, 1);
    asm volatile("s_waitcnt lgkmcnt(0)" ::: "memory");
    float t[32];
#pragma unroll
    for (int j = 31; j >= 0; --j) {
        float acc = 1.f - fminf(fabsf(fr - (float)j), 1.f);
#pragma unroll
        for (int gq = (j + 1) >> 2; gq < 8; ++gq) { const f32x4 lv = *(const LAS f32x4*)(LT + j * GA_LT_PITCH + 4 * gq);
#pragma unroll
            for (int e = 0; e < 4; ++e) if (4 * gq + e > j) acc -= t[4 * gq + e] * lv[e]; }
        t[j] = acc;
    }
    bf16x8 t1f[2], t2f[2];
#pragma unroll
    for (int sp = 0; sp < 2; ++sp) { float x1[8], x2[8];
#pragma unroll
        for (int e = 0; e < 8; ++e) { const int j0 = 16 * sp + e, j1 = j0 + 8; const float tv = h ? t[j1] : t[j0], bj = h ? bev[j1] : bev[j0], gj = h ? gcv[j1] : gcv[j0]; x1[e] = tv * bj; x2[e] = x1[e] * __expf(gj); }
        t1f[sp] = __builtin_bit_cast(bf16x8, pack8(x1)); t2f[sp] = __builtin_bit_cast(bf16x8, pack8(x2)); }
    { bf16x8* QFo = (bf16x8*)(F.ws + WS_QF) + (size_t)ch * 512; const bf16* qrow = QN + (size_t)(row0 + r) * 1024 + hd * 128 + 4 * h;
#pragma unroll
      for (int tl = 0; tl < 4; ++tl)
#pragma unroll
          for (int sp = 0; sp < 2; ++sp) { const v2u qlo = *(const v2u*)(qrow + 32 * tl + 16 * sp), qhi = *(const v2u*)(qrow + 32 * tl + 16 * sp + 8); v4u qu; qu.x = qlo.x; qu.y = qlo.y; qu.z = qhi.x; qu.w = qhi.y; QFo[(tl * 2 + sp) * 64 + lane] = __builtin_bit_cast(bf16x8, qu); } }
    const float g_last = gcv[31];
    bf16x8* WF = (bf16x8*)(F.ws + WS_WF) + (size_t)ch * 512; bf16x8* KF = (bf16x8*)(F.ws + WS_KF) + (size_t)ch * 512;
#pragma unroll
    for (int tl = 0; tl < 4; ++tl) {
        f32x16 acc;
#pragma unroll
        for (int i = 0; i < 16; ++i) acc[i] = 0.f;
        const LAS unsigned char* col = TL + (32 * tl + r) * 2;
#pragma unroll
        for (int sp = 0; sp < 2; ++sp) { unsigned w[4];
#pragma unroll
            for (int e = 0; e < 4; ++e) { const unsigned lo = *(const LAS unsigned short*)(col + (16 * sp + 8 * h + 2 * e) * GA_PITCH), hi = *(const LAS unsigned short*)(col + (16 * sp + 8 * h + 2 * e + 1) * GA_PITCH); w[e] = lo | (hi << 16); }
            v4u wu; wu.x = w[0]; wu.y = w[1]; wu.z = w[2]; wu.w = w[3];
            acc = __builtin_amdgcn_mfma_f32_32x32x16_bf16(__builtin_bit_cast(bf16x8, wu), t2f[sp], acc, 0, 0, 0); }
#pragma unroll
        for (int i = 0; i < 16; ++i) acc[i] = -acc[i];
#pragma unroll
        for (int sp = 0; sp < 2; ++sp) { WF[(tl * 2 + sp) * 64 + lane] = pack_acc(acc, sp);
            float x[8];
#pragma unroll
            for (int e = 0; e < 8; ++e) { const int j0 = 16 * sp + 8 * (e >> 2) + (e & 3), j1 = j0 + 4; const float gj = h ? gcv[j1] : gcv[j0];
                const unsigned kv = *(const LAS unsigned short*)(col + (j0 + 4 * h) * GA_PITCH); x[e] = __builtin_bit_cast(float, kv << 16) * __expf(g_last - gj); }
            KF[(tl * 2 + sp) * 64 + lane] = __builtin_bit_cast(bf16x8, pack8(x)); }
    }
    asm volatile("s_waitcnt lgkmcnt(0)" ::: "memory");
#pragma unroll
    for (int i = 0; i < 8; ++i) { const int p = lane + 64 * i, rw = p >> 4, c16 = p & 15; *(LAS v4u*)(TL + rw * GA_PITCH + 16 * c16) = *(const v4u*)(VV + (size_t)(row0 + rw) * 1024 + hd * 128 + 8 * c16); }
    asm volatile("s_waitcnt lgkmcnt(0)" ::: "memory");
    f32x4* UF = (f32x4*)(F.ws + WS_UF) + (size_t)ch * 1024;
#pragma unroll
    for (int tl = 0; tl < 4; ++tl) {
        f32x16 acc;
#pragma unroll
        for (int i = 0; i < 16; ++i) acc[i] = 0.f;
        const LAS unsigned char* col = TL + (32 * tl + r) * 2;
#pragma unroll
        for (int sp = 0; sp < 2; ++sp) { unsigned w[4];
#pragma unroll
            for (int e = 0; e < 4; ++e) { const unsigned lo = *(const LAS unsigned short*)(col + (16 * sp + 8 * h + 2 * e) * GA_PITCH), hi = *(const LAS unsigned short*)(col + (16 * sp + 8 * h + 2 * e + 1) * GA_PITCH); w[e] = lo | (hi << 16); }
            v4u wu; wu.x = w[0]; wu.y = w[1]; wu.z = w[2]; wu.w = w[3];
            acc = __builtin_amdgcn_mfma_f32_32x32x16_bf16(t1f[sp], __builtin_bit_cast(bf16x8, wu), acc, 0, 0, 0); }
#pragma unroll
        for (int g4 = 0; g4 < 4; ++g4) UF[(tl * 4 + g4) * 64 + lane] = (f32x4){acc[4 * g4], acc[4 * g4 + 1], acc[4 * g4 + 2], acc[4 * g4 + 3]};
    }
    if (h == 0) ((float*)(F.ws + WS_TB))[(size_t)ch * 32 + r] = __expf(gc_own);
    asm volatile("s_waitcnt lgkmcnt(0)" ::: "memory");
}

constexpr int GSC_ITEMS = BATCH * HA * 4;
constexpr int GSB_WF = 0, GSB_KF = 8192, GSB_QF = 16384, GSB_UF = 24576, GSB_AF = 28672, GSB_TB = 30720, GSB_AL = 34816, GSB_STRIDE = 36864;
__device__ __forceinline__ void gdn_chunk_scan(Frame& F0, int l, int item) {
    RELANE(F0);
    const int lane = F.lane, r = lane & 31, h = lane >> 5;
    const int sl = item & 3, bh = item >> 2, hd = bh & 7, b = bh >> 3;
    float* ORAW = (float*)(F.ws + WS_ORAW);
    LAS unsigned char* buf = F.lds;
#define GS_DMA(src, off) __builtin_amdgcn_global_load_lds((const unsigned*)(src), (LAS unsigned*)(bp + (off)), 16, 0, 0)
#define GS_FETCH(cc, bsel) do { const size_t ch_ = (size_t)bh * 64 + (cc); LAS unsigned char* bp = buf + (bsel) * GSB_STRIDE; \
        const bf16x8* wf_ = (const bf16x8*)(F.ws + WS_WF) + ch_ * 512 + lane; const bf16x8* kf_ = (const bf16x8*)(F.ws + WS_KF) + ch_ * 512 + lane; const bf16x8* qf_ = (const bf16x8*)(F.ws + WS_QF) + ch_ * 512 + lane; \
        const f32x4* uf_ = (const f32x4*)(F.ws + WS_UF) + ch_ * 1024 + (size_t)sl * 256 + lane; const bf16x8* af_ = (const bf16x8*)(F.ws + WS_AF) + ch_ * 128 + lane; const float* tb_ = (const float*)(F.ws + WS_TB) + ch_ * 32; \
        _Pragma("unroll") for (int i_ = 0; i_ < 8; ++i_) { GS_DMA(wf_ + i_ * 64, GSB_WF + i_ * 1024); GS_DMA(qf_ + i_ * 64, GSB_QF + i_ * 1024); } \
        _Pragma("unroll") for (int i_ = 0; i_ < 4; ++i_) { GS_DMA(uf_ + i_ * 64, GSB_UF + i_ * 1024); GS_DMA(tb_ + 8 * i_ + 4 * h, GSB_TB + i_ * 1024); } \
        GS_DMA(af_, GSB_AF); GS_DMA(af_ + 64, GSB_AF + 1024); GS_DMA(tb_ + 28, GSB_AL); \
        _Pragma("unroll") for (int i_ = 0; i_ < 8; ++i_) GS_DMA(kf_ + i_ * 64, GSB_KF + i_ * 1024); } while (0)
    f32x16 S[4];
#pragma unroll
    for (int tl = 0; tl < 4; ++tl)
#pragma unroll
        for (int i = 0; i < 16; ++i) S[tl][i] = 0.f;
    GS_FETCH(0, 0);
#pragma unroll 1
    for (int c = 0; c < SEQ / 32; ++c) {
        const int row0 = b * SEQ + 32 * c;
        asm volatile("s_waitcnt vmcnt(0)" ::: "memory");
        if (c + 1 < SEQ / 32) GS_FETCH(c + 1, (c + 1) & 1);
        const LAS unsigned char* bp = buf + (c & 1) * GSB_STRIDE + lane * 16;
        f32x16 P, O1;
#pragma unroll
        for (int g4 = 0; g4 < 4; ++g4) { const f32x4 u = *(const LAS f32x4*)(bp + GSB_UF + g4 * 1024); P[4 * g4] = u.x; P[4 * g4 + 1] = u.y; P[4 * g4 + 2] = u.z; P[4 * g4 + 3] = u.w; }
#pragma unroll
        for (int i = 0; i < 16; ++i) O1[i] = 0.f;
#pragma unroll
        for (int tl = 0; tl < 4; ++tl)
#pragma unroll
            for (int sp = 0; sp < 2; ++sp) {
                const bf16x8 sf = pack_acc(S[tl], sp);
                P = __builtin_amdgcn_mfma_f32_32x32x16_bf16(*(const LAS bf16x8*)(bp + GSB_WF + (tl * 2 + sp) * 1024), sf, P, 0, 0, 0);
                O1 = __builtin_amdgcn_mfma_f32_32x32x16_bf16(*(const LAS bf16x8*)(bp + GSB_QF + (tl * 2 + sp) * 1024), sf, O1, 0, 0, 0);
            }
#pragma unroll
        for (int g4 = 0; g4 < 4; ++g4) { const f32x4 eg = *(const LAS f32x4*)(bp + GSB_TB + g4 * 1024); O1[4 * g4] *= eg.x; O1[4 * g4 + 1] *= eg.y; O1[4 * g4 + 2] *= eg.z; O1[4 * g4 + 3] *= eg.w; }
        const bf16x8 vf0 = pack_acc(P, 0), vf1 = pack_acc(P, 1);
        O1 = __builtin_amdgcn_mfma_f32_32x32x16_bf16(*(const LAS bf16x8*)(bp + GSB_AF), vf0, O1, 0, 0, 0);
        O1 = __builtin_amdgcn_mfma_f32_32x32x16_bf16(*(const LAS bf16x8*)(bp + GSB_AF + 1024), vf1, O1, 0, 0, 0);
        const float a_last = (*(const LAS f32x4*)(bp + GSB_AL)).w;
#pragma unroll
        for (int tl = 0; tl < 4; ++tl) {
#pragma unroll
            for (int i = 0; i < 16; ++i) S[tl][i] *= a_last;
            S[tl] = __builtin_amdgcn_mfma_f32_32x32x16_bf16(*(const LAS bf16x8*)(bp + GSB_KF + (tl * 2) * 1024), vf0, S[tl], 0, 0, 0);
            S[tl] = __builtin_amdgcn_mfma_f32_32x32x16_bf16(*(const LAS bf16x8*)(bp + GSB_KF + (tl * 2 + 1) * 1024), vf1, S[tl], 0, 0, 0);
        }
        float* op = ORAW + (size_t)(row0 + 4 * h) * 1024 + hd * 128 + 32 * sl + r;
#pragma unroll
        for (int i = 0; i < 16; ++i) op[(size_t)((i & 3) + 8 * (i >> 2)) * 1024] = O1[i];
    }
#undef GS_DMA
#undef GS_FETCH
    float* Sout = F.out + O_PGDN + (size_t)((l * BATCH + b) * HA + hd) * 16384 + 32 * sl + r;
#pragma unroll
    for (int tl = 0; tl < 4; ++tl)
#pragma unroll
        for (int i = 0; i < 16; ++i) Sout[(size_t)(32 * tl + (i & 3) + 8 * (i >> 2) + 4 * h) * 128] = S[tl][i];
}

constexpr int VT_PITCH = 144, VT_WAVE_LDS = 64 * VT_PITCH, VT_ITEMS = BATCH * 3 * 4 * 2 * 32;
__device__ __forceinline__ void vt_item(Frame& F0, int item) {
    RELANE(F0);
    const int lane = F.lane; LAS unsigned char* T = F.lds + F.wave * VT_WAVE_LDS;
    const int ch = item & 31, dh = (item >> 5) & 1, hh = (item >> 6) & 3, bg = item >> 8, g = bg % 3, b = bg / 3;
    const int dil = 1 << (2 * g), Lc = SEQ >> (2 * g), pos0 = ch * 64, rho = pos0 / Lc, i0 = pos0 % Lc;
    const bf16* PROJ = (const bf16*)(F.ws + WS_PROJ); bf16* VT = (bf16*)(F.ws + WS_VT);
    const bf16* src = PROJ + ((size_t)b * SEQ + (size_t)(i0 + lane) * dil + rho) * NIN + PC_VB + g * 512 + hh * 128 + 64 * dh;
    v4u x[8];
#pragma unroll
    for (int c = 0; c < 8; ++c) x[c] = *(const v4u*)(src + 8 * c);
#pragma unroll
    for (int c = 0; c < 8; ++c) { const unsigned w[4] = {x[c].x, x[c].y, x[c].z, x[c].w};
#pragma unroll
        for (int e = 0; e < 4; ++e) { *(LAS unsigned short*)(T + (8 * c + 2 * e) * VT_PITCH + 2 * lane) = (unsigned short)(w[e] & 0xffffu); *(LAS unsigned short*)(T + (8 * c + 2 * e + 1) * VT_PITCH + 2 * lane) = (unsigned short)(w[e] >> 16); } }
    asm volatile("s_waitcnt lgkmcnt(0)" ::: "memory");
    bf16* dst = VT + ((size_t)((b * 3 + g) * 4 + hh) * 128 + 64 * dh) * 2048 + pos0;
#pragma unroll
    for (int it = 0; it < 8; ++it) { const int p = lane + 64 * it, row = p >> 3, cc = p & 7; const v4u v = *(const LAS v4u*)(T + row * VT_PITCH + 16 * cc); *(v4u*)(dst + (size_t)row * 2048 + 8 * cc) = v; }
    asm volatile("s_waitcnt lgkmcnt(0)" ::: "memory");
}

constexpr int ATT_UNITS = BATCH * 4 * 192;
__device__ __forceinline__ void attn_unit(Frame& F0, int unit) {
    RELANE(F0);
    const int lane = F.lane, r = lane & 31, h = lane >> 5;
    const int bh = unit / 192, b = bh >> 2, hh = bh & 3, u = unit % 192, g = u >> 6, v = u & 63;
    const int dil = 1 << (2 * g), ntpc = 64 >> (2 * g), rho = v / ntpc, i0 = (v % ntpc) * 32, Lc = SEQ >> (2 * g);
    const bf16* PROJ = (const bf16*)(F.ws + WS_PROJ);
    const bf16* cbase = PROJ + ((size_t)b * SEQ + rho) * NIN + g * 512 + hh * 128 + 8 * h;
    const bf16* qp = cbase + (size_t)(i0 + r) * dil * NIN + PC_QB;
    bf16x8 qf[8];
#pragma unroll
    for (int ks = 0; ks < 8; ++ks) qf[ks] = *(const bf16x8*)(qp + 16 * ks);
    f32x16 st[5]; float mx = -1e30f;
    bf16x8 kn[8];
    { const int k0 = i0 - 128; const bf16* kp = cbase + (size_t)((k0 >= 0 ? k0 : 0) + r) * dil * NIN + PC_KB;
#pragma unroll
      for (int ks = 0; ks < 8; ++ks) kn[ks] = *(const bf16x8*)(kp + 16 * ks); }
#pragma unroll
    for (int kt = 0; kt < 5; ++kt) {
        const int k0 = i0 - 128 + 32 * kt; const bool tv = k0 >= 0;
        bf16x8 kc[8];
#pragma unroll
        for (int ks = 0; ks < 8; ++ks) kc[ks] = kn[ks];
        if (kt < 4) { const int k1 = k0 + 32; const bf16* kp = cbase + (size_t)((k1 >= 0 ? k1 : 0) + r) * dil * NIN + PC_KB;
#pragma unroll
            for (int ks = 0; ks < 8; ++ks) kn[ks] = *(const bf16x8*)(kp + 16 * ks); }
        f32x16 acc;
#pragma unroll
        for (int i = 0; i < 16; ++i) acc[i] = 0.f;
#pragma unroll
        for (int ks = 0; ks < 8; ++ks) acc = __builtin_amdgcn_mfma_f32_32x32x16_bf16(kc[ks], qf[ks], acc, 0, 0, 0);
#pragma unroll
        for (int i = 0; i < 16; ++i) { const int row = (i & 3) + 8 * (i >> 2) + 4 * h; float sv = tv ? acc[i] : -1e30f;
            if (kt == 0 && row < r) sv = -1e30f;
            if (kt == 4 && row > r) sv = -1e30f;
            st[kt][i] = sv; mx = fmaxf(mx, sv); }
    }
    mx = fmaxf(mx, __shfl_xor(mx, 32));
    const float c = 0.08838834764831845f * 1.4426950408889634f, mc = mx * c; float ls = 0.f;
#pragma unroll
    for (int kt = 0; kt < 5; ++kt)
#pragma unroll
        for (int i = 0; i < 16; ++i) { const float p = __builtin_amdgcn_exp2f(st[kt][i] * c - mc); st[kt][i] = p; ls += p; }
    ls += __shfl_xor(ls, 32);
    f32x16 ot[4];
#pragma unroll
    for (int dt = 0; dt < 4; ++dt)
#pragma unroll
        for (int i = 0; i < 16; ++i) ot[dt][i] = 0.f;
    const bf16* vt = (const bf16*)(F.ws + WS_VT) + ((size_t)((b * 3 + g) * 4 + hh) * 128 + r) * 2048 + rho * Lc + 4 * h;
    v2u vn[2][4][2];
#define ATT_VLD(kt_) do { const int k0_ = i0 - 128 + 32 * (kt_), kc_ = k0_ >= 0 ? k0_ : 0; _Pragma("unroll") for (int sp = 0; sp < 2; ++sp) _Pragma("unroll") for (int dt = 0; dt < 4; ++dt) { \
            const bf16* vp = vt + (size_t)(32 * dt) * 2048 + kc_ + 16 * sp; vn[sp][dt][0] = *(const v2u*)vp; vn[sp][dt][1] = *(const v2u*)(vp + 8); } } while (0)
    ATT_VLD(0);
#pragma unroll
    for (int kt = 0; kt < 5; ++kt) {
        v2u vc[2][4][2];
#pragma unroll
        for (int sp = 0; sp < 2; ++sp)
#pragma unroll
            for (int dt = 0; dt < 4; ++dt) { vc[sp][dt][0] = vn[sp][dt][0]; vc[sp][dt][1] = vn[sp][dt][1]; }
        if (kt < 4) ATT_VLD(kt + 1);
#pragma unroll
        for (int sp = 0; sp < 2; ++sp) {
            v4u pu; pu.x = pk2(st[kt][8 * sp + 0], st[kt][8 * sp + 1]); pu.y = pk2(st[kt][8 * sp + 2], st[kt][8 * sp + 3]); pu.z = pk2(st[kt][8 * sp + 4], st[kt][8 * sp + 5]); pu.w = pk2(st[kt][8 * sp + 6], st[kt][8 * sp + 7]);
            const bf16x8 pf = __builtin_bit_cast(bf16x8, pu);
#pragma unroll
            for (int dt = 0; dt < 4; ++dt) {
                v4u vu; vu.x = vc[sp][dt][0].x; vu.y = vc[sp][dt][0].y; vu.z = vc[sp][dt][1].x; vu.w = vc[sp][dt][1].y;
                ot[dt] = __builtin_amdgcn_mfma_f32_32x32x16_bf16(__builtin_bit_cast(bf16x8, vu), pf, ot[dt], 0, 0, 0);
            }
        }
    }
#undef ATT_VLD
    const float inv = 1.f / ls; const size_t tok = (size_t)b * SEQ + (size_t)(i0 + r) * dil + rho;
    bf16* op = (bf16*)(F.ws + WS_OBG) + ((size_t)g * MV + tok) * 512 + hh * 128 + 4 * h;
#pragma unroll
    for (int dt = 0; dt < 4; ++dt)
#pragma unroll
        for (int g4 = 0; g4 < 4; ++g4) { v2u w; w.x = pk2(ot[dt][4 * g4] * inv, ot[dt][4 * g4 + 1] * inv); w.y = pk2(ot[dt][4 * g4 + 2] * inv, ot[dt][4 * g4 + 3] * inv); *(v2u*)(op + 32 * dt + 8 * g4) = w; }
    if (h == 0) *(f32x2*)((float*)(F.ws + WS_AST) + (((size_t)g * MV + tok) * 4 + hh) * 2) = (f32x2){mc, ls};
}


__device__ __forceinline__ void attn_sample_item(Frame& F0, int l, int item) {
    RELANE(F0);
    const int lane = F.lane, l16 = lane & 15;
    const int half = item & 1, it2 = item >> 1, g = it2 % 3, bt = it2 / 3, t = bt & 3, b = bt >> 2, dil = 1 << (2 * g), win = 128 * dil, jlo = half ? 65 : 0, part = g + 3 * half;
    const bf16* PROJ = (const bf16*)(F.ws + WS_PROJ);
    const int row = MP + DS * b + t;
    const float* cache = F.in[2 + g] + (size_t)(l * DB + b) * win * 1024 + 8 * lane;
    const bf16* newk = PROJ + (size_t)(MP + DS * b) * NIN + PC_KB + g * 512 + 8 * lane;
    float q[8]; unpack8(*(const v4u*)(PROJ + (size_t)row * NIN + PC_QB + g * 512 + 8 * lane), q);
    const int n_new = (g == 0) ? t + 1 : 1;
    const float c = 0.08838834764831845f * 1.4426950408889634f;
    float sc[5];
#pragma unroll
    for (int jr = 0; jr < 5; ++jr) {
        sc[jr] = -1e30f;
        const int jn = jr < 4 ? 16 : 1;
#pragma unroll 8
        for (int jl = 0; jl < jn; ++jl) {
            const int j = jlo + 16 * jr + jl, jc = j <= 128 ? j : 128; int idx = win + t - jc * dil; idx = idx < win ? idx : win - 1;
            const float* kp = cache + (size_t)idx * 1024; const f32x4 a = *(const f32x4*)kp, bq = *(const f32x4*)(kp + 4);
            float sv = (q[0] * a.x + q[1] * a.y) + (q[2] * a.z + q[3] * a.w) + (q[4] * bq.x + q[5] * bq.y) + (q[6] * bq.z + q[7] * bq.w);
            sv = j <= 128 ? row16_sum(sv) * c : -1e30f;
            sc[jr] = (l16 == jl) ? sv : sc[jr];
        }
    }
#pragma unroll
    for (int jj = 0; jj < 4; ++jj) {
        const int tk = t - jj >= 0 ? t - jj : 0; float k[8]; unpack8(*(const v4u*)(newk + (size_t)tk * NIN), k);
        float sv = (q[0] * k[0] + q[1] * k[1]) + (q[2] * k[2] + q[3] * k[3]) + (q[4] * k[4] + q[5] * k[5]) + (q[6] * k[6] + q[7] * k[7]);
        sv = row16_sum(sv) * c;
        sc[0] = (half == 0 && jj < n_new && l16 == jj) ? sv : sc[0];
    }
    float mx = -1e30f;
#pragma unroll
    for (int jr = 0; jr < 5; ++jr) mx = fmaxf(mx, sc[jr]);
    mx = fmaxf(mx, dpp_f<0xB1>(mx)); mx = fmaxf(mx, dpp_f<0x4E>(mx)); mx = fmaxf(mx, dpp_f<0x124>(mx)); mx = fmaxf(mx, dpp_f<0x128>(mx));
    float ls = 0.f;
#pragma unroll
    for (int jr = 0; jr < 5; ++jr) { sc[jr] = __builtin_amdgcn_exp2f(sc[jr] - mx); ls += sc[jr]; }
    ls = row16_sum(ls);
    float o[8];
#pragma unroll
    for (int e = 0; e < 8; ++e) o[e] = 0.f;
#pragma unroll
    for (int jj = 0; jj < 4; ++jj) {
        const int tk = t - jj >= 0 ? t - jj : 0; float vv[8]; unpack8(*(const v4u*)(newk + (size_t)tk * NIN + (PC_VB - PC_KB)), vv);
        const bool isnew = half == 0 && jj < n_new;
        const float p = isnew ? __shfl(sc[0], (lane & 48) | jj) : 0.f;
#pragma unroll
        for (int e = 0; e < 8; ++e) o[e] += p * vv[e];
        sc[0] = (isnew && l16 == jj) ? 0.f : sc[0];
    }
#pragma unroll
    for (int jr = 0; jr < 5; ++jr) {
        const int jn = jr < 4 ? 16 : 1;
#pragma unroll 8
        for (int jl = 0; jl < jn; ++jl) {
            const int j = jlo + 16 * jr + jl, jc = j <= 128 ? j : 128; int idx = win + t - jc * dil; idx = idx < win ? idx : win - 1;
            const float p = __shfl(sc[jr], (lane & 48) | jl);
            const float* vp = cache + (size_t)idx * 1024 + 512; const f32x4 a = *(const f32x4*)vp, bq = *(const f32x4*)(vp + 4);
            o[0] += p * a.x; o[1] += p * a.y; o[2] += p * a.z; o[3] += p * a.w; o[4] += p * bq.x; o[5] += p * bq.y; o[6] += p * bq.z; o[7] += p * bq.w;
        }
    }
    const float inv = 1.f / ls;
#pragma unroll
    for (int e = 0; e < 8; ++e) o[e] *= inv;
    *(v4u*)((bf16*)(F.ws + WS_OBG) + ((size_t)part * MV + row) * 512 + 8 * lane) = pack8(o);
    if (l16 == 0) *(f32x2*)((float*)(F.ws + WS_AST) + (((size_t)part * MV + row) * 4 + (lane >> 4)) * 2) = (f32x2){mx, ls};
}

__device__ __forceinline__ void gdn_gate_rows(Frame& F0, int l) {
    RELANE(F0);
    const int lane = F.lane, gw = F.vcu * NWAVES + F.wave, NGW = F.G * NWAVES;
    const float* ORAW = (const float*)(F.ws + WS_ORAW); const bf16* PROJ = (const bf16*)(F.ws + WS_PROJ); bf16* OUTA = (bf16*)(F.ws + WS_OUTA);
    const float* gain = F.in[12] + (size_t)l * 128;
    for (int r = gw; r < MV; r += NGW) {
#pragma unroll
        for (int j = 0; j < 4; ++j) {
            const int c0 = 256 * j + 4 * lane; const f32x4 o = *(const f32x4*)(ORAW + (size_t)r * 1024 + c0);
            float ss = (o.x * o.x + o.y * o.y) + (o.z * o.z + o.w * o.w);
            ss += __shfl_xor(ss, 1); ss += __shfl_xor(ss, 2); ss += __shfl_xor(ss, 4); ss += __shfl_xor(ss, 8); ss += __shfl_xor(ss, 16);
            const float rstd = rsqrtf(ss * (1.f / 128.f) + EPS);
            const f32x4 g = *(const f32x4*)(gain + (c0 & 127)); const v2u zu = *(const v2u*)(PROJ + (size_t)r * NIN + PC_ZA + c0);
            const float z0 = bf_lo(zu.x), z1 = bf_hi(zu.x), z2 = bf_lo(zu.y), z3 = bf_hi(zu.y);
            v2u w; w.x = pk2(o.x * rstd * g.x * silu(z0), o.y * rstd * g.y * silu(z1)); w.y = pk2(o.z * rstd * g.z * silu(z2), o.w * rstd * g.w * silu(z3));
            *(v2u*)(OUTA + (size_t)r * 1024 + c0) = w;
        }
        {
            const int c0 = 8 * lane, hh = lane >> 4; const float* ast = (const float*)(F.ws + WS_AST); const bf16* obg = (const bf16*)(F.ws + WS_OBG);
            const int np = r < MP ? 3 : 6;
            f32x2 sg[6]; v4u xo[6]; float M = -1e30f;
#pragma unroll
            for (int g = 0; g < 6; ++g) { const int gg = g < np ? g : 0; sg[g] = *(const f32x2*)(ast + (((size_t)gg * MV + r) * 4 + hh) * 2); xo[g] = *(const v4u*)(obg + ((size_t)gg * MV + r) * 512 + c0); }
#pragma unroll
            for (int g = 0; g < 6; ++g) { if (g >= np) sg[g] = (f32x2){-1e30f, 0.f}; M = fmaxf(M, sg[g].x); }
            float wg[6], den = 0.f;
#pragma unroll
            for (int g = 0; g < 6; ++g) { wg[g] = __builtin_amdgcn_exp2f(sg[g].x - M) * sg[g].y; den += wg[g]; }
            const float inv = 1.f / den; float o[8];
#pragma unroll
            for (int e = 0; e < 8; ++e) o[e] = 0.f;
#pragma unroll
            for (int g = 0; g < 6; ++g) { float x[8]; unpack8(xo[g], x); const float w = wg[g] * inv;
#pragma unroll
                for (int e = 0; e < 8; ++e) o[e] += w * x[e]; }
            *(v4u*)((bf16*)(F.ws + WS_OUTB) + (size_t)r * 512 + c0) = pack8(o);
        }
    }
}


constexpr int CP_PER_B = 31 + 127 + 511, CP_NSUB = DB * CP_PER_B;
constexpr int CP_TAIL_WG = 84, CP_TAIL_PER_WG = 64, CP_TAIL = CP_TAIL_WG * CP_TAIL_PER_WG;
__device__ __forceinline__ void copy_subchunk(Frame& F, int l, int c) {
    const int lane = F.lane, b = c / CP_PER_B, rc = c % CP_PER_B; const int gi = rc < 31 ? 0 : rc < 158 ? 1 : 2, k = rc - (gi == 0 ? 0 : gi == 1 ? 31 : 158), win = 128 << (2 * gi);
    const f32x4* src = (const f32x4*)(F.in[2 + gi] + ((size_t)(l * DB + b) * win + DS + 4 * k) * 1024) + lane;
    f32x4* dst = (f32x4*)(F.out + (gi == 0 ? O_SW1 : gi == 1 ? O_SW2 : O_SW3) + ((size_t)(l * DB + b) * win + 4 * k) * 1024) + lane;
    f32x4 v[16];
#pragma unroll
    for (int i = 0; i < 16; ++i) v[i] = __builtin_nontemporal_load(src + 64 * i);
#pragma unroll
    for (int i = 0; i < 16; ++i) __builtin_nontemporal_store(v[i], dst + 64 * i);
}
__device__ __forceinline__ void side_queue(Frame& F0, int l, volatile LAS unsigned* qctr) {
    RELANE(F0);
    const int lane = F.lane;
    const int nsub = CP_NSUB - (F.G == 256 ? CP_TAIL : 0);
    const int ncp = (nsub - (int)blockIdx.x + F.G - 1) / F.G;
    const int wper = 0,     w0 = (int)blockIdx.x * wper, nw = max(0, min(IT_LAYER, w0 + wper) - w0);
    LAS float* scr = (LAS float*)F.lds;
    for (;;) {
        unsigned q = 0; if (lane == 0) q = __hip_atomic_fetch_add((LAS unsigned*)qctr, 1u, __ATOMIC_RELAXED, __HIP_MEMORY_SCOPE_WORKGROUP);
        q = (unsigned)__builtin_amdgcn_readfirstlane((int)q);
        if ((int)q >= ncp + nw) break;
        if ((int)q < ncp) { copy_subchunk(F, l, (int)q * F.G + (int)blockIdx.x);
        } else weight_item(F, l + 1, w0 + (int)q - ncp, scr);
    }
}


__device__ __forceinline__ f32x16 skinny_kloop(const bf16* ap, const bf16* bp, int nks, f32x16 acc) {
    int ks = 0;
    for (; ks + 8 <= nks; ks += 8) { bf16x8 a[8], b[8];
#pragma unroll
        for (int u = 0; u < 8; ++u) { a[u] = *(const bf16x8*)(ap + 16 * (ks + u)); b[u] = *(const bf16x8*)(bp + 16 * (ks + u)); }
#pragma unroll
        for (int u = 0; u < 8; ++u) acc = __builtin_amdgcn_mfma_f32_32x32x16_bf16(a[u], b[u], acc, 0, 0, 0); }
    for (; ks < nks; ks += 4) { bf16x8 a[4], b[4];
#pragma unroll
        for (int u = 0; u < 4; ++u) { a[u] = *(const bf16x8*)(ap + 16 * (ks + u)); b[u] = *(const bf16x8*)(bp + 16 * (ks + u)); }
#pragma unroll
        for (int u = 0; u < 4; ++u) acc = __builtin_amdgcn_mfma_f32_32x32x16_bf16(a[u], b[u], acc, 0, 0, 0); }
    return acc;
}
__device__ __forceinline__ f32x2 skinny_reduce(Frame& F, const f32x16& acc) {
    LAS float* P = (LAS float*)F.lds; const int r = F.lane & 31, h = F.lane >> 5;
    __syncthreads();
#pragma unroll
    for (int i = 0; i < 16; ++i) P[(F.wave * 32 + (i & 3) + 8 * (i >> 2) + 4 * h) * 33 + r] = acc[i];
    __syncthreads();
    const int row = F.tid >> 4, col = 2 * (F.tid & 15); f32x2 o = {0.f, 0.f};
#pragma unroll
    for (int w = 0; w < 8; ++w) { o.x += P[(w * 32 + row) * 33 + col]; o.y += P[(w * 32 + row) * 33 + col + 1]; }
    return o;
}
__device__ __forceinline__ void skinny_store(Frame& F0, const bf16* A, int lda, const bf16* Bt, int K, bf16* O) {
    RELANE(F0);
    const int r = F.lane & 31, h = F.lane >> 5, kw = K / 8;
    for (int unit = launder_s((int)blockIdx.x); unit < 256; unit += F.G) {
        const int mt = unit >> 6, nt = unit & 63;
        f32x16 acc;
#pragma unroll
        for (int i = 0; i < 16; ++i) acc[i] = 0.f;
        acc = skinny_kloop(A + (size_t)(MP + 32 * mt + r) * lda + F.wave * kw + 8 * h, Bt + (size_t)(32 * nt + r) * K + F.wave * kw + 8 * h, kw / 16, acc);
        const f32x2 o = skinny_reduce(F, acc);
        *(unsigned*)(O + (size_t)(MP + 32 * mt + (F.tid >> 4)) * D + 32 * nt + 2 * (F.tid & 15)) = pk2(o.x, o.y);
    }
}
__device__ __forceinline__ void skinny_merge(Frame& F0, const unsigned char* wl) {
    RELANE(F0);
    const int r = F.lane & 31, h = F.lane >> 5; const bf16* PROJ = (const bf16*)(F.ws + WS_PROJ);
    for (int unit = launder_s((int)blockIdx.x); unit < 256; unit += F.G) {
        const int mt = unit >> 6, nt = unit & 63;
        f32x16 tot;
#pragma unroll
        for (int i = 0; i < 16; ++i) tot[i] = 0.f;
#pragma unroll
        for (int br = 0; br < 3; ++br) {
            const int K = br == 1 ? 512 : 1024, kw = K / 8;
            const bf16* A = (const bf16*)(F.ws + (br == 0 ? WS_OUTA : br == 1 ? WS_OUTB : WS_OC)); const bf16* Bt = (const bf16*)(wl + (br == 0 ? WO_BRA : br == 1 ? WO_BRB : WO_BRC));
            f32x16 acc;
#pragma unroll
            for (int i = 0; i < 16; ++i) acc[i] = 0.f;
            acc = skinny_kloop(A + (size_t)(MP + 32 * mt + r) * K + F.wave * kw + 8 * h, Bt + (size_t)(32 * nt + r) * K + F.wave * kw + 8 * h, kw / 16, acc);
            const bf16* gp = PROJ + (size_t)(MP + 32 * mt + 4 * h) * NIN + PC_GATE + br * 2048 + 32 * nt + r;
#pragma unroll
            for (int i = 0; i < 16; ++i) tot[i] += acc[i] * bf1(gp[(size_t)((i & 3) + 8 * (i >> 2)) * NIN]);
        }
        const f32x2 o = skinny_reduce(F, tot);
        *(unsigned*)((bf16*)(F.ws + WS_MERGED) + (size_t)(MP + 32 * mt + (F.tid >> 4)) * D + 32 * nt + 2 * (F.tid & 15)) = pk2(o.x, o.y);
    }
}

constexpr int N_PHASES = 1 + 11 * DEPTH;
__global__ void __launch_bounds__(NWAVES * 64, 2) fwd(Args args) {
    extern __shared__ __attribute__((aligned(16))) unsigned char lds_raw[];
    Frame F;
    F.lds = (LAS unsigned char*)lds_raw;
    F.tid = threadIdx.x; F.lane = F.tid & 63; F.wave = __builtin_amdgcn_readfirstlane(F.tid >> 6);
    F.G = gridDim.x; { const int bx = blockIdx.x; F.vcu = (F.G % 8 == 0) ? (bx % 8) * (F.G / 8) + bx / 8 : bx; }
    const CAS Args* const ap = (const CAS Args*)__builtin_amdgcn_kernarg_segment_ptr();
    F.in = ap->in; F.out = args.out; F.ws = args.ws;
    volatile LAS unsigned* MISC = (volatile LAS unsigned*)(F.lds + MISC_OFF);
    for (int u = F.tid; u < (LDS_BYTES - LDSCTL_OFF) / 4; u += NWAVES * 64) ((LAS unsigned*)(F.lds + LDSCTL_OFF))[u] = 0u;
    __syncthreads();
#if MK_ONE_LAUNCH
    XcdBarrier bar = xcd_barrier_post((unsigned*)(F.ws + WS_CTL) + CW_BAR, MISC + 8);
#define GRID_BAR() xcd_barrier(bar)
#else
#define GRID_BAR() do {} while (0)
#endif
    const int lo = args.ph_lo, hi = args.ph_hi;
#ifndef PHMASK
#define PHMASK 0xfff
#endif
#define IN(k) (lo <= (k) && (k) < hi)
#define EN(j) ((PHMASK >> (j)) & 1)
#ifndef REPMASK
#define REPMASK 0
#endif
#ifndef SUBREP
#define SUBREP 0
#endif
#define SUBR(j) for (int sr_ = 0; sr_ < 1 + ((SUBREP >> (j)) & 1); ++sr_)
#define REPEAT(j) for (int rep_ = 0; rep_ < 1 + ((REPMASK >> (j)) & 1); ++rep_)
#define REPBAR() do { if (rep_) GRID_BAR(); F.ws = launder_p(args.ws); F.out = launder_p(args.out); F.in = launder_k(ap->in); F.vcu = launder_s(vcu0); F.wave = launder_s(wave0); gw = F.vcu * NWAVES + F.wave; } while (0)
#define SEAM(k) do { if (IN(k) && IN((k) + 1)) GRID_BAR(); } while (0)
    const int vcu0 = F.vcu, wave0 = F.wave; int gw = F.vcu * NWAVES + F.wave; const int NGW = F.G * NWAVES;
    bf16* const H = (bf16*)(F.ws + WS_H); bf16* const PROJ = (bf16*)(F.ws + WS_PROJ);

    if (EN(0) && IN(0)) REPEAT(0) { REPBAR();
        LAS float* scr = (LAS float*)(F.lds + F.wave * 16384);
        for (int it = gw; it < 2 * IT_LAYER; it += NGW) { const int l = it >= IT_LAYER ? 1 : 0; weight_item(F, l, it - l * IT_LAYER, scr); }
        __syncthreads();
        stage_wba(F, 0);
        thin_rows<true>(F, F.in[0], F.in[1], nullptr, nullptr, nullptr, F.in[21], true, 0);
        __syncthreads();
    }
    SEAM(0);
#pragma unroll 1
    for (int l = 0; l < DEPTH; ++l) {
        const int pb = 1 + 11 * l;
        unsigned char* wl = F.ws + WS_W + (size_t)l * WL_BYTES;
        if (EN(1) && IN(pb + 0)) REPEAT(1) { REPBAR();
            pg8::Gemm g{H, (const bf16*)(wl + WO_IN), D, D, D, 0, (unsigned*)(F.ws + WS_PAD)}; pg8::StaticOrder S; S.init(MT, NIN, launder_s(F.G), launder_s((int)blockIdx.x));
            EpiStore E{PROJ, NIN, PC_GATE / 256};
            pg8::gemm_phase<EpiStore, pg8::StaticOrder, true, true>(F.lds, g, S, E);
        }
        SEAM(pb + 0);
        if (EN(2) && IN(pb + 1)) REPEAT(2) { REPBAR(); for (int it = gw; it < PREP_ITEMS; it += NGW) prep_item(F, l, it); prep_out_rows(F, l); for (int it = gw; it < VT_ITEMS; it += NGW) vt_item(F, it); }
        SEAM(pb + 1);
        if (EN(3) && IN(pb + 2)) REPEAT(3) { REPBAR(); for (int it = gw; it < GCH; it += NGW) gdn_ga_item(F, it); }
        SEAM(pb + 2);
        if (EN(4) && IN(pb + 3)) REPEAT(4) { REPBAR();
            if (F.tid == 0) MISC[16] = 0u;
            { pg8::Gemm g{(const bf16*)(F.ws + WS_POOLED), (const bf16*)(wl + WO_POOL), 1024, 256, 256, 512}; pg8::StaticOrder S; S.init(MT, 1024, launder_s(F.G), launder_s((int)blockIdx.x));
              EpiStore E{(bf16*)(F.ws + WS_OC), 1024, 1 << 30};
              pg8::gemm_phase<EpiStore, pg8::StaticOrder>(F.lds, g, S, E); }
            SUBR(3) for (int it = gw; it < DB * HA * 8; it += NGW) { const int s = it & 7, bh = it >> 3, b = bh >> 3, h = bh & 7;
                gdn_scan_item(F, MP + DS * b, h, s, F.in[5] + (size_t)((l * DB + b) * HA + h) * 16384, F.out + O_SGDN + (size_t)((l * DB + b) * HA + h) * 16384); }
            {
                const bool scanw = (F.wave == 0) && (F.vcu < GSC_ITEMS);
                if (scanw) { SUBR(0) gdn_chunk_scan(F, l, F.vcu); }
                else {
                    const int aw = F.vcu < GSC_ITEMS ? F.vcu * 7 + F.wave - 1 : GSC_ITEMS * 7 + (F.vcu - GSC_ITEMS) * 8 + F.wave, naw = F.G * 8 - GSC_ITEMS;
                    SUBR(1) for (int it = aw; it < ATT_UNITS; it += naw) attn_unit(F, it);
                    SUBR(2) for (int it = (aw + naw - ATT_UNITS % naw) % naw; it < MS * 6; it += naw) attn_sample_item(F, l, it);
                }
            }
            side_queue(F, l, MISC + 16);
        }
        SEAM(pb + 3);
        if (EN(5) && IN(pb + 4)) REPEAT(5) { REPBAR(); gdn_gate_rows(F, l); }
        SEAM(pb + 4);
        if (EN(6) && IN(pb + 5)) REPEAT(6) { REPBAR();
            pg8::StaticOrder S; S.init(MP, D, launder_s(F.G), launder_s((int)blockIdx.x)); bf16* MG = (bf16*)(F.ws + WS_MERGED);
            { pg8::Gemm g{(const bf16*)(F.ws + WS_OUTA), (const bf16*)(wl + WO_BRA), 1024, 1024, 1024, 0}; EpiMerge<false> E{MG, PROJ + PC_GATE}; pg8::gemm_phase<EpiMerge<false>, pg8::StaticOrder>(F.lds, g, S, E); }
            { pg8::Gemm g{(const bf16*)(F.ws + WS_OUTB), (const bf16*)(wl + WO_BRB), 512, 512, 512, 0}; EpiMerge<true> E{MG, PROJ + PC_GATE + 2048}; pg8::gemm_phase<EpiMerge<true>, pg8::StaticOrder>(F.lds, g, S, E); }
            { pg8::Gemm g{(const bf16*)(F.ws + WS_OC), (const bf16*)(wl + WO_BRC), 1024, 1024, 1024, 0}; EpiMerge<true> E{MG, PROJ + PC_GATE + 4096}; pg8::gemm_phase<EpiMerge<true>, pg8::StaticOrder>(F.lds, g, S, E); }
            skinny_merge(F, wl);
        }
        SEAM(pb + 5);
        if (EN(7) && IN(pb + 6)) REPEAT(7) { REPBAR();
            pg8::Gemm g{(const bf16*)(F.ws + WS_MERGED), (const bf16*)(wl + WO_OUT), D, D, D, 0}; pg8::StaticOrder S; S.init(MP, D, launder_s(F.G), launder_s((int)blockIdx.x));
            EpiStore E{(bf16*)(F.ws + WS_Y), D, 1 << 30};
            pg8::gemm_phase<EpiStore, pg8::StaticOrder>(F.lds, g, S, E);
            skinny_store(F, (const bf16*)(F.ws + WS_MERGED), D, (const bf16*)(wl + WO_OUT), D, (bf16*)(F.ws + WS_Y));
        }
        SEAM(pb + 6);
        if (EN(8) && IN(pb + 7)) REPEAT(8) { REPBAR();
            thin_rows<false>(F, nullptr, nullptr, (const bf16*)(F.ws + WS_Y), F.in[22] + (size_t)l * D, nullptr, F.in[23] + (size_t)l * D, false, 0, 0);
        }
        SEAM(pb + 7);
        if (EN(9) && IN(pb + 8)) REPEAT(9) { REPBAR();
            pg8::Gemm g{H, (const bf16*)(wl + WO_GU), D, D, D, 0, (unsigned*)(F.ws + WS_PAD)}; pg8::StaticOrder S; S.init(MT, 2 * DFF, launder_s(F.G), launder_s((int)blockIdx.x));
            EpiSwiglu E{(bf16*)(F.ws + WS_ACT)};
            pg8::gemm_phase<EpiSwiglu, pg8::StaticOrder, true, true>(F.lds, g, S, E);
            const int bxl = launder_s((int)blockIdx.x), Gl = launder_s(F.G);
            if (Gl == 256 && bxl >= 256 - CP_TAIL_WG) {
                Frame Fc = F; Fc.lane = launder(F.lane);
                const int base = CP_NSUB - CP_TAIL + (bxl - (256 - CP_TAIL_WG)) * CP_TAIL_PER_WG;
                for (int q = F.wave; q < CP_TAIL_PER_WG; q += NWAVES) copy_subchunk(Fc, 1 - l, base + q);
            }
        }
        SEAM(pb + 8);
        if (EN(10) && IN(pb + 9)) REPEAT(10) { REPBAR();
            pg8::Gemm g{(const bf16*)(F.ws + WS_ACT), (const bf16*)(wl + WO_DOWN), DFF, DFF, DFF, 0}; pg8::StaticOrder S; S.init(MP, D, launder_s(F.G), launder_s((int)blockIdx.x));
            EpiStore E{(bf16*)(F.ws + WS_Y), D, 1 << 30};
            pg8::gemm_phase<EpiStore, pg8::StaticOrder>(F.lds, g, S, E);
            skinny_store(F, (const bf16*)(F.ws + WS_ACT), DFF, (const bf16*)(wl + WO_DOWN), DFF, (bf16*)(F.ws + WS_Y));
        }
        SEAM(pb + 9);
        if (EN(11) && IN(pb + 10)) REPEAT(11) { REPBAR();
            if (l + 1 < DEPTH) { stage_wba(F, l + 1);
                thin_rows<false>(F, nullptr, nullptr, (const bf16*)(F.ws + WS_Y), F.in[24] + (size_t)l * D, nullptr, F.in[21] + (size_t)(l + 1) * D, true, l + 1, 0);
                __syncthreads(); }
            else thin_rows<false>(F, nullptr, nullptr, (const bf16*)(F.ws + WS_Y), F.in[24] + (size_t)l * D, F.out + O_YP, nullptr, false, 0, 0);
        }
        SEAM(pb + 10);
    }
#undef IN
#undef SEAM
}

extern "C" void kernel_launch(void* const* d_in, const int* in_sizes, int n_in, void* d_out, int out_size, void* d_ws, size_t ws_size, hipStream_t stream) {
    static int grid = 0;
    if (grid == 0) {
        if (n_in != 25 || (size_t)out_size != O_END || ws_size < WS_END) { fprintf(stderr, "kernel_launch: unexpected sizes n_in %d out %d ws %zu\n", n_in, out_size, ws_size); grid = -1; return; }
        int dev = 0, cus = 0, per_cu = 0;
        if (hipGetDevice(&dev) != hipSuccess || hipDeviceGetAttribute(&cus, hipDeviceAttributeMultiprocessorCount, dev) != hipSuccess) { grid = -1; return; }
        if (hipFuncSetAttribute((const void*)fwd, hipFuncAttributeMaxDynamicSharedMemorySize, LDS_BYTES) != hipSuccess) { fprintf(stderr, "kernel_launch: hipFuncSetAttribute failed\n"); grid = -1; return; }
        if (hipOccupancyMaxActiveBlocksPerMultiprocessor(&per_cu, (const void*)fwd, NWAVES * 64, LDS_BYTES) != hipSuccess || per_cu < 1) fprintf(stderr, "kernel_launch: occupancy query says %d\n", per_cu);
        (void)hipGetLastError();
        grid = cus;
    }
    if (grid < 0) return;
    if (hipMemsetAsync((char*)d_ws + WS_CTL, 0, CTL_BYTES, stream) != hipSuccess) return;
    Args a{};
    for (int i = 0; i < 25; ++i) a.in[i] = (const float*)d_in[i];
    a.out = (float*)d_out; a.ws = (unsigned char*)d_ws;
#if MK_ONE_LAUNCH
    a.ph_lo = 0; a.ph_hi = N_PHASES;
    hipLaunchKernelGGL(fwd, dim3(grid), dim3(NWAVES * 64), LDS_BYTES, stream, a);
#else
    for (int p = 0; p < N_PHASES; ++p) { a.ph_lo = p; a.ph_hi = p + 1; hipLaunchKernelGGL(fwd, dim3(grid), dim3(NWAVES * 64), LDS_BYTES, stream, a); }
#endif
}
```

```cpp
#include <hip/hip_runtime.h>
#include <cstdio>
#include <cstdint>

#ifndef MK_ONE_LAUNCH
#define MK_ONE_LAUNCH 1
#endif

#define GAS __attribute__((address_space(1)))
#define CAS __attribute__((address_space(4)))
typedef const float* cfp_t;
#define LAS __attribute__((address_space(3)))
typedef unsigned short bf16;
typedef unsigned v4u __attribute__((ext_vector_type(4)));
typedef unsigned v2u __attribute__((ext_vector_type(2)));
typedef float f32x4 __attribute__((ext_vector_type(4)));
typedef float f32x2 __attribute__((ext_vector_type(2)));
typedef short bf16x8 __attribute__((ext_vector_type(8)));
typedef float f32x16 __attribute__((ext_vector_type(16)));

constexpr int D = 2048, BATCH = 4, SEQ = 2048, DEPTH = 2, DB = 32, DS = 4;
constexpr int MP = BATCH * SEQ;
constexpr int MS = DB * DS;
constexpr int MV = MP + MS;
constexpr int MT = 8448;
constexpr int HA = 8, CONVCH = 3072;
constexpr int CPOOL = 1024, PHIST = 15;
constexpr int DFF = 5632;
constexpr int NIN_SRC = 15888, NIN = 15872;
constexpr int PC_ZA = 3072, PC_QB = 4096, PC_KB = 5632, PC_VB = 7168, PC_UC = 8704, PC_GATE = 9728;
constexpr float EPS = 1e-6f;
constexpr size_t O_YP = 0, O_YS = O_YP + (size_t)MP * D, O_PW1 = O_YS + (size_t)MS * D;
constexpr size_t O_PW2 = O_PW1 + (size_t)2 * 4 * 128 * 1024, O_PW3 = O_PW2 + (size_t)2 * 4 * 512 * 1024, O_PGDN = O_PW3 + (size_t)2 * 4 * 2048 * 1024;
constexpr size_t O_PCONV = O_PGDN + (size_t)2 * 4 * 8 * 16384, O_PPOOL = O_PCONV + (size_t)2 * 4 * 3 * 3072, O_SW1 = O_PPOOL + (size_t)2 * 4 * 15 * 1024;
constexpr size_t O_SW2 = O_SW1 + (size_t)2 * 32 * 128 * 1024, O_SW3 = O_SW2 + (size_t)2 * 32 * 512 * 1024, O_SGDN = O_SW3 + (size_t)2 * 32 * 2048 * 1024;
constexpr size_t O_SCONV = O_SGDN + (size_t)2 * 32 * 8 * 16384, O_SPOOL = O_SCONV + (size_t)2 * 32 * 3 * 3072, O_END = O_SPOOL + (size_t)2 * 32 * 15 * 1024;
static_assert(O_END == 226426880ull, "output size");

constexpr size_t WS_CTL = 0, CTL_BYTES = 1u << 20;
constexpr size_t SZ_WIN = (size_t)NIN * D * 2, SZ_WBRA = (size_t)D * 1024 * 2, SZ_WBRB = (size_t)D * 512 * 2, SZ_WBRC = (size_t)D * 1024 * 2, SZ_WPOOL = (size_t)4 * 256 * 256 * 2;
constexpr size_t SZ_WOUT = (size_t)D * D * 2, SZ_WGU = (size_t)2 * DFF * D * 2, SZ_WDOWN = (size_t)D * DFF * 2;
constexpr size_t WO_IN = 0, WO_BRA = WO_IN + SZ_WIN, WO_BRB = WO_BRA + SZ_WBRA, WO_BRC = WO_BRB + SZ_WBRB, WO_POOL = WO_BRC + SZ_WBRC, WO_OUT = WO_POOL + SZ_WPOOL;
constexpr size_t WO_GU = WO_OUT + SZ_WOUT, WO_DOWN = WO_GU + SZ_WGU, WL_BYTES = WO_DOWN + SZ_WDOWN;
constexpr size_t WS_W = CTL_BYTES;
constexpr size_t WS_H = WS_W + 2 * WL_BYTES;
constexpr size_t WS_PROJ = WS_H + (size_t)MT * D * 2;
constexpr size_t WS_GB = WS_PROJ + (size_t)MT * NIN * 2;
constexpr size_t WS_TOK = WS_GB + (size_t)MT * 16 * 4;
constexpr size_t WS_QN = WS_TOK + (size_t)MT * 8 * 16;
constexpr size_t WS_KN = WS_QN + (size_t)MT * 1024 * 2;
constexpr size_t WS_VV = WS_KN + (size_t)MT * 1024 * 2;
constexpr size_t WS_ORAW = WS_VV + (size_t)MT * 1024 * 2;
constexpr size_t WS_POOLED = WS_ORAW + (size_t)MT * 1024 * 4;
constexpr size_t WS_OUTA = WS_POOLED + (size_t)MT * 1024 * 2;
constexpr size_t WS_OUTB = WS_OUTA + (size_t)MT * 1024 * 2;
constexpr size_t WS_OC = WS_OUTB + (size_t)MT * 512 * 2;
constexpr size_t WS_MERGED = WS_OC + (size_t)MT * 1024 * 2;
constexpr size_t WS_Y = WS_MERGED + (size_t)MT * D * 2;
constexpr size_t WS_X1 = WS_Y + (size_t)MT * D * 2;
constexpr size_t WS_X2 = WS_X1 + (size_t)MT * D * 4;
constexpr size_t WS_ACT = WS_X2 + (size_t)MT * D * 4;
constexpr size_t WS_VT = WS_ACT + (size_t)MT * DFF * 2;
constexpr size_t WS_OBG = WS_VT + (size_t)BATCH * 3 * 4 * 128 * 2048 * 2;
constexpr size_t WS_AST = WS_OBG + (size_t)6 * MV * 512 * 2;
constexpr int GCH = BATCH * HA * (SEQ / 32);
constexpr size_t WS_WF = WS_AST + (size_t)6 * MV * 4 * 8;
constexpr size_t WS_KF = WS_WF + (size_t)GCH * 8192;
constexpr size_t WS_UF = WS_KF + (size_t)GCH * 8192;
constexpr size_t WS_AF = WS_UF + (size_t)GCH * 16384;
constexpr size_t WS_TB = WS_AF + (size_t)GCH * 2048;
constexpr size_t WS_QF = WS_TB + (size_t)GCH * 128;
constexpr size_t WS_XCH = WS_QF + (size_t)GCH * 8192;
constexpr size_t WS_PAD = WS_XCH + (size_t)4 * 32 * 256 * 8 * 16;
constexpr size_t WS_END = WS_PAD + (size_t)1024 * 16 * 512 * 4;
static_assert(WS_END < 2000000000ull, "workspace");

__device__ __forceinline__ int lane_id() { return (int)__builtin_amdgcn_mbcnt_hi(~0u, __builtin_amdgcn_mbcnt_lo(~0u, 0u)); }
namespace pg8 {
#define PG8_LAS __attribute__((address_space(3)))
typedef unsigned short bf16_t;
typedef unsigned u32x4 __attribute__((ext_vector_type(4)));
constexpr int BM = 256, BK = 64, HALF = 128, HTB = HALF * BK * 2, STAGE_BYTES = 8 * HTB, NXCD = 8, WGM = 8;
__host__ __device__ __forceinline__ int lds_byte(int r, int c) { const int st = (r >> 4) * 2 + (c >> 5), rr = r & 15, cc = c & 31, ob = rr * 64 + cc * 2; return st * 1024 + (ob ^ (((ob >> 9) & 1) << 5)); }
__host__ __device__ __forceinline__ void stage_rc(int b, int& R, int& C) { const int st = b / 1024, sb = b % 1024, swz = sb ^ (((sb >> 9) & 1) << 5); R = (st >> 1) * 16 + swz / 64; C = (st & 1) * 32 + (swz % 64) / 2; }
__host__ __device__ __forceinline__ int perm32(int rho) { const int n = rho >> 4, i = rho & 15; return 8 * (i >> 2) + 4 * n + (i & 3); }
struct Unit { int pm, pn; };
struct Gemm { const bf16_t* A; const bf16_t* Bt; int lda, ldb, K; int a_pn_step; unsigned* pad = nullptr; };
struct StaticOrder {
    int nM, nN, nwg, G, c;
    __host__ __device__ void init(int M, int N, int G_, int c_) { nM = M / BM; nN = N / BM; nwg = nM * nN; G = G_; c = c_; }
    __host__ __device__ bool next(int i, Unit& u) const {
        const long L = (long)i * G + c; if (L >= nwg) return false;
        int wgid = (int)L; { const int q = nwg / NXCD, r = nwg % NXCD, xcd = wgid % NXCD, off = wgid / NXCD; wgid = (xcd < r ? xcd * (q + 1) : r * (q + 1) + (xcd - r) * q) + off; }
        const int nig = WGM * nN, gid = wgid / nig, fm = gid * WGM, gsz = (nM - fm) < WGM ? (nM - fm) : WGM;
        u.pm = fm + ((wgid % nig) % gsz); u.pn = (wgid % nig) / gsz; return true;
    }
    __device__ __forceinline__ void a_ready(const Unit&) const {}
    __device__ __forceinline__ void done(const Unit&) const {}
};
__device__ __forceinline__ unsigned cvt_pk_bf16(float lo, float hi) { unsigned r; asm volatile("v_cvt_pk_bf16_f32 %0, %1, %2" : "=v"(r) : "v"(lo), "v"(hi)); return r; }

template <class Epi, class Sched, bool ALIGN_EPI = true, bool RELAX = false>
__device__ __forceinline__ void gemm_phase(PG8_LAS unsigned char* lds, const Gemm g, const Sched& S, const Epi& E) {
    int tid = threadIdx.x; asm volatile("" : "+v"(tid));
    const int wid = __builtin_amdgcn_readfirstlane(tid >> 6), lane = tid & 63, wr = wid >> 2, wc = wid & 3, fr = lane & 15, fq = lane >> 4;
    int K = g.K; asm volatile("" : "+s"(K));
    const int nt = K / BK;
    unsigned voffA[2], voffB[2];
#pragma unroll
    for (int i = 0; i < 2; ++i) { int R, C; stage_rc(tid * 16 + i * 8192, R, C); const int Rb = ((R & ~31) + perm32(R & 31));
        voffA[i] = (unsigned)(R * g.lda + C) * 2u; voffB[i] = (unsigned)(Rb * g.ldb + C) * 2u; }
    const size_t kstep = (size_t)(BK * 2);
    const size_t hstepA = (size_t)HALF * g.lda * 2, hstepB = (size_t)HALF * g.ldb * 2;
    const size_t tstepA = 2 * hstepA, tstepB = 2 * hstepB;
    const unsigned ldsw = (unsigned)wid * 1024u;
    const int aoff = lds_byte(wr * 64 + fr, fq * 8), boff = lds_byte(wc * 32 + fr, fq * 8);
#define PG8_SA(b, h) (((b) * 2 + (h)) * HTB)
#define PG8_SB(b, h) ((4 + (b) * 2 + (h)) * HTB)
#define PG8_STAGE(bufoff, gbase, voff) do { const char* _gb = (const char*)(gbase); asm volatile("" : "+s"(_gb));     \
        _Pragma("unroll") for (int _i = 0; _i < 2; ++_i) { unsigned _vo = (voff)[_i]; asm volatile("" : "+v"(_vo));     \
        __builtin_amdgcn_global_load_lds((const unsigned*)(_gb + _vo), (PG8_LAS unsigned*)(lds + (bufoff) + ldsw + _i * 8192), 16, 0, 0); } } while (0)
#define PG8_LDA(dst, b, h) do { _Pragma("unroll") for (int m = 0; m < 4; ++m) _Pragma("unroll") for (int k = 0; k < 2; ++k) dst[m][k] = *(const PG8_LAS bf16x8*)(lds + PG8_SA(b, h) + aoff + m * 2048 + k * 1024); } while (0)
#define PG8_LDB(dst, b, h) do { _Pragma("unroll") for (int n = 0; n < 2; ++n) _Pragma("unroll") for (int k = 0; k < 2; ++k) dst[n][k] = *(const PG8_LAS bf16x8*)(lds + PG8_SB(b, h) + boff + n * 2048 + k * 1024); } while (0)
#define PG8_MMA(ai, bj, At, Bt) do { __builtin_amdgcn_s_setprio(1); _Pragma("unroll") for (int m = 0; m < 4; ++m) _Pragma("unroll") for (int n = 0; n < 2; ++n) _Pragma("unroll") for (int k = 0; k < 2; ++k) \
        acc[ai][bj][m][n] = __builtin_amdgcn_mfma_f32_16x16x32_bf16(Bt[n][k], At[m][k], acc[ai][bj][m][n], 0, 0, 0); __builtin_amdgcn_s_setprio(0); } while (0)
#define PG8_WAIT_V(n) asm volatile("s_waitcnt vmcnt(" #n ")" ::: "memory")
#define PG8_WAIT_L(n) asm volatile("s_waitcnt lgkmcnt(" #n ")" ::: "memory")
#define PG8_BAR __builtin_amdgcn_s_barrier()
#define PG8_SCHED __builtin_amdgcn_sched_barrier(0)
    Unit cur, nxt; int ui = 0;
    if (!S.next(0, cur)) return;
    f32x4 acc[2][2][4][2];
#pragma unroll
    for (int a = 0; a < 2; ++a)
#pragma unroll
        for (int b = 0; b < 2; ++b)
#pragma unroll
            for (int m = 0; m < 4; ++m)
#pragma unroll
                for (int n = 0; n < 2; ++n) acc[a][b][m][n] = (f32x4){0.f, 0.f, 0.f, 0.f};
    bf16x8 At[4][2], B0[2][2], B1[2][2];
    const char* cA = (const char*)g.A + (size_t)cur.pm * tstepA + (size_t)cur.pn * (size_t)g.a_pn_step; const char* cB = (const char*)g.Bt + (size_t)cur.pn * tstepB;
    S.a_ready(cur);
    PG8_STAGE(PG8_SB(0, 0), cB, voffB); PG8_STAGE(PG8_SB(0, 1), cB + hstepB, voffB); PG8_STAGE(PG8_SA(0, 0), cA, voffA); PG8_STAGE(PG8_SA(0, 1), cA + hstepA, voffA);
    if (wr == 1) PG8_BAR;
    PG8_WAIT_V(2); PG8_BAR;
    PG8_STAGE(PG8_SB(1, 0), cB + kstep, voffB); PG8_STAGE(PG8_SA(1, 0), cA + kstep, voffA); PG8_STAGE(PG8_SB(1, 1), cB + hstepB + kstep, voffB);
    PG8_WAIT_V(6); PG8_BAR;
    if constexpr (RELAX && Epi::NSTORE > 0) {
#pragma unroll
        for (int i = 0; i < Epi::NSTORE; ++i) __builtin_nontemporal_store((unsigned)tid, (__attribute__((address_space(1))) unsigned*)g.pad + ((size_t)blockIdx.x * 16 + i) * 512 + tid);
    }
    for (;;) {
        const bool has_next = S.next(ui + 1, nxt);
        const char* nA = has_next ? (const char*)g.A + (size_t)nxt.pm * tstepA + (size_t)nxt.pn * (size_t)g.a_pn_step : cA; const char* nB = has_next ? (const char*)g.Bt + (size_t)nxt.pn * tstepB : cB;
#define PG8_TRIP(W1, W2) do { \
            const bool last = (t == nt - 2); \
            const char* a1 = cA + (size_t)(t + 1) * kstep; \
            const char* a2 = last ? nA : cA + (size_t)(t + 2) * kstep; const char* b2 = last ? nB : cB + (size_t)(t + 2) * kstep; \
            const char* a3 = a2 + kstep; const char* b3 = b2 + kstep; \
            if (last && has_next) S.a_ready(nxt); \
            PG8_LDB(B0, 0, 0); PG8_LDB(B1, 0, 1); PG8_SCHED; PG8_LDA(At, 0, 0); PG8_STAGE(PG8_SA(1, 1), a1 + hstepA, voffA); \
            W1; PG8_WAIT_L(0); PG8_BAR; PG8_MMA(0, 0, At, B0); PG8_MMA(0, 1, At, B1); PG8_BAR; PG8_SCHED; \
            PG8_LDA(At, 0, 1); PG8_STAGE(PG8_SB(0, 0), b2, voffB); PG8_STAGE(PG8_SB(0, 1), b2 + hstepB, voffB); PG8_STAGE(PG8_SA(0, 0), a2, voffA); \
            W2; PG8_WAIT_L(0); PG8_BAR; PG8_MMA(1, 0, At, B0); PG8_MMA(1, 1, At, B1); PG8_BAR; PG8_SCHED; \
            PG8_LDB(B0, 1, 0); PG8_LDB(B1, 1, 1); PG8_SCHED; PG8_LDA(At, 1, 0); PG8_STAGE(PG8_SA(0, 1), a2 + hstepA, voffA); \
            PG8_WAIT_V(8); PG8_WAIT_L(0); PG8_BAR; PG8_MMA(0, 0, At, B0); PG8_MMA(0, 1, At, B1); PG8_BAR; PG8_SCHED; \
            PG8_LDA(At, 1, 1); PG8_STAGE(PG8_SB(1, 0), b3, voffB); PG8_STAGE(PG8_SB(1, 1), b3 + hstepB, voffB); PG8_STAGE(PG8_SA(1, 0), a3, voffA); \
            PG8_WAIT_V(8); PG8_WAIT_L(0); PG8_BAR; PG8_MMA(1, 0, At, B0); PG8_MMA(1, 1, At, B1); PG8_BAR; PG8_SCHED; } while (0)
        int t = 0;
        if constexpr (RELAX && Epi::NSTORE == 16) { PG8_TRIP(PG8_WAIT_V(24), PG8_WAIT_V(24)); t = 2; }
        if constexpr (RELAX && Epi::NSTORE == 8) { PG8_TRIP(PG8_WAIT_V(16), PG8_WAIT_V(16)); t = 2; }
        for (; t < nt; t += 2) PG8_TRIP(PG8_WAIT_V(8), PG8_WAIT_V(8));
#undef PG8_TRIP
        if constexpr (ALIGN_EPI) { if (wr == 0) PG8_BAR; }
        if constexpr (!Epi::AFTER_DRAIN) { E(acc, cur, wr, wc, fr, fq); S.done(cur); }
        if (!has_next) break;
#pragma unroll
        for (int a = 0; a < 2; ++a)
#pragma unroll
            for (int b = 0; b < 2; ++b)
#pragma unroll
                for (int m = 0; m < 4; ++m)
#pragma unroll
                    for (int n = 0; n < 2; ++n) acc[a][b][m][n] = (f32x4){0.f, 0.f, 0.f, 0.f};
        cur = nxt; cA = nA; cB = nB; ++ui;
        if constexpr (ALIGN_EPI) { if (wr == 1) PG8_BAR; }
    }
    PG8_WAIT_V(0);
    if constexpr (!ALIGN_EPI) { if (wr == 0) PG8_BAR; }
    PG8_BAR;
    if constexpr (Epi::AFTER_DRAIN) { E.fused(acc, cur, wr, wc, fr, fq, lds, wid, lane); S.done(cur); }
#undef PG8_SA
#undef PG8_SB
#undef PG8_STAGE
#undef PG8_LDA
#undef PG8_LDB
#undef PG8_MMA
#undef PG8_WAIT_V
#undef PG8_WAIT_L
#undef PG8_BAR
#undef PG8_SCHED
}
}

#define LDS_WAIT() asm volatile("s_waitcnt lgkmcnt(0)" ::: "memory")
#define VM_WAIT() asm volatile("s_waitcnt vmcnt(0)" ::: "memory")
__device__ __forceinline__ unsigned f2bf(float f) { unsigned u = __builtin_bit_cast(unsigned, f); return (u + 0x7fffu + ((u >> 16) & 1u)) >> 16; }
typedef __bf16 bf16v2 __attribute__((ext_vector_type(2)));
__device__ __forceinline__ unsigned pk2(float lo, float hi) { const f32x2 v = {lo, hi}; return __builtin_bit_cast(unsigned, __builtin_convertvector(v, bf16v2)); }
__device__ __forceinline__ float bf_lo(unsigned u) { return __builtin_bit_cast(float, u << 16); }
__device__ __forceinline__ float bf_hi(unsigned u) { return __builtin_bit_cast(float, u & 0xffff0000u); }
__device__ __forceinline__ float bf1(bf16 b) { return __builtin_bit_cast(float, ((unsigned)b) << 16); }
__device__ __forceinline__ void unpack8(const v4u u, float (&x)[8]) { x[0] = bf_lo(u.x); x[1] = bf_hi(u.x); x[2] = bf_lo(u.y); x[3] = bf_hi(u.y); x[4] = bf_lo(u.z); x[5] = bf_hi(u.z); x[6] = bf_lo(u.w); x[7] = bf_hi(u.w); }
__device__ __forceinline__ v4u pack8(const float (&x)[8]) { v4u o; o.x = pk2(x[0], x[1]); o.y = pk2(x[2], x[3]); o.z = pk2(x[4], x[5]); o.w = pk2(x[6], x[7]); return o; }
__device__ __forceinline__ float wave_max(float v) {
#pragma unroll
    for (int o = 1; o < 64; o <<= 1) v = fmaxf(v, __shfl_xor(v, o));
    return v;
}
template <int CTRL> __device__ __forceinline__ float dpp_f(float x) { return __builtin_bit_cast(float, __builtin_amdgcn_update_dpp(0, __builtin_bit_cast(int, x), CTRL, 0xf, 0xf, true)); }
__device__ __forceinline__ float row16_sum(float x) { x += dpp_f<0xB1>(x); x += dpp_f<0x4E>(x); x += dpp_f<0x124>(x); x += dpp_f<0x128>(x); return x; }
__device__ __forceinline__ float wave_sum(float v) { v = row16_sum(v); v += __shfl_xor(v, 16); v += __shfl_xor(v, 32); return v; }
__device__ __forceinline__ float sigm(float x) { return __builtin_amdgcn_rcpf(1.f + __expf(-x)); }
__device__ __forceinline__ float silu(float x) { return x * __builtin_amdgcn_rcpf(1.f + __expf(-x)); }

#define XB_TMO      128
#define XB_XCNT(j)  (256  + 64 * (j))
#define XB_XSUB(j)  (1280 + 64 * (j))
#define XB_XGEN(j)  (2304 + 64 * (j))
#define XB_TOP      3328
#define XB_TOPGEN   3392
#define XCD_BAR_WORDS 3456
#define XB_SPIN_CAP (1u << 18)
__device__ __forceinline__ unsigned xb_ld(unsigned* p)              { return __hip_atomic_load(p, __ATOMIC_RELAXED, __HIP_MEMORY_SCOPE_AGENT); }
__device__ __forceinline__ unsigned xb_add(unsigned* p, unsigned v) { return __hip_atomic_fetch_add(p, v, __ATOMIC_RELAXED, __HIP_MEMORY_SCOPE_AGENT); }
__device__ __forceinline__ unsigned xb_xcc_id() { return (unsigned)__builtin_amdgcn_s_getreg((3 << 11) | 20) & 0xFu; }
#define XB_SPIN(cond, bar) do { unsigned _sp = 0; while (cond) { __builtin_amdgcn_s_sleep(1); \
    if ((++_sp & 255u) == 0u) { if (xb_ld(&(bar)[XB_TMO])) break; if (_sp > XB_SPIN_CAP) { atomicAdd(&(bar)[XB_TMO], 1u); break; } } } } while (0)
struct XcdBarrier { unsigned* bar; unsigned x; volatile LAS unsigned* st; };
__device__ __forceinline__ XcdBarrier xcd_barrier_post(unsigned* bar, volatile LAS unsigned* st) {
    XcdBarrier b; b.bar = bar; b.x = xb_xcc_id(); b.st = st;
    if (threadIdx.x == 0) (void)xb_add(&bar[XB_XCNT(b.x)], 1u);
    return b;
}
__device__ __forceinline__ void xcd_barrier_complete(unsigned* bar, unsigned x, unsigned& nloc, unsigned& nx) {
    const unsigned G = gridDim.x * gridDim.y * gridDim.z;
    unsigned sum, cnt, mine, sp = 0u;
    for (;;) {
        sum = 0u; cnt = 0u; mine = 0u;
#pragma unroll
        for (unsigned j = 0; j < 16; ++j) { const unsigned c = xb_ld(&bar[XB_XCNT(j)]); sum += c; cnt += (c > 0u) ? 1u : 0u; mine = (j == x) ? c : mine; }
        if (sum == G) break;
        __builtin_amdgcn_s_sleep(1);
        if ((++sp & 255u) == 0u) { if (xb_ld(&bar[XB_TMO])) break; if (sp > XB_SPIN_CAP) { atomicAdd(&bar[XB_TMO], 1u); break; } }
    }
    nloc = mine > 0u ? mine : 1u; nx = cnt > 0u ? cnt : 1u;
}
__device__ __forceinline__ void xcd_barrier(const XcdBarrier& b) {
    asm volatile("s_waitcnt vmcnt(0)" ::: "memory");
    __syncthreads();
    if (threadIdx.x == 0) {
        unsigned* bar = b.bar;
        __builtin_amdgcn_s_waitcnt(0);
        unsigned nloc = b.st[0], nx = b.st[1];
        if (nloc == 0u) { xcd_barrier_complete(bar, b.x, nloc, nx); b.st[0] = nloc; b.st[1] = nx; }
        const unsigned old = xb_add(&bar[XB_XSUB(b.x)], 1u);
        const unsigned gen = old / nloc;
        if (old + 1u == (gen + 1u) * nloc) {
            __builtin_amdgcn_fence(__ATOMIC_RELEASE, "agent");
            asm volatile("s_waitcnt vmcnt(0)" ::: "memory");
            const unsigned og = xb_add(&bar[XB_TOP], 1u);
            const unsigned tg = og / nx;
            if (og + 1u == (tg + 1u) * nx) xb_add(&bar[XB_TOPGEN], 1u);
            else XB_SPIN(xb_ld(&bar[XB_TOPGEN]) == tg, bar);
            __builtin_amdgcn_fence(__ATOMIC_ACQUIRE, "agent");
            xb_add(&bar[XB_XGEN(b.x)], 1u);
            asm volatile("s_waitcnt vmcnt(0)" ::: "memory");
        } else {
            XB_SPIN(xb_ld(&bar[XB_XGEN(b.x)]) == gen, bar);
            __builtin_amdgcn_fence(__ATOMIC_ACQUIRE, "agent");
            asm volatile("s_waitcnt vmcnt(0)" ::: "memory");
        }
    }
    __syncthreads();
}

constexpr int NWAVES = 8;
constexpr int RING_BYTES = 131072, SCANTV_BYTES = 0, LDSCTL_OFF = RING_BYTES + SCANTV_BYTES, MISC_OFF = LDSCTL_OFF + 320, LDS_BYTES = 147456;
constexpr int CW_BAR = 4096;
constexpr int CW_TMO = 0, CW_RMS = 16384, RMS_BANK = 2048;

struct Args { const float* in[25]; float* out; unsigned char* ws; int ph_lo, ph_hi; };
struct Frame {
    LAS unsigned char* lds;
    int tid, lane, wave, vcu, G;
    const CAS cfp_t* in; float* out; unsigned char* ws;
};

__device__ __forceinline__ int launder(int x) { asm volatile("" : "+v"(x)); return x; }
__device__ __forceinline__ int launder_s(int x) { asm volatile("" : "+s"(x)); return x; }
template <class T> __device__ __forceinline__ T* launder_p(T* p) { asm volatile("" : "+s"(p)); return p; }
__device__ __forceinline__ const CAS cfp_t* launder_k(const CAS cfp_t* p) { asm volatile("" : "+s"(p)); return p; }
template <class T> __device__ __forceinline__ T* launder_pg(T* p) { GAS T* q = (GAS T*)p; asm volatile("" : "+s"(q)); return (T*)q; }
#define RELANE_G(F0) RELANE(F0); F.ws = launder_pg(F.ws); F.out = launder_pg(F.out)
#define RELANE(F0) Frame F = F0; F.lane = launder(F0.lane); F.tid = launder(F0.tid)

struct EpiStore {
    static constexpr bool AFTER_DRAIN = false; static constexpr int NSTORE = 16;
    bf16* O; int ldc; int sig_pn;
    __device__ __forceinline__ void operator()(const f32x4 (&acc)[2][2][4][2], const pg8::Unit& u, int wr, int wc, int fr, int fq) const {
        { const int l_ = launder(lane_id()); fr = l_ & 15; fq = l_ >> 4; }
        const int row0 = u.pm * 256 + wr * 64 + fr, col0 = u.pn * 256 + wc * 32 + 8 * fq; const bool sg = u.pn >= sig_pn;
#pragma unroll
        for (int ai = 0; ai < 2; ++ai)
#pragma unroll
            for (int m = 0; m < 4; ++m) { bf16* rowp = O + (size_t)(row0 + ai * 128 + m * 16) * ldc + col0;
#pragma unroll
                for (int bj = 0; bj < 2; ++bj) { f32x4 v0 = acc[ai][bj][m][0], v1 = acc[ai][bj][m][1];
                    if (sg) {
#pragma unroll
                        for (int j = 0; j < 4; ++j) { v0[j] = sigm(v0[j]); v1[j] = sigm(v1[j]); } }
                    v4u w; w.x = pg8::cvt_pk_bf16(v0[0], v0[1]); w.y = pg8::cvt_pk_bf16(v0[2], v0[3]); w.z = pg8::cvt_pk_bf16(v1[0], v1[1]); w.w = pg8::cvt_pk_bf16(v1[2], v1[3]);
                    *(v4u*)(rowp + bj * 128) = w; } }
    }
};
template <bool ACCUM> struct EpiMerge {
    static constexpr bool AFTER_DRAIN = false; static constexpr int NSTORE = 0;
    bf16* O; const bf16* gate;
    __device__ __forceinline__ void operator()(const f32x4 (&acc)[2][2][4][2], const pg8::Unit& u, int wr, int wc, int fr, int fq) const {
        { const int l_ = launder(lane_id()); fr = l_ & 15; fq = l_ >> 4; }
        const int row0 = u.pm * 256 + wr * 64 + fr, col0 = u.pn * 256 + wc * 32 + 8 * fq;
#pragma unroll
        for (int ai = 0; ai < 2; ++ai)
#pragma unroll
            for (int m = 0; m < 4; ++m) { const int row = row0 + ai * 128 + m * 16; bf16* rowp = O + (size_t)row * D + col0; const bf16* gp = gate + (size_t)row * NIN + col0;
#pragma unroll
                for (int bj = 0; bj < 2; ++bj) {
                    float gv[8]; unpack8(*(const v4u*)(gp + bj * 128), gv);
                    float o[8];
#pragma unroll
                    for (int j = 0; j < 4; ++j) { o[j] = acc[ai][bj][m][0][j] * gv[j]; o[4 + j] = acc[ai][bj][m][1][j] * gv[4 + j]; }
                    if (ACCUM) { float p[8]; unpack8(*(const v4u*)(rowp + bj * 128), p);
#pragma unroll
                        for (int j = 0; j < 8; ++j) o[j] += p[j]; }
                    v4u w; w.x = pg8::cvt_pk_bf16(o[0], o[1]); w.y = pg8::cvt_pk_bf16(o[2], o[3]); w.z = pg8::cvt_pk_bf16(o[4], o[5]); w.w = pg8::cvt_pk_bf16(o[6], o[7]);
                    *(v4u*)(rowp + bj * 128) = w; }
                asm volatile("" ::: "memory"); }
    }
};

struct EpiRmsRes {
    static constexpr bool AFTER_DRAIN = true; static constexpr int NSTORE = 0;
    unsigned char* ws; const CAS cfp_t* in; float* outp; int l, which;
    __device__ __forceinline__ void fused(const f32x4 (&acc)[2][2][4][2], const pg8::Unit& u, int wr, int wc, int fr, int fq, LAS unsigned char* lds, int wid, int lane) const {
        { const int l_ = launder(lane_id()); fr = l_ & 15; fq = l_ >> 4; }
        const bool lastl = which == 1 && l + 1 == DEPTH;
        bf16* const XB = (bf16*)(ws + WS_X1); bf16* const H = lastl ? nullptr : (bf16*)(ws + WS_H); float* const fout = lastl ? outp + O_YP : nullptr;
        const float* const gpost = (which ? in[24] : in[22]) + (size_t)l * D; const float* const gpre = lastl ? nullptr : (which ? in[21] + (size_t)(l + 1) * D : in[23] + (size_t)l * D);
        float* const slots = (float*)(ws + WS_XCH) + (size_t)(l * 2 + which) * 32 * 256 * 8 * 4;
        unsigned* const cnt = (unsigned*)(ws + WS_CTL) + CW_RMS + (l * 2 + which) * RMS_BANK; unsigned* const tmo = (unsigned*)(ws + WS_CTL) + CW_TMO;
        LAS f32x4* P = (LAS f32x4*)lds;
        LAS f32x2* SR = (LAS f32x2*)(lds + 16384);
        const int lr0 = wr * 64 + fr, col0 = u.pn * 256 + wc * 32 + 8 * fq;
        f32x4 gp[2][2];
#pragma unroll
        for (int bj = 0; bj < 2; ++bj) { gp[bj][0] = *(const f32x4*)(gpost + col0 + bj * 128); gp[bj][1] = *(const f32x4*)(gpost + col0 + bj * 128 + 4); }
#pragma unroll
        for (int ai = 0; ai < 2; ++ai)
#pragma unroll
            for (int m = 0; m < 4; ++m) {
                const int lr = lr0 + ai * 128 + m * 16; const bf16* xp = XB + (size_t)(u.pm * 256 + lr) * D + col0;
                float syy = 0.f, sxx = 0.f, sxy = 0.f, sgg = 0.f;
#pragma unroll
                for (int bj = 0; bj < 2; ++bj) { float xv[8]; unpack8(*(const v4u*)(xp + bj * 128), xv);
#pragma unroll
                    for (int n = 0; n < 2; ++n)
#pragma unroll
                        for (int j = 0; j < 4; ++j) { const float y = acc[ai][bj][m][n][j], yg = y * gp[bj][n][j], x = xv[4 * n + j]; syy += y * y; sxx += x * x; sxy += x * yg; sgg += yg * yg; } }
                syy += __shfl_xor(syy, 16); sxx += __shfl_xor(sxx, 16); sxy += __shfl_xor(sxy, 16); sgg += __shfl_xor(sgg, 16);
                syy += __shfl_xor(syy, 32); sxx += __shfl_xor(sxx, 32); sxy += __shfl_xor(sxy, 32); sgg += __shfl_xor(sgg, 32);
                if (fq == 0) P[lr * 4 + wc] = (f32x4){syy, sxx, sxy, sgg};
            }
        asm volatile("s_waitcnt lgkmcnt(0)" ::: "memory"); __builtin_amdgcn_s_barrier(); asm volatile("" ::: "memory");
        const int row = wid * 32 + (lane & 31);
        unsigned long long* slot = (unsigned long long*)slots + ((size_t)(u.pm * 256 + row) * 8 + u.pn) * 2;
        if (lane < 32) { const f32x4 a = P[row * 4 + 0], b = P[row * 4 + 1], c = P[row * 4 + 2], d = P[row * 4 + 3]; const f32x4 t = (a + b) + (c + d);
            __hip_atomic_store(slot, ((unsigned long long)__builtin_bit_cast(unsigned, t.y) << 32) | __builtin_bit_cast(unsigned, t.x), __ATOMIC_RELAXED, __HIP_MEMORY_SCOPE_AGENT);
            __hip_atomic_store(slot + 1, ((unsigned long long)__builtin_bit_cast(unsigned, t.w) << 32) | __builtin_bit_cast(unsigned, t.z), __ATOMIC_RELAXED, __HIP_MEMORY_SCOPE_AGENT); }
        asm volatile("s_waitcnt vmcnt(0)" ::: "memory");
        if (lane == 0) __hip_atomic_fetch_add(cnt + 64 * u.pm, 1u, __ATOMIC_RELAXED, __HIP_MEMORY_SCOPE_AGENT);
        if (wid == 0) {
            const unsigned long long t0 = __builtin_amdgcn_s_memrealtime();
            while ((unsigned)__builtin_amdgcn_readfirstlane((int)__hip_atomic_load(cnt + 64 * u.pm, __ATOMIC_RELAXED, __HIP_MEMORY_SCOPE_AGENT)) < 64u) {
                if (__builtin_amdgcn_s_memrealtime() - t0 > 2000000ull) { if (lane == 0) __hip_atomic_store(tmo, 1u, __ATOMIC_RELAXED, __HIP_MEMORY_SCOPE_AGENT); break; }
                __builtin_amdgcn_s_sleep(2); }
            __builtin_amdgcn_fence(__ATOMIC_ACQUIRE, "agent");
        }
        asm volatile("s_waitcnt vmcnt(0) lgkmcnt(0)" ::: "memory"); __builtin_amdgcn_s_barrier(); asm volatile("" ::: "memory");
        if (lane < 32) { const unsigned long long* sl = (const unsigned long long*)slots + (size_t)(u.pm * 256 + row) * 16; float syy = 0.f, sxx = 0.f, sxy = 0.f, sgg = 0.f;
#pragma unroll
            for (int t = 0; t < 8; ++t) { const unsigned long long w0 = __hip_atomic_load(sl + 2 * t, __ATOMIC_RELAXED, __HIP_MEMORY_SCOPE_AGENT), w1 = __hip_atomic_load(sl + 2 * t + 1, __ATOMIC_RELAXED, __HIP_MEMORY_SCOPE_AGENT);
                syy += __builtin_bit_cast(float, (unsigned)w0); sxx += __builtin_bit_cast(float, (unsigned)(w0 >> 32)); sxy += __builtin_bit_cast(float, (unsigned)w1); sgg += __builtin_bit_cast(float, (unsigned)(w1 >> 32)); }
            const float ry = rsqrtf(syy * (1.f / D) + EPS), s1 = sxx + 2.f * ry * sxy + ry * ry * sgg;
            SR[row] = (f32x2){ry, rsqrtf(fmaxf(s1, 0.f) * (1.f / D) + EPS)}; }
        asm volatile("s_waitcnt lgkmcnt(0)" ::: "memory"); __builtin_amdgcn_s_barrier(); asm volatile("" ::: "memory");
        f32x4 gq[2][2];
#pragma unroll
        for (int bj = 0; bj < 2; ++bj) { gq[bj][0] = gpre ? *(const f32x4*)(gpre + col0 + bj * 128) : (f32x4){0.f, 0.f, 0.f, 0.f}; gq[bj][1] = gpre ? *(const f32x4*)(gpre + col0 + bj * 128 + 4) : (f32x4){0.f, 0.f, 0.f, 0.f}; }
#pragma unroll
        for (int ai = 0; ai < 2; ++ai)
#pragma unroll
            for (int m = 0; m < 4; ++m) {
                const int lr = lr0 + ai * 128 + m * 16; const size_t off = (size_t)(u.pm * 256 + lr) * D + col0; const f32x2 sr = SR[lr];
#pragma unroll
                for (int bj = 0; bj < 2; ++bj) { float xv[8], x1[8]; unpack8(*(const v4u*)(XB + off + bj * 128), xv);
#pragma unroll
                    for (int n = 0; n < 2; ++n)
#pragma unroll
                        for (int j = 0; j < 4; ++j) x1[4 * n + j] = xv[4 * n + j] + acc[ai][bj][m][n][j] * sr.x * gp[bj][n][j];
                    if (fout) { *(f32x4*)(fout + off + bj * 128) = (f32x4){x1[0], x1[1], x1[2], x1[3]}; *(f32x4*)(fout + off + bj * 128 + 4) = (f32x4){x1[4], x1[5], x1[6], x1[7]}; }
                    else { *(v4u*)(XB + off + bj * 128) = pack8(x1);
                        if (H) { float hv[8];
#pragma unroll
                            for (int n = 0; n < 2; ++n)
#pragma unroll
                                for (int j = 0; j < 4; ++j) hv[4 * n + j] = x1[4 * n + j] * sr.y * gq[bj][n][j];
                            *(v4u*)(H + off + bj * 128) = pack8(hv); } } }
                asm volatile("" ::: "memory"); }
    }
};
struct EpiSwiglu {
    static constexpr bool AFTER_DRAIN = false; static constexpr int NSTORE = 8;
    bf16* O;
    __device__ __forceinline__ void operator()(const f32x4 (&acc)[2][2][4][2], const pg8::Unit& u, int wr, int wc, int fr, int fq) const {
        { const int l_ = launder(lane_id()); fr = l_ & 15; fq = l_ >> 4; }
        const int row0 = u.pm * 256 + wr * 64 + fr, col0 = u.pn * 128 + wc * 32 + 8 * fq;
#pragma unroll
        for (int ai = 0; ai < 2; ++ai)
#pragma unroll
            for (int m = 0; m < 4; ++m) { bf16* rowp = O + (size_t)(row0 + ai * 128 + m * 16) * DFF + col0;
                float o[8];
#pragma unroll
                for (int j = 0; j < 4; ++j) { o[j] = silu(acc[ai][0][m][0][j]) * acc[ai][1][m][0][j]; o[4 + j] = silu(acc[ai][0][m][1][j]) * acc[ai][1][m][1][j]; }
                v4u w; w.x = pg8::cvt_pk_bf16(o[0], o[1]); w.y = pg8::cvt_pk_bf16(o[2], o[3]); w.z = pg8::cvt_pk_bf16(o[4], o[5]); w.w = pg8::cvt_pk_bf16(o[6], o[7]);
                *(v4u*)rowp = w; }
    }
};

__device__ __forceinline__ void transpose_item(const float* W, int ldw, int src_col0, int k0, bf16* WT, int ldt, int dst_row0, LAS float* scr, int lane, const float* rscale = nullptr) {
#pragma unroll 8
    for (int i = 0; i < 32; ++i) { const int kk = 2 * i + (lane >> 5); scr[kk * 33 + (lane & 31)] = W[(size_t)(k0 + kk) * ldw + src_col0 + (lane & 31)]; }
    LDS_WAIT(); asm volatile("" ::: "memory");
    const int c = lane & 7;
#pragma unroll
    for (int j = 0; j < 4; ++j) { const int n = (lane >> 3) + 8 * j; const LAS float* s = scr + (8 * c) * 33 + n; const float m = rscale ? rscale[n] : 1.f;
        v4u o; o.x = pk2(s[0 * 33] * m, s[1 * 33] * m); o.y = pk2(s[2 * 33] * m, s[3 * 33] * m); o.z = pk2(s[4 * 33] * m, s[5 * 33] * m); o.w = pk2(s[6 * 33] * m, s[7 * 33] * m);
        *(v4u*)(WT + (size_t)(dst_row0 + n) * ldt + k0 + 8 * c) = o; }
    LDS_WAIT(); asm volatile("" ::: "memory");
}
constexpr int IT_IN = 32 * 496, IT_BRA = 16 * 64, IT_BRB = 8 * 64, IT_BRC = 16 * 64, IT_POOL = 4 * 4 * 8, IT_OUT = 32 * 64, IT_GU = 32 * 352, IT_DOWN = 88 * 64;
constexpr int IT_LAYER = IT_IN + IT_BRA + IT_BRB + IT_BRC + IT_POOL + IT_OUT + IT_GU + IT_DOWN;
__device__ __forceinline__ void weight_item(Frame& F0, int l, int r, LAS float* scr) {
    RELANE(F0);
    unsigned char* wl = F.ws + WS_W + (size_t)l * WL_BYTES; const int lane = F.lane;
    if (r < IT_IN) { const int kb = r / 496, nb = r % 496, n0 = nb * 32; transpose_item(F.in[8] + (size_t)l * D * NIN_SRC, NIN_SRC, n0 + (n0 >= 4096 ? 16 : 0), kb * 64, (bf16*)(wl + WO_IN), D, n0, scr, lane); return; } r -= IT_IN;
    if (r < IT_BRA) { const int kb = r / 64, nb = r % 64; transpose_item(F.in[15] + (size_t)l * 1024 * D, D, nb * 32, kb * 64, (bf16*)(wl + WO_BRA), 1024, nb * 32, scr, lane); return; } r -= IT_BRA;
    if (r < IT_BRB) { const int kb = r / 64, nb = r % 64; transpose_item(F.in[16] + (size_t)l * 512 * D, D, nb * 32, kb * 64, (bf16*)(wl + WO_BRB), 512, nb * 32, scr, lane); return; } r -= IT_BRB;
    if (r < IT_BRC) { const int kb = r / 64, nb = r % 64; transpose_item(F.in[17] + (size_t)l * 1024 * D, D, nb * 32, kb * 64, (bf16*)(wl + WO_BRC), 1024, nb * 32, scr, lane); return; } r -= IT_BRC;
    if (r < IT_POOL) { const int g = r / 32, kb = (r % 32) / 8, nb = r % 8; transpose_item(F.in[13] + (size_t)(l * 4 + g) * 65536, 256, nb * 32, kb * 64, (bf16*)(wl + WO_POOL) + (size_t)g * 65536, 256, nb * 32, scr, lane, F.in[14] + (size_t)l * CPOOL + g * 256 + nb * 32); return; } r -= IT_POOL;
    if (r < IT_OUT) { const int kb = r / 64, nb = r % 64; transpose_item(F.in[18] + (size_t)l * D * D, D, nb * 32, kb * 64, (bf16*)(wl + WO_OUT), D, nb * 32, scr, lane); return; } r -= IT_OUT;
    if (r < IT_GU) { const int kb = r / 352, nb = r % 352, n0 = nb * 32, pn = n0 >> 8, bj = (n0 >> 7) & 1, rr = n0 & 127;
        transpose_item(F.in[19] + (size_t)l * D * 2 * DFF, 2 * DFF, bj * DFF + 128 * pn + rr, kb * 64, (bf16*)(wl + WO_GU), D, n0, scr, lane); return; } r -= IT_GU;
    { const int kb = r / 64, nb = r % 64; transpose_item(F.in[20] + (size_t)l * DFF * D, D, nb * 32, kb * 64, (bf16*)(wl + WO_DOWN), DFF, nb * 32, scr, lane); }
}

__device__ __forceinline__ void stage_wba(Frame& F0, int l) {
    RELANE(F0);
    LAS float* Wl = (LAS float*)F.lds; const float* w = F.in[8] + (size_t)l * D * NIN_SRC + 4096;
    for (int k = F.tid; k < D; k += NWAVES * 64) { const float* p = w + (size_t)k * NIN_SRC;
        const f32x4 a = *(const f32x4*)p, b = *(const f32x4*)(p + 4), c = *(const f32x4*)(p + 8), d = *(const f32x4*)(p + 12);
        Wl[0 * D + k] = a.x; Wl[1 * D + k] = a.y; Wl[2 * D + k] = a.z; Wl[3 * D + k] = a.w; Wl[4 * D + k] = b.x; Wl[5 * D + k] = b.y; Wl[6 * D + k] = b.z; Wl[7 * D + k] = b.w;
        Wl[8 * D + k] = c.x; Wl[9 * D + k] = c.y; Wl[10 * D + k] = c.z; Wl[11 * D + k] = c.w; Wl[12 * D + k] = d.x; Wl[13 * D + k] = d.y; Wl[14 * D + k] = d.z; Wl[15 * D + k] = d.w; }
    __syncthreads();
}
template <bool X32>
__device__ __forceinline__ void thin_rows(Frame& F0, const float* xa, const float* xb, const bf16* Y, const float* gpost, float* fout, const float* gpre, bool do_ba, int l_ba, int r_lo = 0) {
    RELANE(F0);
    const int lane = F.lane, gw = F.vcu * NWAVES + F.wave, NGW = F.G * NWAVES;
    bf16* H = (bf16*)(F.ws + WS_H); bf16* XB = (bf16*)(F.ws + WS_X1); float* GB = (float*)(F.ws + WS_GB);
    const LAS float* Wl = (const LAS float*)F.lds;
    f32x4 vn[8]; v2u xn[8], yn[8];
#define THIN_LOAD(rr) do { const int r_ = (rr); \
        if (X32) { const float* xr_ = (r_ < MP) ? xa + (size_t)r_ * D : xb + (size_t)(r_ - MP) * D; _Pragma("unroll") for (int j = 0; j < 8; ++j) vn[j] = *(const f32x4*)(xr_ + 4 * lane + 256 * j); } \
        else { _Pragma("unroll") for (int j = 0; j < 8; ++j) xn[j] = *(const v2u*)(XB + (size_t)r_ * D + 4 * lane + 256 * j); } \
        if (Y) { _Pragma("unroll") for (int j = 0; j < 8; ++j) yn[j] = *(const v2u*)(Y + (size_t)r_ * D + 4 * lane + 256 * j); } } while (0)
#pragma unroll
    for (int j = 0; j < 8; ++j) { yn[j] = (v2u){0u, 0u}; xn[j] = (v2u){0u, 0u}; vn[j] = (f32x4){0.f, 0.f, 0.f, 0.f}; }
    if (r_lo + gw < MV) THIN_LOAD(r_lo + gw);
    for (int r = r_lo + gw; r < MV; r += NGW) {
        f32x4 v[8]; v2u yu[8];
#pragma unroll
        for (int j = 0; j < 8; ++j) { v[j] = X32 ? vn[j] : (f32x4){bf_lo(xn[j].x), bf_hi(xn[j].x), bf_lo(xn[j].y), bf_hi(xn[j].y)}; yu[j] = yn[j]; }
        if (r + NGW < MV) THIN_LOAD(r + NGW);
        if (Y) {
            f32x4 y[8]; float ss = 0.f;
#pragma unroll
            for (int j = 0; j < 8; ++j) { const v2u u = yu[j]; y[j] = (f32x4){bf_lo(u.x), bf_hi(u.x), bf_lo(u.y), bf_hi(u.y)}; ss += (y[j].x * y[j].x + y[j].y * y[j].y) + (y[j].z * y[j].z + y[j].w * y[j].w); }
            const float rstd = rsqrtf(wave_sum(ss) * (1.f / D) + EPS);
#pragma unroll
            for (int j = 0; j < 8; ++j) { const f32x4 g = *(const f32x4*)(gpost + 4 * lane + 256 * j); v[j] = v[j] + y[j] * rstd * g; }
        }
        if (fout) {
#pragma unroll
            for (int j = 0; j < 8; ++j) *(f32x4*)(fout + (size_t)r * D + 4 * lane + 256 * j) = v[j];
        } else {
#pragma unroll
            for (int j = 0; j < 8; ++j) { v2u o; o.x = pk2(v[j].x, v[j].y); o.y = pk2(v[j].z, v[j].w); *(v2u*)(XB + (size_t)r * D + 4 * lane + 256 * j) = o; }
        }
        if (gpre) {
            float ss = 0.f;
#pragma unroll
            for (int j = 0; j < 8; ++j) ss += (v[j].x * v[j].x + v[j].y * v[j].y) + (v[j].z * v[j].z + v[j].w * v[j].w);
            const float rstd = rsqrtf(wave_sum(ss) * (1.f / D) + EPS);
#pragma unroll
            for (int j = 0; j < 8; ++j) { const f32x4 g = *(const f32x4*)(gpre + 4 * lane + 256 * j); v[j] = v[j] * rstd * g;
                v2u o; o.x = pk2(v[j].x, v[j].y); o.y = pk2(v[j].z, v[j].w); *(v2u*)(H + (size_t)r * D + 4 * lane + 256 * j) = o; }
            if (do_ba) {
                float pc[16], mine = 0.f;
#pragma unroll
                for (int c = 0; c < 16; ++c) { float p = 0.f;
#pragma unroll
                    for (int j = 0; j < 8; ++j) { const f32x4 w = *(const LAS f32x4*)(Wl + c * D + 256 * j + 4 * lane); p += (v[j].x * w.x + v[j].y * w.y) + (v[j].z * w.z + v[j].w * w.w); }
                    pc[c] = row16_sum(p); }
#pragma unroll
                for (int c = 0; c < 16; ++c) pc[c] += __shfl_xor(pc[c], 16);
#pragma unroll
                for (int c = 0; c < 16; ++c) { pc[c] += __shfl_xor(pc[c], 32); mine = (lane == c) ? pc[c] : mine; }
                if (lane < 16) { float o;
                    if (lane < 8) o = sigm(mine);
                    else { const float al = F.in[10][l_ba * HA + lane - 8], dtb = F.in[11][l_ba * HA + lane - 8]; const float z = mine + dtb; const float sp = fmaxf(z, 0.f) + __logf(1.f + __expf(-fabsf(z))); o = -__expf(al) * sp; }
                    GB[(size_t)r * 16 + lane] = o; }
            }
        }
    }
}
#undef THIN_LOAD
__device__ __forceinline__ void ba_rows(Frame& F0, int l_ba) {
    RELANE(F0);
    const int lane = F.lane, gw = F.vcu * NWAVES + F.wave, NGW = F.G * NWAVES;
    const bf16* H = (const bf16*)(F.ws + WS_H); float* GB = (float*)(F.ws + WS_GB); const LAS float* Wl = (const LAS float*)F.lds;
    for (int r = gw; r < MP; r += NGW) {
        f32x4 v[8];
#pragma unroll
        for (int j = 0; j < 8; ++j) { const v2u u = *(const v2u*)(H + (size_t)r * D + 4 * lane + 256 * j); v[j] = (f32x4){bf_lo(u.x), bf_hi(u.x), bf_lo(u.y), bf_hi(u.y)}; }
        float mine = 0.f;
#pragma unroll 1
        for (int c = 0; c < 16; ++c) { float p = 0.f;
#pragma unroll
            for (int j = 0; j < 8; ++j) { const f32x4 w = *(const LAS f32x4*)(Wl + c * D + 256 * j + 4 * lane); p += (v[j].x * w.x + v[j].y * w.y) + (v[j].z * w.z + v[j].w * w.w); }
            p = wave_sum(p); if (lane == c) mine = p; }
        if (lane < 16) { float o;
            if (lane < 8) o = sigm(mine);
            else { const float al = F.in[10][l_ba * HA + lane - 8], dtb = F.in[11][l_ba * HA + lane - 8]; const float z = mine + dtb; const float sp = fmaxf(z, 0.f) + __logf(1.f + __expf(-fabsf(z))); o = -__expf(al) * sp; }
            GB[(size_t)r * 16 + lane] = o; }
    }
}

__device__ __forceinline__ void ld8f(const float* p, float (&x)[8]) { const f32x4 a = *(const f32x4*)p, b = *(const f32x4*)(p + 4); x[0] = a.x; x[1] = a.y; x[2] = a.z; x[3] = a.w; x[4] = b.x; x[5] = b.y; x[6] = b.z; x[7] = b.w; }
template <bool QK> __device__ __forceinline__ void conv_item(Frame& F0, int l, int row0, int T, int hmode, int sb, int j) {
    RELANE_G(F0);
    const int lane = F.lane;
    const bf16* PROJ = (const bf16*)(F.ws + WS_PROJ); const float* convw = F.in[9] + (size_t)l * 4 * CONVCH;
    const int c0 = QK ? 512 * j + 8 * lane : 2048 + 512 * j + 8 * lane, c1 = 1024 + 512 * j + 8 * lane;
    float w0[4][8], w1[4][8], x0[4][8], x1[4][8];
#pragma unroll
    for (int tap = 0; tap < 4; ++tap) { ld8f(convw + tap * CONVCH + c0, w0[tap]); if (QK) ld8f(convw + tap * CONVCH + c1, w1[tap]); }
#pragma unroll
    for (int i = 0; i < 3; ++i) {
        if (hmode == 1) { unpack8(*(const v4u*)(PROJ + (size_t)(row0 - 3 + i) * NIN + c0), x0[i + 1]); if (QK) unpack8(*(const v4u*)(PROJ + (size_t)(row0 - 3 + i) * NIN + c1), x1[i + 1]); }
        else if (hmode == 2) { const float* hp = F.in[6] + ((size_t)(l * DB + sb) * 3 + i) * CONVCH; ld8f(hp + c0, x0[i + 1]); if (QK) ld8f(hp + c1, x1[i + 1]); }
        else {
#pragma unroll
            for (int e = 0; e < 8; ++e) { x0[i + 1][e] = 0.f; x1[i + 1][e] = 0.f; } }
    }
    bf16* O0 = (bf16*)(F.ws + (QK ? WS_QN : WS_VV)) + 512 * j + 8 * lane; bf16* O1 = (bf16*)(F.ws + WS_KN) + 512 * j + 8 * lane;
    const float* GB = (const float*)(F.ws + WS_GB); f32x4* TOK = (f32x4*)(F.ws + WS_TOK); const int hd = 4 * j + (lane >> 4);
    v4u n0[4], n1[4]; float ng[4], nb[4];
#pragma unroll
    for (int u = 0; u < 4; ++u) { n0[u] = *(const v4u*)(PROJ + (size_t)(row0 + u) * NIN + c0); n1[u] = n0[u]; ng[u] = 0.f; nb[u] = 0.f; if (QK) { n1[u] = *(const v4u*)(PROJ + (size_t)(row0 + u) * NIN + c1); ng[u] = GB[(size_t)(row0 + u) * 16 + 8 + hd]; nb[u] = GB[(size_t)(row0 + u) * 16 + hd]; } }
    for (int tb = 0; tb < T; tb += 4) {
        v4u m0[4], m1[4]; float mg[4], mb[4];
#pragma unroll
        for (int u = 0; u < 4; ++u) { m0[u] = n0[u]; m1[u] = n1[u]; mg[u] = ng[u]; mb[u] = nb[u]; }
        if (tb + 4 < T) {
#pragma unroll
            for (int u = 0; u < 4; ++u) { n0[u] = *(const v4u*)(PROJ + (size_t)(row0 + tb + 4 + u) * NIN + c0); if (QK) { n1[u] = *(const v4u*)(PROJ + (size_t)(row0 + tb + 4 + u) * NIN + c1); ng[u] = GB[(size_t)(row0 + tb + 4 + u) * 16 + 8 + hd]; nb[u] = GB[(size_t)(row0 + tb + 4 + u) * 16 + hd]; } } }
#pragma unroll
        for (int u = 0; u < 4; ++u) {
            const int t = tb + u; const size_t r = (size_t)(row0 + t);
            unpack8(m0[u], x0[u]); if (QK) unpack8(m1[u], x1[u]);
            float a0[8], a1[8]; float s0 = 0.f, s1 = 0.f;
#pragma unroll
            for (int e = 0; e < 8; ++e) {
                a0[e] = silu(w0[3][e] * x0[u][e] + w0[2][e] * x0[(u + 3) & 3][e] + w0[1][e] * x0[(u + 2) & 3][e] + w0[0][e] * x0[(u + 1) & 3][e]); s0 += a0[e] * a0[e];
                if (QK) { a1[e] = silu(w1[3][e] * x1[u][e] + w1[2][e] * x1[(u + 3) & 3][e] + w1[1][e] * x1[(u + 2) & 3][e] + w1[0][e] * x1[(u + 1) & 3][e]); s1 += a1[e] * a1[e]; } }
            if (QK) {
                const float q_sc = rsqrtf(row16_sum(s0) + 1e-6f) * 0.08838834764831845f, k_sc = rsqrtf(row16_sum(s1) + 1e-6f); float p = 0.f;
#pragma unroll
                for (int e = 0; e < 8; ++e) { a0[e] *= q_sc; a1[e] *= k_sc; p += a0[e] * a1[e]; }
                p = row16_sum(p);
                *(v4u*)(O1 + r * 1024) = pack8(a1);
                if ((lane & 15) == 0) TOK[r * 8 + hd] = (f32x4){__expf(mg[u]), mb[u], p, mg[u]};
            }
            *(v4u*)(O0 + r * 1024) = pack8(a0);
        }
    }
}
__device__ __forceinline__ void pool_item(Frame& F0, int l, int row0, int T, int pos0, int hmode, int sb, int j) {
    RELANE_G(F0);
    const int lane = F.lane, win = 2 << (2 * j + (lane >> 5)), cc = 512 * j + 8 * lane;
    const bf16* U = (const bf16*)(F.ws + WS_PROJ) + PC_UC + cc; const float* hist = F.in[7] + (size_t)(l * DB + sb) * PHIST * CPOOL + cc;
    bf16* PO = (bf16*)(F.ws + WS_POOLED) + cc;
    float S[8];
#pragma unroll
    for (int e = 0; e < 8; ++e) S[e] = 0.f;
    if (hmode == 2) {
        for (int i = 1; i < 16; ++i) if (i < win) { float x[8]; ld8f(hist + (size_t)(PHIST - i) * CPOOL, x);
#pragma unroll
            for (int e = 0; e < 8; ++e) S[e] += x[e]; }
        for (int t = 0; t < T; ++t) {
            float xn[8], xo[8]; unpack8(*(const v4u*)(U + (size_t)(row0 + t) * NIN), xn);
            const int to = t - win + 1;
            if (to >= 0) unpack8(*(const v4u*)(U + (size_t)(row0 + to) * NIN), xo); else ld8f(hist + (size_t)(PHIST + to) * CPOOL, xo);
            const float inv = 1.f / (float)win; float o[8];
#pragma unroll
            for (int e = 0; e < 8; ++e) { S[e] += xn[e]; o[e] = S[e] * inv - xn[e]; S[e] -= xo[e]; }
            *(v4u*)(PO + (size_t)(row0 + t) * 1024) = pack8(o);
        }
        return;
    }
    {
        v4u h[15];
#pragma unroll
        for (int i = 1; i < 16; ++i) { const int back = (pos0 - i >= 0) ? i : pos0; h[i - 1] = *(const v4u*)(U + (size_t)(row0 - back) * NIN); }
#pragma unroll
        for (int i = 1; i < 16; ++i) { float x[8]; unpack8(h[i - 1], x); const float wgt = (i < win && pos0 - i >= 0) ? 1.f : 0.f;
#pragma unroll
            for (int e = 0; e < 8; ++e) S[e] += wgt * x[e]; }
    }
    v4u nn[4], no[4];
#define POOL_LD(tb_) do { _Pragma("unroll") for (int u = 0; u < 4; ++u) { const int t_ = (tb_) + u, to_ = t_ - win + 1; nn[u] = *(const v4u*)(U + (size_t)(row0 + t_) * NIN); no[u] = *(const v4u*)(U + (size_t)(row0 + (pos0 + to_ >= 0 ? to_ : -pos0)) * NIN); } } while (0)
    POOL_LD(0);
    for (int tb = 0; tb < T; tb += 4) {
        v4u mn[4], mo[4];
#pragma unroll
        for (int u = 0; u < 4; ++u) { mn[u] = nn[u]; mo[u] = no[u]; }
        if (tb + 4 < T) POOL_LD(tb + 4);
#pragma unroll
        for (int u = 0; u < 4; ++u) {
            const int t = tb + u, to = t - win + 1; const float wo = (pos0 + to >= 0) ? 1.f : 0.f;
            float xn[8], xo[8]; unpack8(mn[u], xn); unpack8(mo[u], xo);
            const float cnt = (float)(win < pos0 + t + 1 ? win : pos0 + t + 1), inv = __builtin_amdgcn_rcpf(cnt); float o[8];
#pragma unroll
            for (int e = 0; e < 8; ++e) { S[e] += xn[e]; o[e] = S[e] * inv - xn[e]; S[e] -= wo * xo[e]; }
            *(v4u*)(PO + (size_t)(row0 + t) * 1024) = pack8(o);
        }
    }
#undef POOL_LD
}
constexpr int CV_BLK = 16, CV_NB = SEQ / CV_BLK;
constexpr int CV_P_ITEMS = BATCH * CV_NB * 2, CV_S_ITEMS = DB * 2;
constexpr int PREP_ITEMS = 2 * (CV_P_ITEMS + CV_S_ITEMS) + CV_P_ITEMS + CV_S_ITEMS;
__device__ __forceinline__ void prep_item(Frame& F, int l, int it) {
    int kind = 0;
    if (it >= CV_P_ITEMS + CV_S_ITEMS) { it -= CV_P_ITEMS + CV_S_ITEMS; kind = 1; if (it >= CV_P_ITEMS + CV_S_ITEMS) { it -= CV_P_ITEMS + CV_S_ITEMS; kind = 2; } }
    int row0, T, hmode, sb = 0, pos0; const int j = it & 1;
    if (it < CV_P_ITEMS) { const int blk = (it >> 1) % CV_NB, b = (it >> 1) / CV_NB; row0 = b * SEQ + blk * CV_BLK; T = CV_BLK; hmode = blk ? 1 : 0; pos0 = blk * CV_BLK; }
    else { sb = (it - CV_P_ITEMS) >> 1; row0 = MP + DS * sb; T = DS; hmode = 2; pos0 = 0; }
    if (kind == 0) conv_item<true>(F, l, row0, T, hmode, sb, j); else if (kind == 1) conv_item<false>(F, l, row0, T, hmode, sb, j); else pool_item(F, l, row0, T, pos0, hmode, sb, j);
}

__device__ __forceinline__ void st8f(float* p, const v4u u) { float x[8]; unpack8(u, x); *(f32x4*)p = (f32x4){x[0], x[1], x[2], x[3]}; *(f32x4*)(p + 4) = (f32x4){x[4], x[5], x[6], x[7]}; }
__device__ __forceinline__ void prep_out_rows(Frame& F0, int l) {
    RELANE_G(F0);
    const int lane = F.lane, gw = F.vcu * NWAVES + F.wave, NGW = F.G * NWAVES;
    const bf16* PROJ = (const bf16*)(F.ws + WS_PROJ);
    float* out = F.out;
    for (int r = gw; r < MV; r += NGW) {
        const bool samp = r >= MP; const int b = samp ? (r - MP) / DS : r / SEQ, t = samp ? (r - MP) % DS : r % SEQ;
        const bf16* prow = PROJ + (size_t)r * NIN;
        const int ci = samp ? t - 1 : t - (SEQ - 3), pi = samp ? 11 + t : t - (SEQ - PHIST);
        v4u kvr[3][2], cv[6], pv[2];
#pragma unroll
        for (int gi = 0; gi < 3; ++gi) { kvr[gi][0] = *(const v4u*)(prow + PC_KB + gi * 512 + 8 * lane); kvr[gi][1] = *(const v4u*)(prow + PC_VB + gi * 512 + 8 * lane); }
        const bool needc = (ci >= 0) || (pi >= 0);
        if (needc) {
#pragma unroll
            for (int j = 0; j < 6; ++j) cv[j] = *(const v4u*)(prow + 512 * j + 8 * lane);
#pragma unroll
            for (int j = 0; j < 2; ++j) pv[j] = *(const v4u*)(prow + PC_UC + 512 * j + 8 * lane);
        }
#pragma unroll
        for (int gi = 0; gi < 3; ++gi) {
            const int win = 128 << (2 * gi); const int w = samp ? win - DS + t : t - (SEQ - win);
            if (w >= 0) {
                const size_t obase = samp ? (gi == 0 ? O_SW1 : gi == 1 ? O_SW2 : O_SW3) : (gi == 0 ? O_PW1 : gi == 1 ? O_PW2 : O_PW3);
                float* dst = out + obase + ((size_t)(l * (samp ? DB : BATCH) + b) * win + w) * 1024 + 8 * lane;
                st8f(dst, kvr[gi][0]); st8f(dst + 512, kvr[gi][1]);
            }
        }
        if (needc) {
            if (ci >= 0) { float* dst = out + (samp ? O_SCONV + ((size_t)(l * DB + b) * 3 + ci) * CONVCH : O_PCONV + ((size_t)(l * BATCH + b) * 3 + ci) * CONVCH) + 8 * lane;
#pragma unroll
                for (int j = 0; j < 6; ++j) st8f(dst + 512 * j, cv[j]); }
            if (pi >= 0) { float* dst = out + (samp ? O_SPOOL + ((size_t)(l * DB + b) * PHIST + pi) * CPOOL : O_PPOOL + ((size_t)(l * BATCH + b) * PHIST + pi) * CPOOL) + 8 * lane;
#pragma unroll
                for (int j = 0; j < 2; ++j) st8f(dst + 512 * j, pv[j]); }
            if (samp && t == 0) {
                const float* phist = F.in[7] + (size_t)(l * DB + b) * PHIST * CPOOL;
                float* dst = out + O_SPOOL + (size_t)(l * DB + b) * PHIST * CPOOL; const float* src = phist + 4 * CPOOL;
                for (int i = lane; i < 11 * CPOOL / 4; i += 64) *(f32x4*)(dst + 4 * i) = *(const f32x4*)(src + 4 * i);
            }
        }
    }
}

__device__ __forceinline__ void gdn_scan_item(Frame& F0, int row0, int h, int s, const float* S0, float* Sout) {
    RELANE(F0);
    const int lane = F.lane, dvl = lane & 15, kg = lane >> 4;
    const bf16* QN = (const bf16*)(F.ws + WS_QN); const bf16* KN = (const bf16*)(F.ws + WS_KN); const bf16* VV = (const bf16*)(F.ws + WS_VV);
    const f32x4* TOK = (const f32x4*)(F.ws + WS_TOK); float* ORAW = (float*)(F.ws + WS_ORAW);
    float S[32]; v4u ku[DS][4], qu[DS][4]; float vv[DS]; f32x4 tk[DS];
    const float* sp = S0 + (size_t)(32 * kg) * 128 + 16 * s + dvl;
#pragma unroll
    for (int i = 0; i < 32; ++i) S[i] = sp[(size_t)i * 128];
#pragma unroll
    for (int t = 0; t < DS; ++t) { const size_t r = (size_t)(row0 + t);
#pragma unroll
        for (int c = 0; c < 4; ++c) { ku[t][c] = *(const v4u*)(KN + r * 1024 + h * 128 + 32 * kg + 8 * c); qu[t][c] = *(const v4u*)(QN + r * 1024 + h * 128 + 32 * kg + 8 * c); }
        vv[t] = bf1(VV[r * 1024 + h * 128 + 16 * s + dvl]); tk[t] = TOK[r * 8 + h]; }
#pragma unroll
    for (int t = 0; t < DS; ++t) {
        float rk = 0.f, rq = 0.f; float kf[32];
#pragma unroll
        for (int c = 0; c < 4; ++c) { float k8[8], q8[8]; unpack8(ku[t][c], k8); unpack8(qu[t][c], q8);
#pragma unroll
            for (int e = 0; e < 8; ++e) { kf[8 * c + e] = k8[e]; rk += k8[e] * S[8 * c + e]; rq += q8[e] * S[8 * c + e]; } }
        rk += __shfl_xor(rk, 16); rq += __shfl_xor(rq, 16); rk += __shfl_xor(rk, 32); rq += __shfl_xor(rq, 32);
        const float a = tk[t].x, d = tk[t].y * (vv[t] - a * rk), o = a * rq + tk[t].z * d;
#pragma unroll
        for (int i = 0; i < 32; ++i) S[i] = a * S[i] + kf[i] * d;
        if (kg == 0) ORAW[(size_t)(row0 + t) * 1024 + h * 128 + 16 * s + dvl] = o;
    }
    float* op = Sout + (size_t)(32 * kg) * 128 + 16 * s + dvl;
#pragma unroll
    for (int i = 0; i < 32; ++i) op[(size_t)i * 128] = S[i];
}

__device__ __forceinline__ bf16x8 pack_acc(const f32x16& x, int sp) {
    v4u p; p.x = pk2(x[8 * sp + 0], x[8 * sp + 1]); p.y = pk2(x[8 * sp + 2], x[8 * sp + 3]); p.z = pk2(x[8 * sp + 4], x[8 * sp + 5]); p.w = pk2(x[8 * sp + 6], x[8 * sp + 7]);
    return __builtin_bit_cast(bf16x8, p);
}
constexpr int GA_PITCH = 272, GA_LT_PITCH = 36, GA_WAVE_LDS = 32 * GA_PITCH + 32 * GA_LT_PITCH * 4 + 384;
__device__ __forceinline__ void gdn_ga_item(Frame& F0, int ch) {
    RELANE_G(F0);
    const int lane = F.lane, r = lane & 31, h = lane >> 5;
    const int c = ch & 63, bh = ch >> 6, hd = bh & 7, b = bh >> 3, row0 = b * SEQ + 32 * c;
    LAS unsigned char* TL = F.lds + F.wave * GA_WAVE_LDS; LAS float* LT = (LAS float*)(TL + 32 * GA_PITCH); LAS float* GS = (LAS float*)(TL + 32 * GA_PITCH + 32 * GA_LT_PITCH * 4);
    const bf16* QN = (const bf16*)(F.ws + WS_QN); const bf16* KN = (const bf16*)(F.ws + WS_KN); const bf16* VV = (const bf16*)(F.ws + WS_VV); const f32x4* TOK = (const f32x4*)(F.ws + WS_TOK);
    { const f32x4 tk = TOK[(size_t)(row0 + r) * 8 + hd]; if (h == 0) { GS[r] = tk.w; GS[32 + r] = tk.y; } }
#pragma unroll
    for (int i = 0; i < 8; ++i) { const int p = lane + 64 * i, rw = p >> 4, c16 = p & 15; *(LAS v4u*)(TL + rw * GA_PITCH + 16 * c16) = *(const v4u*)(KN + (size_t)(row0 + rw) * 1024 + hd * 128 + 8 * c16); }
    asm volatile("s_waitcnt lgkmcnt(0)" ::: "memory");
    float gcv[32], bev[32];
#pragma unroll
    for (int i = 0; i < 8; ++i) { const f32x4 a = *(const LAS f32x4*)(GS + 4 * i), bq = *(const LAS f32x4*)(GS + 32 + 4 * i);
        gcv[4 * i] = a.x; gcv[4 * i + 1] = a.y; gcv[4 * i + 2] = a.z; gcv[4 * i + 3] = a.w; bev[4 * i] = bq.x; bev[4 * i + 1] = bq.y; bev[4 * i + 2] = bq.z; bev[4 * i + 3] = bq.w; }
#pragma unroll
    for (int i = 1; i < 32; ++i) gcv[i] += gcv[i - 1];
    if (lane == 0) {
#pragma unroll
        for (int i = 0; i < 8; ++i) *(LAS f32x4*)(GS + 64 + 4 * i) = (f32x4){gcv[4 * i], gcv[4 * i + 1], gcv[4 * i + 2], gcv[4 * i + 3]}; }
    asm volatile("s_waitcnt lgkmcnt(0)" ::: "memory");
    const float gc_own = GS[64 + r], fr = (float)r;
    const bf16* kp = KN + (size_t)(row0 + r) * 1024 + hd * 128 + 8 * h; const bf16* qp = QN + (size_t)(row0 + r) * 1024 + hd * 128 + 8 * h;
    f32x16 akk, aqk;
#pragma unroll
    for (int i = 0; i < 16; ++i) { akk[i] = 0.f; aqk[i] = 0.f; }
#pragma unroll
    for (int ks = 0; ks < 8; ++ks) { const bf16x8 kf = *(const bf16x8*)(kp + 16 * ks), qf = *(const bf16x8*)(qp + 16 * ks);
        akk = __builtin_amdgcn_mfma_f32_32x32x16_bf16(kf, kf, akk, 0, 0, 0); aqk = __builtin_amdgcn_mfma_f32_32x32x16_bf16(kf, qf, aqk, 0, 0, 0); }
#pragma unroll
    for (int g4 = 0; g4 < 4; ++g4) { f32x4 w;
#pragma unroll
        for (int e = 0; e < 4; ++e) { const int k0 = 8 * g4 + e, k1 = k0 + 4; const float gk = h ? gcv[k1] : gcv[k0], bk = h ? bev[k1] : bev[k0]; const int kk = h ? k1 : k0;
            const float lo = fminf(fmaxf((float)kk - fr, 0.f), 1.f);
            w[e] = lo * bk * akk[4 * g4 + e] * __expf(fminf(gk - gc_own, 0.f));
            aqk[4 * g4 + e] = (1.f - lo) * aqk[4 * g4 + e] * __expf(fminf(gc_own - gk, 0.f)); }
        *(LAS f32x4*)(LT + r * GA_LT_PITCH + 8 * g4 + 4 * h) = w; }
    bf16x8* AF = (bf16x8*)(F.ws + WS_AF) + (size_t)ch * 128;
    AF[lane] = pack_acc(aqk, 0); AF[64 + lane] = pack_acc(aqk, 1);
    asm volatile("s_waitcnt lgkmcnt(0)" ::: "memory");
    float t[32];
#pragma unroll
    for (int j = 31; j >= 0; --j) {
        float acc = 1.f - fminf(fabsf(fr - (float)j), 1.f);
#pragma unroll
        for (int gq = (j + 1) >> 2; gq < 8; ++gq) { const f32x4 lv = *(const LAS f32x4*)(LT + j * GA_LT_PITCH + 4 * gq);
#pragma unroll
            for (int e = 0; e < 4; ++e) if (4 * gq + e > j) acc -= t[4 * gq + e] * lv[e]; }
        t[j] = acc;
    }
    bf16x8 t1f[2], t2f[2];
#pragma unroll
    for (int sp = 0; sp < 2; ++sp) { float x1[8], x2[8];
#pragma unroll
        for (int e = 0; e < 8; ++e) { const int j0 = 16 * sp + e, j1 = j0 + 8; const float tv = h ? t[j1] : t[j0], bj = h ? bev[j1] : bev[j0], gj = h ? gcv[j1] : gcv[j0]; x1[e] = tv * bj; x2[e] = x1[e] * __expf(gj); }
        t1f[sp] = __builtin_bit_cast(bf16x8, pack8(x1)); t2f[sp] = __builtin_bit_cast(bf16x8, pack8(x2)); }
    { bf16x8* QFo = (bf16x8*)(F.ws + WS_QF) + (size_t)ch * 512; const bf16* qrow = QN + (size_t)(row0 + r) * 1024 + hd * 128 + 4 * h;
#pragma unroll
      for (int tl = 0; tl < 4; ++tl)
#pragma unroll
          for (int sp = 0; sp < 2; ++sp) { const v2u qlo = *(const v2u*)(qrow + 32 * tl + 16 * sp), qhi = *(const v2u*)(qrow + 32 * tl + 16 * sp + 8); v4u qu; qu.x = qlo.x; qu.y = qlo.y; qu.z = qhi.x; qu.w = qhi.y; QFo[(tl * 2 + sp) * 64 + lane] = __builtin_bit_cast(bf16x8, qu); } }
    const float g_last = gcv[31];
    bf16x8* WF = (bf16x8*)(F.ws + WS_WF) + (size_t)ch * 512; bf16x8* KF = (bf16x8*)(F.ws + WS_KF) + (size_t)ch * 512;
#pragma unroll
    for (int tl = 0; tl < 4; ++tl) {
        f32x16 acc;
#pragma unroll
        for (int i = 0; i < 16; ++i) acc[i] = 0.f;
        const LAS unsigned char* col = TL + (32 * tl + r) * 2;
#pragma unroll
        for (int sp = 0; sp < 2; ++sp) { unsigned w[4];
#pragma unroll
            for (int e = 0; e < 4; ++e) { const unsigned lo = *(const LAS unsigned short*)(col + (16 * sp + 8 * h + 2 * e) * GA_PITCH), hi = *(const LAS unsigned short*)(col + (16 * sp + 8 * h + 2 * e + 1) * GA_PITCH); w[e] = lo | (hi << 16); }
            v4u wu; wu.x = w[0]; wu.y = w[1]; wu.z = w[2]; wu.w = w[3];
            acc = __builtin_amdgcn_mfma_f32_32x32x16_bf16(__builtin_bit_cast(bf16x8, wu), t2f[sp], acc, 0, 0, 0); }
#pragma unroll
        for (int i = 0; i < 16; ++i) acc[i] = -acc[i];
#pragma unroll
        for (int sp = 0; sp < 2; ++sp) { WF[(tl * 2 + sp) * 64 + lane] = pack_acc(acc, sp);
            float x[8];
#pragma unroll
            for (int e = 0; e < 8; ++e) { const int j0 = 16 * sp + 8 * (e >> 2) + (e & 3), j1 = j0 + 4; const float gj = h ? gcv[j1] : gcv[j0];
                const unsigned kv = *(const LAS unsigned short*)(col + (j0 + 4 * h) * GA_PITCH); x[e] = __builtin_bit_cast(float, kv << 16) * __expf(g_last - gj); }
            KF[(tl * 2 + sp) * 64 + lane] = __builtin_bit_cast(bf16x8, pack8(x)); }
    }
    asm volatile("s_waitcnt lgkmcnt(0)" ::: "memory");
#pragma unroll
    for (int i = 0; i < 8; ++i) { const int p = lane + 64 * i, rw = p >> 4, c16 = p & 15; *(LAS v4u*)(TL + rw * GA_PITCH + 16 * c16) = *(const v4u*)(VV + (size_t)(row0 + rw) * 1024 + hd * 128 + 8 * c16); }
    asm volatile("s_waitcnt lgkmcnt(0)" ::: "memory");
    f32x4* UF = (f32x4*)(F.ws + WS_UF) + (size_t)ch * 1024;
#pragma unroll
    for (int tl = 0; tl < 4; ++tl) {
        f32x16 acc;
#pragma unroll
        for (int i = 0; i < 16; ++i) acc[i] = 0.f;
        const LAS unsigned char* col = TL + (32 * tl + r) * 2;
#pragma unroll
        for (int sp = 0; sp < 2; ++sp) { unsigned w[4];
#pragma unroll
            for (int e = 0; e < 4; ++e) { const unsigned lo = *(const LAS unsigned short*)(col + (16 * sp + 8 * h + 2 * e) * GA_PITCH), hi = *(const LAS unsigned short*)(col + (16 * sp + 8 * h + 2 * e + 1) * GA_PITCH); w[e] = lo | (hi << 16); }
            v4u wu; wu.x = w[0]; wu.y = w[1]; wu.z = w[2]; wu.w = w[3];
            acc = __builtin_amdgcn_mfma_f32_32x32x16_bf16(t1f[sp], __builtin_bit_cast(bf16x8, wu), acc, 0, 0, 0); }
#pragma unroll
        for (int g4 = 0; g4 < 4; ++g4) UF[(tl * 4 + g4) * 64 + lane] = (f32x4){acc[4 * g4], acc[4 * g4 + 1], acc[4 * g4 + 2], acc[4 * g4 + 3]};
    }
    if (h == 0) ((float*)(F.ws + WS_TB))[(size_t)ch * 32 + r] = __expf(gc_own);
    asm volatile("s_waitcnt lgkmcnt(0)" ::: "memory");
}

constexpr int GSC_ITEMS = BATCH * HA * 4;
constexpr int GSB_WF = 0, GSB_KF = 8192, GSB_QF = 16384, GSB_UF = 24576, GSB_AF = 28672, GSB_TB = 30720, GSB_AL = 34816, GSB_STRIDE = 36864;
__device__ __forceinline__ void gdn_chunk_scan(Frame& F0, int l, int item) {
    RELANE(F0);
    const int lane = F.lane, r = lane & 31, h = lane >> 5;
    const int sl = item & 3, bh = item >> 2, hd = bh & 7, b = bh >> 3;
    float* ORAW = (float*)(F.ws + WS_ORAW);
    LAS unsigned char* buf = F.lds;
#define GS_DMA(src, off) __builtin_amdgcn_global_load_lds((const unsigned*)(src), (LAS unsigned*)(bp + (off)), 16, 0, 0)
#define GS_FETCH(cc, bsel) do { const size_t ch_ = (size_t)bh * 64 + (cc); LAS unsigned char* bp = buf + (bsel) * GSB_STRIDE; \
        const bf16x8* wf_ = (const bf16x8*)(F.ws + WS_WF) + ch_ * 512 + lane; const bf16x8* kf_ = (const bf16x8*)(F.ws + WS_KF) + ch_ * 512 + lane; const bf16x8* qf_ = (const bf16x8*)(F.ws + WS_QF) + ch_ * 512 + lane; \
        const f32x4* uf_ = (const f32x4*)(F.ws + WS_UF) + ch_ * 1024 + (size_t)sl * 256 + lane; const bf16x8* af_ = (const bf16x8*)(F.ws + WS_AF) + ch_ * 128 + lane; const float* tb_ = (const float*)(F.ws + WS_TB) + ch_ * 32; \
        _Pragma("unroll") for (int i_ = 0; i_ < 8; ++i_) { GS_DMA(wf_ + i_ * 64, GSB_WF + i_ * 1024); GS_DMA(qf_ + i_ * 64, GSB_QF + i_ * 1024); } \
        _Pragma("unroll") for (int i_ = 0; i_ < 4; ++i_) { GS_DMA(uf_ + i_ * 64, GSB_UF + i_ * 1024); GS_DMA(tb_ + 8 * i_ + 4 * h, GSB_TB + i_ * 1024); } \
        GS_DMA(af_, GSB_AF); GS_DMA(af_ + 64, GSB_AF + 1024); GS_DMA(tb_ + 28, GSB_AL); \
        _Pragma("unroll") for (int i_ = 0; i_ < 8; ++i_) GS_DMA(kf_ + i_ * 64, GSB_KF + i_ * 1024); } while (0)
    f32x16 S[4];
#pragma unroll
    for (int tl = 0; tl < 4; ++tl)
#pragma unroll
        for (int i = 0; i < 16; ++i) S[tl][i] = 0.f;
    GS_FETCH(0, 0);
#pragma unroll 1
    for (int c = 0; c < SEQ / 32; ++c) {
        const int row0 = b * SEQ + 32 * c;
        asm volatile("s_waitcnt vmcnt(0)" ::: "memory");
        if (c + 1 < SEQ / 32) GS_FETCH(c + 1, (c + 1) & 1);
        const LAS unsigned char* bp = buf + (c & 1) * GSB_STRIDE + lane * 16;
        f32x16 P, O1;
#pragma unroll
        for (int g4 = 0; g4 < 4; ++g4) { const f32x4 u = *(const LAS f32x4*)(bp + GSB_UF + g4 * 1024); P[4 * g4] = u.x; P[4 * g4 + 1] = u.y; P[4 * g4 + 2] = u.z; P[4 * g4 + 3] = u.w; }
#pragma unroll
        for (int i = 0; i < 16; ++i) O1[i] = 0.f;
#pragma unroll
        for (int tl = 0; tl < 4; ++tl)
#pragma unroll
            for (int sp = 0; sp < 2; ++sp) {
                const bf16x8 sf = pack_acc(S[tl], sp);
                P = __builtin_amdgcn_mfma_f32_32x32x16_bf16(*(const LAS bf16x8*)(bp + GSB_WF + (tl * 2 + sp) * 1024), sf, P, 0, 0, 0);
                O1 = __builtin_amdgcn_mfma_f32_32x32x16_bf16(*(const LAS bf16x8*)(bp + GSB_QF + (tl * 2 + sp) * 1024), sf, O1, 0, 0, 0);
            }
#pragma unroll
        for (int g4 = 0; g4 < 4; ++g4) { const f32x4 eg = *(const LAS f32x4*)(bp + GSB_TB + g4 * 1024); O1[4 * g4] *= eg.x; O1[4 * g4 + 1] *= eg.y; O1[4 * g4 + 2] *= eg.z; O1[4 * g4 + 3] *= eg.w; }
        const bf16x8 vf0 = pack_acc(P, 0), vf1 = pack_acc(P, 1);
        O1 = __builtin_amdgcn_mfma_f32_32x32x16_bf16(*(const LAS bf16x8*)(bp + GSB_AF), vf0, O1, 0, 0, 0);
        O1 = __builtin_amdgcn_mfma_f32_32x32x16_bf16(*(const LAS bf16x8*)(bp + GSB_AF + 1024), vf1, O1, 0, 0, 0);
        const float a_last = (*(const LAS f32x4*)(bp + GSB_AL)).w;
#pragma unroll
        for (int tl = 0; tl < 4; ++tl) {
#pragma unroll
            for (int i = 0; i < 16; ++i) S[tl][i] *= a_last;
            S[tl] = __builtin_amdgcn_mfma_f32_32x32x16_bf16(*(const LAS bf16x8*)(bp + GSB_KF + (tl * 2) * 1024), vf0, S[tl], 0, 0, 0);
            S[tl] = __builtin_amdgcn_mfma_f32_32x32x16_bf16(*(const LAS bf16x8*)(bp + GSB_KF + (tl * 2 + 1) * 1024), vf1, S[tl], 0, 0, 0);
        }
        float* op = ORAW + (size_t)(row0 + 4 * h) * 1024 + hd * 128 + 32 * sl + r;
#pragma unroll
        for (int i = 0; i < 16; ++i) op[(size_t)((i & 3) + 8 * (i >> 2)) * 1024] = O1[i];
    }
#undef GS_DMA
#undef GS_FETCH
    float* Sout = F.out + O_PGDN + (size_t)((l * BATCH + b) * HA + hd) * 16384 + 32 * sl + r;
#pragma unroll
    for (int tl = 0; tl < 4; ++tl)
#pragma unroll
        for (int i = 0; i < 16; ++i) Sout[(size_t)(32 * tl + (i & 3) + 8 * (i >> 2) + 4 * h) * 128] = S[tl][i];
}

constexpr int VT_PITCH = 144, VT_WAVE_LDS = 64 * VT_PITCH, VT_ITEMS = BATCH * 3 * 4 * 2 * 32;
__device__ __forceinline__ void vt_item(Frame& F0, int item) {
    RELANE_G(F0);
    const int lane = F.lane; LAS unsigned char* T = F.lds + F.wave * VT_WAVE_LDS;
    const int ch = item & 31, dh = (item >> 5) & 1, hh = (item >> 6) & 3, bg = item >> 8, g = bg % 3, b = bg / 3;
    const int dil = 1 << (2 * g), Lc = SEQ >> (2 * g), pos0 = ch * 64, rho = pos0 / Lc, i0 = pos0 % Lc;
    const bf16* PROJ = (const bf16*)(F.ws + WS_PROJ); bf16* VT = (bf16*)(F.ws + WS_VT);
    const bf16* src = PROJ + ((size_t)b * SEQ + (size_t)(i0 + lane) * dil + rho) * NIN + PC_VB + g * 512 + hh * 128 + 64 * dh;
    v4u x[8];
#pragma unroll
    for (int c = 0; c < 8; ++c) x[c] = *(const v4u*)(src + 8 * c);
#pragma unroll
    for (int c = 0; c < 8; ++c) { const unsigned w[4] = {x[c].x, x[c].y, x[c].z, x[c].w};
#pragma unroll
        for (int e = 0; e < 4; ++e) { *(LAS unsigned short*)(T + (8 * c + 2 * e) * VT_PITCH + 2 * lane) = (unsigned short)(w[e] & 0xffffu); *(LAS unsigned short*)(T + (8 * c + 2 * e + 1) * VT_PITCH + 2 * lane) = (unsigned short)(w[e] >> 16); } }
    asm volatile("s_waitcnt lgkmcnt(0)" ::: "memory");
    bf16* dst = VT + ((size_t)((b * 3 + g) * 4 + hh) * 128 + 64 * dh) * 2048 + pos0;
#pragma unroll
    for (int it = 0; it < 8; ++it) { const int p = lane + 64 * it, row = p >> 3, cc = p & 7; const v4u v = *(const LAS v4u*)(T + row * VT_PITCH + 16 * cc); *(v4u*)(dst + (size_t)row * 2048 + 8 * cc) = v; }
    asm volatile("s_waitcnt lgkmcnt(0)" ::: "memory");
}

constexpr int ATT_UNITS = BATCH * 4 * 192;
__device__ __forceinline__ void attn_unit(Frame& F0, int unit) {
    RELANE(F0);
    const int lane = F.lane, r = lane & 31, h = lane >> 5;
    const int bh = unit / 192, b = bh >> 2, hh = bh & 3, u = unit % 192, g = u >> 6, v = u & 63;
    const int dil = 1 << (2 * g), ntpc = 64 >> (2 * g), rho = v / ntpc, i0 = (v % ntpc) * 32, Lc = SEQ >> (2 * g);
    const bf16* PROJ = (const bf16*)(F.ws + WS_PROJ);
    const bf16* cbase = PROJ + ((size_t)b * SEQ + rho) * NIN + g * 512 + hh * 128 + 8 * h;
    const bf16* qp = cbase + (size_t)(i0 + r) * dil * NIN + PC_QB;
    bf16x8 qf[8];
#pragma unroll
    for (int ks = 0; ks < 8; ++ks) qf[ks] = *(const bf16x8*)(qp + 16 * ks);
    f32x16 st[5]; float mx = -1e30f;
    bf16x8 kn[8];
    { const int k0 = i0 - 128; const bf16* kp = cbase + (size_t)((k0 >= 0 ? k0 : 0) + r) * dil * NIN + PC_KB;
#pragma unroll
      for (int ks = 0; ks < 8; ++ks) kn[ks] = *(const bf16x8*)(kp + 16 * ks); }
#pragma unroll
    for (int kt = 0; kt < 5; ++kt) {
        const int k0 = i0 - 128 + 32 * kt; const bool tv = k0 >= 0;
        bf16x8 kc[8];
#pragma unroll
        for (int ks = 0; ks < 8; ++ks) kc[ks] = kn[ks];
        if (kt < 4) { const int k1 = k0 + 32; const bf16* kp = cbase + (size_t)((k1 >= 0 ? k1 : 0) + r) * dil * NIN + PC_KB;
#pragma unroll
            for (int ks = 0; ks < 8; ++ks) kn[ks] = *(const bf16x8*)(kp + 16 * ks); }
        f32x16 acc;
#pragma unroll
        for (int i = 0; i < 16; ++i) acc[i] = 0.f;
#pragma unroll
        for (int ks = 0; ks < 8; ++ks) acc = __builtin_amdgcn_mfma_f32_32x32x16_bf16(kc[ks], qf[ks], acc, 0, 0, 0);
#pragma unroll
        for (int i = 0; i < 16; ++i) { const int row = (i & 3) + 8 * (i >> 2) + 4 * h; float sv = tv ? acc[i] : -1e30f;
            if (kt == 0 && row < r) sv = -1e30f;
            if (kt == 4 && row > r) sv = -1e30f;
            st[kt][i] = sv; mx = fmaxf(mx, sv); }
    }
    mx = fmaxf(mx, __shfl_xor(mx, 32));
    const float c = 0.08838834764831845f * 1.4426950408889634f, mc = mx * c; float ls = 0.f;
#pragma unroll
    for (int kt = 0; kt < 5; ++kt)
#pragma unroll
        for (int i = 0; i < 16; ++i) { const float p = __builtin_amdgcn_exp2f(st[kt][i] * c - mc); st[kt][i] = p; ls += p; }
    ls += __shfl_xor(ls, 32);
    f32x16 ot[4];
#pragma unroll
    for (int dt = 0; dt < 4; ++dt)
#pragma unroll
        for (int i = 0; i < 16; ++i) ot[dt][i] = 0.f;
    const bf16* vt = (const bf16*)(F.ws + WS_VT) + ((size_t)((b * 3 + g) * 4 + hh) * 128 + r) * 2048 + rho * Lc + 4 * h;
    v2u vn[2][4][2];
#define ATT_VLD(kt_) do { const int k0_ = i0 - 128 + 32 * (kt_), kc_ = k0_ >= 0 ? k0_ : 0; _Pragma("unroll") for (int sp = 0; sp < 2; ++sp) _Pragma("unroll") for (int dt = 0; dt < 4; ++dt) { \
            const bf16* vp = vt + (size_t)(32 * dt) * 2048 + kc_ + 16 * sp; vn[sp][dt][0] = *(const v2u*)vp; vn[sp][dt][1] = *(const v2u*)(vp + 8); } } while (0)
    ATT_VLD(0);
#pragma unroll
    for (int kt = 0; kt < 5; ++kt) {
        v2u vc[2][4][2];
#pragma unroll
        for (int sp = 0; sp < 2; ++sp)
#pragma unroll
            for (int dt = 0; dt < 4; ++dt) { vc[sp][dt][0] = vn[sp][dt][0]; vc[sp][dt][1] = vn[sp][dt][1]; }
        if (kt < 4) ATT_VLD(kt + 1);
#pragma unroll
        for (int sp = 0; sp < 2; ++sp) {
            v4u pu; pu.x = pk2(st[kt][8 * sp + 0], st[kt][8 * sp + 1]); pu.y = pk2(st[kt][8 * sp + 2], st[kt][8 * sp + 3]); pu.z = pk2(st[kt][8 * sp + 4], st[kt][8 * sp + 5]); pu.w = pk2(st[kt][8 * sp + 6], st[kt][8 * sp + 7]);
            const bf16x8 pf = __builtin_bit_cast(bf16x8, pu);
#pragma unroll
            for (int dt = 0; dt < 4; ++dt) {
                v4u vu; vu.x = vc[sp][dt][0].x; vu.y = vc[sp][dt][0].y; vu.z = vc[sp][dt][1].x; vu.w = vc[sp][dt][1].y;
                ot[dt] = __builtin_amdgcn_mfma_f32_32x32x16_bf16(__builtin_bit_cast(bf16x8, vu), pf, ot[dt], 0, 0, 0);
            }
        }
    }
#undef ATT_VLD
    const float inv = 1.f / ls; const size_t tok = (size_t)b * SEQ + (size_t)(i0 + r) * dil + rho;
    bf16* op = (bf16*)(F.ws + WS_OBG) + ((size_t)g * MV + tok) * 512 + hh * 128 + 4 * h;
#pragma unroll
    for (int dt = 0; dt < 4; ++dt)
#pragma unroll
        for (int g4 = 0; g4 < 4; ++g4) { v2u w; w.x = pk2(ot[dt][4 * g4] * inv, ot[dt][4 * g4 + 1] * inv); w.y = pk2(ot[dt][4 * g4 + 2] * inv, ot[dt][4 * g4 + 3] * inv); *(v2u*)(op + 32 * dt + 8 * g4) = w; }
    if (h == 0) *(f32x2*)((float*)(F.ws + WS_AST) + (((size_t)g * MV + tok) * 4 + hh) * 2) = (f32x2){mc, ls};
}


__device__ __forceinline__ void attn_sample_item(Frame& F0, int l, int item) {
    RELANE(F0);
    const int lane = F.lane, l16 = lane & 15;
    const int half = item & 1, it2 = item >> 1, g = it2 % 3, bt = it2 / 3, t = bt & 3, b = bt >> 2, dil = 1 << (2 * g), win = 128 * dil, jlo = half ? 65 : 0, part = g + 3 * half;
    const bf16* PROJ = (const bf16*)(F.ws + WS_PROJ);
    const int row = MP + DS * b + t;
    const float* cache = F.in[2 + g] + (size_t)(l * DB + b) * win * 1024 + 8 * lane;
    const bf16* newk = PROJ + (size_t)(MP + DS * b) * NIN + PC_KB + g * 512 + 8 * lane;
    float q[8]; unpack8(*(const v4u*)(PROJ + (size_t)row * NIN + PC_QB + g * 512 + 8 * lane), q);
    const int n_new = (g == 0) ? t + 1 : 1;
    const float c = 0.08838834764831845f * 1.4426950408889634f;
    float sc[5];
#pragma unroll
    for (int jr = 0; jr < 5; ++jr) {
        sc[jr] = -1e30f;
        const int jn = jr < 4 ? 16 : 1;
#pragma unroll 8
        for (int jl = 0; jl < jn; ++jl) {
            const int j = jlo + 16 * jr + jl, jc = j <= 128 ? j : 128; int idx = win + t - jc * dil; idx = idx < win ? idx : win - 1;
            const float* kp = cache + (size_t)idx * 1024; const f32x4 a = *(const f32x4*)kp, bq = *(const f32x4*)(kp + 4);
            float sv = (q[0] * a.x + q[1] * a.y) + (q[2] * a.z + q[3] * a.w) + (q[4] * bq.x + q[5] * bq.y) + (q[6] * bq.z + q[7] * bq.w);
            sv = j <= 128 ? row16_sum(sv) * c : -1e30f;
            sc[jr] = (l16 == jl) ? sv : sc[jr];
        }
    }
#pragma unroll
    for (int jj = 0; jj < 4; ++jj) {
        const int tk = t - jj >= 0 ? t - jj : 0; float k[8]; unpack8(*(const v4u*)(newk + (size_t)tk * NIN), k);
        float sv = (q[0] * k[0] + q[1] * k[1]) + (q[2] * k[2] + q[3] * k[3]) + (q[4] * k[4] + q[5] * k[5]) + (q[6] * k[6] + q[7] * k[7]);
        sv = row16_sum(sv) * c;
        sc[0] = (half == 0 && jj < n_new && l16 == jj) ? sv : sc[0];
    }
    float mx = -1e30f;
#pragma unroll
    for (int jr = 0; jr < 5; ++jr) mx = fmaxf(mx, sc[jr]);
    mx = fmaxf(mx, dpp_f<0xB1>(mx)); mx = fmaxf(mx, dpp_f<0x4E>(mx)); mx = fmaxf(mx, dpp_f<0x124>(mx)); mx = fmaxf(mx, dpp_f<0x128>(mx));
    float ls = 0.f;
#pragma unroll
    for (int jr = 0; jr < 5; ++jr) { sc[jr] = __builtin_amdgcn_exp2f(sc[jr] - mx); ls += sc[jr]; }
    ls = row16_sum(ls);
    float o[8];
#pragma unroll
    for (int e = 0; e < 8; ++e) o[e] = 0.f;
#pragma unroll
    for (int jj = 0; jj < 4; ++jj) {
        const int tk = t - jj >= 0 ? t - jj : 0; float vv[8]; unpack8(*(const v4u*)(newk + (size_t)tk * NIN + (PC_VB - PC_KB)), vv);
        const bool isnew = half == 0 && jj < n_new;
        const float p = isnew ? __shfl(sc[0], (lane & 48) | jj) : 0.f;
#pragma unroll
        for (int e = 0; e < 8; ++e) o[e] += p * vv[e];
        sc[0] = (isnew && l16 == jj) ? 0.f : sc[0];
    }
#pragma unroll
    for (int jr = 0; jr < 5; ++jr) {
        const int jn = jr < 4 ? 16 : 1;
#pragma unroll 8
        for (int jl = 0; jl < jn; ++jl) {
            const int j = jlo + 16 * jr + jl, jc = j <= 128 ? j : 128; int idx = win + t - jc * dil; idx = idx < win ? idx : win - 1;
            const float p = __shfl(sc[jr], (lane & 48) | jl);
            const float* vp = cache + (size_t)idx * 1024 + 512; const f32x4 a = *(const f32x4*)vp, bq = *(const f32x4*)(vp + 4);
            o[0] += p * a.x; o[1] += p * a.y; o[2] += p * a.z; o[3] += p * a.w; o[4] += p * bq.x; o[5] += p * bq.y; o[6] += p * bq.z; o[7] += p * bq.w;
        }
    }
    const float inv = 1.f / ls;
#pragma unroll
    for (int e = 0; e < 8; ++e) o[e] *= inv;
    *(v4u*)((bf16*)(F.ws + WS_OBG) + ((size_t)part * MV + row) * 512 + 8 * lane) = pack8(o);
    if (l16 == 0) *(f32x2*)((float*)(F.ws + WS_AST) + (((size_t)part * MV + row) * 4 + (lane >> 4)) * 2) = (f32x2){mx, ls};
}

__device__ __forceinline__ void gdn_gate_rows(Frame& F0, int l) {
    RELANE_G(F0);
    const int lane = F.lane, gw = F.vcu * NWAVES + F.wave, NGW = F.G * NWAVES;
    const float* ORAW = (const float*)(F.ws + WS_ORAW); const bf16* PROJ = (const bf16*)(F.ws + WS_PROJ); bf16* OUTA = (bf16*)(F.ws + WS_OUTA);
    const float* gain = F.in[12] + (size_t)l * 128;
    for (int r = gw; r < MV; r += NGW) {
#pragma unroll
        for (int j = 0; j < 4; ++j) {
            const int c0 = 256 * j + 4 * lane; const f32x4 o = *(const f32x4*)(ORAW + (size_t)r * 1024 + c0);
            float ss = (o.x * o.x + o.y * o.y) + (o.z * o.z + o.w * o.w);
            ss += __shfl_xor(ss, 1); ss += __shfl_xor(ss, 2); ss += __shfl_xor(ss, 4); ss += __shfl_xor(ss, 8); ss += __shfl_xor(ss, 16);
            const float rstd = rsqrtf(ss * (1.f / 128.f) + EPS);
            const f32x4 g = *(const f32x4*)(gain + (c0 & 127)); const v2u zu = *(const v2u*)(PROJ + (size_t)r * NIN + PC_ZA + c0);
            const float z0 = bf_lo(zu.x), z1 = bf_hi(zu.x), z2 = bf_lo(zu.y), z3 = bf_hi(zu.y);
            v2u w; w.x = pk2(o.x * rstd * g.x * silu(z0), o.y * rstd * g.y * silu(z1)); w.y = pk2(o.z * rstd * g.z * silu(z2), o.w * rstd * g.w * silu(z3));
            *(v2u*)(OUTA + (size_t)r * 1024 + c0) = w;
        }
        {
            const int c0 = 8 * lane, hh = lane >> 4; const float* ast = (const float*)(F.ws + WS_AST); const bf16* obg = (const bf16*)(F.ws + WS_OBG);
            const int np = r < MP ? 3 : 6;
            f32x2 sg[6]; v4u xo[6]; float M = -1e30f;
#pragma unroll
            for (int g = 0; g < 6; ++g) { const int gg = g < np ? g : 0; sg[g] = *(const f32x2*)(ast + (((size_t)gg * MV + r) * 4 + hh) * 2); xo[g] = *(const v4u*)(obg + ((size_t)gg * MV + r) * 512 + c0); }
#pragma unroll
            for (int g = 0; g < 6; ++g) { if (g >= np) sg[g] = (f32x2){-1e30f, 0.f}; M = fmaxf(M, sg[g].x); }
            float wg[6], den = 0.f;
#pragma unroll
            for (int g = 0; g < 6; ++g) { wg[g] = __builtin_amdgcn_exp2f(sg[g].x - M) * sg[g].y; den += wg[g]; }
            const float inv = 1.f / den; float o[8];
#pragma unroll
            for (int e = 0; e < 8; ++e) o[e] = 0.f;
#pragma unroll
            for (int g = 0; g < 6; ++g) { float x[8]; unpack8(xo[g], x); const float w = wg[g] * inv;
#pragma unroll
                for (int e = 0; e < 8; ++e) o[e] += w * x[e]; }
            *(v4u*)((bf16*)(F.ws + WS_OUTB) + (size_t)r * 512 + c0) = pack8(o);
        }
    }
}


constexpr int CP_PER_B = 31 + 127 + 511, CP_NSUB = DB * CP_PER_B;
constexpr int CP_TAIL_WG = 84, CP_TAIL_PER_WG = 64, CP_TAIL = CP_TAIL_WG * CP_TAIL_PER_WG;
__device__ __forceinline__ void copy_subchunk(Frame& F, int l, int c) {
    const int lane = F.lane, b = c / CP_PER_B, rc = c % CP_PER_B; const int gi = rc < 31 ? 0 : rc < 158 ? 1 : 2, k = rc - (gi == 0 ? 0 : gi == 1 ? 31 : 158), win = 128 << (2 * gi);
    const f32x4* src = (const f32x4*)(F.in[2 + gi] + ((size_t)(l * DB + b) * win + DS + 4 * k) * 1024) + lane;
    f32x4* dst = (f32x4*)(F.out + (gi == 0 ? O_SW1 : gi == 1 ? O_SW2 : O_SW3) + ((size_t)(l * DB + b) * win + 4 * k) * 1024) + lane;
    f32x4 v[16];
#pragma unroll
    for (int i = 0; i < 16; ++i) v[i] = __builtin_nontemporal_load(src + 64 * i);
#pragma unroll
    for (int i = 0; i < 16; ++i) __builtin_nontemporal_store(v[i], dst + 64 * i);
}
__device__ __forceinline__ void side_queue(Frame& F0, int l, volatile LAS unsigned* qctr) {
    RELANE(F0);
    const int lane = F.lane;
    const int nsub = CP_NSUB - (F.G == 256 ? CP_TAIL : 0);
    const int ncp = (nsub - (int)blockIdx.x + F.G - 1) / F.G;
    const int wper = 0,     w0 = (int)blockIdx.x * wper, nw = max(0, min(IT_LAYER, w0 + wper) - w0);
    LAS float* scr = (LAS float*)F.lds;
    for (;;) {
        unsigned q = 0; if (lane == 0) q = __hip_atomic_fetch_add((LAS unsigned*)qctr, 1u, __ATOMIC_RELAXED, __HIP_MEMORY_SCOPE_WORKGROUP);
        q = (unsigned)__builtin_amdgcn_readfirstlane((int)q);
        if ((int)q >= ncp + nw) break;
        if ((int)q < ncp) { copy_subchunk(F, l, (int)q * F.G + (int)blockIdx.x);
        } else weight_item(F, l + 1, w0 + (int)q - ncp, scr);
    }
}


__device__ __forceinline__ f32x16 skinny_kloop(const bf16* ap, const bf16* bp, int nks, f32x16 acc) {
    int ks = 0;
    for (; ks + 8 <= nks; ks += 8) { bf16x8 a[8], b[8];
#pragma unroll
        for (int u = 0; u < 8; ++u) { a[u] = *(const bf16x8*)(ap + 16 * (ks + u)); b[u] = *(const bf16x8*)(bp + 16 * (ks + u)); }
#pragma unroll
        for (int u = 0; u < 8; ++u) acc = __builtin_amdgcn_mfma_f32_32x32x16_bf16(a[u], b[u], acc, 0, 0, 0); }
    for (; ks < nks; ks += 4) { bf16x8 a[4], b[4];
#pragma unroll
        for (int u = 0; u < 4; ++u) { a[u] = *(const bf16x8*)(ap + 16 * (ks + u)); b[u] = *(const bf16x8*)(bp + 16 * (ks + u)); }
#pragma unroll
        for (int u = 0; u < 4; ++u) acc = __builtin_amdgcn_mfma_f32_32x32x16_bf16(a[u], b[u], acc, 0, 0, 0); }
    return acc;
}
__device__ __forceinline__ f32x2 skinny_reduce(Frame& F, const f32x16& acc) {
    LAS float* P = (LAS float*)F.lds; const int r = F.lane & 31, h = F.lane >> 5;
    __syncthreads();
#pragma unroll
    for (int i = 0; i < 16; ++i) P[(F.wave * 32 + (i & 3) + 8 * (i >> 2) + 4 * h) * 33 + r] = acc[i];
    __syncthreads();
    const int row = F.tid >> 4, col = 2 * (F.tid & 15); f32x2 o = {0.f, 0.f};
#pragma unroll
    for (int w = 0; w < 8; ++w) { o.x += P[(w * 32 + row) * 33 + col]; o.y += P[(w * 32 + row) * 33 + col + 1]; }
    return o;
}
__device__ __forceinline__ void skinny_store(Frame& F0, const bf16* A, int lda, const bf16* Bt, int K, bf16* O) {
    RELANE(F0);
    const int r = F.lane & 31, h = F.lane >> 5, kw = K / 8;
    for (int unit = launder_s((int)blockIdx.x); unit < 256; unit += F.G) {
        const int mt = unit >> 6, nt = unit & 63;
        f32x16 acc;
#pragma unroll
        for (int i = 0; i < 16; ++i) acc[i] = 0.f;
        acc = skinny_kloop(A + (size_t)(MP + 32 * mt + r) * lda + F.wave * kw + 8 * h, Bt + (size_t)(32 * nt + r) * K + F.wave * kw + 8 * h, kw / 16, acc);
        const f32x2 o = skinny_reduce(F, acc);
        *(unsigned*)(O + (size_t)(MP + 32 * mt + (F.tid >> 4)) * D + 32 * nt + 2 * (F.tid & 15)) = pk2(o.x, o.y);
    }
}
__device__ __forceinline__ void skinny_merge(Frame& F0, const unsigned char* wl) {
    RELANE(F0);
    const int r = F.lane & 31, h = F.lane >> 5; const bf16* PROJ = (const bf16*)(F.ws + WS_PROJ);
    for (int unit = launder_s((int)blockIdx.x); unit < 256; unit += F.G) {
        const int mt = unit >> 6, nt = unit & 63;
        f32x16 tot;
#pragma unroll
        for (int i = 0; i < 16; ++i) tot[i] = 0.f;
#pragma unroll
        for (int br = 0; br < 3; ++br) {
            const int K = br == 1 ? 512 : 1024, kw = K / 8;
            const bf16* A = (const bf16*)(F.ws + (br == 0 ? WS_OUTA : br == 1 ? WS_OUTB : WS_OC)); const bf16* Bt = (const bf16*)(wl + (br == 0 ? WO_BRA : br == 1 ? WO_BRB : WO_BRC));
            f32x16 acc;
#pragma unroll
            for (int i = 0; i < 16; ++i) acc[i] = 0.f;
            acc = skinny_kloop(A + (size_t)(MP + 32 * mt + r) * K + F.wave * kw + 8 * h, Bt + (size_t)(32 * nt + r) * K + F.wave * kw + 8 * h, kw / 16, acc);
            const bf16* gp = PROJ + (size_t)(MP + 32 * mt + 4 * h) * NIN + PC_GATE + br * 2048 + 32 * nt + r;
#pragma unroll
            for (int i = 0; i < 16; ++i) tot[i] += acc[i] * bf1(gp[(size_t)((i & 3) + 8 * (i >> 2)) * NIN]);
        }
        const f32x2 o = skinny_reduce(F, tot);
        *(unsigned*)((bf16*)(F.ws + WS_MERGED) + (size_t)(MP + 32 * mt + (F.tid >> 4)) * D + 32 * nt + 2 * (F.tid & 15)) = pk2(o.x, o.y);
    }
}

constexpr int N_PHASES = 1 + 11 * DEPTH;
__global__ void __launch_bounds__(NWAVES * 64, 2) fwd(Args args) {
    extern __shared__ __attribute__((aligned(16))) unsigned char lds_raw[];
    Frame F;
    F.lds = (LAS unsigned char*)lds_raw;
    F.tid = threadIdx.x; F.lane = F.tid & 63; F.wave = __builtin_amdgcn_readfirstlane(F.tid >> 6);
    F.G = gridDim.x; { const int bx = blockIdx.x; F.vcu = (F.G % 8 == 0) ? (bx % 8) * (F.G / 8) + bx / 8 : bx; }
    const CAS Args* const ap = (const CAS Args*)__builtin_amdgcn_kernarg_segment_ptr();
    F.in = ap->in; F.out = args.out; F.ws = args.ws;
    volatile LAS unsigned* MISC = (volatile LAS unsigned*)(F.lds + MISC_OFF);
    for (int u = F.tid; u < (LDS_BYTES - LDSCTL_OFF) / 4; u += NWAVES * 64) ((LAS unsigned*)(F.lds + LDSCTL_OFF))[u] = 0u;
    __syncthreads();
#if MK_ONE_LAUNCH
    XcdBarrier bar = xcd_barrier_post((unsigned*)(F.ws + WS_CTL) + CW_BAR, MISC + 8);
#define GRID_BAR() xcd_barrier(bar)
#else
#define GRID_BAR() do {} while (0)
#endif
    const int lo = args.ph_lo, hi = args.ph_hi;
#ifndef PHMASK
#define PHMASK 0xfff
#endif
#define IN(k) (lo <= (k) && (k) < hi)
#define EN(j) ((PHMASK >> (j)) & 1)
#ifndef REPMASK
#define REPMASK 0
#endif
#ifndef SUBREP
#define SUBREP 0
#endif
#define SUBR(j) for (int sr_ = 0; sr_ < 1 + ((SUBREP >> (j)) & 1); ++sr_)
#define REPEAT(j) for (int rep_ = 0; rep_ < 1 + ((REPMASK >> (j)) & 1); ++rep_)
#define REPBAR() do { if (rep_) GRID_BAR(); F.ws = launder_p(args.ws); F.out = launder_p(args.out); F.in = launder_k(ap->in); F.vcu = launder_s(vcu0); F.wave = launder_s(wave0); gw = F.vcu * NWAVES + F.wave; } while (0)
#define SEAM(k) do { if (IN(k) && IN((k) + 1)) GRID_BAR(); } while (0)
    const int vcu0 = F.vcu, wave0 = F.wave; int gw = F.vcu * NWAVES + F.wave; const int NGW = F.G * NWAVES;
    bf16* const H = (bf16*)(F.ws + WS_H); bf16* const PROJ = (bf16*)(F.ws + WS_PROJ);

    if (EN(0) && IN(0)) REPEAT(0) { REPBAR();
        LAS float* scr = (LAS float*)(F.lds + F.wave * 16384);
        for (int it = gw; it < 2 * IT_LAYER; it += NGW) { const int l = it >= IT_LAYER ? 1 : 0; weight_item(F, l, it - l * IT_LAYER, scr); }
        __syncthreads();
        stage_wba(F, 0);
        thin_rows<true>(F, F.in[0], F.in[1], nullptr, nullptr, nullptr, F.in[21], true, 0);
        __syncthreads();
    }
    SEAM(0);
#pragma unroll 1
    for (int l = 0; l < DEPTH; ++l) {
        const int pb = 1 + 11 * l;
        unsigned char* wl = F.ws + WS_W + (size_t)l * WL_BYTES;
        if (EN(1) && IN(pb + 0)) REPEAT(1) { REPBAR();
            pg8::Gemm g{H, (const bf16*)(wl + WO_IN), D, D, D, 0, (unsigned*)(F.ws + WS_PAD)}; pg8::StaticOrder S; S.init(MT, NIN, launder_s(F.G), launder_s((int)blockIdx.x));
            EpiStore E{PROJ, NIN, PC_GATE / 256};
            pg8::gemm_phase<EpiStore, pg8::StaticOrder, true, true>(F.lds, g, S, E);
        }
        SEAM(pb + 0);
        if (EN(2) && IN(pb + 1)) REPEAT(2) { REPBAR(); for (int it = gw; it < PREP_ITEMS; it += NGW) prep_item(F, l, it); prep_out_rows(F, l); for (int it = gw; it < VT_ITEMS; it += NGW) vt_item(F, it); }
        SEAM(pb + 1);
        if (EN(3) && IN(pb + 2)) REPEAT(3) { REPBAR(); for (int it = gw; it < GCH; it += NGW) gdn_ga_item(F, it); }
        SEAM(pb + 2);
        if (EN(4) && IN(pb + 3)) REPEAT(4) { REPBAR();
            if (F.tid == 0) MISC[16] = 0u;
            { pg8::Gemm g{(const bf16*)(F.ws + WS_POOLED), (const bf16*)(wl + WO_POOL), 1024, 256, 256, 512}; pg8::StaticOrder S; S.init(MT, 1024, launder_s(F.G), launder_s((int)blockIdx.x));
              EpiStore E{(bf16*)(F.ws + WS_OC), 1024, 1 << 30};
              pg8::gemm_phase<EpiStore, pg8::StaticOrder>(F.lds, g, S, E); }
            SUBR(3) for (int it = gw; it < DB * HA * 8; it += NGW) { const int s = it & 7, bh = it >> 3, b = bh >> 3, h = bh & 7;
                gdn_scan_item(F, MP + DS * b, h, s, F.in[5] + (size_t)((l * DB + b) * HA + h) * 16384, F.out + O_SGDN + (size_t)((l * DB + b) * HA + h) * 16384); }
            {
                const bool scanw = (F.wave == 0) && (F.vcu < GSC_ITEMS);
                if (scanw) { SUBR(0) gdn_chunk_scan(F, l, F.vcu); }
                else {
                    const int aw = F.vcu < GSC_ITEMS ? F.vcu * 7 + F.wave - 1 : GSC_ITEMS * 7 + (F.vcu - GSC_ITEMS) * 8 + F.wave, naw = F.G * 8 - GSC_ITEMS;
                    SUBR(1) for (int it = aw; it < ATT_UNITS; it += naw) attn_unit(F, it);
                    SUBR(2) for (int it = (aw + naw - ATT_UNITS % naw) % naw; it < MS * 6; it += naw) attn_sample_item(F, l, it);
                }
            }
            side_queue(F, l, MISC + 16);
        }
        SEAM(pb + 3);
        if (EN(5) && IN(pb + 4)) REPEAT(5) { REPBAR(); gdn_gate_rows(F, l); }
        SEAM(pb + 4);
        if (EN(6) && IN(pb + 5)) REPEAT(6) { REPBAR();
            pg8::StaticOrder S; S.init(MP, D, launder_s(F.G), launder_s((int)blockIdx.x)); bf16* MG = (bf16*)(F.ws + WS_MERGED);
            { pg8::Gemm g{(const bf16*)(F.ws + WS_OUTA), (const bf16*)(wl + WO_BRA), 1024, 1024, 1024, 0}; EpiMerge<false> E{MG, PROJ + PC_GATE}; pg8::gemm_phase<EpiMerge<false>, pg8::StaticOrder>(F.lds, g, S, E); }
            { pg8::Gemm g{(const bf16*)(F.ws + WS_OUTB), (const bf16*)(wl + WO_BRB), 512, 512, 512, 0}; EpiMerge<true> E{MG, PROJ + PC_GATE + 2048}; pg8::gemm_phase<EpiMerge<true>, pg8::StaticOrder>(F.lds, g, S, E); }
            { pg8::Gemm g{(const bf16*)(F.ws + WS_OC), (const bf16*)(wl + WO_BRC), 1024, 1024, 1024, 0}; EpiMerge<true> E{MG, PROJ + PC_GATE + 4096}; pg8::gemm_phase<EpiMerge<true>, pg8::StaticOrder>(F.lds, g, S, E); }
            skinny_merge(F, wl);
        }
        SEAM(pb + 5);
        if (EN(7) && IN(pb + 6)) REPEAT(7) { REPBAR();
            pg8::Gemm g{(const bf16*)(F.ws + WS_MERGED), (const bf16*)(wl + WO_OUT), D, D, D, 0}; pg8::StaticOrder S; S.init(MP, D, launder_s(F.G), launder_s((int)blockIdx.x));
            EpiStore E{(bf16*)(F.ws + WS_Y), D, 1 << 30};
            pg8::gemm_phase<EpiStore, pg8::StaticOrder>(F.lds, g, S, E);
            skinny_store(F, (const bf16*)(F.ws + WS_MERGED), D, (const bf16*)(wl + WO_OUT), D, (bf16*)(F.ws + WS_Y));
        }
        SEAM(pb + 6);
        if (EN(8) && IN(pb + 7)) REPEAT(8) { REPBAR();
            thin_rows<false>(F, nullptr, nullptr, (const bf16*)(F.ws + WS_Y), F.in[22] + (size_t)l * D, nullptr, F.in[23] + (size_t)l * D, false, 0, 0);
        }
        SEAM(pb + 7);
        if (EN(9) && IN(pb + 8)) REPEAT(9) { REPBAR();
            pg8::Gemm g{H, (const bf16*)(wl + WO_GU), D, D, D, 0, (unsigned*)(F.ws + WS_PAD)}; pg8::StaticOrder S; S.init(MT, 2 * DFF, launder_s(F.G), launder_s((int)blockIdx.x));
            EpiSwiglu E{(bf16*)(F.ws + WS_ACT)};
            pg8::gemm_phase<EpiSwiglu, pg8::StaticOrder, true, true>(F.lds, g, S, E);
            const int bxl = launder_s((int)blockIdx.x), Gl = launder_s(F.G);
            if (Gl == 256 && bxl >= 256 - CP_TAIL_WG) {
                Frame Fc = F; Fc.lane = launder(F.lane);
                const int base = CP_NSUB - CP_TAIL + (bxl - (256 - CP_TAIL_WG)) * CP_TAIL_PER_WG;
                for (int q = F.wave; q < CP_TAIL_PER_WG; q += NWAVES) copy_subchunk(Fc, 1 - l, base + q);
            }
        }
        SEAM(pb + 8);
        if (EN(10) && IN(pb + 9)) REPEAT(10) { REPBAR();
            pg8::Gemm g{(const bf16*)(F.ws + WS_ACT), (const bf16*)(wl + WO_DOWN), DFF, DFF, DFF, 0}; pg8::StaticOrder S; S.init(MP, D, launder_s(F.G), launder_s((int)blockIdx.x));
            EpiStore E{(bf16*)(F.ws + WS_Y), D, 1 << 30};
            pg8::gemm_phase<EpiStore, pg8::StaticOrder>(F.lds, g, S, E);
            skinny_store(F, (const bf16*)(F.ws + WS_ACT), DFF, (const bf16*)(wl + WO_DOWN), DFF, (bf16*)(F.ws + WS_Y));
        }
        SEAM(pb + 9);
        if (EN(11) && IN(pb + 10)) REPEAT(11) { REPBAR();
            if (l + 1 < DEPTH) { stage_wba(F, l + 1);
                thin_rows<false>(F, nullptr, nullptr, (const bf16*)(F.ws + WS_Y), F.in[24] + (size_t)l * D, nullptr, F.in[21] + (size_t)(l + 1) * D, true, l + 1, 0);
                __syncthreads(); }
            else thin_rows<false>(F, nullptr, nullptr, (const bf16*)(F.ws + WS_Y), F.in[24] + (size_t)l * D, F.out + O_YP, nullptr, false, 0, 0);
        }
        SEAM(pb + 10);
    }
#undef IN
#undef SEAM
}

extern "C" void kernel_launch(void* const* d_in, const int* in_sizes, int n_in, void* d_out, int out_size, void* d_ws, size_t ws_size, hipStream_t stream) {
    static int grid = 0;
    if (grid == 0) {
        if (n_in != 25 || (size_t)out_size != O_END || ws_size < WS_END) { fprintf(stderr, "kernel_launch: unexpected sizes n_in %d out %d ws %zu\n", n_in, out_size, ws_size); grid = -1; return; }
        int dev = 0, cus = 0, per_cu = 0;
        if (hipGetDevice(&dev) != hipSuccess || hipDeviceGetAttribute(&cus, hipDeviceAttributeMultiprocessorCount, dev) != hipSuccess) { grid = -1; return; }
        if (hipFuncSetAttribute((const void*)fwd, hipFuncAttributeMaxDynamicSharedMemorySize, LDS_BYTES) != hipSuccess) { fprintf(stderr, "kernel_launch: hipFuncSetAttribute failed\n"); grid = -1; return; }
        if (hipOccupancyMaxActiveBlocksPerMultiprocessor(&per_cu, (const void*)fwd, NWAVES * 64, LDS_BYTES) != hipSuccess || per_cu < 1) fprintf(stderr, "kernel_launch: occupancy query says %d\n", per_cu);
        (void)hipGetLastError();
        grid = cus;
    }
    if (grid < 0) return;
    if (hipMemsetAsync((char*)d_ws + WS_CTL, 0, CTL_BYTES, stream) != hipSuccess) return;
    Args a{};
    for (int i = 0; i < 25; ++i) a.in[i] = (const float*)d_in[i];
    a.out = (float*)d_out; a.ws = (unsigned char*)d_ws;
#if MK_ONE_LAUNCH
    a.ph_lo = 0; a.ph_hi = N_PHASES;
    hipLaunchKernelGGL(fwd, dim3(grid), dim3(NWAVES * 64), LDS_BYTES, stream, a);
#else
    for (int p = 0; p < N_PHASES; ++p) { a.ph_lo = p; a.ph_hi = p + 1; hipLaunchKernelGGL(fwd, dim3(grid), dim3(NWAVES * 64), LDS_BYTES, stream, a); }
#endif
}
```

```cpp
#include <hip/hip_runtime.h>
#include <cstdio>
#include <cstdint>

#ifndef MK_ONE_LAUNCH
#define MK_ONE_LAUNCH 1
#endif

#define GAS __attribute__((address_space(1)))
#define CAS __attribute__((address_space(4)))
typedef const float* cfp_t;
#define LAS __attribute__((address_space(3)))
typedef unsigned short bf16;
typedef unsigned v4u __attribute__((ext_vector_type(4)));
typedef unsigned v2u __attribute__((ext_vector_type(2)));
typedef float f32x4 __attribute__((ext_vector_type(4)));
typedef float f32x2 __attribute__((ext_vector_type(2)));
typedef short bf16x8 __attribute__((ext_vector_type(8)));
typedef float f32x16 __attribute__((ext_vector_type(16)));

constexpr int D = 2048, BATCH = 4, SEQ = 2048, DEPTH = 2, DB = 32, DS = 4;
constexpr int MP = BATCH * SEQ;
constexpr int MS = DB * DS;
constexpr int MV = MP + MS;
constexpr int MT = 8448;
constexpr int HA = 8, CONVCH = 3072;
constexpr int CPOOL = 1024, PHIST = 15;
constexpr int DFF = 5632;
constexpr int NIN_SRC = 15888, NIN = 15872;
constexpr int PC_ZA = 3072, PC_QB = 4096, PC_KB = 5632, PC_VB = 7168, PC_UC = 8704, PC_GATE = 9728;
constexpr float EPS = 1e-6f;
constexpr size_t O_YP = 0, O_YS = O_YP + (size_t)MP * D, O_PW1 = O_YS + (size_t)MS * D;
constexpr size_t O_PW2 = O_PW1 + (size_t)2 * 4 * 128 * 1024, O_PW3 = O_PW2 + (size_t)2 * 4 * 512 * 1024, O_PGDN = O_PW3 + (size_t)2 * 4 * 2048 * 1024;
constexpr size_t O_PCONV = O_PGDN + (size_t)2 * 4 * 8 * 16384, O_PPOOL = O_PCONV + (size_t)2 * 4 * 3 * 3072, O_SW1 = O_PPOOL + (size_t)2 * 4 * 15 * 1024;
constexpr size_t O_SW2 = O_SW1 + (size_t)2 * 32 * 128 * 1024, O_SW3 = O_SW2 + (size_t)2 * 32 * 512 * 1024, O_SGDN = O_SW3 + (size_t)2 * 32 * 2048 * 1024;
constexpr size_t O_SCONV = O_SGDN + (size_t)2 * 32 * 8 * 16384, O_SPOOL = O_SCONV + (size_t)2 * 32 * 3 * 3072, O_END = O_SPOOL + (size_t)2 * 32 * 15 * 1024;
static_assert(O_END == 226426880ull, "output size");

constexpr size_t WS_CTL = 0, CTL_BYTES = 1u << 20;
constexpr size_t SZ_WIN = (size_t)NIN * D * 2, SZ_WBRA = (size_t)D * 1024 * 2, SZ_WBRB = (size_t)D * 512 * 2, SZ_WBRC = (size_t)D * 1024 * 2, SZ_WPOOL = (size_t)4 * 256 * 256 * 2;
constexpr size_t SZ_WOUT = (size_t)D * D * 2, SZ_WGU = (size_t)2 * DFF * D * 2, SZ_WDOWN = (size_t)D * DFF * 2;
constexpr size_t WO_IN = 0, WO_BRA = WO_IN + SZ_WIN, WO_BRB = WO_BRA + SZ_WBRA, WO_BRC = WO_BRB + SZ_WBRB, WO_POOL = WO_BRC + SZ_WBRC, WO_OUT = WO_POOL + SZ_WPOOL;
constexpr size_t WO_GU = WO_OUT + SZ_WOUT, WO_DOWN = WO_GU + SZ_WGU, WL_BYTES = WO_DOWN + SZ_WDOWN;
constexpr size_t WS_W = CTL_BYTES;
constexpr size_t WS_H = WS_W + 2 * WL_BYTES;
constexpr size_t WS_PROJ = WS_H + (size_t)MT * D * 2;
constexpr size_t WS_GB = WS_PROJ + (size_t)MT * NIN * 2;
constexpr size_t WS_TOK = WS_GB + (size_t)MT * 16 * 4;
constexpr size_t WS_QN = WS_TOK + (size_t)MT * 8 * 16;
constexpr size_t WS_KN = WS_QN + (size_t)MT * 1024 * 2;
constexpr size_t WS_VV = WS_KN + (size_t)MT * 1024 * 2;
constexpr size_t WS_ORAW = WS_VV + (size_t)MT * 1024 * 2;
constexpr size_t WS_POOLED = WS_ORAW + (size_t)MT * 1024 * 4;
constexpr size_t WS_OUTA = WS_POOLED + (size_t)MT * 1024 * 2;
constexpr size_t WS_OUTB = WS_OUTA + (size_t)MT * 1024 * 2;
constexpr size_t WS_OC = WS_OUTB + (size_t)MT * 512 * 2;
constexpr size_t WS_MERGED = WS_OC + (size_t)MT * 1024 * 2;
constexpr size_t WS_Y = WS_MERGED + (size_t)MT * D * 2;
constexpr size_t WS_X1 = WS_Y + (size_t)MT * D * 2;
constexpr size_t WS_X2 = WS_X1 + (size_t)MT * D * 4;
constexpr size_t WS_ACT = WS_X2 + (size_t)MT * D * 4;
constexpr size_t WS_VT = WS_ACT + (size_t)MT * DFF * 2;
constexpr size_t WS_OBG = WS_VT + (size_t)BATCH * 3 * 4 * 128 * 2048 * 2;
constexpr size_t WS_AST = WS_OBG + (size_t)6 * MV * 512 * 2;
constexpr int GCH = BATCH * HA * (SEQ / 32);
constexpr size_t WS_WF = WS_AST + (size_t)6 * MV * 4 * 8;
constexpr size_t WS_KF = WS_WF + (size_t)GCH * 8192;
constexpr size_t WS_UF = WS_KF + (size_t)GCH * 8192;
constexpr size_t WS_AF = WS_UF + (size_t)GCH * 16384;
constexpr size_t WS_TB = WS_AF + (size_t)GCH * 2048;
constexpr size_t WS_QF = WS_TB + (size_t)GCH * 128;
constexpr size_t WS_XCH = WS_QF + (size_t)GCH * 8192;
constexpr size_t WS_PAD = WS_XCH + (size_t)4 * 32 * 256 * 8 * 16;
constexpr size_t WS_END = WS_PAD + (size_t)1024 * 16 * 512 * 4;
static_assert(WS_END < 2000000000ull, "workspace");

__device__ __forceinline__ int lane_id() { return (int)__builtin_amdgcn_mbcnt_hi(~0u, __builtin_amdgcn_mbcnt_lo(~0u, 0u)); }
namespace pg8 {
#define PG8_LAS __attribute__((address_space(3)))
typedef unsigned short bf16_t;
typedef unsigned u32x4 __attribute__((ext_vector_type(4)));
constexpr int BM = 256, BK = 64, HALF = 128, HTB = HALF * BK * 2, STAGE_BYTES = 8 * HTB, NXCD = 8, WGM = 8;
__host__ __device__ __forceinline__ int lds_byte(int r, int c) { const int st = (r >> 4) * 2 + (c >> 5), rr = r & 15, cc = c & 31, ob = rr * 64 + cc * 2; return st * 1024 + (ob ^ (((ob >> 9) & 1) << 5)); }
__host__ __device__ __forceinline__ void stage_rc(int b, int& R, int& C) { const int st = b / 1024, sb = b % 1024, swz = sb ^ (((sb >> 9) & 1) << 5); R = (st >> 1) * 16 + swz / 64; C = (st & 1) * 32 + (swz % 64) / 2; }
__host__ __device__ __forceinline__ int perm32(int rho) { const int n = rho >> 4, i = rho & 15; return 8 * (i >> 2) + 4 * n + (i & 3); }
struct Unit { int pm, pn; };
struct Gemm { const bf16_t* A; const bf16_t* Bt; int lda, ldb, K; int a_pn_step; unsigned* pad = nullptr; };
struct StaticOrder {
    int nM, nN, nwg, G, c;
    __host__ __device__ void init(int M, int N, int G_, int c_) { nM = M / BM; nN = N / BM; nwg = nM * nN; G = G_; c = c_; }
    __host__ __device__ bool next(int i, Unit& u) const {
        const long L = (long)i * G + c; if (L >= nwg) return false;
        int wgid = (int)L; { const int q = nwg / NXCD, r = nwg % NXCD, xcd = wgid % NXCD, off = wgid / NXCD; wgid = (xcd < r ? xcd * (q + 1) : r * (q + 1) + (xcd - r) * q) + off; }
        const int nig = WGM * nN, gid = wgid / nig, fm = gid * WGM, gsz = (nM - fm) < WGM ? (nM - fm) : WGM;
        u.pm = fm + ((wgid % nig) % gsz); u.pn = (wgid % nig) / gsz; return true;
    }
    __device__ __forceinline__ void a_ready(const Unit&) const {}
    __device__ __forceinline__ void done(const Unit&) const {}
};
__device__ __forceinline__ unsigned cvt_pk_bf16(float lo, float hi) { unsigned r; asm volatile("v_cvt_pk_bf16_f32 %0, %1, %2" : "=v"(r) : "v"(lo), "v"(hi)); return r; }

template <class Epi, class Sched, bool ALIGN_EPI = true, bool RELAX = false>
__device__ __forceinline__ void gemm_phase(PG8_LAS unsigned char* lds, const Gemm g, const Sched& S, const Epi& E) {
    int tid = threadIdx.x; asm volatile("" : "+v"(tid));
    const int wid = __builtin_amdgcn_readfirstlane(tid >> 6), lane = tid & 63, wr = wid >> 2, wc = wid & 3, fr = lane & 15, fq = lane >> 4;
    int K = g.K; asm volatile("" : "+s"(K));
    const int nt = K / BK;
    unsigned voffA[2], voffB[2];
#pragma unroll
    for (int i = 0; i < 2; ++i) { int R, C; stage_rc(tid * 16 + i * 8192, R, C); const int Rb = ((R & ~31) + perm32(R & 31));
        voffA[i] = (unsigned)(R * g.lda + C) * 2u; voffB[i] = (unsigned)(Rb * g.ldb + C) * 2u; }
    const size_t kstep = (size_t)(BK * 2);
    const size_t hstepA = (size_t)HALF * g.lda * 2, hstepB = (size_t)HALF * g.ldb * 2;
    const size_t tstepA = 2 * hstepA, tstepB = 2 * hstepB;
    const unsigned ldsw = (unsigned)wid * 1024u;
    const int aoff = lds_byte(wr * 64 + fr, fq * 8), boff = lds_byte(wc * 32 + fr, fq * 8);
#define PG8_SA(b, h) (((b) * 2 + (h)) * HTB)
#define PG8_SB(b, h) ((4 + (b) * 2 + (h)) * HTB)
#define PG8_STAGE(bufoff, gbase, voff) do { const char* _gb = (const char*)(gbase); asm volatile("" : "+s"(_gb));     \
        _Pragma("unroll") for (int _i = 0; _i < 2; ++_i) { unsigned _vo = (voff)[_i]; asm volatile("" : "+v"(_vo));     \
        __builtin_amdgcn_global_load_lds((const unsigned*)(_gb + _vo), (PG8_LAS unsigned*)(lds + (bufoff) + ldsw + _i * 8192), 16, 0, 0); } } while (0)
#define PG8_LDA(dst, b, h) do { _Pragma("unroll") for (int m = 0; m < 4; ++m) _Pragma("unroll") for (int k = 0; k < 2; ++k) dst[m][k] = *(const PG8_LAS bf16x8*)(lds + PG8_SA(b, h) + aoff + m * 2048 + k * 1024); } while (0)
#define PG8_LDB(dst, b, h) do { _Pragma("unroll") for (int n = 0; n < 2; ++n) _Pragma("unroll") for (int k = 0; k < 2; ++k) dst[n][k] = *(const PG8_LAS bf16x8*)(lds + PG8_SB(b, h) + boff + n * 2048 + k * 1024); } while (0)
#define PG8_MMA(ai, bj, At, Bt) do { __builtin_amdgcn_s_setprio(1); _Pragma("unroll") for (int m = 0; m < 4; ++m) _Pragma("unroll") for (int n = 0; n < 2; ++n) _Pragma("unroll") for (int k = 0; k < 2; ++k) \
        acc[ai][bj][m][n] = __builtin_amdgcn_mfma_f32_16x16x32_bf16(Bt[n][k], At[m][k], acc[ai][bj][m][n], 0, 0, 0); __builtin_amdgcn_s_setprio(0); } while (0)
#define PG8_WAIT_V(n) asm volatile("s_waitcnt vmcnt(" #n ")" ::: "memory")
#define PG8_WAIT_L(n) asm volatile("s_waitcnt lgkmcnt(" #n ")" ::: "memory")
#define PG8_BAR __builtin_amdgcn_s_barrier()
#define PG8_SCHED __builtin_amdgcn_sched_barrier(0)
    Unit cur, nxt; int ui = 0;
    if (!S.next(0, cur)) return;
    f32x4 acc[2][2][4][2];
#pragma unroll
    for (int a = 0; a < 2; ++a)
#pragma unroll
        for (int b = 0; b < 2; ++b)
#pragma unroll
            for (int m = 0; m < 4; ++m)
#pragma unroll
                for (int n = 0; n < 2; ++n) acc[a][b][m][n] = (f32x4){0.f, 0.f, 0.f, 0.f};
    bf16x8 At[4][2], B0[2][2], B1[2][2];
    const char* cA = (const char*)g.A + (size_t)cur.pm * tstepA + (size_t)cur.pn * (size_t)g.a_pn_step; const char* cB = (const char*)g.Bt + (size_t)cur.pn * tstepB;
    S.a_ready(cur);
    PG8_STAGE(PG8_SB(0, 0), cB, voffB); PG8_STAGE(PG8_SB(0, 1), cB + hstepB, voffB); PG8_STAGE(PG8_SA(0, 0), cA, voffA); PG8_STAGE(PG8_SA(0, 1), cA + hstepA, voffA);
    if (wr == 1) PG8_BAR;
    PG8_WAIT_V(2); PG8_BAR;
    PG8_STAGE(PG8_SB(1, 0), cB + kstep, voffB); PG8_STAGE(PG8_SA(1, 0), cA + kstep, voffA); PG8_STAGE(PG8_SB(1, 1), cB + hstepB + kstep, voffB);
    PG8_WAIT_V(6); PG8_BAR;
    if constexpr (RELAX && Epi::NSTORE > 0) {
#pragma unroll
        for (int i = 0; i < Epi::NSTORE; ++i) __builtin_nontemporal_store((unsigned)tid, (__attribute__((address_space(1))) unsigned*)g.pad + ((size_t)blockIdx.x * 16 + i) * 512 + tid);
    }
    for (;;) {
        const bool has_next = S.next(ui + 1, nxt);
        const char* nA = has_next ? (const char*)g.A + (size_t)nxt.pm * tstepA + (size_t)nxt.pn * (size_t)g.a_pn_step : cA; const char* nB = has_next ? (const char*)g.Bt + (size_t)nxt.pn * tstepB : cB;
#define PG8_TRIP(W1, W2) do { \
            const bool last = (t == nt - 2); \
            const char* a1 = cA + (size_t)(t + 1) * kstep; \
            const char* a2 = last ? nA : cA + (size_t)(t + 2) * kstep; const char* b2 = last ? nB : cB + (size_t)(t + 2) * kstep; \
            const char* a3 = a2 + kstep; const char* b3 = b2 + kstep; \
            if (last && has_next) S.a_ready(nxt); \
            PG8_LDB(B0, 0, 0); PG8_LDB(B1, 0, 1); PG8_SCHED; PG8_LDA(At, 0, 0); PG8_STAGE(PG8_SA(1, 1), a1 + hstepA, voffA); \
            W1; PG8_WAIT_L(0); PG8_BAR; PG8_MMA(0, 0, At, B0); PG8_MMA(0, 1, At, B1); PG8_BAR; PG8_SCHED; \
            PG8_LDA(At, 0, 1); PG8_STAGE(PG8_SB(0, 0), b2, voffB); PG8_STAGE(PG8_SB(0, 1), b2 + hstepB, voffB); PG8_STAGE(PG8_SA(0, 0), a2, voffA); \
            W2; PG8_WAIT_L(0); PG8_BAR; PG8_MMA(1, 0, At, B0); PG8_MMA(1, 1, At, B1); PG8_BAR; PG8_SCHED; \
            PG8_LDB(B0, 1, 0); PG8_LDB(B1, 1, 1); PG8_SCHED; PG8_LDA(At, 1, 0); PG8_STAGE(PG8_SA(0, 1), a2 + hstepA, voffA); \
            PG8_WAIT_V(8); PG8_WAIT_L(0); PG8_BAR; PG8_MMA(0, 0, At, B0); PG8_MMA(0, 1, At, B1); PG8_BAR; PG8_SCHED; \
            PG8_LDA(At, 1, 1); PG8_STAGE(PG8_SB(1, 0), b3, voffB); PG8_STAGE(PG8_SB(1, 1), b3 + hstepB, voffB); PG8_STAGE(PG8_SA(1, 0), a3, voffA); \
            PG8_WAIT_V(8); PG8_WAIT_L(0); PG8_BAR; PG8_MMA(1, 0, At, B0); PG8_MMA(1, 1, At, B1); PG8_BAR; PG8_SCHED; } while (0)
        int t = 0;
        if constexpr (RELAX && Epi::NSTORE == 16) { PG8_TRIP(PG8_WAIT_V(24), PG8_WAIT_V(24)); t = 2; }
        if constexpr (RELAX && Epi::NSTORE == 8) { PG8_TRIP(PG8_WAIT_V(16), PG8_WAIT_V(16)); t = 2; }
        for (; t < nt; t += 2) PG8_TRIP(PG8_WAIT_V(8), PG8_WAIT_V(8));
#undef PG8_TRIP
        if constexpr (ALIGN_EPI) { if (wr == 0) PG8_BAR; }
        if constexpr (!Epi::AFTER_DRAIN) { E(acc, cur, wr, wc, fr, fq); S.done(cur); }
        if (!has_next) break;
#pragma unroll
        for (int a = 0; a < 2; ++a)
#pragma unroll
            for (int b = 0; b < 2; ++b)
#pragma unroll
                for (int m = 0; m < 4; ++m)
#pragma unroll
                    for (int n = 0; n < 2; ++n) acc[a][b][m][n] = (f32x4){0.f, 0.f, 0.f, 0.f};
        cur = nxt; cA = nA; cB = nB; ++ui;
        if constexpr (ALIGN_EPI) { if (wr == 1) PG8_BAR; }
    }
    PG8_WAIT_V(0);
    if constexpr (!ALIGN_EPI) { if (wr == 0) PG8_BAR; }
    PG8_BAR;
    if constexpr (Epi::AFTER_DRAIN) { E.fused(acc, cur, wr, wc, fr, fq, lds, wid, lane); S.done(cur); }
#undef PG8_SA
#undef PG8_SB
#undef PG8_STAGE
#undef PG8_LDA
#undef PG8_LDB
#undef PG8_MMA
#undef PG8_WAIT_V
#undef PG8_WAIT_L
#undef PG8_BAR
#undef PG8_SCHED
}
}

#define LDS_WAIT() asm volatile("s_waitcnt lgkmcnt(0)" ::: "memory")
#define VM_WAIT() asm volatile("s_waitcnt vmcnt(0)" ::: "memory")
__device__ __forceinline__ unsigned f2bf(float f) { unsigned u = __builtin_bit_cast(unsigned, f); return (u + 0x7fffu + ((u >> 16) & 1u)) >> 16; }
typedef __bf16 bf16v2 __attribute__((ext_vector_type(2)));
__device__ __forceinline__ unsigned pk2(float lo, float hi) { const f32x2 v = {lo, hi}; return __builtin_bit_cast(unsigned, __builtin_convertvector(v, bf16v2)); }
__device__ __forceinline__ float bf_lo(unsigned u) { return __builtin_bit_cast(float, u << 16); }
__device__ __forceinline__ float bf_hi(unsigned u) { return __builtin_bit_cast(float, u & 0xffff0000u); }
__device__ __forceinline__ float bf1(bf16 b) { return __builtin_bit_cast(float, ((unsigned)b) << 16); }
__device__ __forceinline__ void unpack8(const v4u u, float (&x)[8]) { x[0] = bf_lo(u.x); x[1] = bf_hi(u.x); x[2] = bf_lo(u.y); x[3] = bf_hi(u.y); x[4] = bf_lo(u.z); x[5] = bf_hi(u.z); x[6] = bf_lo(u.w); x[7] = bf_hi(u.w); }
__device__ __forceinline__ v4u pack8(const float (&x)[8]) { v4u o; o.x = pk2(x[0], x[1]); o.y = pk2(x[2], x[3]); o.z = pk2(x[4], x[5]); o.w = pk2(x[6], x[7]); return o; }
__device__ __forceinline__ float wave_max(float v) {
#pragma unroll
    for (int o = 1; o < 64; o <<= 1) v = fmaxf(v, __shfl_xor(v, o));
    return v;
}
template <int CTRL> __device__ __forceinline__ float dpp_f(float x) { return __builtin_bit_cast(float, __builtin_amdgcn_update_dpp(0, __builtin_bit_cast(int, x), CTRL, 0xf, 0xf, true)); }
__device__ __forceinline__ float row16_sum(float x) { x += dpp_f<0xB1>(x); x += dpp_f<0x4E>(x); x += dpp_f<0x124>(x); x += dpp_f<0x128>(x); return x; }
__device__ __forceinline__ float wave_sum(float v) { v = row16_sum(v); v += __shfl_xor(v, 16); v += __shfl_xor(v, 32); return v; }
__device__ __forceinline__ float sigm(float x) { return __builtin_amdgcn_rcpf(1.f + __expf(-x)); }
__device__ __forceinline__ float silu(float x) { return x * __builtin_amdgcn_rcpf(1.f + __expf(-x)); }

#define XB_TMO      128
#define XB_XCNT(j)  (256  + 64 * (j))
#define XB_XSUB(j)  (1280 + 64 * (j))
#define XB_XGEN(j)  (2304 + 64 * (j))
#define XB_TOP      3328
#define XB_TOPGEN   3392
#define XCD_BAR_WORDS 3456
#define XB_SPIN_CAP (1u << 18)
__device__ __forceinline__ unsigned xb_ld(unsigned* p)              { return __hip_atomic_load(p, __ATOMIC_RELAXED, __HIP_MEMORY_SCOPE_AGENT); }
__device__ __forceinline__ unsigned xb_add(unsigned* p, unsigned v) { return __hip_atomic_fetch_add(p, v, __ATOMIC_RELAXED, __HIP_MEMORY_SCOPE_AGENT); }
__device__ __forceinline__ unsigned xb_xcc_id() { return (unsigned)__builtin_amdgcn_s_getreg((3 << 11) | 20) & 0xFu; }
#define XB_SPIN(cond, bar) do { unsigned _sp = 0; while (cond) { __builtin_amdgcn_s_sleep(1); \
    if ((++_sp & 255u) == 0u) { if (xb_ld(&(bar)[XB_TMO])) break; if (_sp > XB_SPIN_CAP) { atomicAdd(&(bar)[XB_TMO], 1u); break; } } } } while (0)
struct XcdBarrier { unsigned* bar; unsigned x; volatile LAS unsigned* st; };
__device__ __forceinline__ XcdBarrier xcd_barrier_post(unsigned* bar, volatile LAS unsigned* st) {
    XcdBarrier b; b.bar = bar; b.x = xb_xcc_id(); b.st = st;
    if (threadIdx.x == 0) (void)xb_add(&bar[XB_XCNT(b.x)], 1u);
    return b;
}
__device__ __forceinline__ void xcd_barrier_complete(unsigned* bar, unsigned x, unsigned& nloc, unsigned& nx) {
    const unsigned G = gridDim.x * gridDim.y * gridDim.z;
    unsigned sum, cnt, mine, sp = 0u;
    for (;;) {
        sum = 0u; cnt = 0u; mine = 0u;
#pragma unroll
        for (unsigned j = 0; j < 16; ++j) { const unsigned c = xb_ld(&bar[XB_XCNT(j)]); sum += c; cnt += (c > 0u) ? 1u : 0u; mine = (j == x) ? c : mine; }
        if (sum == G) break;
        __builtin_amdgcn_s_sleep(1);
        if ((++sp & 255u) == 0u) { if (xb_ld(&bar[XB_TMO])) break; if (sp > XB_SPIN_CAP) { atomicAdd(&bar[XB_TMO], 1u); break; } }
    }
    nloc = mine > 0u ? mine : 1u; nx = cnt > 0u ? cnt : 1u;
}
__device__ __forceinline__ void xcd_barrier(const XcdBarrier& b) {
    asm volatile("s_waitcnt vmcnt(0)" ::: "memory");
    __syncthreads();
    if (threadIdx.x == 0) {
        unsigned* bar = b.bar;
        __builtin_amdgcn_s_waitcnt(0);
        unsigned nloc = b.st[0], nx = b.st[1];
        if (nloc == 0u) { xcd_barrier_complete(bar, b.x, nloc, nx); b.st[0] = nloc; b.st[1] = nx; }
        const unsigned old = xb_add(&bar[XB_XSUB(b.x)], 1u);
        const unsigned gen = old / nloc;
        if (old + 1u == (gen + 1u) * nloc) {
            __builtin_amdgcn_fence(__ATOMIC_RELEASE, "agent");
            asm volatile("s_waitcnt vmcnt(0)" ::: "memory");
            const unsigned og = xb_add(&bar[XB_TOP], 1u);
            const unsigned tg = og / nx;
            if (og + 1u == (tg + 1u) * nx) xb_add(&bar[XB_TOPGEN], 1u);
            else XB_SPIN(xb_ld(&bar[XB_TOPGEN]) == tg, bar);
            __builtin_amdgcn_fence(__ATOMIC_ACQUIRE, "agent");
            xb_add(&bar[XB_XGEN(b.x)], 1u);
            asm volatile("s_waitcnt vmcnt(0)" ::: "memory");
        } else {
            XB_SPIN(xb_ld(&bar[XB_XGEN(b.x)]) == gen, bar);
            __builtin_amdgcn_fence(__ATOMIC_ACQUIRE, "agent");
            asm volatile("s_waitcnt vmcnt(0)" ::: "memory");
        }
    }
    __syncthreads();
}

constexpr int NWAVES = 8;
constexpr int RING_BYTES = 131072, SCANTV_BYTES = 0, LDSCTL_OFF = RING_BYTES + SCANTV_BYTES, MISC_OFF = LDSCTL_OFF + 320, LDS_BYTES = 147456;
constexpr int CW_BAR = 4096;
constexpr int CW_TMO = 0, CW_RMS = 16384, RMS_BANK = 2048;

struct Args { const float* in[25]; float* out; unsigned char* ws; int ph_lo, ph_hi; };
struct Frame {
    LAS unsigned char* lds;
    int tid, lane, wave, vcu, G;
    const CAS cfp_t* in; float* out; unsigned char* ws;
};

__device__ __forceinline__ int launder(int x) { asm volatile("" : "+v"(x)); return x; }
__device__ __forceinline__ int launder_s(int x) { asm volatile("" : "+s"(x)); return x; }
template <class T> __device__ __forceinline__ T* launder_p(T* p) { asm volatile("" : "+s"(p)); return p; }
__device__ __forceinline__ const CAS cfp_t* launder_k(const CAS cfp_t* p) { asm volatile("" : "+s"(p)); return p; }
template <class T> __device__ __forceinline__ T* launder_pg(T* p) { GAS T* q = (GAS T*)p; asm volatile("" : "+s"(q)); return (T*)q; }
#define RELANE_G(F0) RELANE(F0); F.ws = launder_pg(F.ws); F.out = launder_pg(F.out)
#define RELANE(F0) Frame F = F0; F.lane = launder(F0.lane); F.tid = launder(F0.tid)

struct EpiStore {
    static constexpr bool AFTER_DRAIN = false; static constexpr int NSTORE = 16;
    bf16* O; int ldc; int sig_pn;
    __device__ __forceinline__ void operator()(const f32x4 (&acc)[2][2][4][2], const pg8::Unit& u, int wr, int wc, int fr, int fq) const {
        { const int l_ = launder(lane_id()); fr = l_ & 15; fq = l_ >> 4; }
        const int row0 = u.pm * 256 + wr * 64 + fr, col0 = u.pn * 256 + wc * 32 + 8 * fq; const bool sg = u.pn >= sig_pn;
#pragma unroll
        for (int ai = 0; ai < 2; ++ai)
#pragma unroll
            for (int m = 0; m < 4; ++m) { bf16* rowp = O + (size_t)(row0 + ai * 128 + m * 16) * ldc + col0;
#pragma unroll
                for (int bj = 0; bj < 2; ++bj) { f32x4 v0 = acc[ai][bj][m][0], v1 = acc[ai][bj][m][1];
                    if (sg) {
#pragma unroll
                        for (int j = 0; j < 4; ++j) { v0[j] = sigm(v0[j]); v1[j] = sigm(v1[j]); } }
                    v4u w; w.x = pg8::cvt_pk_bf16(v0[0], v0[1]); w.y = pg8::cvt_pk_bf16(v0[2], v0[3]); w.z = pg8::cvt_pk_bf16(v1[0], v1[1]); w.w = pg8::cvt_pk_bf16(v1[2], v1[3]);
                    *(v4u*)(rowp + bj * 128) = w; } }
    }
};
template <bool ACCUM> struct EpiMerge {
    static constexpr bool AFTER_DRAIN = false; static constexpr int NSTORE = 0;
    bf16* O; const bf16* gate;
    __device__ __forceinline__ void operator()(const f32x4 (&acc)[2][2][4][2], const pg8::Unit& u, int wr, int wc, int fr, int fq) const {
        { const int l_ = launder(lane_id()); fr = l_ & 15; fq = l_ >> 4; }
        const int row0 = u.pm * 256 + wr * 64 + fr, col0 = u.pn * 256 + wc * 32 + 8 * fq;
#pragma unroll
        for (int ai = 0; ai < 2; ++ai)
#pragma unroll
            for (int m = 0; m < 4; ++m) { const int row = row0 + ai * 128 + m * 16; bf16* rowp = O + (size_t)row * D + col0; const bf16* gp = gate + (size_t)row * NIN + col0;
#pragma unroll
                for (int bj = 0; bj < 2; ++bj) {
                    float gv[8]; unpack8(*(const v4u*)(gp + bj * 128), gv);
                    float o[8];
#pragma unroll
                    for (int j = 0; j < 4; ++j) { o[j] = acc[ai][bj][m][0][j] * gv[j]; o[4 + j] = acc[ai][bj][m][1][j] * gv[4 + j]; }
                    if (ACCUM) { float p[8]; unpack8(*(const v4u*)(rowp + bj * 128), p);
#pragma unroll
                        for (int j = 0; j < 8; ++j) o[j] += p[j]; }
                    v4u w; w.x = pg8::cvt_pk_bf16(o[0], o[1]); w.y = pg8::cvt_pk_bf16(o[2], o[3]); w.z = pg8::cvt_pk_bf16(o[4], o[5]); w.w = pg8::cvt_pk_bf16(o[6], o[7]);
                    *(v4u*)(rowp + bj * 128) = w; }
                asm volatile("" ::: "memory"); }
    }
};

struct EpiRmsRes {
    static constexpr bool AFTER_DRAIN = true; static constexpr int NSTORE = 0;
    unsigned char* ws; const CAS cfp_t* in; float* outp; int l, which;
    __device__ __forceinline__ void fused(const f32x4 (&acc)[2][2][4][2], const pg8::Unit& u, int wr, int wc, int fr, int fq, LAS unsigned char* lds, int wid, int lane) const {
        { const int l_ = launder(lane_id()); fr = l_ & 15; fq = l_ >> 4; }
        const bool lastl = which == 1 && l + 1 == DEPTH;
        bf16* const XB = (bf16*)(ws + WS_X1); bf16* const H = lastl ? nullptr : (bf16*)(ws + WS_H); float* const fout = lastl ? outp + O_YP : nullptr;
        const float* const gpost = (which ? in[24] : in[22]) + (size_t)l * D; const float* const gpre = lastl ? nullptr : (which ? in[21] + (size_t)(l + 1) * D : in[23] + (size_t)l * D);
        float* const slots = (float*)(ws + WS_XCH) + (size_t)(l * 2 + which) * 32 * 256 * 8 * 4;
        unsigned* const cnt = (unsigned*)(ws + WS_CTL) + CW_RMS + (l * 2 + which) * RMS_BANK; unsigned* const tmo = (unsigned*)(ws + WS_CTL) + CW_TMO;
        LAS f32x4* P = (LAS f32x4*)lds;
        LAS f32x2* SR = (LAS f32x2*)(lds + 16384);
        const int lr0 = wr * 64 + fr, col0 = u.pn * 256 + wc * 32 + 8 * fq;
        f32x4 gp[2][2];
#pragma unroll
        for (int bj = 0; bj < 2; ++bj) { gp[bj][0] = *(const f32x4*)(gpost + col0 + bj * 128); gp[bj][1] = *(const f32x4*)(gpost + col0 + bj * 128 + 4); }
#pragma unroll
        for (int ai = 0; ai < 2; ++ai)
#pragma unroll
            for (int m = 0; m < 4; ++m) {
                const int lr = lr0 + ai * 128 + m * 16; const bf16* xp = XB + (size_t)(u.pm * 256 + lr) * D + col0;
                float syy = 0.f, sxx = 0.f, sxy = 0.f, sgg = 0.f;
#pragma unroll
                for (int bj = 0; bj < 2; ++bj) { float xv[8]; unpack8(*(const v4u*)(xp + bj * 128), xv);
#pragma unroll
                    for (int n = 0; n < 2; ++n)
#pragma unroll
                        for (int j = 0; j < 4; ++j) { const float y = acc[ai][bj][m][n][j], yg = y * gp[bj][n][j], x = xv[4 * n + j]; syy += y * y; sxx += x * x; sxy += x * yg; sgg += yg * yg; } }
                syy += __shfl_xor(syy, 16); sxx += __shfl_xor(sxx, 16); sxy += __shfl_xor(sxy, 16); sgg += __shfl_xor(sgg, 16);
                syy += __shfl_xor(syy, 32); sxx += __shfl_xor(sxx, 32); sxy += __shfl_xor(sxy, 32); sgg += __shfl_xor(sgg, 32);
                if (fq == 0) P[lr * 4 + wc] = (f32x4){syy, sxx, sxy, sgg};
            }
        asm volatile("s_waitcnt lgkmcnt(0)" ::: "memory"); __builtin_amdgcn_s_barrier(); asm volatile("" ::: "memory");
        const int row = wid * 32 + (lane & 31);
        unsigned long long* slot = (unsigned long long*)slots + ((size_t)(u.pm * 256 + row) * 8 + u.pn) * 2;
        if (lane < 32) { const f32x4 a = P[row * 4 + 0], b = P[row * 4 + 1], c = P[row * 4 + 2], d = P[row * 4 + 3]; const f32x4 t = (a + b) + (c + d);
            __hip_atomic_store(slot, ((unsigned long long)__builtin_bit_cast(unsigned, t.y) << 32) | __builtin_bit_cast(unsigned, t.x), __ATOMIC_RELAXED, __HIP_MEMORY_SCOPE_AGENT);
            __hip_atomic_store(slot + 1, ((unsigned long long)__builtin_bit_cast(unsigned, t.w) << 32) | __builtin_bit_cast(unsigned, t.z), __ATOMIC_RELAXED, __HIP_MEMORY_SCOPE_AGENT); }
        asm volatile("s_waitcnt vmcnt(0)" ::: "memory");
        if (lane == 0) __hip_atomic_fetch_add(cnt + 64 * u.pm, 1u, __ATOMIC_RELAXED, __HIP_MEMORY_SCOPE_AGENT);
        if (wid == 0) {
            const unsigned long long t0 = __builtin_amdgcn_s_memrealtime();
            while ((unsigned)__builtin_amdgcn_readfirstlane((int)__hip_atomic_load(cnt + 64 * u.pm, __ATOMIC_RELAXED, __HIP_MEMORY_SCOPE_AGENT)) < 64u) {
                if (__builtin_amdgcn_s_memrealtime() - t0 > 2000000ull) { if (lane == 0) __hip_atomic_store(tmo, 1u, __ATOMIC_RELAXED, __HIP_MEMORY_SCOPE_AGENT); break; }
                __builtin_amdgcn_s_sleep(2); }
            __builtin_amdgcn_fence(__ATOMIC_ACQUIRE, "agent");
        }
        asm volatile("s_waitcnt vmcnt(0) lgkmcnt(0)" ::: "memory"); __builtin_amdgcn_s_barrier(); asm volatile("" ::: "memory");
        if (lane < 32) { const unsigned long long* sl = (const unsigned long long*)slots + (size_t)(u.pm * 256 + row) * 16; float syy = 0.f, sxx = 0.f, sxy = 0.f, sgg = 0.f;
#pragma unroll
            for (int t = 0; t < 8; ++t) { const unsigned long long w0 = __hip_atomic_load(sl + 2 * t, __ATOMIC_RELAXED, __HIP_MEMORY_SCOPE_AGENT), w1 = __hip_atomic_load(sl + 2 * t + 1, __ATOMIC_RELAXED, __HIP_MEMORY_SCOPE_AGENT);
                syy += __builtin_bit_cast(float, (unsigned)w0); sxx += __builtin_bit_cast(float, (unsigned)(w0 >> 32)); sxy += __builtin_bit_cast(float, (unsigned)w1); sgg += __builtin_bit_cast(float, (unsigned)(w1 >> 32)); }
            const float ry = rsqrtf(syy * (1.f / D) + EPS), s1 = sxx + 2.f * ry * sxy + ry * ry * sgg;
            SR[row] = (f32x2){ry, rsqrtf(fmaxf(s1, 0.f) * (1.f / D) + EPS)}; }
        asm volatile("s_waitcnt lgkmcnt(0)" ::: "memory"); __builtin_amdgcn_s_barrier(); asm volatile("" ::: "memory");
        f32x4 gq[2][2];
#pragma unroll
        for (int bj = 0; bj < 2; ++bj) { gq[bj][0] = gpre ? *(const f32x4*)(gpre + col0 + bj * 128) : (f32x4){0.f, 0.f, 0.f, 0.f}; gq[bj][1] = gpre ? *(const f32x4*)(gpre + col0 + bj * 128 + 4) : (f32x4){0.f, 0.f, 0.f, 0.f}; }
#pragma unroll
        for (int ai = 0; ai < 2; ++ai)
#pragma unroll
            for (int m = 0; m < 4; ++m) {
                const int lr = lr0 + ai * 128 + m * 16; const size_t off = (size_t)(u.pm * 256 + lr) * D + col0; const f32x2 sr = SR[lr];
#pragma unroll
                for (int bj = 0; bj < 2; ++bj) { float xv[8], x1[8]; unpack8(*(const v4u*)(XB + off + bj * 128), xv);
#pragma unroll
                    for (int n = 0; n < 2; ++n)
#pragma unroll
                        for (int j = 0; j < 4; ++j) x1[4 * n + j] = xv[4 * n + j] + acc[ai][bj][m][n][j] * sr.x * gp[bj][n][j];
                    if (fout) { *(f32x4*)(fout + off + bj * 128) = (f32x4){x1[0], x1[1], x1[2], x1[3]}; *(f32x4*)(fout + off + bj * 128 + 4) = (f32x4){x1[4], x1[5], x1[6], x1[7]}; }
                    else { *(v4u*)(XB + off + bj * 128) = pack8(x1);
                        if (H) { float hv[8];
#pragma unroll
                            for (int n = 0; n < 2; ++n)
#pragma unroll
                                for (int j = 0; j < 4; ++j) hv[4 * n + j] = x1[4 * n + j] * sr.y * gq[bj][n][j];
                            *(v4u*)(H + off + bj * 128) = pack8(hv); } } }
                asm volatile("" ::: "memory"); }
    }
};
struct EpiSwiglu {
    static constexpr bool AFTER_DRAIN = false; static constexpr int NSTORE = 8;
    bf16* O;
    __device__ __forceinline__ void operator()(const f32x4 (&acc)[2][2][4][2], const pg8::Unit& u, int wr, int wc, int fr, int fq) const {
        { const int l_ = launder(lane_id()); fr = l_ & 15; fq = l_ >> 4; }
        const int row0 = u.pm * 256 + wr * 64 + fr, col0 = u.pn * 128 + wc * 32 + 8 * fq;
#pragma unroll
        for (int ai = 0; ai < 2; ++ai)
#pragma unroll
            for (int m = 0; m < 4; ++m) { bf16* rowp = O + (size_t)(row0 + ai * 128 + m * 16) * DFF + col0;
                float o[8];
#pragma unroll
                for (int j = 0; j < 4; ++j) { o[j] = silu(acc[ai][0][m][0][j]) * acc[ai][1][m][0][j]; o[4 + j] = silu(acc[ai][0][m][1][j]) * acc[ai][1][m][1][j]; }
                v4u w; w.x = pg8::cvt_pk_bf16(o[0], o[1]); w.y = pg8::cvt_pk_bf16(o[2], o[3]); w.z = pg8::cvt_pk_bf16(o[4], o[5]); w.w = pg8::cvt_pk_bf16(o[6], o[7]);
                *(v4u*)rowp = w; }
    }
};

__device__ __forceinline__ void transpose_item(const float* W, int ldw, int src_col0, int k0, bf16* WT, int ldt, int dst_row0, LAS float* scr, int lane, const float* rscale = nullptr) {
#pragma unroll 8
    for (int i = 0; i < 32; ++i) { const int kk = 2 * i + (lane >> 5); scr[kk * 33 + (lane & 31)] = W[(size_t)(k0 + kk) * ldw + src_col0 + (lane & 31)]; }
    LDS_WAIT(); asm volatile("" ::: "memory");
    const int c = lane & 7;
#pragma unroll
    for (int j = 0; j < 4; ++j) { const int n = (lane >> 3) + 8 * j; const LAS float* s = scr + (8 * c) * 33 + n; const float m = rscale ? rscale[n] : 1.f;
        v4u o; o.x = pk2(s[0 * 33] * m, s[1 * 33] * m); o.y = pk2(s[2 * 33] * m, s[3 * 33] * m); o.z = pk2(s[4 * 33] * m, s[5 * 33] * m); o.w = pk2(s[6 * 33] * m, s[7 * 33] * m);
        *(v4u*)(WT + (size_t)(dst_row0 + n) * ldt + k0 + 8 * c) = o; }
    LDS_WAIT(); asm volatile("" ::: "memory");
}
constexpr int IT_IN = 32 * 496, IT_BRA = 16 * 64, IT_BRB = 8 * 64, IT_BRC = 16 * 64, IT_POOL = 4 * 4 * 8, IT_OUT = 32 * 64, IT_GU = 32 * 352, IT_DOWN = 88 * 64;
constexpr int IT_LAYER = IT_IN + IT_BRA + IT_BRB + IT_BRC + IT_POOL + IT_OUT + IT_GU + IT_DOWN;
__device__ __forceinline__ void weight_item(Frame& F0, int l, int r, LAS float* scr) {
    RELANE(F0);
    unsigned char* wl = F.ws + WS_W + (size_t)l * WL_BYTES; const int lane = F.lane;
    if (r < IT_IN) { const int kb = r / 496, nb = r % 496, n0 = nb * 32; transpose_item(F.in[8] + (size_t)l * D * NIN_SRC, NIN_SRC, n0 + (n0 >= 4096 ? 16 : 0), kb * 64, (bf16*)(wl + WO_IN), D, n0, scr, lane); return; } r -= IT_IN;
    if (r < IT_BRA) { const int kb = r / 64, nb = r % 64; transpose_item(F.in[15] + (size_t)l * 1024 * D, D, nb * 32, kb * 64, (bf16*)(wl + WO_BRA), 1024, nb * 32, scr, lane); return; } r -= IT_BRA;
    if (r < IT_BRB) { const int kb = r / 64, nb = r % 64; transpose_item(F.in[16] + (size_t)l * 512 * D, D, nb * 32, kb * 64, (bf16*)(wl + WO_BRB), 512, nb * 32, scr, lane); return; } r -= IT_BRB;
    if (r < IT_BRC) { const int kb = r / 64, nb = r % 64; transpose_item(F.in[17] + (size_t)l * 1024 * D, D, nb * 32, kb * 64, (bf16*)(wl + WO_BRC), 1024, nb * 32, scr, lane); return; } r -= IT_BRC;
    if (r < IT_POOL) { const int g = r / 32, kb = (r % 32) / 8, nb = r % 8; transpose_item(F.in[13] + (size_t)(l * 4 + g) * 65536, 256, nb * 32, kb * 64, (bf16*)(wl + WO_POOL) + (size_t)g * 65536, 256, nb * 32, scr, lane, F.in[14] + (size_t)l * CPOOL + g * 256 + nb * 32); return; } r -= IT_POOL;
    if (r < IT_OUT) { const int kb = r / 64, nb = r % 64; transpose_item(F.in[18] + (size_t)l * D * D, D, nb * 32, kb * 64, (bf16*)(wl + WO_OUT), D, nb * 32, scr, lane); return; } r -= IT_OUT;
    if (r < IT_GU) { const int kb = r / 352, nb = r % 352, n0 = nb * 32, pn = n0 >> 8, bj = (n0 >> 7) & 1, rr = n0 & 127;
        transpose_item(F.in[19] + (size_t)l * D * 2 * DFF, 2 * DFF, bj * DFF + 128 * pn + rr, kb * 64, (bf16*)(wl + WO_GU), D, n0, scr, lane); return; } r -= IT_GU;
    { const int kb = r / 64, nb = r % 64; transpose_item(F.in[20] + (size_t)l * DFF * D, D, nb * 32, kb * 64, (bf16*)(wl + WO_DOWN), DFF, nb * 32, scr, lane); }
}

__device__ __forceinline__ void stage_wba(Frame& F0, int l) {
    RELANE(F0);
    LAS float* Wl = (LAS float*)F.lds; const float* w = F.in[8] + (size_t)l * D * NIN_SRC + 4096;
    for (int k = F.tid; k < D; k += NWAVES * 64) { const float* p = w + (size_t)k * NIN_SRC;
        const f32x4 a = *(const f32x4*)p, b = *(const f32x4*)(p + 4), c = *(const f32x4*)(p + 8), d = *(const f32x4*)(p + 12);
        Wl[0 * D + k] = a.x; Wl[1 * D + k] = a.y; Wl[2 * D + k] = a.z; Wl[3 * D + k] = a.w; Wl[4 * D + k] = b.x; Wl[5 * D + k] = b.y; Wl[6 * D + k] = b.z; Wl[7 * D + k] = b.w;
        Wl[8 * D + k] = c.x; Wl[9 * D + k] = c.y; Wl[10 * D + k] = c.z; Wl[11 * D + k] = c.w; Wl[12 * D + k] = d.x; Wl[13 * D + k] = d.y; Wl[14 * D + k] = d.z; Wl[15 * D + k] = d.w; }
    __syncthreads();
}
template <bool X32>
__device__ __forceinline__ void thin_rows(Frame& F0, const float* xa, const float* xb, const bf16* Y, const float* gpost, float* fout, const float* gpre, bool do_ba, int l_ba, int r_lo = 0) {
    RELANE(F0);
    const int lane = F.lane, gw = F.vcu * NWAVES + F.wave, NGW = F.G * NWAVES;
    bf16* H = (bf16*)(F.ws + WS_H); bf16* XB = (bf16*)(F.ws + WS_X1); float* GB = (float*)(F.ws + WS_GB);
    const LAS float* Wl = (const LAS float*)F.lds;
    f32x4 vn[8]; v2u xn[8], yn[8];
#define THIN_LOAD(rr) do { const int r_ = (rr); \
        if (X32) { const float* xr_ = (r_ < MP) ? xa + (size_t)r_ * D : xb + (size_t)(r_ - MP) * D; _Pragma("unroll") for (int j = 0; j < 8; ++j) vn[j] = *(const f32x4*)(xr_ + 4 * lane + 256 * j); } \
        else { _Pragma("unroll") for (int j = 0; j < 8; ++j) xn[j] = *(const v2u*)(XB + (size_t)r_ * D + 4 * lane + 256 * j); } \
        if (Y) { _Pragma("unroll") for (int j = 0; j < 8; ++j) yn[j] = *(const v2u*)(Y + (size_t)r_ * D + 4 * lane + 256 * j); } } while (0)
#pragma unroll
    for (int j = 0; j < 8; ++j) { yn[j] = (v2u){0u, 0u}; xn[j] = (v2u){0u, 0u}; vn[j] = (f32x4){0.f, 0.f, 0.f, 0.f}; }
    if (r_lo + gw < MV) THIN_LOAD(r_lo + gw);
    for (int r = r_lo + gw; r < MV; r += NGW) {
        f32x4 v[8]; v2u yu[8];
#pragma unroll
        for (int j = 0; j < 8; ++j) { v[j] = X32 ? vn[j] : (f32x4){bf_lo(xn[j].x), bf_hi(xn[j].x), bf_lo(xn[j].y), bf_hi(xn[j].y)}; yu[j] = yn[j]; }
        if (r + NGW < MV) THIN_LOAD(r + NGW);
        if (Y) {
            f32x4 y[8]; float ss = 0.f;
#pragma unroll
            for (int j = 0; j < 8; ++j) { const v2u u = yu[j]; y[j] = (f32x4){bf_lo(u.x), bf_hi(u.x), bf_lo(u.y), bf_hi(u.y)}; ss += (y[j].x * y[j].x + y[j].y * y[j].y) + (y[j].z * y[j].z + y[j].w * y[j].w); }
            const float rstd = rsqrtf(wave_sum(ss) * (1.f / D) + EPS);
#pragma unroll
            for (int j = 0; j < 8; ++j) { const f32x4 g = *(const f32x4*)(gpost + 4 * lane + 256 * j); v[j] = v[j] + y[j] * rstd * g; }
        }
        if (fout) {
#pragma unroll
            for (int j = 0; j < 8; ++j) *(f32x4*)(fout + (size_t)r * D + 4 * lane + 256 * j) = v[j];
        } else {
#pragma unroll
            for (int j = 0; j < 8; ++j) { v2u o; o.x = pk2(v[j].x, v[j].y); o.y = pk2(v[j].z, v[j].w); *(v2u*)(XB + (size_t)r * D + 4 * lane + 256 * j) = o; }
        }
        if (gpre) {
            float ss = 0.f;
#pragma unroll
            for (int j = 0; j < 8; ++j) ss += (v[j].x * v[j].x + v[j].y * v[j].y) + (v[j].z * v[j].z + v[j].w * v[j].w);
            const float rstd = rsqrtf(wave_sum(ss) * (1.f / D) + EPS);
#pragma unroll
            for (int j = 0; j < 8; ++j) { const f32x4 g = *(const f32x4*)(gpre + 4 * lane + 256 * j); v[j] = v[j] * rstd * g;
                v2u o; o.x = pk2(v[j].x, v[j].y); o.y = pk2(v[j].z, v[j].w); *(v2u*)(H + (size_t)r * D + 4 * lane + 256 * j) = o; }
            if (do_ba) {
                float pc[16], mine = 0.f;
#pragma unroll
                for (int c = 0; c < 16; ++c) { float p = 0.f;
#pragma unroll
                    for (int j = 0; j < 8; ++j) { const f32x4 w = *(const LAS f32x4*)(Wl + c * D + 256 * j + 4 * lane); p += (v[j].x * w.x + v[j].y * w.y) + (v[j].z * w.z + v[j].w * w.w); }
                    pc[c] = row16_sum(p); }
#pragma unroll
                for (int c = 0; c < 16; ++c) pc[c] += __shfl_xor(pc[c], 16);
#pragma unroll
                for (int c = 0; c < 16; ++c) { pc[c] += __shfl_xor(pc[c], 32); mine = (lane == c) ? pc[c] : mine; }
                if (lane < 16) { float o;
                    if (lane < 8) o = sigm(mine);
                    else { const float al = F.in[10][l_ba * HA + lane - 8], dtb = F.in[11][l_ba * HA + lane - 8]; const float z = mine + dtb; const float sp = fmaxf(z, 0.f) + __logf(1.f + __expf(-fabsf(z))); o = -__expf(al) * sp; }
                    GB[(size_t)r * 16 + lane] = o; }
            }
        }
    }
}
#undef THIN_LOAD
__device__ __forceinline__ void ba_rows(Frame& F0, int l_ba) {
    RELANE(F0);
    const int lane = F.lane, gw = F.vcu * NWAVES + F.wave, NGW = F.G * NWAVES;
    const bf16* H = (const bf16*)(F.ws + WS_H); float* GB = (float*)(F.ws + WS_GB); const LAS float* Wl = (const LAS float*)F.lds;
    for (int r = gw; r < MP; r += NGW) {
        f32x4 v[8];
#pragma unroll
        for (int j = 0; j < 8; ++j) { const v2u u = *(const v2u*)(H + (size_t)r * D + 4 * lane + 256 * j); v[j] = (f32x4){bf_lo(u.x), bf_hi(u.x), bf_lo(u.y), bf_hi(u.y)}; }
        float mine = 0.f;
#pragma unroll 1
        for (int c = 0; c < 16; ++c) { float p = 0.f;
#pragma unroll
            for (int j = 0; j < 8; ++j) { const f32x4 w = *(const LAS f32x4*)(Wl + c * D + 256 * j + 4 * lane); p += (v[j].x * w.x + v[j].y * w.y) + (v[j].z * w.z + v[j].w * w.w); }
            p = wave_sum(p); if (lane == c) mine = p; }
        if (lane < 16) { float o;
            if (lane < 8) o = sigm(mine);
            else { const float al = F.in[10][l_ba * HA + lane - 8], dtb = F.in[11][l_ba * HA + lane - 8]; const float z = mine + dtb; const float sp = fmaxf(z, 0.f) + __logf(1.f + __expf(-fabsf(z))); o = -__expf(al) * sp; }
            GB[(size_t)r * 16 + lane] = o; }
    }
}

__device__ __forceinline__ void ld8f(const float* p, float (&x)[8]) { const f32x4 a = *(const f32x4*)p, b = *(const f32x4*)(p + 4); x[0] = a.x; x[1] = a.y; x[2] = a.z; x[3] = a.w; x[4] = b.x; x[5] = b.y; x[6] = b.z; x[7] = b.w; }
template <bool QK> __device__ __forceinline__ void conv_item(Frame& F0, int l, int row0, int T, int hmode, int sb, int j) {
    RELANE_G(F0);
    const int lane = F.lane;
    const bf16* PROJ = (const bf16*)(F.ws + WS_PROJ); const float* convw = F.in[9] + (size_t)l * 4 * CONVCH;
    const int c0 = QK ? 512 * j + 8 * lane : 2048 + 512 * j + 8 * lane, c1 = 1024 + 512 * j + 8 * lane;
    float w0[4][8], w1[4][8], x0[4][8], x1[4][8];
#pragma unroll
    for (int tap = 0; tap < 4; ++tap) { ld8f(convw + tap * CONVCH + c0, w0[tap]); if (QK) ld8f(convw + tap * CONVCH + c1, w1[tap]); }
#pragma unroll
    for (int i = 0; i < 3; ++i) {
        if (hmode == 1) { unpack8(*(const v4u*)(PROJ + (size_t)(row0 - 3 + i) * NIN + c0), x0[i + 1]); if (QK) unpack8(*(const v4u*)(PROJ + (size_t)(row0 - 3 + i) * NIN + c1), x1[i + 1]); }
        else if (hmode == 2) { const float* hp = F.in[6] + ((size_t)(l * DB + sb) * 3 + i) * CONVCH; ld8f(hp + c0, x0[i + 1]); if (QK) ld8f(hp + c1, x1[i + 1]); }
        else {
#pragma unroll
            for (int e = 0; e < 8; ++e) { x0[i + 1][e] = 0.f; x1[i + 1][e] = 0.f; } }
    }
    bf16* O0 = (bf16*)(F.ws + (QK ? WS_QN : WS_VV)) + 512 * j + 8 * lane; bf16* O1 = (bf16*)(F.ws + WS_KN) + 512 * j + 8 * lane;
    const float* GB = (const float*)(F.ws + WS_GB); f32x4* TOK = (f32x4*)(F.ws + WS_TOK); const int hd = 4 * j + (lane >> 4);
    v4u n0[4], n1[4]; float ng[4], nb[4];
#pragma unroll
    for (int u = 0; u < 4; ++u) { n0[u] = *(const v4u*)(PROJ + (size_t)(row0 + u) * NIN + c0); n1[u] = n0[u]; ng[u] = 0.f; nb[u] = 0.f; if (QK) { n1[u] = *(const v4u*)(PROJ + (size_t)(row0 + u) * NIN + c1); ng[u] = GB[(size_t)(row0 + u) * 16 + 8 + hd]; nb[u] = GB[(size_t)(row0 + u) * 16 + hd]; } }
    for (int tb = 0; tb < T; tb += 4) {
        v4u m0[4], m1[4]; float mg[4], mb[4];
#pragma unroll
        for (int u = 0; u < 4; ++u) { m0[u] = n0[u]; m1[u] = n1[u]; mg[u] = ng[u]; mb[u] = nb[u]; }
        if (tb + 4 < T) {
#pragma unroll
            for (int u = 0; u < 4; ++u) { n0[u] = *(const v4u*)(PROJ + (size_t)(row0 + tb + 4 + u) * NIN + c0); if (QK) { n1[u] = *(const v4u*)(PROJ + (size_t)(row0 + tb + 4 + u) * NIN + c1); ng[u] = GB[(size_t)(row0 + tb + 4 + u) * 16 + 8 + hd]; nb[u] = GB[(size_t)(row0 + tb + 4 + u) * 16 + hd]; } } }
#pragma unroll
        for (int u = 0; u < 4; ++u) {
            const int t = tb + u; const size_t r = (size_t)(row0 + t);
            unpack8(m0[u], x0[u]); if (QK) unpack8(m1[u], x1[u]);
            float a0[8], a1[8]; float s0 = 0.f, s1 = 0.f;
#pragma unroll
            for (int e = 0; e < 8; ++e) {
                a0[e] = silu(w0[3][e] * x0[u][e] + w0[2][e] * x0[(u + 3) & 3][e] + w0[1][e] * x0[(u + 2) & 3][e] + w0[0][e] * x0[(u + 1) & 3][e]); s0 += a0[e] * a0[e];
                if (QK) { a1[e] = silu(w1[3][e] * x1[u][e] + w1[2][e] * x1[(u + 3) & 3][e] + w1[1][e] * x1[(u + 2) & 3][e] + w1[0][e] * x1[(u + 1) & 3][e]); s1 += a1[e] * a1[e]; } }
            if (QK) {
                const float q_sc = rsqrtf(row16_sum(s0) + 1e-6f) * 0.08838834764831845f, k_sc = rsqrtf(row16_sum(s1) + 1e-6f); float p = 0.f;
#pragma unroll
                for (int e = 0; e < 8; ++e) { a0[e] *= q_sc; a1[e] *= k_sc; p += a0[e] * a1[e]; }
                p = row16_sum(p);
                *(v4u*)(O1 + r * 1024) = pack8(a1);
                if ((lane & 15) == 0) TOK[r * 8 + hd] = (f32x4){__expf(mg[u]), mb[u], p, mg[u]};
            }
            *(v4u*)(O0 + r * 1024) = pack8(a0);
        }
    }
}
__device__ __forceinline__ void pool_item(Frame& F0, int l, int row0, int T, int pos0, int hmode, int sb, int j) {
    RELANE_G(F0);
    const int lane = F.lane, win = 2 << (2 * j + (lane >> 5)), cc = 512 * j + 8 * lane;
    const bf16* U = (const bf16*)(F.ws + WS_PROJ) + PC_UC + cc; const float* hist = F.in[7] + (size_t)(l * DB + sb) * PHIST * CPOOL + cc;
    bf16* PO = (bf16*)(F.ws + WS_POOLED) + cc;
    float S[8];
#pragma unroll
    for (int e = 0; e < 8; ++e) S[e] = 0.f;
    if (hmode == 2) {
        for (int i = 1; i < 16; ++i) if (i < win) { float x[8]; ld8f(hist + (size_t)(PHIST - i) * CPOOL, x);
#pragma unroll
            for (int e = 0; e < 8; ++e) S[e] += x[e]; }
        for (int t = 0; t < T; ++t) {
            float xn[8], xo[8]; unpack8(*(const v4u*)(U + (size_t)(row0 + t) * NIN), xn);
            const int to = t - win + 1;
            if (to >= 0) unpack8(*(const v4u*)(U + (size_t)(row0 + to) * NIN), xo); else ld8f(hist + (size_t)(PHIST + to) * CPOOL, xo);
            const float inv = 1.f / (float)win; float o[8];
#pragma unroll
            for (int e = 0; e < 8; ++e) { S[e] += xn[e]; o[e] = S[e] * inv - xn[e]; S[e] -= xo[e]; }
            *(v4u*)(PO + (size_t)(row0 + t) * 1024) = pack8(o);
        }
        return;
    }
    {
        v4u h[15];
#pragma unroll
        for (int i = 1; i < 16; ++i) { const int back = (pos0 - i >= 0) ? i : pos0; h[i - 1] = *(const v4u*)(U + (size_t)(row0 - back) * NIN); }
#pragma unroll
        for (int i = 1; i < 16; ++i) { float x[8]; unpack8(h[i - 1], x); const float wgt = (i < win && pos0 - i >= 0) ? 1.f : 0.f;
#pragma unroll
            for (int e = 0; e < 8; ++e) S[e] += wgt * x[e]; }
    }
    v4u nn[4], no[4];
#define POOL_LD(tb_) do { _Pragma("unroll") for (int u = 0; u < 4; ++u) { const int t_ = (tb_) + u, to_ = t_ - win + 1; nn[u] = *(const v4u*)(U + (size_t)(row0 + t_) * NIN); no[u] = *(const v4u*)(U + (size_t)(row0 + (pos0 + to_ >= 0 ? to_ : -pos0)) * NIN); } } while (0)
    POOL_LD(0);
    for (int tb = 0; tb < T; tb += 4) {
        v4u mn[4], mo[4];
#pragma unroll
        for (int u = 0; u < 4; ++u) { mn[u] = nn[u]; mo[u] = no[u]; }
        if (tb + 4 < T) POOL_LD(tb + 4);
#pragma unroll
        for (int u = 0; u < 4; ++u) {
            const int t = tb + u, to = t - win + 1; const float wo = (pos0 + to >= 0) ? 1.f : 0.f;
            float xn[8], xo[8]; unpack8(mn[u], xn); unpack8(mo[u], xo);
            const float cnt = (float)(win < pos0 + t + 1 ? win : pos0 + t + 1), inv = __builtin_amdgcn_rcpf(cnt); float o[8];
#pragma unroll
            for (int e = 0; e < 8; ++e) { S[e] += xn[e]; o[e] = S[e] * inv - xn[e]; S[e] -= wo * xo[e]; }
            *(v4u*)(PO + (size_t)(row0 + t) * 1024) = pack8(o);
        }
    }
#undef POOL_LD
}
constexpr int CV_BLK = 16, CV_NB = SEQ / CV_BLK;
constexpr int CV_P_ITEMS = BATCH * CV_NB * 2, CV_S_ITEMS = DB * 2;
constexpr int PREP_ITEMS = 2 * (CV_P_ITEMS + CV_S_ITEMS) + CV_P_ITEMS + CV_S_ITEMS;
__device__ __forceinline__ void prep_item(Frame& F, int l, int it) {
    int kind = 0;
    if (it >= CV_P_ITEMS + CV_S_ITEMS) { it -= CV_P_ITEMS + CV_S_ITEMS; kind = 1; if (it >= CV_P_ITEMS + CV_S_ITEMS) { it -= CV_P_ITEMS + CV_S_ITEMS; kind = 2; } }
    int row0, T, hmode, sb = 0, pos0; const int j = it & 1;
    if (it < CV_P_ITEMS) { const int blk = (it >> 1) % CV_NB, b = (it >> 1) / CV_NB; row0 = b * SEQ + blk * CV_BLK; T = CV_BLK; hmode = blk ? 1 : 0; pos0 = blk * CV_BLK; }
    else { sb = (it - CV_P_ITEMS) >> 1; row0 = MP + DS * sb; T = DS; hmode = 2; pos0 = 0; }
    if (kind == 0) conv_item<true>(F, l, row0, T, hmode, sb, j); else if (kind == 1) conv_item<false>(F, l, row0, T, hmode, sb, j); else pool_item(F, l, row0, T, pos0, hmode, sb, j);
}

__device__ __forceinline__ void st8f(float* p, const v4u u) { float x[8]; unpack8(u, x); *(f32x4*)p = (f32x4){x[0], x[1], x[2], x[3]}; *(f32x4*)(p + 4) = (f32x4){x[4], x[5], x[6], x[7]}; }
__device__ __forceinline__ void prep_out_rows(Frame& F0, int l) {
    RELANE_G(F0);
    const int lane = F.lane, gw = F.vcu * NWAVES + F.wave, NGW = F.G * NWAVES;
    const bf16* PROJ = (const bf16*)(F.ws + WS_PROJ);
    float* out = F.out;
    for (int r = gw; r < MV; r += NGW) {
        const bool samp = r >= MP; const int b = samp ? (r - MP) / DS : r / SEQ, t = samp ? (r - MP) % DS : r % SEQ;
        const bf16* prow = PROJ + (size_t)r * NIN;
        const int ci = samp ? t - 1 : t - (SEQ - 3), pi = samp ? 11 + t : t - (SEQ - PHIST);
        v4u kvr[3][2], cv[6], pv[2];
#pragma unroll
        for (int gi = 0; gi < 3; ++gi) { kvr[gi][0] = *(const v4u*)(prow + PC_KB + gi * 512 + 8 * lane); kvr[gi][1] = *(const v4u*)(prow + PC_VB + gi * 512 + 8 * lane); }
        const bool needc = (ci >= 0) || (pi >= 0);
        if (needc) {
#pragma unroll
            for (int j = 0; j < 6; ++j) cv[j] = *(const v4u*)(prow + 512 * j + 8 * lane);
#pragma unroll
            for (int j = 0; j < 2; ++j) pv[j] = *(const v4u*)(prow + PC_UC + 512 * j + 8 * lane);
        }
#pragma unroll
        for (int gi = 0; gi < 3; ++gi) {
            const int win = 128 << (2 * gi); const int w = samp ? win - DS + t : t - (SEQ - win);
            if (w >= 0) {
                const size_t obase = samp ? (gi == 0 ? O_SW1 : gi == 1 ? O_SW2 : O_SW3) : (gi == 0 ? O_PW1 : gi == 1 ? O_PW2 : O_PW3);
                float* dst = out + obase + ((size_t)(l * (samp ? DB : BATCH) + b) * win + w) * 1024 + 8 * lane;
                st8f(dst, kvr[gi][0]); st8f(dst + 512, kvr[gi][1]);
            }
        }
        if (needc) {
            if (ci >= 0) { float* dst = out + (samp ? O_SCONV + ((size_t)(l * DB + b) * 3 + ci) * CONVCH : O_PCONV + ((size_t)(l * BATCH + b) * 3 + ci) * CONVCH) + 8 * lane;
#pragma unroll
                for (int j = 0; j < 6; ++j) st8f(dst + 512 * j, cv[j]); }
            if (pi >= 0) { float* dst = out + (samp ? O_SPOOL + ((size_t)(l * DB + b) * PHIST + pi) * CPOOL : O_PPOOL + ((size_t)(l * BATCH + b) * PHIST + pi) * CPOOL) + 8 * lane;
#pragma unroll
                for (int j = 0; j < 2; ++j) st8f(dst + 512 * j, pv[j]); }
            if (samp && t == 0) {
                const float* phist = F.in[7] + (size_t)(l * DB + b) * PHIST * CPOOL;
                float* dst = out + O_SPOOL + (size_t)(l * DB + b) * PHIST * CPOOL; const float* src = phist + 4 * CPOOL;
                for (int i = lane; i < 11 * CPOOL / 4; i += 64) *(f32x4*)(dst + 4 * i) = *(const f32x4*)(src + 4 * i);
            }
        }
    }
}

__device__ __forceinline__ void gdn_scan_item(Frame& F0, int row0, int h, int s, const float* S0, float* Sout) {
    RELANE(F0);
    const int lane = F.lane, dvl = lane & 15, kg = lane >> 4;
    const bf16* QN = (const bf16*)(F.ws + WS_QN); const bf16* KN = (const bf16*)(F.ws + WS_KN); const bf16* VV = (const bf16*)(F.ws + WS_VV);
    const f32x4* TOK = (const f32x4*)(F.ws + WS_TOK); float* ORAW = (float*)(F.ws + WS_ORAW);
    float S[32]; v4u ku[DS][4], qu[DS][4]; float vv[DS]; f32x4 tk[DS];
    const float* sp = S0 + (size_t)(32 * kg) * 128 + 16 * s + dvl;
#pragma unroll
    for (int i = 0; i < 32; ++i) S[i] = sp[(size_t)i * 128];
#pragma unroll
    for (int t = 0; t < DS; ++t) { const size_t r = (size_t)(row0 + t);
#pragma unroll
        for (int c = 0; c < 4; ++c) { ku[t][c] = *(const v4u*)(KN + r * 1024 + h * 128 + 32 * kg + 8 * c); qu[t][c] = *(const v4u*)(QN + r * 1024 + h * 128 + 32 * kg + 8 * c); }
        vv[t] = bf1(VV[r * 1024 + h * 128 + 16 * s + dvl]); tk[t] = TOK[r * 8 + h]; }
#pragma unroll
    for (int t = 0; t < DS; ++t) {
        float rk = 0.f, rq = 0.f; float kf[32];
#pragma unroll
        for (int c = 0; c < 4; ++c) { float k8[8], q8[8]; unpack8(ku[t][c], k8); unpack8(qu[t][c], q8);
#pragma unroll
            for (int e = 0; e < 8; ++e) { kf[8 * c + e] = k8[e]; rk += k8[e] * S[8 * c + e]; rq += q8[e] * S[8 * c + e]; } }
        rk += __shfl_xor(rk, 16); rq += __shfl_xor(rq, 16); rk += __shfl_xor(rk, 32); rq += __shfl_xor(rq, 32);
        const float a = tk[t].x, d = tk[t].y * (vv[t] - a * rk), o = a * rq + tk[t].z * d;
#pragma unroll
        for (int i = 0; i < 32; ++i) S[i] = a * S[i] + kf[i] * d;
        if (kg == 0) ORAW[(size_t)(row0 + t) * 1024 + h * 128 + 16 * s + dvl] = o;
    }
    float* op = Sout + (size_t)(32 * kg) * 128 + 16 * s + dvl;
#pragma unroll
    for (int i = 0; i < 32; ++i) op[(size_t)i * 128] = S[i];
}

__device__ __forceinline__ bf16x8 pack_acc(const f32x16& x, int sp) {
    v4u p; p.x = pk2(x[8 * sp + 0], x[8 * sp + 1]); p.y = pk2(x[8 * sp + 2], x[8 * sp + 3]); p.z = pk2(x[8 * sp + 4], x[8 * sp + 5]); p.w = pk2(x[8 * sp + 6], x[8 * sp + 7]);
    return __builtin_bit_cast(bf16x8, p);
}
constexpr int GA_PITCH = 272, GA_LT_PITCH = 36, GA_WAVE_LDS = 32 * GA_PITCH + 32 * GA_LT_PITCH * 4 + 384;
__device__ __forceinline__ void gdn_ga_item(Frame& F0, int ch) {
    RELANE_G(F0);
    const int lane = F.lane, r = lane & 31, h = lane >> 5;
    const int c = ch & 63, bh = ch >> 6, hd = bh & 7, b = bh >> 3, row0 = b * SEQ + 32 * c;
    LAS unsigned char* TL = F.lds + F.wave * GA_WAVE_LDS; LAS float* LT = (LAS float*)(TL + 32 * GA_PITCH); LAS float* GS = (LAS float*)(TL + 32 * GA_PITCH + 32 * GA_LT_PITCH * 4);
    const bf16* QN = (const bf16*)(F.ws + WS_QN); const bf16* KN = (const bf16*)(F.ws + WS_KN); const bf16* VV = (const bf16*)(F.ws + WS_VV); const f32x4* TOK = (const f32x4*)(F.ws + WS_TOK);
    { const f32x4 tk = TOK[(size_t)(row0 + r) * 8 + hd]; if (h == 0) { GS[r] = tk.w; GS[32 + r] = tk.y; } }
#pragma unroll
    for (int i = 0; i < 8; ++i) { const int p = lane + 64 * i, rw = p >> 4, c16 = p & 15; *(LAS v4u*)(TL + rw * GA_PITCH + 16 * c16) = *(const v4u*)(KN + (size_t)(row0 + rw) * 1024 + hd * 128 + 8 * c16); }
    asm volatile("s_waitcnt lgkmcnt(0)" ::: "memory");
    float gcv[32], bev[32];
#pragma unroll
    for (int i = 0; i < 8; ++i) { const f32x4 a = *(const LAS f32x4*)(GS + 4 * i), bq = *(const LAS f32x4*)(GS + 32 + 4 * i);
        gcv[4 * i] = a.x; gcv[4 * i + 1] = a.y; gcv[4 * i + 2] = a.z; gcv[4 * i + 3] = a.w; bev[4 * i] = bq.x; bev[4 * i + 1] = bq.y; bev[4 * i + 2] = bq.z; bev[4 * i + 3] = bq.w; }
#pragma unroll
    for (int i = 1; i < 32; ++i) gcv[i] += gcv[i - 1];
    if (lane == 0) {
#pragma unroll
        for (int i = 0; i < 8; ++i) *(LAS f32x4*)(GS + 64 + 4 * i) = (f32x4){gcv[4 * i], gcv[4 * i + 1], gcv[4 * i + 2], gcv[4 * i + 3]}; }
    asm volatile("s_waitcnt lgkmcnt(0)" ::: "memory");
    const float gc_own = GS[64 + r], fr = (float)r;
    const bf16* kp = KN + (size_t)(row0 + r) * 1024 + hd * 128 + 8 * h; const bf16* qp = QN + (size_t)(row0 + r) * 1024 + hd * 128 + 8 * h;
    f32x16 akk, aqk;
#pragma unroll
    for (int i = 0; i < 16; ++i) { akk[i] = 0.f; aqk[i] = 0.f; }
#pragma unroll
    for (int ks = 0; ks < 8; ++ks) { const bf16x8 kf = *(const bf16x8*)(kp + 16 * ks), qf = *(const bf16x8*)(qp + 16 * ks);
        akk = __builtin_amdgcn_mfma_f32_32x32x16_bf16(kf, kf, akk, 0, 0, 0); aqk = __builtin_amdgcn_mfma_f32_32x32x16_bf16(kf, qf, aqk, 0, 0, 0); }
#pragma unroll
    for (int g4 = 0; g4 < 4; ++g4) { f32x4 w;
#pragma unroll
        for (int e = 0; e < 4; ++e) { const int k0 = 8 * g4 + e, k1 = k0 + 4; const float gk = h ? gcv[k1] : gcv[k0], bk = h ? bev[k1] : bev[k0]; const int kk = h ? k1 : k0;
            const float lo = fminf(fmaxf((float)kk - fr, 0.f), 1.f);
            w[e] = lo * bk * akk[4 * g4 + e] * __expf(fminf(gk - gc_own, 0.f));
            aqk[4 * g4 + e] = (1.f - lo) * aqk[4 * g4 + e] * __expf(fminf(gc_own - gk, 0.f)); }
        *(LAS f32x4*)(LT + r * GA_LT_PITCH + 8 * g4 + 4 * h) = w; }
    bf16x8* AF = (bf16x8*)(F.ws + WS_AF) + (size_t)ch * 128;
    AF[lane] = pack_acc(aqk, 0); AF[64 + lane] = pack_acc(aqk, 1);
    asm volatile("s_waitcnt lgkmcnt(0)" ::: "memory");
    float t[32];
#pragma unroll
    for (int j = 31; j >= 0; --j) {
        float acc = 1.f - fminf(fabsf(fr - (float)j), 1.f);
#pragma unroll
        for (int gq = (j + 1) >> 2; gq < 8; ++gq) { const f32x4 lv = *(const LAS f32x4*)(LT + j * GA_LT_PITCH + 4 * gq);
#pragma unroll
            for (int e = 0; e < 4; ++e) if (4 * gq + e > j) acc -= t[4 * gq + e] * lv[e]; }
        t[j] = acc;
    }
    bf16x8 t1f[2], t2f[2];
#pragma unroll
    for (int sp = 0; sp < 2; ++sp) { float x1[8], x2[8];
#pragma unroll
        for (int e = 0; e < 8; ++e) { const int j0 = 16 * sp + e, j1 = j0 + 8; const float tv = h ? t[j1] : t[j0], bj = h ? bev[j1] : bev[j0], gj = h ? gcv[j1] : gcv[j0]; x1[e] = tv * bj; x2[e] = x1[e] * __expf(gj); }
        t1f[sp] = __builtin_bit_cast(bf16x8, pack8(x1)); t2f[sp] = __builtin_bit_cast(bf16x8, pack8(x2)); }
    { bf16x8* QFo = (bf16x8*)(F.ws + WS_QF) + (size_t)ch * 512; const bf16* qrow = QN + (size_t)(row0 + r) * 1024 + hd * 128 + 4 * h;
#pragma unroll
      for (int tl = 0; tl < 4; ++tl)
#pragma unroll
          for (int sp = 0; sp < 2; ++sp) { const v2u qlo = *(const v2u*)(qrow + 32 * tl + 16 * sp), qhi = *(const v2u*)(qrow + 32 * tl + 16 * sp + 8); v4u qu; qu.x = qlo.x; qu.y = qlo.y; qu.z = qhi.x; qu.w = qhi.y; QFo[(tl * 2 + sp) * 64 + lane] = __builtin_bit_cast(bf16x8, qu); } }
    const float g_last = gcv[31];
    bf16x8* WF = (bf16x8*)(F.ws + WS_WF) + (size_t)ch * 512; bf16x8* KF = (bf16x8*)(F.ws + WS_KF) + (size_t)ch * 512;
#pragma unroll
    for (int tl = 0; tl < 4; ++tl) {
        f32x16 acc;
#pragma unroll
        for (int i = 0; i < 16; ++i) acc[i] = 0.f;
        const LAS unsigned char* col = TL + (32 * tl + r) * 2;
#pragma unroll
        for (int sp = 0; sp < 2; ++sp) { unsigned w[4];
#pragma unroll
            for (int e = 0; e < 4; ++e) { const unsigned lo = *(const LAS unsigned short*)(col + (16 * sp + 8 * h + 2 * e) * GA_PITCH), hi = *(const LAS unsigned short*)(col + (16 * sp + 8 * h + 2 * e + 1) * GA_PITCH); w[e] = lo | (hi << 16); }
            v4u wu; wu.x = w[0]; wu.y = w[1]; wu.z = w[2]; wu.w = w[3];
            acc = __builtin_amdgcn_mfma_f32_32x32x16_bf16(__builtin_bit_cast(bf16x8, wu), t2f[sp], acc, 0, 0, 0); }
#pragma unroll
        for (int i = 0; i < 16; ++i) acc[i] = -acc[i];
#pragma unroll
        for (int sp = 0; sp < 2; ++sp) { WF[(tl * 2 + sp) * 64 + lane] = pack_acc(acc, sp);
            float x[8];
#pragma unroll
            for (int e = 0; e < 8; ++e) { const int j0 = 16 * sp + 8 * (e >> 2) + (e & 3), j1 = j0 + 4; const float gj = h ? gcv[j1] : gcv[j0];
                const unsigned kv = *(const LAS unsigned short*)(col + (j0 + 4 * h) * GA_PITCH); x[e] = __builtin_bit_cast(float, kv << 16) * __expf(g_last - gj); }
            KF[(tl * 2 + sp) * 64 + lane] = __builtin_bit_cast(bf16x8, pack8(x)); }
    }
    asm volatile("s_waitcnt lgkmcnt(0)" ::: "memory");
#pragma unroll
    for (int i = 0; i < 8; ++i) { const int p = lane + 64 * i, rw = p >> 4, c16 = p & 15; *(LAS v4u*)(TL + rw * GA_PITCH + 16 * c16) = *(const v4u*)(VV + (size_t)(row0 + rw) * 1024 + hd * 128 + 8 * c16); }
    asm volatile("s_waitcnt lgkmcnt(0)" ::: "memory");
    f32x4* UF = (f32x4*)(F.ws + WS_UF) + (size_t)ch * 1024;
#pragma unroll
    for (int tl = 0; tl < 4; ++tl) {
        f32x16 acc;
#pragma unroll
        for (int i = 0; i < 16; ++i) acc[i] = 0.f;
        const LAS unsigned char* col = TL + (32 * tl + r) * 2;
#pragma unroll
        for (int sp = 0; sp < 2; ++sp) { unsigned w[4];
#pragma unroll
            for (int e = 0; e < 4; ++e) { const unsigned lo = *(const LAS unsigned short*)(col + (16 * sp + 8 * h + 2 * e) * GA_PITCH), hi = *(const LAS unsigned short*)(col + (16 * sp + 8 * h + 2 * e + 1) * GA_PITCH); w[e] = lo | (hi << 16); }
            v4u wu; wu.x = w[0]; wu.y = w[1]; wu.z = w[2]; wu.w = w[3];
            acc = __builtin_amdgcn_mfma_f32_32x32x16_bf16(t1f[sp], __builtin_bit_cast(bf16x8, wu), acc, 0, 0, 0); }
#pragma unroll
        for (int g4 = 0; g4 < 4; ++g4) UF[(tl * 4 + g4) * 64 + lane] = (f32x4){acc[4 * g4], acc[4 * g4 + 1], acc[4 * g4 + 2], acc[4 * g4 + 3]};
    }
    if (h == 0) ((float*)(F.ws + WS_TB))[(size_t)ch * 32 + r] = __expf(gc_own);
    asm volatile("s_waitcnt lgkmcnt(0)" ::: "memory");
}

constexpr int GSC_ITEMS = BATCH * HA * 4;
constexpr int GSB_WF = 0, GSB_KF = 8192, GSB_QF = 16384, GSB_UF = 24576, GSB_AF = 28672, GSB_TB = 30720, GSB_AL = 34816, GSB_STRIDE = 36864;
__device__ __forceinline__ void gdn_chunk_scan(Frame& F0, int l, int item) {
    RELANE(F0);
    const int lane = F.lane, r = lane & 31, h = lane >> 5;
    const int sl = item & 3, bh = item >> 2, hd = bh & 7, b = bh >> 3;
    float* ORAW = launder_pg((float*)(F.ws + WS_ORAW));
    LAS unsigned char* buf = F.lds;
#define GS_DMA(src, off) __builtin_amdgcn_global_load_lds((const unsigned*)(src), (LAS unsigned*)(bp + (off)), 16, 0, 0)
#define GS_FETCH(cc, bsel) do { const size_t ch_ = (size_t)bh * 64 + (cc); LAS unsigned char* bp = buf + (bsel) * GSB_STRIDE; \
        const bf16x8* wf_ = (const bf16x8*)(F.ws + WS_WF) + ch_ * 512 + lane; const bf16x8* kf_ = (const bf16x8*)(F.ws + WS_KF) + ch_ * 512 + lane; const bf16x8* qf_ = (const bf16x8*)(F.ws + WS_QF) + ch_ * 512 + lane; \
        const f32x4* uf_ = (const f32x4*)(F.ws + WS_UF) + ch_ * 1024 + (size_t)sl * 256 + lane; const bf16x8* af_ = (const bf16x8*)(F.ws + WS_AF) + ch_ * 128 + lane; const float* tb_ = (const float*)(F.ws + WS_TB) + ch_ * 32; \
        _Pragma("unroll") for (int i_ = 0; i_ < 8; ++i_) { GS_DMA(wf_ + i_ * 64, GSB_WF + i_ * 1024); GS_DMA(qf_ + i_ * 64, GSB_QF + i_ * 1024); } \
        _Pragma("unroll") for (int i_ = 0; i_ < 4; ++i_) { GS_DMA(uf_ + i_ * 64, GSB_UF + i_ * 1024); GS_DMA(tb_ + 8 * i_ + 4 * h, GSB_TB + i_ * 1024); } \
        GS_DMA(af_, GSB_AF); GS_DMA(af_ + 64, GSB_AF + 1024); \
        _Pragma("unroll") for (int i_ = 0; i_ < 8; ++i_) GS_DMA(kf_ + i_ * 64, GSB_KF + i_ * 1024); } while (0)
    f32x16 S[4];
#pragma unroll
    for (int tl = 0; tl < 4; ++tl)
#pragma unroll
        for (int i = 0; i < 16; ++i) S[tl][i] = 0.f;
    GS_FETCH(0, 0); GS_FETCH(1, 1);
    int bsel = 0;
#pragma unroll 1
    for (int c = 0; c < SEQ / 32; ++c) {
        const int row0 = b * SEQ + 32 * c;
        if (c < 2) asm volatile("s_waitcnt vmcnt(34)" ::: "memory"); else if (c + 1 < SEQ / 32) asm volatile("s_waitcnt vmcnt(63)" ::: "memory"); else asm volatile("s_waitcnt vmcnt(0)" ::: "memory");
        if (c + 2 < SEQ / 32) GS_FETCH(c + 2, (bsel == 0 ? 2 : bsel - 1));
        const LAS unsigned char* bp = buf + bsel * GSB_STRIDE + lane * 16; bsel = (bsel == 2) ? 0 : bsel + 1;
        f32x16 P, O1;
#pragma unroll
        for (int g4 = 0; g4 < 4; ++g4) { const f32x4 u = *(const LAS f32x4*)(bp + GSB_UF + g4 * 1024); P[4 * g4] = u.x; P[4 * g4 + 1] = u.y; P[4 * g4 + 2] = u.z; P[4 * g4 + 3] = u.w; }
#pragma unroll
        for (int i = 0; i < 16; ++i) O1[i] = 0.f;
#pragma unroll
        for (int tl = 0; tl < 4; ++tl)
#pragma unroll
            for (int sp = 0; sp < 2; ++sp) {
                const bf16x8 sf = pack_acc(S[tl], sp);
                P = __builtin_amdgcn_mfma_f32_32x32x16_bf16(*(const LAS bf16x8*)(bp + GSB_WF + (tl * 2 + sp) * 1024), sf, P, 0, 0, 0);
                O1 = __builtin_amdgcn_mfma_f32_32x32x16_bf16(*(const LAS bf16x8*)(bp + GSB_QF + (tl * 2 + sp) * 1024), sf, O1, 0, 0, 0);
            }
        float eg3w = 0.f;
#pragma unroll
        for (int g4 = 0; g4 < 4; ++g4) { const f32x4 eg = *(const LAS f32x4*)(bp + GSB_TB + g4 * 1024); O1[4 * g4] *= eg.x; O1[4 * g4 + 1] *= eg.y; O1[4 * g4 + 2] *= eg.z; O1[4 * g4 + 3] *= eg.w; if (g4 == 3) eg3w = eg.w; }
        const bf16x8 vf0 = pack_acc(P, 0), vf1 = pack_acc(P, 1);
        O1 = __builtin_amdgcn_mfma_f32_32x32x16_bf16(*(const LAS bf16x8*)(bp + GSB_AF), vf0, O1, 0, 0, 0);
        O1 = __builtin_amdgcn_mfma_f32_32x32x16_bf16(*(const LAS bf16x8*)(bp + GSB_AF + 1024), vf1, O1, 0, 0, 0);
        const float a_last = __builtin_bit_cast(float, __builtin_amdgcn_readlane(__builtin_bit_cast(int, eg3w), 32));
#pragma unroll
        for (int tl = 0; tl < 4; ++tl) {
#pragma unroll
            for (int i = 0; i < 16; ++i) S[tl][i] *= a_last;
            S[tl] = __builtin_amdgcn_mfma_f32_32x32x16_bf16(*(const LAS bf16x8*)(bp + GSB_KF + (tl * 2) * 1024), vf0, S[tl], 0, 0, 0);
            S[tl] = __builtin_amdgcn_mfma_f32_32x32x16_bf16(*(const LAS bf16x8*)(bp + GSB_KF + (tl * 2 + 1) * 1024), vf1, S[tl], 0, 0, 0);
        }
        float* op = ORAW + (size_t)(row0 + 4 * h) * 1024 + hd * 128 + 32 * sl + r;
#pragma unroll
        for (int i = 0; i < 16; ++i) op[(size_t)((i & 3) + 8 * (i >> 2)) * 1024] = O1[i];
    }
#undef GS_DMA
#undef GS_FETCH
    float* Sout = F.out + O_PGDN + (size_t)((l * BATCH + b) * HA + hd) * 16384 + 32 * sl + r;
#pragma unroll
    for (int tl = 0; tl < 4; ++tl)
#pragma unroll
        for (int i = 0; i < 16; ++i) Sout[(size_t)(32 * tl + (i & 3) + 8 * (i >> 2) + 4 * h) * 128] = S[tl][i];
}

constexpr int VT_PITCH = 144, VT_WAVE_LDS = 64 * VT_PITCH, VT_ITEMS = BATCH * 3 * 4 * 2 * 32;
__device__ __forceinline__ void vt_item(Frame& F0, int item) {
    RELANE_G(F0);
    const int lane = F.lane; LAS unsigned char* T = F.lds + F.wave * VT_WAVE_LDS;
    const int ch = item & 31, dh = (item >> 5) & 1, hh = (item >> 6) & 3, bg = item >> 8, g = bg % 3, b = bg / 3;
    const int dil = 1 << (2 * g), Lc = SEQ >> (2 * g), pos0 = ch * 64, rho = pos0 / Lc, i0 = pos0 % Lc;
    const bf16* PROJ = (const bf16*)(F.ws + WS_PROJ); bf16* VT = (bf16*)(F.ws + WS_VT);
    const bf16* src = PROJ + ((size_t)b * SEQ + (size_t)(i0 + lane) * dil + rho) * NIN + PC_VB + g * 512 + hh * 128 + 64 * dh;
    v4u x[8];
#pragma unroll
    for (int c = 0; c < 8; ++c) x[c] = *(const v4u*)(src + 8 * c);
#pragma unroll
    for (int c = 0; c < 8; ++c) { const unsigned w[4] = {x[c].x, x[c].y, x[c].z, x[c].w};
#pragma unroll
        for (int e = 0; e < 4; ++e) { *(LAS unsigned short*)(T + (8 * c + 2 * e) * VT_PITCH + 2 * lane) = (unsigned short)(w[e] & 0xffffu); *(LAS unsigned short*)(T + (8 * c + 2 * e + 1) * VT_PITCH + 2 * lane) = (unsigned short)(w[e] >> 16); } }
    asm volatile("s_waitcnt lgkmcnt(0)" ::: "memory");
    bf16* dst = VT + ((size_t)((b * 3 + g) * 4 + hh) * 128 + 64 * dh) * 2048 + pos0;
#pragma unroll
    for (int it = 0; it < 8; ++it) { const int p = lane + 64 * it, row = p >> 3, cc = p & 7; const v4u v = *(const LAS v4u*)(T + row * VT_PITCH + 16 * cc); *(v4u*)(dst + (size_t)row * 2048 + 8 * cc) = v; }
    asm volatile("s_waitcnt lgkmcnt(0)" ::: "memory");
}

constexpr int ATT_UNITS = BATCH * 4 * 192;
__device__ __forceinline__ void attn_unit(Frame& F0, int unit) {
    RELANE(F0);
    const int lane = F.lane, r = lane & 31, h = lane >> 5;
    const int bh = unit / 192, b = bh >> 2, hh = bh & 3, u = unit % 192, g = u >> 6, v = u & 63;
    const int dil = 1 << (2 * g), ntpc = 64 >> (2 * g), rho = v / ntpc, i0 = (v % ntpc) * 32, Lc = SEQ >> (2 * g);
    const bf16* PROJ = (const bf16*)(F.ws + WS_PROJ);
    const bf16* cbase = PROJ + ((size_t)b * SEQ + rho) * NIN + g * 512 + hh * 128 + 8 * h;
    const bf16* qp = cbase + (size_t)(i0 + r) * dil * NIN + PC_QB;
    bf16x8 qf[8];
#pragma unroll
    for (int ks = 0; ks < 8; ++ks) qf[ks] = *(const bf16x8*)(qp + 16 * ks);
    f32x16 st[5]; float mx = -1e30f;
    bf16x8 kn[8];
    { const int k0 = i0 - 128; const bf16* kp = cbase + (size_t)((k0 >= 0 ? k0 : 0) + r) * dil * NIN + PC_KB;
#pragma unroll
      for (int ks = 0; ks < 8; ++ks) kn[ks] = *(const bf16x8*)(kp + 16 * ks); }
#pragma unroll
    for (int kt = 0; kt < 5; ++kt) {
        const int k0 = i0 - 128 + 32 * kt; const bool tv = k0 >= 0;
        bf16x8 kc[8];
#pragma unroll
        for (int ks = 0; ks < 8; ++ks) kc[ks] = kn[ks];
        if (kt < 4) { const int k1 = k0 + 32; const bf16* kp = cbase + (size_t)((k1 >= 0 ? k1 : 0) + r) * dil * NIN + PC_KB;
#pragma unroll
            for (int ks = 0; ks < 8; ++ks) kn[ks] = *(const bf16x8*)(kp + 16 * ks); }
        f32x16 acc;
#pragma unroll
        for (int i = 0; i < 16; ++i) acc[i] = 0.f;
#pragma unroll
        for (int ks = 0; ks < 8; ++ks) acc = __builtin_amdgcn_mfma_f32_32x32x16_bf16(kc[ks], qf[ks], acc, 0, 0, 0);
#pragma unroll
        for (int i = 0; i < 16; ++i) { const int row = (i & 3) + 8 * (i >> 2) + 4 * h; float sv = tv ? acc[i] : -1e30f;
            if (kt == 0 && row < r) sv = -1e30f;
            if (kt == 4 && row > r) sv = -1e30f;
            st[kt][i] = sv; mx = fmaxf(mx, sv); }
    }
    mx = fmaxf(mx, __shfl_xor(mx, 32));
    const float c = 0.08838834764831845f * 1.4426950408889634f, mc = mx * c; float ls = 0.f;
#pragma unroll
    for (int kt = 0; kt < 5; ++kt)
#pragma unroll
        for (int i = 0; i < 16; ++i) { const float p = __builtin_amdgcn_exp2f(st[kt][i] * c - mc); st[kt][i] = p; ls += p; }
    ls += __shfl_xor(ls, 32);
    f32x16 ot[4];
#pragma unroll
    for (int dt = 0; dt < 4; ++dt)
#pragma unroll
        for (int i = 0; i < 16; ++i) ot[dt][i] = 0.f;
    const bf16* vt = (const bf16*)(F.ws + WS_VT) + ((size_t)((b * 3 + g) * 4 + hh) * 128 + r) * 2048 + rho * Lc + 4 * h;
    v2u vn[2][4][2];
#define ATT_VLD(kt_) do { const int k0_ = i0 - 128 + 32 * (kt_), kc_ = k0_ >= 0 ? k0_ : 0; _Pragma("unroll") for (int sp = 0; sp < 2; ++sp) _Pragma("unroll") for (int dt = 0; dt < 4; ++dt) { \
            const bf16* vp = vt + (size_t)(32 * dt) * 2048 + kc_ + 16 * sp; vn[sp][dt][0] = *(const v2u*)vp; vn[sp][dt][1] = *(const v2u*)(vp + 8); } } while (0)
    ATT_VLD(0);
#pragma unroll
    for (int kt = 0; kt < 5; ++kt) {
        v2u vc[2][4][2];
#pragma unroll
        for (int sp = 0; sp < 2; ++sp)
#pragma unroll
            for (int dt = 0; dt < 4; ++dt) { vc[sp][dt][0] = vn[sp][dt][0]; vc[sp][dt][1] = vn[sp][dt][1]; }
        if (kt < 4) ATT_VLD(kt + 1);
#pragma unroll
        for (int sp = 0; sp < 2; ++sp) {
            v4u pu; pu.x = pk2(st[kt][8 * sp + 0], st[kt][8 * sp + 1]); pu.y = pk2(st[kt][8 * sp + 2], st[kt][8 * sp + 3]); pu.z = pk2(st[kt][8 * sp + 4], st[kt][8 * sp + 5]); pu.w = pk2(st[kt][8 * sp + 6], st[kt][8 * sp + 7]);
            const bf16x8 pf = __builtin_bit_cast(bf16x8, pu);
#pragma unroll
            for (int dt = 0; dt < 4; ++dt) {
                v4u vu; vu.x = vc[sp][dt][0].x; vu.y = vc[sp][dt][0].y; vu.z = vc[sp][dt][1].x; vu.w = vc[sp][dt][1].y;
                ot[dt] = __builtin_amdgcn_mfma_f32_32x32x16_bf16(__builtin_bit_cast(bf16x8, vu), pf, ot[dt], 0, 0, 0);
            }
        }
    }
#undef ATT_VLD
    const float inv = 1.f / ls; const size_t tok = (size_t)b * SEQ + (size_t)(i0 + r) * dil + rho;
    bf16* op = (bf16*)(F.ws + WS_OBG) + ((size_t)g * MV + tok) * 512 + hh * 128 + 4 * h;
#pragma unroll
    for (int dt = 0; dt < 4; ++dt)
#pragma unroll
        for (int g4 = 0; g4 < 4; ++g4) { v2u w; w.x = pk2(ot[dt][4 * g4] * inv, ot[dt][4 * g4 + 1] * inv); w.y = pk2(ot[dt][4 * g4 + 2] * inv, ot[dt][4 * g4 + 3] * inv); *(v2u*)(op + 32 * dt + 8 * g4) = w; }
    if (h == 0) *(f32x2*)((float*)(F.ws + WS_AST) + (((size_t)g * MV + tok) * 4 + hh) * 2) = (f32x2){mc, ls};
}


__device__ __forceinline__ void attn_sample_item(Frame& F0, int l, int item) {
    RELANE(F0);
    const int lane = F.lane, l16 = lane & 15;
    const int half = item & 1, it2 = item >> 1, g = it2 % 3, bt = it2 / 3, t = bt & 3, b = bt >> 2, dil = 1 << (2 * g), win = 128 * dil, jlo = half ? 65 : 0, part = g + 3 * half;
    const bf16* PROJ = (const bf16*)(F.ws + WS_PROJ);
    const int row = MP + DS * b + t;
    const float* cache = F.in[2 + g] + (size_t)(l * DB + b) * win * 1024 + 8 * lane;
    const bf16* newk = PROJ + (size_t)(MP + DS * b) * NIN + PC_KB + g * 512 + 8 * lane;
    float q[8]; unpack8(*(const v4u*)(PROJ + (size_t)row * NIN + PC_QB + g * 512 + 8 * lane), q);
    const int n_new = (g == 0) ? t + 1 : 1;
    const float c = 0.08838834764831845f * 1.4426950408889634f;
    float sc[5];
#pragma unroll
    for (int jr = 0; jr < 5; ++jr) {
        sc[jr] = -1e30f;
        const int jn = jr < 4 ? 16 : 1;
#pragma unroll 8
        for (int jl = 0; jl < jn; ++jl) {
            const int j = jlo + 16 * jr + jl, jc = j <= 128 ? j : 128; int idx = win + t - jc * dil; idx = idx < win ? idx : win - 1;
            const float* kp = cache + (size_t)idx * 1024; const f32x4 a = *(const f32x4*)kp, bq = *(const f32x4*)(kp + 4);
            float sv = (q[0] * a.x + q[1] * a.y) + (q[2] * a.z + q[3] * a.w) + (q[4] * bq.x + q[5] * bq.y) + (q[6] * bq.z + q[7] * bq.w);
            sv = j <= 128 ? row16_sum(sv) * c : -1e30f;
            sc[jr] = (l16 == jl) ? sv : sc[jr];
        }
    }
#pragma unroll
    for (int jj = 0; jj < 4; ++jj) {
        const int tk = t - jj >= 0 ? t - jj : 0; float k[8]; unpack8(*(const v4u*)(newk + (size_t)tk * NIN), k);
        float sv = (q[0] * k[0] + q[1] * k[1]) + (q[2] * k[2] + q[3] * k[3]) + (q[4] * k[4] + q[5] * k[5]) + (q[6] * k[6] + q[7] * k[7]);
        sv = row16_sum(sv) * c;
        sc[0] = (half == 0 && jj < n_new && l16 == jj) ? sv : sc[0];
    }
    float mx = -1e30f;
#pragma unroll
    for (int jr = 0; jr < 5; ++jr) mx = fmaxf(mx, sc[jr]);
    mx = fmaxf(mx, dpp_f<0xB1>(mx)); mx = fmaxf(mx, dpp_f<0x4E>(mx)); mx = fmaxf(mx, dpp_f<0x124>(mx)); mx = fmaxf(mx, dpp_f<0x128>(mx));
    float ls = 0.f;
#pragma unroll
    for (int jr = 0; jr < 5; ++jr) { sc[jr] = __builtin_amdgcn_exp2f(sc[jr] - mx); ls += sc[jr]; }
    ls = row16_sum(ls);
    float o[8];
#pragma unroll
    for (int e = 0; e < 8; ++e) o[e] = 0.f;
#pragma unroll
    for (int jj = 0; jj < 4; ++jj) {
        const int tk = t - jj >= 0 ? t - jj : 0; float vv[8]; unpack8(*(const v4u*)(newk + (size_t)tk * NIN + (PC_VB - PC_KB)), vv);
        const bool isnew = half == 0 && jj < n_new;
        const float p = isnew ? __shfl(sc[0], (lane & 48) | jj) : 0.f;
#pragma unroll
        for (int e = 0; e < 8; ++e) o[e] += p * vv[e];
        sc[0] = (isnew && l16 == jj) ? 0.f : sc[0];
    }
#pragma unroll
    for (int jr = 0; jr < 5; ++jr) {
        const int jn = jr < 4 ? 16 : 1;
#pragma unroll 8
        for (int jl = 0; jl < jn; ++jl) {
            const int j = jlo + 16 * jr + jl, jc = j <= 128 ? j : 128; int idx = win + t - jc * dil; idx = idx < win ? idx : win - 1;
            const float p = __shfl(sc[jr], (lane & 48) | jl);
            const float* vp = cache + (size_t)idx * 1024 + 512; const f32x4 a = *(const f32x4*)vp, bq = *(const f32x4*)(vp + 4);
            o[0] += p * a.x; o[1] += p * a.y; o[2] += p * a.z; o[3] += p * a.w; o[4] += p * bq.x; o[5] += p * bq.y; o[6] += p * bq.z; o[7] += p * bq.w;
        }
    }
    const float inv = 1.f / ls;
#pragma unroll
    for (int e = 0; e < 8; ++e) o[e] *= inv;
    *(v4u*)((bf16*)(F.ws + WS_OBG) + ((size_t)part * MV + row) * 512 + 8 * lane) = pack8(o);
    if (l16 == 0) *(f32x2*)((float*)(F.ws + WS_AST) + (((size_t)part * MV + row) * 4 + (lane >> 4)) * 2) = (f32x2){mx, ls};
}

__device__ __forceinline__ void gdn_gate_rows(Frame& F0, int l) {
    RELANE_G(F0);
    const int lane = F.lane, gw = F.vcu * NWAVES + F.wave, NGW = F.G * NWAVES;
    const float* ORAW = (const float*)(F.ws + WS_ORAW); const bf16* PROJ = (const bf16*)(F.ws + WS_PROJ); bf16* OUTA = (bf16*)(F.ws + WS_OUTA);
    const float* gain = F.in[12] + (size_t)l * 128;
    for (int r = gw; r < MV; r += NGW) {
#pragma unroll
        for (int j = 0; j < 4; ++j) {
            const int c0 = 256 * j + 4 * lane; const f32x4 o = *(const f32x4*)(ORAW + (size_t)r * 1024 + c0);
            float ss = (o.x * o.x + o.y * o.y) + (o.z * o.z + o.w * o.w);
            ss += __shfl_xor(ss, 1); ss += __shfl_xor(ss, 2); ss += __shfl_xor(ss, 4); ss += __shfl_xor(ss, 8); ss += __shfl_xor(ss, 16);
            const float rstd = rsqrtf(ss * (1.f / 128.f) + EPS);
            const f32x4 g = *(const f32x4*)(gain + (c0 & 127)); const v2u zu = *(const v2u*)(PROJ + (size_t)r * NIN + PC_ZA + c0);
            const float z0 = bf_lo(zu.x), z1 = bf_hi(zu.x), z2 = bf_lo(zu.y), z3 = bf_hi(zu.y);
            v2u w; w.x = pk2(o.x * rstd * g.x * silu(z0), o.y * rstd * g.y * silu(z1)); w.y = pk2(o.z * rstd * g.z * silu(z2), o.w * rstd * g.w * silu(z3));
            *(v2u*)(OUTA + (size_t)r * 1024 + c0) = w;
        }
        {
            const int c0 = 8 * lane, hh = lane >> 4; const float* ast = (const float*)(F.ws + WS_AST); const bf16* obg = (const bf16*)(F.ws + WS_OBG);
            const int np = r < MP ? 3 : 6;
            f32x2 sg[6]; v4u xo[6]; float M = -1e30f;
#pragma unroll
            for (int g = 0; g < 6; ++g) { const int gg = g < np ? g : 0; sg[g] = *(const f32x2*)(ast + (((size_t)gg * MV + r) * 4 + hh) * 2); xo[g] = *(const v4u*)(obg + ((size_t)gg * MV + r) * 512 + c0); }
#pragma unroll
            for (int g = 0; g < 6; ++g) { if (g >= np) sg[g] = (f32x2){-1e30f, 0.f}; M = fmaxf(M, sg[g].x); }
            float wg[6], den = 0.f;
#pragma unroll
            for (int g = 0; g < 6; ++g) { wg[g] = __builtin_amdgcn_exp2f(sg[g].x - M) * sg[g].y; den += wg[g]; }
            const float inv = 1.f / den; float o[8];
#pragma unroll
            for (int e = 0; e < 8; ++e) o[e] = 0.f;
#pragma unroll
            for (int g = 0; g < 6; ++g) { float x[8]; unpack8(xo[g], x); const float w = wg[g] * inv;
#pragma unroll
                for (int e = 0; e < 8; ++e) o[e] += w * x[e]; }
            *(v4u*)((bf16*)(F.ws + WS_OUTB) + (size_t)r * 512 + c0) = pack8(o);
        }
    }
}


constexpr int CP_PER_B = 31 + 127 + 511, CP_NSUB = DB * CP_PER_B;
constexpr int CP_TAIL_WG = 84, CP_TAIL_PER_WG = 64, CP_TAIL = CP_TAIL_WG * CP_TAIL_PER_WG;
__device__ __forceinline__ void copy_subchunk(Frame& F, int l, int c) {
    const int lane = F.lane, b = c / CP_PER_B, rc = c % CP_PER_B; const int gi = rc < 31 ? 0 : rc < 158 ? 1 : 2, k = rc - (gi == 0 ? 0 : gi == 1 ? 31 : 158), win = 128 << (2 * gi);
    const f32x4* src = (const f32x4*)(F.in[2 + gi] + ((size_t)(l * DB + b) * win + DS + 4 * k) * 1024) + lane;
    f32x4* dst = (f32x4*)(F.out + (gi == 0 ? O_SW1 : gi == 1 ? O_SW2 : O_SW3) + ((size_t)(l * DB + b) * win + 4 * k) * 1024) + lane;
    f32x4 v[16];
#pragma unroll
    for (int i = 0; i < 16; ++i) v[i] = __builtin_nontemporal_load(src + 64 * i);
#pragma unroll
    for (int i = 0; i < 16; ++i) __builtin_nontemporal_store(v[i], dst + 64 * i);
}
__device__ __forceinline__ void side_queue(Frame& F0, int l, volatile LAS unsigned* qctr) {
    RELANE(F0);
    const int lane = F.lane;
    const int nsub = CP_NSUB - (F.G == 256 ? CP_TAIL : 0);
    const int ncp = (nsub - (int)blockIdx.x + F.G - 1) / F.G;
    const int wper = 0,     w0 = (int)blockIdx.x * wper, nw = max(0, min(IT_LAYER, w0 + wper) - w0);
    LAS float* scr = (LAS float*)F.lds;
    for (;;) {
        unsigned q = 0; if (lane == 0) q = __hip_atomic_fetch_add((LAS unsigned*)qctr, 1u, __ATOMIC_RELAXED, __HIP_MEMORY_SCOPE_WORKGROUP);
        q = (unsigned)__builtin_amdgcn_readfirstlane((int)q);
        if ((int)q >= ncp + nw) break;
        if ((int)q < ncp) { copy_subchunk(F, l, (int)q * F.G + (int)blockIdx.x);
        } else weight_item(F, l + 1, w0 + (int)q - ncp, scr);
    }
}


__device__ __forceinline__ f32x16 skinny_kloop(const bf16* ap, const bf16* bp, int nks, f32x16 acc) {
    int ks = 0;
    for (; ks + 8 <= nks; ks += 8) { bf16x8 a[8], b[8];
#pragma unroll
        for (int u = 0; u < 8; ++u) { a[u] = *(const bf16x8*)(ap + 16 * (ks + u)); b[u] = *(const bf16x8*)(bp + 16 * (ks + u)); }
#pragma unroll
        for (int u = 0; u < 8; ++u) acc = __builtin_amdgcn_mfma_f32_32x32x16_bf16(a[u], b[u], acc, 0, 0, 0); }
    for (; ks < nks; ks += 4) { bf16x8 a[4], b[4];
#pragma unroll
        for (int u = 0; u < 4; ++u) { a[u] = *(const bf16x8*)(ap + 16 * (ks + u)); b[u] = *(const bf16x8*)(bp + 16 * (ks + u)); }
#pragma unroll
        for (int u = 0; u < 4; ++u) acc = __builtin_amdgcn_mfma_f32_32x32x16_bf16(a[u], b[u], acc, 0, 0, 0); }
    return acc;
}
__device__ __forceinline__ f32x2 skinny_reduce(Frame& F, const f32x16& acc) {
    LAS float* P = (LAS float*)F.lds; const int r = F.lane & 31, h = F.lane >> 5;
    __syncthreads();
#pragma unroll
    for (int i = 0; i < 16; ++i) P[(F.wave * 32 + (i & 3) + 8 * (i >> 2) + 4 * h) * 33 + r] = acc[i];
    __syncthreads();
    const int row = F.tid >> 4, col = 2 * (F.tid & 15); f32x2 o = {0.f, 0.f};
#pragma unroll
    for (int w = 0; w < 8; ++w) { o.x += P[(w * 32 + row) * 33 + col]; o.y += P[(w * 32 + row) * 33 + col + 1]; }
    return o;
}
__device__ __forceinline__ void skinny_store(Frame& F0, const bf16* A, int lda, const bf16* Bt, int K, bf16* O) {
    RELANE(F0);
    const int r = F.lane & 31, h = F.lane >> 5, kw = K / 8;
    for (int unit = launder_s((int)blockIdx.x); unit < 256; unit += F.G) {
        const int mt = unit >> 6, nt = unit & 63;
        f32x16 acc;
#pragma unroll
        for (int i = 0; i < 16; ++i) acc[i] = 0.f;
        acc = skinny_kloop(A + (size_t)(MP + 32 * mt + r) * lda + F.wave * kw + 8 * h, Bt + (size_t)(32 * nt + r) * K + F.wave * kw + 8 * h, kw / 16, acc);
        const f32x2 o = skinny_reduce(F, acc);
        *(unsigned*)(O + (size_t)(MP + 32 * mt + (F.tid >> 4)) * D + 32 * nt + 2 * (F.tid & 15)) = pk2(o.x, o.y);
    }
}
__device__ __forceinline__ void skinny_merge(Frame& F0, const unsigned char* wl) {
    RELANE(F0);
    const int r = F.lane & 31, h = F.lane >> 5; const bf16* PROJ = (const bf16*)(F.ws + WS_PROJ);
    for (int unit = launder_s((int)blockIdx.x); unit < 256; unit += F.G) {
        const int mt = unit >> 6, nt = unit & 63;
        f32x16 tot;
#pragma unroll
        for (int i = 0; i < 16; ++i) tot[i] = 0.f;
#pragma unroll
        for (int br = 0; br < 3; ++br) {
            const int K = br == 1 ? 512 : 1024, kw = K / 8;
            const bf16* A = (const bf16*)(F.ws + (br == 0 ? WS_OUTA : br == 1 ? WS_OUTB : WS_OC)); const bf16* Bt = (const bf16*)(wl + (br == 0 ? WO_BRA : br == 1 ? WO_BRB : WO_BRC));
            f32x16 acc;
#pragma unroll
            for (int i = 0; i < 16; ++i) acc[i] = 0.f;
            acc = skinny_kloop(A + (size_t)(MP + 32 * mt + r) * K + F.wave * kw + 8 * h, Bt + (size_t)(32 * nt + r) * K + F.wave * kw + 8 * h, kw / 16, acc);
            const bf16* gp = PROJ + (size_t)(MP + 32 * mt + 4 * h) * NIN + PC_GATE + br * 2048 + 32 * nt + r;
#pragma unroll
            for (int i = 0; i < 16; ++i) tot[i] += acc[i] * bf1(gp[(size_t)((i & 3) + 8 * (i >> 2)) * NIN]);
        }
        const f32x2 o = skinny_reduce(F, tot);
        *(unsigned*)((bf16*)(F.ws + WS_MERGED) + (size_t)(MP + 32 * mt + (F.tid >> 4)) * D + 32 * nt + 2 * (F.tid & 15)) = pk2(o.x, o.y);
    }
}

constexpr int N_PHASES = 1 + 11 * DEPTH;
__global__ void __launch_bounds__(NWAVES * 64, 2) fwd(Args args) {
    extern __shared__ __attribute__((aligned(16))) unsigned char lds_raw[];
    Frame F;
    F.lds = (LAS unsigned char*)lds_raw;
    F.tid = threadIdx.x; F.lane = F.tid & 63; F.wave = __builtin_amdgcn_readfirstlane(F.tid >> 6);
    F.G = gridDim.x; { const int bx = blockIdx.x; F.vcu = (F.G % 8 == 0) ? (bx % 8) * (F.G / 8) + bx / 8 : bx; }
    const CAS Args* const ap = (const CAS Args*)__builtin_amdgcn_kernarg_segment_ptr();
    F.in = ap->in; F.out = args.out; F.ws = args.ws;
    volatile LAS unsigned* MISC = (volatile LAS unsigned*)(F.lds + MISC_OFF);
    for (int u = F.tid; u < (LDS_BYTES - LDSCTL_OFF) / 4; u += NWAVES * 64) ((LAS unsigned*)(F.lds + LDSCTL_OFF))[u] = 0u;
    __syncthreads();
#if MK_ONE_LAUNCH
    XcdBarrier bar = xcd_barrier_post((unsigned*)(F.ws + WS_CTL) + CW_BAR, MISC + 8);
#define GRID_BAR() xcd_barrier(bar)
#else
#define GRID_BAR() do {} while (0)
#endif
    const int lo = args.ph_lo, hi = args.ph_hi;
#ifndef PHMASK
#define PHMASK 0xfff
#endif
#define IN(k) (lo <= (k) && (k) < hi)
#define EN(j) ((PHMASK >> (j)) & 1)
#ifndef REPMASK
#define REPMASK 0
#endif
#ifndef SUBREP
#define SUBREP 0
#endif
#define SUBR(j) for (int sr_ = 0; sr_ < 1 + ((SUBREP >> (j)) & 1); ++sr_)
#define REPEAT(j) for (int rep_ = 0; rep_ < 1 + ((REPMASK >> (j)) & 1); ++rep_)
#define REPBAR() do { if (rep_) GRID_BAR(); F.ws = launder_p(args.ws); F.out = launder_p(args.out); F.in = launder_k(ap->in); F.vcu = launder_s(vcu0); F.wave = launder_s(wave0); gw = F.vcu * NWAVES + F.wave; } while (0)
#define SEAM(k) do { if (IN(k) && IN((k) + 1)) GRID_BAR(); } while (0)
    const int vcu0 = F.vcu, wave0 = F.wave; int gw = F.vcu * NWAVES + F.wave; const int NGW = F.G * NWAVES;
    bf16* const H = (bf16*)(F.ws + WS_H); bf16* const PROJ = (bf16*)(F.ws + WS_PROJ);

    if (EN(0) && IN(0)) REPEAT(0) { REPBAR();
        LAS float* scr = (LAS float*)(F.lds + F.wave * 16384);
        for (int it = gw; it < 2 * IT_LAYER; it += NGW) { const int l = it >= IT_LAYER ? 1 : 0; weight_item(F, l, it - l * IT_LAYER, scr); }
        __syncthreads();
        stage_wba(F, 0);
        thin_rows<true>(F, F.in[0], F.in[1], nullptr, nullptr, nullptr, F.in[21], true, 0);
        __syncthreads();
    }
    SEAM(0);
#pragma unroll 1
    for (int l = 0; l < DEPTH; ++l) {
        const int pb = 1 + 11 * l;
        unsigned char* wl = F.ws + WS_W + (size_t)l * WL_BYTES;
        if (EN(1) && IN(pb + 0)) REPEAT(1) { REPBAR();
            pg8::Gemm g{H, (const bf16*)(wl + WO_IN), D, D, D, 0, (unsigned*)(F.ws + WS_PAD)}; pg8::StaticOrder S; S.init(MT, NIN, launder_s(F.G), launder_s((int)blockIdx.x));
            EpiStore E{PROJ, NIN, PC_GATE / 256};
            pg8::gemm_phase<EpiStore, pg8::StaticOrder, true, true>(F.lds, g, S, E);
        }
        SEAM(pb + 0);
        if (EN(2) && IN(pb + 1)) REPEAT(2) { REPBAR(); for (int it = gw; it < PREP_ITEMS; it += NGW) prep_item(F, l, it); prep_out_rows(F, l); for (int it = gw; it < VT_ITEMS; it += NGW) vt_item(F, it); }
        SEAM(pb + 1);
        if (EN(3) && IN(pb + 2)) REPEAT(3) { REPBAR(); for (int it = gw; it < GCH; it += NGW) gdn_ga_item(F, it); }
        SEAM(pb + 2);
        if (EN(4) && IN(pb + 3)) REPEAT(4) { REPBAR();
            if (F.tid == 0) MISC[16] = 0u;
            { pg8::Gemm g{(const bf16*)(F.ws + WS_POOLED), (const bf16*)(wl + WO_POOL), 1024, 256, 256, 512}; pg8::StaticOrder S; S.init(MT, 1024, launder_s(F.G), launder_s((int)blockIdx.x));
              EpiStore E{(bf16*)(F.ws + WS_OC), 1024, 1 << 30};
              pg8::gemm_phase<EpiStore, pg8::StaticOrder>(F.lds, g, S, E); }
            SUBR(3) for (int it = gw; it < DB * HA * 8; it += NGW) { const int s = it & 7, bh = it >> 3, b = bh >> 3, h = bh & 7;
                gdn_scan_item(F, MP + DS * b, h, s, F.in[5] + (size_t)((l * DB + b) * HA + h) * 16384, F.out + O_SGDN + (size_t)((l * DB + b) * HA + h) * 16384); }
            {
                const bool scanw = (F.wave == 0) && (F.vcu < GSC_ITEMS);
                if (scanw) { SUBR(0) gdn_chunk_scan(F, l, F.vcu); }
                else {
                    const int aw = F.vcu < GSC_ITEMS ? F.vcu * 7 + F.wave - 1 : GSC_ITEMS * 7 + (F.vcu - GSC_ITEMS) * 8 + F.wave, naw = F.G * 8 - GSC_ITEMS;
                    SUBR(1) for (int it = aw; it < ATT_UNITS; it += naw) attn_unit(F, it);
                    SUBR(2) for (int it = (aw + naw - ATT_UNITS % naw) % naw; it < MS * 6; it += naw) attn_sample_item(F, l, it);
                }
            }
            side_queue(F, l, MISC + 16);
        }
        SEAM(pb + 3);
        if (EN(5) && IN(pb + 4)) REPEAT(5) { REPBAR(); gdn_gate_rows(F, l); }
        SEAM(pb + 4);
        if (EN(6) && IN(pb + 5)) REPEAT(6) { REPBAR();
            pg8::StaticOrder S; S.init(MP, D, launder_s(F.G), launder_s((int)blockIdx.x)); bf16* MG = (bf16*)(F.ws + WS_MERGED);
            { pg8::Gemm g{(const bf16*)(F.ws + WS_OUTA), (const bf16*)(wl + WO_BRA), 1024, 1024, 1024, 0}; EpiMerge<false> E{MG, PROJ + PC_GATE}; pg8::gemm_phase<EpiMerge<false>, pg8::StaticOrder>(F.lds, g, S, E); }
            { pg8::Gemm g{(const bf16*)(F.ws + WS_OUTB), (const bf16*)(wl + WO_BRB), 512, 512, 512, 0}; EpiMerge<true> E{MG, PROJ + PC_GATE + 2048}; pg8::gemm_phase<EpiMerge<true>, pg8::StaticOrder>(F.lds, g, S, E); }
            { pg8::Gemm g{(const bf16*)(F.ws + WS_OC), (const bf16*)(wl + WO_BRC), 1024, 1024, 1024, 0}; EpiMerge<true> E{MG, PROJ + PC_GATE + 4096}; pg8::gemm_phase<EpiMerge<true>, pg8::StaticOrder>(F.lds, g, S, E); }
            skinny_merge(F, wl);
        }
        SEAM(pb + 5);
        if (EN(7) && IN(pb + 6)) REPEAT(7) { REPBAR();
            pg8::Gemm g{(const bf16*)(F.ws + WS_MERGED), (const bf16*)(wl + WO_OUT), D, D, D, 0}; pg8::StaticOrder S; S.init(MP, D, launder_s(F.G), launder_s((int)blockIdx.x));
            EpiStore E{(bf16*)(F.ws + WS_Y), D, 1 << 30};
            pg8::gemm_phase<EpiStore, pg8::StaticOrder>(F.lds, g, S, E);
            skinny_store(F, (const bf16*)(F.ws + WS_MERGED), D, (const bf16*)(wl + WO_OUT), D, (bf16*)(F.ws + WS_Y));
        }
        SEAM(pb + 6);
        if (EN(8) && IN(pb + 7)) REPEAT(8) { REPBAR();
            thin_rows<false>(F, nullptr, nullptr, (const bf16*)(F.ws + WS_Y), F.in[22] + (size_t)l * D, nullptr, F.in[23] + (size_t)l * D, false, 0, 0);
        }
        SEAM(pb + 7);
        if (EN(9) && IN(pb + 8)) REPEAT(9) { REPBAR();
            pg8::Gemm g{H, (const bf16*)(wl + WO_GU), D, D, D, 0, (unsigned*)(F.ws + WS_PAD)}; pg8::StaticOrder S; S.init(MT, 2 * DFF, launder_s(F.G), launder_s((int)blockIdx.x));
            EpiSwiglu E{(bf16*)(F.ws + WS_ACT)};
            pg8::gemm_phase<EpiSwiglu, pg8::StaticOrder, true, true>(F.lds, g, S, E);
            const int bxl = launder_s((int)blockIdx.x), Gl = launder_s(F.G);
            if (Gl == 256 && bxl >= 256 - CP_TAIL_WG) {
                Frame Fc = F; Fc.lane = launder(F.lane);
                const int base = CP_NSUB - CP_TAIL + (bxl - (256 - CP_TAIL_WG)) * CP_TAIL_PER_WG;
                for (int q = F.wave; q < CP_TAIL_PER_WG; q += NWAVES) copy_subchunk(Fc, 1 - l, base + q);
            }
        }
        SEAM(pb + 8);
        if (EN(10) && IN(pb + 9)) REPEAT(10) { REPBAR();
            pg8::Gemm g{(const bf16*)(F.ws + WS_ACT), (const bf16*)(wl + WO_DOWN), DFF, DFF, DFF, 0}; pg8::StaticOrder S; S.init(MP, D, launder_s(F.G), launder_s((int)blockIdx.x));
            EpiStore E{(bf16*)(F.ws + WS_Y), D, 1 << 30};
            pg8::gemm_phase<EpiStore, pg8::StaticOrder>(F.lds, g, S, E);
            skinny_store(F, (const bf16*)(F.ws + WS_ACT), DFF, (const bf16*)(wl + WO_DOWN), DFF, (bf16*)(F.ws + WS_Y));
        }
        SEAM(pb + 9);
        if (EN(11) && IN(pb + 10)) REPEAT(11) { REPBAR();
            if (l + 1 < DEPTH) { stage_wba(F, l + 1);
                thin_rows<false>(F, nullptr, nullptr, (const bf16*)(F.ws + WS_Y), F.in[24] + (size_t)l * D, nullptr, F.in[21] + (size_t)(l + 1) * D, true, l + 1, 0);
                __syncthreads(); }
            else thin_rows<false>(F, nullptr, nullptr, (const bf16*)(F.ws + WS_Y), F.in[24] + (size_t)l * D, F.out + O_YP, nullptr, false, 0, 0);
        }
        SEAM(pb + 10);
    }
#undef IN
#undef SEAM
}

extern "C" void kernel_launch(void* const* d_in, const int* in_sizes, int n_in, void* d_out, int out_size, void* d_ws, size_t ws_size, hipStream_t stream) {
    static int grid = 0;
    if (grid == 0) {
        if (n_in != 25 || (size_t)out_size != O_END || ws_size < WS_END) { fprintf(stderr, "kernel_launch: unexpected sizes n_in %d out %d ws %zu\n", n_in, out_size, ws_size); grid = -1; return; }
        int dev = 0, cus = 0, per_cu = 0;
        if (hipGetDevice(&dev) != hipSuccess || hipDeviceGetAttribute(&cus, hipDeviceAttributeMultiprocessorCount, dev) != hipSuccess) { grid = -1; return; }
        if (hipFuncSetAttribute((const void*)fwd, hipFuncAttributeMaxDynamicSharedMemorySize, LDS_BYTES) != hipSuccess) { fprintf(stderr, "kernel_launch: hipFuncSetAttribute failed\n"); grid = -1; return; }
        if (hipOccupancyMaxActiveBlocksPerMultiprocessor(&per_cu, (const void*)fwd, NWAVES * 64, LDS_BYTES) != hipSuccess || per_cu < 1) fprintf(stderr, "kernel_launch: occupancy query says %d\n", per_cu);
        (void)hipGetLastError();
        grid = cus;
    }
    if (grid < 0) return;
    if (hipMemsetAsync((char*)d_ws + WS_CTL, 0, CTL_BYTES, stream) != hipSuccess) return;
    Args a{};
    for (int i = 0; i < 25; ++i) a.in[i] = (const float*)d_in[i];
    a.out = (float*)d_out; a.ws = (unsigned char*)d_ws;
#if MK_ONE_LAUNCH
    a.ph_lo = 0; a.ph_hi = N_PHASES;
    hipLaunchKernelGGL(fwd, dim3(grid), dim3(NWAVES * 64), LDS_BYTES, stream, a);
#else
    for (int p = 0; p < N_PHASES; ++p) { a.ph_lo = p; a.ph_hi = p + 1; hipLaunchKernelGGL(fwd, dim3(grid), dim3(NWAVES * 64), LDS_BYTES, stream, a); }
#endif
}
```

```cpp
#include <hip/hip_runtime.h>
#include <cstdio>
#include <cstdint>

#ifndef MK_ONE_LAUNCH
#define MK_ONE_LAUNCH 1
#endif

#define GAS __attribute__((address_space(1)))
#define CAS __attribute__((address_space(4)))
typedef const float* cfp_t;
#define LAS __attribute__((address_space(3)))
typedef unsigned short bf16;
typedef unsigned v4u __attribute__((ext_vector_type(4)));
typedef unsigned v2u __attribute__((ext_vector_type(2)));
typedef float f32x4 __attribute__((ext_vector_type(4)));
typedef float f32x2 __attribute__((ext_vector_type(2)));
typedef short bf16x8 __attribute__((ext_vector_type(8)));
typedef float f32x16 __attribute__((ext_vector_type(16)));

constexpr int D = 2048, BATCH = 4, SEQ = 2048, DEPTH = 2, DB = 32, DS = 4;
constexpr int MP = BATCH * SEQ;
constexpr int MS = DB * DS;
constexpr int MV = MP + MS;
constexpr int MT = 8448;
constexpr int HA = 8, CONVCH = 3072;
constexpr int CPOOL = 1024, PHIST = 15;
constexpr int DFF = 5632;
constexpr int NIN_SRC = 15888, NIN = 15872;
constexpr int PC_ZA = 3072, PC_QB = 4096, PC_KB = 5632, PC_VB = 7168, PC_UC = 8704, PC_GATE = 9728;
constexpr float EPS = 1e-6f;
constexpr size_t O_YP = 0, O_YS = O_YP + (size_t)MP * D, O_PW1 = O_YS + (size_t)MS * D;
constexpr size_t O_PW2 = O_PW1 + (size_t)2 * 4 * 128 * 1024, O_PW3 = O_PW2 + (size_t)2 * 4 * 512 * 1024, O_PGDN = O_PW3 + (size_t)2 * 4 * 2048 * 1024;
constexpr size_t O_PCONV = O_PGDN + (size_t)2 * 4 * 8 * 16384, O_PPOOL = O_PCONV + (size_t)2 * 4 * 3 * 3072, O_SW1 = O_PPOOL + (size_t)2 * 4 * 15 * 1024;
constexpr size_t O_SW2 = O_SW1 + (size_t)2 * 32 * 128 * 1024, O_SW3 = O_SW2 + (size_t)2 * 32 * 512 * 1024, O_SGDN = O_SW3 + (size_t)2 * 32 * 2048 * 1024;
constexpr size_t O_SCONV = O_SGDN + (size_t)2 * 32 * 8 * 16384, O_SPOOL = O_SCONV + (size_t)2 * 32 * 3 * 3072, O_END = O_SPOOL + (size_t)2 * 32 * 15 * 1024;
static_assert(O_END == 226426880ull, "output size");

constexpr size_t WS_CTL = 0, CTL_BYTES = 1u << 20;
constexpr size_t SZ_WIN = (size_t)NIN * D * 2, SZ_WBRA = (size_t)D * 1024 * 2, SZ_WBRB = (size_t)D * 512 * 2, SZ_WBRC = (size_t)D * 1024 * 2, SZ_WPOOL = (size_t)4 * 256 * 256 * 2;
constexpr size_t SZ_WOUT = (size_t)D * D * 2, SZ_WGU = (size_t)2 * DFF * D * 2, SZ_WDOWN = (size_t)D * DFF * 2;
constexpr size_t WO_IN = 0, WO_BRA = WO_IN + SZ_WIN, WO_BRB = WO_BRA + SZ_WBRA, WO_BRC = WO_BRB + SZ_WBRB, WO_POOL = WO_BRC + SZ_WBRC, WO_OUT = WO_POOL + SZ_WPOOL;
constexpr size_t WO_GU = WO_OUT + SZ_WOUT, WO_DOWN = WO_GU + SZ_WGU, WL_BYTES = WO_DOWN + SZ_WDOWN;
constexpr size_t WS_W = CTL_BYTES;
constexpr size_t WS_H = WS_W + 2 * WL_BYTES;
constexpr size_t WS_PROJ = WS_H + (size_t)MT * D * 2;
constexpr size_t WS_GB = WS_PROJ + (size_t)MT * NIN * 2;
constexpr size_t WS_TOK = WS_GB + (size_t)MT * 16 * 4;
constexpr size_t WS_QN = WS_TOK + (size_t)MT * 8 * 16;
constexpr size_t WS_KN = WS_QN + (size_t)MT * 1024 * 2;
constexpr size_t WS_VV = WS_KN + (size_t)MT * 1024 * 2;
constexpr size_t WS_ORAW = WS_VV + (size_t)MT * 1024 * 2;
constexpr size_t WS_POOLED = WS_ORAW + (size_t)MT * 1024 * 4;
constexpr size_t WS_OUTA = WS_POOLED + (size_t)MT * 1024 * 2;
constexpr size_t WS_OUTB = WS_OUTA + (size_t)MT * 1024 * 2;
constexpr size_t WS_OC = WS_OUTB + (size_t)MT * 512 * 2;
constexpr size_t WS_MERGED = WS_OC + (size_t)MT * 1024 * 2;
constexpr size_t WS_Y = WS_MERGED + (size_t)MT * D * 2;
constexpr size_t WS_X1 = WS_Y + (size_t)MT * D * 2;
constexpr size_t WS_X2 = WS_X1 + (size_t)MT * D * 4;
constexpr size_t WS_ACT = WS_X2 + (size_t)MT * D * 4;
constexpr size_t WS_VT = WS_ACT + (size_t)MT * DFF * 2;
constexpr size_t WS_OBG = WS_VT + (size_t)BATCH * 3 * 4 * 128 * 2048 * 2;
constexpr size_t WS_AST = WS_OBG + (size_t)6 * MV * 512 * 2;
constexpr int GCH = BATCH * HA * (SEQ / 32);
constexpr size_t WS_WF = WS_AST + (size_t)6 * MV * 4 * 8;
constexpr size_t WS_KF = WS_WF + (size_t)GCH * 8192;
constexpr size_t WS_UF = WS_KF + (size_t)GCH * 8192;
constexpr size_t WS_AF = WS_UF + (size_t)GCH * 16384;
constexpr size_t WS_TB = WS_AF + (size_t)GCH * 2048;
constexpr size_t WS_QF = WS_TB + (size_t)GCH * 128;
constexpr size_t WS_XCH = WS_QF + (size_t)GCH * 8192;
constexpr size_t WS_PAD = WS_XCH + (size_t)4 * 32 * 256 * 8 * 16;
constexpr size_t WS_END = WS_PAD + (size_t)1024 * 16 * 512 * 4;
static_assert(WS_END < 2000000000ull, "workspace");

__device__ __forceinline__ int lane_id() { return (int)__builtin_amdgcn_mbcnt_hi(~0u, __builtin_amdgcn_mbcnt_lo(~0u, 0u)); }
namespace pg8 {
#define PG8_LAS __attribute__((address_space(3)))
typedef unsigned short bf16_t;
typedef unsigned u32x4 __attribute__((ext_vector_type(4)));
constexpr int BM = 256, BK = 64, HALF = 128, HTB = HALF * BK * 2, STAGE_BYTES = 8 * HTB, NXCD = 8, WGM = 8;
__host__ __device__ __forceinline__ int lds_byte(int r, int c) { const int st = (r >> 4) * 2 + (c >> 5), rr = r & 15, cc = c & 31, ob = rr * 64 + cc * 2; return st * 1024 + (ob ^ (((ob >> 9) & 1) << 5)); }
__host__ __device__ __forceinline__ void stage_rc(int b, int& R, int& C) { const int st = b / 1024, sb = b % 1024, swz = sb ^ (((sb >> 9) & 1) << 5); R = (st >> 1) * 16 + swz / 64; C = (st & 1) * 32 + (swz % 64) / 2; }
__host__ __device__ __forceinline__ int perm32(int rho) { const int n = rho >> 4, i = rho & 15; return 8 * (i >> 2) + 4 * n + (i & 3); }
struct Unit { int pm, pn; };
struct Gemm { const bf16_t* A; const bf16_t* Bt; int lda, ldb, K; int a_pn_step; unsigned* pad = nullptr; };
struct StaticOrder {
    int nM, nN, nwg, G, c;
    __host__ __device__ void init(int M, int N, int G_, int c_) { nM = M / BM; nN = N / BM; nwg = nM * nN; G = G_; c = c_; }
    __host__ __device__ bool next(int i, Unit& u) const {
        const long L = (long)i * G + c; if (L >= nwg) return false;
        int wgid = (int)L; { const int q = nwg / NXCD, r = nwg % NXCD, xcd = wgid % NXCD, off = wgid / NXCD; wgid = (xcd < r ? xcd * (q + 1) : r * (q + 1) + (xcd - r) * q) + off; }
        const int nig = WGM * nN, gid = wgid / nig, fm = gid * WGM, gsz = (nM - fm) < WGM ? (nM - fm) : WGM;
        u.pm = fm + ((wgid % nig) % gsz); u.pn = (wgid % nig) / gsz; return true;
    }
    __device__ __forceinline__ void a_ready(const Unit&) const {}
    __device__ __forceinline__ void done(const Unit&) const {}
};
__device__ __forceinline__ unsigned cvt_pk_bf16(float lo, float hi) { unsigned r; asm volatile("v_cvt_pk_bf16_f32 %0, %1, %2" : "=v"(r) : "v"(lo), "v"(hi)); return r; }

template <class Epi, class Sched, bool ALIGN_EPI = true, bool RELAX = false>
__device__ __forceinline__ void gemm_phase(PG8_LAS unsigned char* lds, const Gemm g, const Sched& S, const Epi& E) {
    int tid = threadIdx.x; asm volatile("" : "+v"(tid));
    const int wid = __builtin_amdgcn_readfirstlane(tid >> 6), lane = tid & 63, wr = wid >> 2, wc = wid & 3, fr = lane & 15, fq = lane >> 4;
    int K = g.K; asm volatile("" : "+s"(K));
    const int nt = K / BK;
    unsigned voffA[2], voffB[2];
#pragma unroll
    for (int i = 0; i < 2; ++i) { int R, C; stage_rc(tid * 16 + i * 8192, R, C); const int Rb = ((R & ~31) + perm32(R & 31));
        voffA[i] = (unsigned)(R * g.lda + C) * 2u; voffB[i] = (unsigned)(Rb * g.ldb + C) * 2u; }
    const size_t kstep = (size_t)(BK * 2);
    const size_t hstepA = (size_t)HALF * g.lda * 2, hstepB = (size_t)HALF * g.ldb * 2;
    const size_t tstepA = 2 * hstepA, tstepB = 2 * hstepB;
    const unsigned ldsw = (unsigned)wid * 1024u;
    const int aoff = lds_byte(wr * 64 + fr, fq * 8), boff = lds_byte(wc * 32 + fr, fq * 8);
#define PG8_SA(b, h) (((b) * 2 + (h)) * HTB)
#define PG8_SB(b, h) ((4 + (b) * 2 + (h)) * HTB)
#define PG8_STAGE(bufoff, gbase, voff) do { const char* _gb = (const char*)(gbase); asm volatile("" : "+s"(_gb));     \
        _Pragma("unroll") for (int _i = 0; _i < 2; ++_i) { unsigned _vo = (voff)[_i]; asm volatile("" : "+v"(_vo));     \
        __builtin_amdgcn_global_load_lds((const unsigned*)(_gb + _vo), (PG8_LAS unsigned*)(lds + (bufoff) + ldsw + _i * 8192), 16, 0, 0); } } while (0)
#define PG8_LDA(dst, b, h) do { _Pragma("unroll") for (int m = 0; m < 4; ++m) _Pragma("unroll") for (int k = 0; k < 2; ++k) dst[m][k] = *(const PG8_LAS bf16x8*)(lds + PG8_SA(b, h) + aoff + m * 2048 + k * 1024); } while (0)
#define PG8_LDB(dst, b, h) do { _Pragma("unroll") for (int n = 0; n < 2; ++n) _Pragma("unroll") for (int k = 0; k < 2; ++k) dst[n][k] = *(const PG8_LAS bf16x8*)(lds + PG8_SB(b, h) + boff + n * 2048 + k * 1024); } while (0)
#define PG8_MMA(ai, bj, At, Bt) do { __builtin_amdgcn_s_setprio(1); _Pragma("unroll") for (int m = 0; m < 4; ++m) _Pragma("unroll") for (int n = 0; n < 2; ++n) _Pragma("unroll") for (int k = 0; k < 2; ++k) \
        acc[ai][bj][m][n] = __builtin_amdgcn_mfma_f32_16x16x32_bf16(Bt[n][k], At[m][k], acc[ai][bj][m][n], 0, 0, 0); __builtin_amdgcn_s_setprio(0); } while (0)
#define PG8_WAIT_V(n) asm volatile("s_waitcnt vmcnt(" #n ")" ::: "memory")
#define PG8_WAIT_L(n) asm volatile("s_waitcnt lgkmcnt(" #n ")" ::: "memory")
#define PG8_BAR __builtin_amdgcn_s_barrier()
#define PG8_SCHED __builtin_amdgcn_sched_barrier(0)
    Unit cur, nxt; int ui = 0;
    if (!S.next(0, cur)) return;
    f32x4 acc[2][2][4][2];
#pragma unroll
    for (int a = 0; a < 2; ++a)
#pragma unroll
        for (int b = 0; b < 2; ++b)
#pragma unroll
            for (int m = 0; m < 4; ++m)
#pragma unroll
                for (int n = 0; n < 2; ++n) acc[a][b][m][n] = (f32x4){0.f, 0.f, 0.f, 0.f};
    bf16x8 At[4][2], B0[2][2], B1[2][2];
    const char* cA = (const char*)g.A + (size_t)cur.pm * tstepA + (size_t)cur.pn * (size_t)g.a_pn_step; const char* cB = (const char*)g.Bt + (size_t)cur.pn * tstepB;
    S.a_ready(cur);
    PG8_STAGE(PG8_SB(0, 0), cB, voffB); PG8_STAGE(PG8_SB(0, 1), cB + hstepB, voffB); PG8_STAGE(PG8_SA(0, 0), cA, voffA); PG8_STAGE(PG8_SA(0, 1), cA + hstepA, voffA);
    if (wr == 1) PG8_BAR;
    PG8_WAIT_V(2); PG8_BAR;
    PG8_STAGE(PG8_SB(1, 0), cB + kstep, voffB); PG8_STAGE(PG8_SA(1, 0), cA + kstep, voffA); PG8_STAGE(PG8_SB(1, 1), cB + hstepB + kstep, voffB);
    PG8_WAIT_V(6); PG8_BAR;
    if constexpr (RELAX && Epi::NSTORE > 0) {
#pragma unroll
        for (int i = 0; i < Epi::NSTORE; ++i) __builtin_nontemporal_store((unsigned)tid, (__attribute__((address_space(1))) unsigned*)g.pad + ((size_t)blockIdx.x * 16 + i) * 512 + tid);
    }
    for (;;) {
        const bool has_next = S.next(ui + 1, nxt);
        const char* nA = has_next ? (const char*)g.A + (size_t)nxt.pm * tstepA + (size_t)nxt.pn * (size_t)g.a_pn_step : cA; const char* nB = has_next ? (const char*)g.Bt + (size_t)nxt.pn * tstepB : cB;
#define PG8_TRIP(W1, W2) do { \
            const bool last = (t == nt - 2); \
            const char* a1 = cA + (size_t)(t + 1) * kstep; \
            const char* a2 = last ? nA : cA + (size_t)(t + 2) * kstep; const char* b2 = last ? nB : cB + (size_t)(t + 2) * kstep; \
            const char* a3 = a2 + kstep; const char* b3 = b2 + kstep; \
            if (last && has_next) S.a_ready(nxt); \
            PG8_LDB(B0, 0, 0); PG8_LDB(B1, 0, 1); PG8_SCHED; PG8_LDA(At, 0, 0); PG8_STAGE(PG8_SA(1, 1), a1 + hstepA, voffA); \
            W1; PG8_WAIT_L(0); PG8_BAR; PG8_MMA(0, 0, At, B0); PG8_MMA(0, 1, At, B1); PG8_BAR; PG8_SCHED; \
            PG8_LDA(At, 0, 1); PG8_STAGE(PG8_SB(0, 0), b2, voffB); PG8_STAGE(PG8_SB(0, 1), b2 + hstepB, voffB); PG8_STAGE(PG8_SA(0, 0), a2, voffA); \
            W2; PG8_WAIT_L(0); PG8_BAR; PG8_MMA(1, 0, At, B0); PG8_MMA(1, 1, At, B1); PG8_BAR; PG8_SCHED; \
            PG8_LDB(B0, 1, 0); PG8_LDB(B1, 1, 1); PG8_SCHED; PG8_LDA(At, 1, 0); PG8_STAGE(PG8_SA(0, 1), a2 + hstepA, voffA); \
            PG8_WAIT_V(8); PG8_WAIT_L(0); PG8_BAR; PG8_MMA(0, 0, At, B0); PG8_MMA(0, 1, At, B1); PG8_BAR; PG8_SCHED; \
            PG8_LDA(At, 1, 1); PG8_STAGE(PG8_SB(1, 0), b3, voffB); PG8_STAGE(PG8_SB(1, 1), b3 + hstepB, voffB); PG8_STAGE(PG8_SA(1, 0), a3, voffA); \
            PG8_WAIT_V(8); PG8_WAIT_L(0); PG8_BAR; PG8_MMA(1, 0, At, B0); PG8_MMA(1, 1, At, B1); PG8_BAR; PG8_SCHED; } while (0)
        int t = 0;
        if constexpr (RELAX && Epi::NSTORE == 16) { PG8_TRIP(PG8_WAIT_V(24), PG8_WAIT_V(24)); t = 2; }
        if constexpr (RELAX && Epi::NSTORE == 8) { PG8_TRIP(PG8_WAIT_V(16), PG8_WAIT_V(16)); t = 2; }
        for (; t < nt; t += 2) PG8_TRIP(PG8_WAIT_V(8), PG8_WAIT_V(8));
#undef PG8_TRIP
        if constexpr (ALIGN_EPI) { if (wr == 0) PG8_BAR; }
        if constexpr (!Epi::AFTER_DRAIN) { E(acc, cur, wr, wc, fr, fq); S.done(cur); }
        if (!has_next) break;
#pragma unroll
        for (int a = 0; a < 2; ++a)
#pragma unroll
            for (int b = 0; b < 2; ++b)
#pragma unroll
                for (int m = 0; m < 4; ++m)
#pragma unroll
                    for (int n = 0; n < 2; ++n) acc[a][b][m][n] = (f32x4){0.f, 0.f, 0.f, 0.f};
        cur = nxt; cA = nA; cB = nB; ++ui;
        if constexpr (ALIGN_EPI) { if (wr == 1) PG8_BAR; }
    }
    PG8_WAIT_V(0);
    if constexpr (!ALIGN_EPI) { if (wr == 0) PG8_BAR; }
    PG8_BAR;
    if constexpr (Epi::AFTER_DRAIN) { E.fused(acc, cur, wr, wc, fr, fq, lds, wid, lane); S.done(cur); }
#undef PG8_SA
#undef PG8_SB
#undef PG8_STAGE
#undef PG8_LDA
#undef PG8_LDB
#undef PG8_MMA
#undef PG8_WAIT_V
#undef PG8_WAIT_L
#undef PG8_BAR
#undef PG8_SCHED
}
}

#define LDS_WAIT() asm volatile("s_waitcnt lgkmcnt(0)" ::: "memory")
#define VM_WAIT() asm volatile("s_waitcnt vmcnt(0)" ::: "memory")
__device__ __forceinline__ unsigned f2bf(float f) { unsigned u = __builtin_bit_cast(unsigned, f); return (u + 0x7fffu + ((u >> 16) & 1u)) >> 16; }
typedef __bf16 bf16v2 __attribute__((ext_vector_type(2)));
__device__ __forceinline__ unsigned pk2(float lo, float hi) { const f32x2 v = {lo, hi}; return __builtin_bit_cast(unsigned, __builtin_convertvector(v, bf16v2)); }
__device__ __forceinline__ float bf_lo(unsigned u) { return __builtin_bit_cast(float, u << 16); }
__device__ __forceinline__ float bf_hi(unsigned u) { return __builtin_bit_cast(float, u & 0xffff0000u); }
__device__ __forceinline__ float bf1(bf16 b) { return __builtin_bit_cast(float, ((unsigned)b) << 16); }
__device__ __forceinline__ void unpack8(const v4u u, float (&x)[8]) { x[0] = bf_lo(u.x); x[1] = bf_hi(u.x); x[2] = bf_lo(u.y); x[3] = bf_hi(u.y); x[4] = bf_lo(u.z); x[5] = bf_hi(u.z); x[6] = bf_lo(u.w); x[7] = bf_hi(u.w); }
__device__ __forceinline__ v4u pack8(const float (&x)[8]) { v4u o; o.x = pk2(x[0], x[1]); o.y = pk2(x[2], x[3]); o.z = pk2(x[4], x[5]); o.w = pk2(x[6], x[7]); return o; }
__device__ __forceinline__ float wave_max(float v) {
#pragma unroll
    for (int o = 1; o < 64; o <<= 1) v = fmaxf(v, __shfl_xor(v, o));
    return v;
}
template <int CTRL> __device__ __forceinline__ float dpp_f(float x) { return __builtin_bit_cast(float, __builtin_amdgcn_update_dpp(0, __builtin_bit_cast(int, x), CTRL, 0xf, 0xf, true)); }
__device__ __forceinline__ float row16_sum(float x) { x += dpp_f<0xB1>(x); x += dpp_f<0x4E>(x); x += dpp_f<0x124>(x); x += dpp_f<0x128>(x); return x; }
__device__ __forceinline__ float wave_sum(float v) { v = row16_sum(v); v += __shfl_xor(v, 16); v += __shfl_xor(v, 32); return v; }
__device__ __forceinline__ float sigm(float x) { return __builtin_amdgcn_rcpf(1.f + __expf(-x)); }
__device__ __forceinline__ float silu(float x) { return x * __builtin_amdgcn_rcpf(1.f + __expf(-x)); }

#define XB_TMO      128
#define XB_XCNT(j)  (256  + 64 * (j))
#define XB_XSUB(j)  (1280 + 64 * (j))
#define XB_XGEN(j)  (2304 + 64 * (j))
#define XB_TOP      3328
#define XB_TOPGEN   3392
#define XCD_BAR_WORDS 3456
#define XB_SPIN_CAP (1u << 18)
__device__ __forceinline__ unsigned xb_ld(unsigned* p)              { return __hip_atomic_load(p, __ATOMIC_RELAXED, __HIP_MEMORY_SCOPE_AGENT); }
__device__ __forceinline__ unsigned xb_add(unsigned* p, unsigned v) { return __hip_atomic_fetch_add(p, v, __ATOMIC_RELAXED, __HIP_MEMORY_SCOPE_AGENT); }
__device__ __forceinline__ unsigned xb_xcc_id() { return (unsigned)__builtin_amdgcn_s_getreg((3 << 11) | 20) & 0xFu; }
#define XB_SPIN(cond, bar) do { unsigned _sp = 0; while (cond) { __builtin_amdgcn_s_sleep(1); \
    if ((++_sp & 255u) == 0u) { if (xb_ld(&(bar)[XB_TMO])) break; if (_sp > XB_SPIN_CAP) { atomicAdd(&(bar)[XB_TMO], 1u); break; } } } } while (0)
struct XcdBarrier { unsigned* bar; unsigned x; volatile LAS unsigned* st; };
__device__ __forceinline__ XcdBarrier xcd_barrier_post(unsigned* bar, volatile LAS unsigned* st) {
    XcdBarrier b; b.bar = bar; b.x = xb_xcc_id(); b.st = st;
    if (threadIdx.x == 0) (void)xb_add(&bar[XB_XCNT(b.x)], 1u);
    return b;
}
__device__ __forceinline__ void xcd_barrier_complete(unsigned* bar, unsigned x, unsigned& nloc, unsigned& nx) {
    const unsigned G = gridDim.x * gridDim.y * gridDim.z;
    unsigned sum, cnt, mine, sp = 0u;
    for (;;) {
        sum = 0u; cnt = 0u; mine = 0u;
#pragma unroll
        for (unsigned j = 0; j < 16; ++j) { const unsigned c = xb_ld(&bar[XB_XCNT(j)]); sum += c; cnt += (c > 0u) ? 1u : 0u; mine = (j == x) ? c : mine; }
        if (sum == G) break;
        __builtin_amdgcn_s_sleep(1);
        if ((++sp & 255u) == 0u) { if (xb_ld(&bar[XB_TMO])) break; if (sp > XB_SPIN_CAP) { atomicAdd(&bar[XB_TMO], 1u); break; } }
    }
    nloc = mine > 0u ? mine : 1u; nx = cnt > 0u ? cnt : 1u;
}
__device__ __forceinline__ void xcd_barrier(const XcdBarrier& b) {
    asm volatile("s_waitcnt vmcnt(0)" ::: "memory");
    __syncthreads();
    if (threadIdx.x == 0) {
        unsigned* bar = b.bar;
        __builtin_amdgcn_s_waitcnt(0);
        unsigned nloc = b.st[0], nx = b.st[1];
        if (nloc == 0u) { xcd_barrier_complete(bar, b.x, nloc, nx); b.st[0] = nloc; b.st[1] = nx; }
        const unsigned old = xb_add(&bar[XB_XSUB(b.x)], 1u);
        const unsigned gen = old / nloc;
        if (old + 1u == (gen + 1u) * nloc) {
            __builtin_amdgcn_fence(__ATOMIC_RELEASE, "agent");
            asm volatile("s_waitcnt vmcnt(0)" ::: "memory");
            const unsigned og = xb_add(&bar[XB_TOP], 1u);
            const unsigned tg = og / nx;
            if (og + 1u == (tg + 1u) * nx) xb_add(&bar[XB_TOPGEN], 1u);
            else XB_SPIN(xb_ld(&bar[XB_TOPGEN]) == tg, bar);
            __builtin_amdgcn_fence(__ATOMIC_ACQUIRE, "agent");
            xb_add(&bar[XB_XGEN(b.x)], 1u);
            asm volatile("s_waitcnt vmcnt(0)" ::: "memory");
        } else {
            XB_SPIN(xb_ld(&bar[XB_XGEN(b.x)]) == gen, bar);
            __builtin_amdgcn_fence(__ATOMIC_ACQUIRE, "agent");
            asm volatile("s_waitcnt vmcnt(0)" ::: "memory");
        }
    }
    __syncthreads();
}

constexpr int NWAVES = 8;
constexpr int RING_BYTES = 131072, SCANTV_BYTES = 0, LDSCTL_OFF = RING_BYTES + SCANTV_BYTES, MISC_OFF = LDSCTL_OFF + 320, LDS_BYTES = 147456;
constexpr int CW_BAR = 4096;
constexpr int CW_TMO = 0, CW_RMS = 16384, RMS_BANK = 2048;

struct Args { const float* in[25]; float* out; unsigned char* ws; int ph_lo, ph_hi; };
struct Frame {
    LAS unsigned char* lds;
    int tid, lane, wave, vcu, G;
    const CAS cfp_t* in; float* out; unsigned char* ws;
};

__device__ __forceinline__ int launder(int x) { asm volatile("" : "+v"(x)); return x; }
__device__ __forceinline__ int launder_s(int x) { asm volatile("" : "+s"(x)); return x; }
template <class T> __device__ __forceinline__ T* launder_p(T* p) { asm volatile("" : "+s"(p)); return p; }
__device__ __forceinline__ const CAS cfp_t* launder_k(const CAS cfp_t* p) { asm volatile("" : "+s"(p)); return p; }
template <class T> __device__ __forceinline__ T* launder_pg(T* p) { GAS T* q = (GAS T*)p; asm volatile("" : "+s"(q)); return (T*)q; }
#define RELANE_G(F0) RELANE(F0); F.ws = launder_pg(F.ws); F.out = launder_pg(F.out)
#define RELANE(F0) Frame F = F0; F.lane = launder(F0.lane); F.tid = launder(F0.tid)

struct EpiStore {
    static constexpr bool AFTER_DRAIN = false; static constexpr int NSTORE = 16;
    bf16* O; int ldc; int sig_pn;
    __device__ __forceinline__ void operator()(const f32x4 (&acc)[2][2][4][2], const pg8::Unit& u, int wr, int wc, int fr, int fq) const {
        { const int l_ = launder(lane_id()); fr = l_ & 15; fq = l_ >> 4; }
        const int row0 = u.pm * 256 + wr * 64 + fr, col0 = u.pn * 256 + wc * 32 + 8 * fq; const bool sg = u.pn >= sig_pn;
#pragma unroll
        for (int ai = 0; ai < 2; ++ai)
#pragma unroll
            for (int m = 0; m < 4; ++m) { bf16* rowp = O + (size_t)(row0 + ai * 128 + m * 16) * ldc + col0;
#pragma unroll
                for (int bj = 0; bj < 2; ++bj) { f32x4 v0 = acc[ai][bj][m][0], v1 = acc[ai][bj][m][1];
                    if (sg) {
#pragma unroll
                        for (int j = 0; j < 4; ++j) { v0[j] = sigm(v0[j]); v1[j] = sigm(v1[j]); } }
                    v4u w; w.x = pg8::cvt_pk_bf16(v0[0], v0[1]); w.y = pg8::cvt_pk_bf16(v0[2], v0[3]); w.z = pg8::cvt_pk_bf16(v1[0], v1[1]); w.w = pg8::cvt_pk_bf16(v1[2], v1[3]);
                    *(v4u*)(rowp + bj * 128) = w; } }
    }
};
template <bool ACCUM> struct EpiMerge {
    static constexpr bool AFTER_DRAIN = false; static constexpr int NSTORE = 0;
    bf16* O; const bf16* gate;
    __device__ __forceinline__ void operator()(const f32x4 (&acc)[2][2][4][2], const pg8::Unit& u, int wr, int wc, int fr, int fq) const {
        { const int l_ = launder(lane_id()); fr = l_ & 15; fq = l_ >> 4; }
        const int row0 = u.pm * 256 + wr * 64 + fr, col0 = u.pn * 256 + wc * 32 + 8 * fq;
#pragma unroll
        for (int ai = 0; ai < 2; ++ai)
#pragma unroll
            for (int m = 0; m < 4; ++m) { const int row = row0 + ai * 128 + m * 16; bf16* rowp = O + (size_t)row * D + col0; const bf16* gp = gate + (size_t)row * NIN + col0;
#pragma unroll
                for (int bj = 0; bj < 2; ++bj) {
                    float gv[8]; unpack8(*(const v4u*)(gp + bj * 128), gv);
                    float o[8];
#pragma unroll
                    for (int j = 0; j < 4; ++j) { o[j] = acc[ai][bj][m][0][j] * gv[j]; o[4 + j] = acc[ai][bj][m][1][j] * gv[4 + j]; }
                    if (ACCUM) { float p[8]; unpack8(*(const v4u*)(rowp + bj * 128), p);
#pragma unroll
                        for (int j = 0; j < 8; ++j) o[j] += p[j]; }
                    v4u w; w.x = pg8::cvt_pk_bf16(o[0], o[1]); w.y = pg8::cvt_pk_bf16(o[2], o[3]); w.z = pg8::cvt_pk_bf16(o[4], o[5]); w.w = pg8::cvt_pk_bf16(o[6], o[7]);
                    *(v4u*)(rowp + bj * 128) = w; }
                asm volatile("" ::: "memory"); }
    }
};

struct EpiRmsRes {
    static constexpr bool AFTER_DRAIN = true; static constexpr int NSTORE = 0;
    unsigned char* ws; const CAS cfp_t* in; float* outp; int l, which;
    __device__ __forceinline__ void fused(const f32x4 (&acc)[2][2][4][2], const pg8::Unit& u, int wr, int wc, int fr, int fq, LAS unsigned char* lds, int wid, int lane) const {
        { const int l_ = launder(lane_id()); fr = l_ & 15; fq = l_ >> 4; }
        const bool lastl = which == 1 && l + 1 == DEPTH;
        bf16* const XB = (bf16*)(ws + WS_X1); bf16* const H = lastl ? nullptr : (bf16*)(ws + WS_H); float* const fout = lastl ? outp + O_YP : nullptr;
        const float* const gpost = (which ? in[24] : in[22]) + (size_t)l * D; const float* const gpre = lastl ? nullptr : (which ? in[21] + (size_t)(l + 1) * D : in[23] + (size_t)l * D);
        float* const slots = (float*)(ws + WS_XCH) + (size_t)(l * 2 + which) * 32 * 256 * 8 * 4;
        unsigned* const cnt = (unsigned*)(ws + WS_CTL) + CW_RMS + (l * 2 + which) * RMS_BANK; unsigned* const tmo = (unsigned*)(ws + WS_CTL) + CW_TMO;
        LAS f32x4* P = (LAS f32x4*)lds;
        LAS f32x2* SR = (LAS f32x2*)(lds + 16384);
        const int lr0 = wr * 64 + fr, col0 = u.pn * 256 + wc * 32 + 8 * fq;
        f32x4 gp[2][2];
#pragma unroll
        for (int bj = 0; bj < 2; ++bj) { gp[bj][0] = *(const f32x4*)(gpost + col0 + bj * 128); gp[bj][1] = *(const f32x4*)(gpost + col0 + bj * 128 + 4); }
#pragma unroll
        for (int ai = 0; ai < 2; ++ai)
#pragma unroll
            for (int m = 0; m < 4; ++m) {
                const int lr = lr0 + ai * 128 + m * 16; const bf16* xp = XB + (size_t)(u.pm * 256 + lr) * D + col0;
                float syy = 0.f, sxx = 0.f, sxy = 0.f, sgg = 0.f;
#pragma unroll
                for (int bj = 0; bj < 2; ++bj) { float xv[8]; unpack8(*(const v4u*)(xp + bj * 128), xv);
#pragma unroll
                    for (int n = 0; n < 2; ++n)
#pragma unroll
                        for (int j = 0; j < 4; ++j) { const float y = acc[ai][bj][m][n][j], yg = y * gp[bj][n][j], x = xv[4 * n + j]; syy += y * y; sxx += x * x; sxy += x * yg; sgg += yg * yg; } }
                syy += __shfl_xor(syy, 16); sxx += __shfl_xor(sxx, 16); sxy += __shfl_xor(sxy, 16); sgg += __shfl_xor(sgg, 16);
                syy += __shfl_xor(syy, 32); sxx += __shfl_xor(sxx, 32); sxy += __shfl_xor(sxy, 32); sgg += __shfl_xor(sgg, 32);
                if (fq == 0) P[lr * 4 + wc] = (f32x4){syy, sxx, sxy, sgg};
            }
        asm volatile("s_waitcnt lgkmcnt(0)" ::: "memory"); __builtin_amdgcn_s_barrier(); asm volatile("" ::: "memory");
        const int row = wid * 32 + (lane & 31);
        unsigned long long* slot = (unsigned long long*)slots + ((size_t)(u.pm * 256 + row) * 8 + u.pn) * 2;
        if (lane < 32) { const f32x4 a = P[row * 4 + 0], b = P[row * 4 + 1], c = P[row * 4 + 2], d = P[row * 4 + 3]; const f32x4 t = (a + b) + (c + d);
            __hip_atomic_store(slot, ((unsigned long long)__builtin_bit_cast(unsigned, t.y) << 32) | __builtin_bit_cast(unsigned, t.x), __ATOMIC_RELAXED, __HIP_MEMORY_SCOPE_AGENT);
            __hip_atomic_store(slot + 1, ((unsigned long long)__builtin_bit_cast(unsigned, t.w) << 32) | __builtin_bit_cast(unsigned, t.z), __ATOMIC_RELAXED, __HIP_MEMORY_SCOPE_AGENT); }
        asm volatile("s_waitcnt vmcnt(0)" ::: "memory");
        if (lane == 0) __hip_atomic_fetch_add(cnt + 64 * u.pm, 1u, __ATOMIC_RELAXED, __HIP_MEMORY_SCOPE_AGENT);
        if (wid == 0) {
            const unsigned long long t0 = __builtin_amdgcn_s_memrealtime();
            while ((unsigned)__builtin_amdgcn_readfirstlane((int)__hip_atomic_load(cnt + 64 * u.pm, __ATOMIC_RELAXED, __HIP_MEMORY_SCOPE_AGENT)) < 64u) {
                if (__builtin_amdgcn_s_memrealtime() - t0 > 2000000ull) { if (lane == 0) __hip_atomic_store(tmo, 1u, __ATOMIC_RELAXED, __HIP_MEMORY_SCOPE_AGENT); break; }
                __builtin_amdgcn_s_sleep(2); }
            __builtin_amdgcn_fence(__ATOMIC_ACQUIRE, "agent");
        }
        asm volatile("s_waitcnt vmcnt(0) lgkmcnt(0)" ::: "memory"); __builtin_amdgcn_s_barrier(); asm volatile("" ::: "memory");
        if (lane < 32) { const unsigned long long* sl = (const unsigned long long*)slots + (size_t)(u.pm * 256 + row) * 16; float syy = 0.f, sxx = 0.f, sxy = 0.f, sgg = 0.f;
#pragma unroll
            for (int t = 0; t < 8; ++t) { const unsigned long long w0 = __hip_atomic_load(sl + 2 * t, __ATOMIC_RELAXED, __HIP_MEMORY_SCOPE_AGENT), w1 = __hip_atomic_load(sl + 2 * t + 1, __ATOMIC_RELAXED, __HIP_MEMORY_SCOPE_AGENT);
                syy += __builtin_bit_cast(float, (unsigned)w0); sxx += __builtin_bit_cast(float, (unsigned)(w0 >> 32)); sxy += __builtin_bit_cast(float, (unsigned)w1); sgg += __builtin_bit_cast(float, (unsigned)(w1 >> 32)); }
            const float ry = rsqrtf(syy * (1.f / D) + EPS), s1 = sxx + 2.f * ry * sxy + ry * ry * sgg;
            SR[row] = (f32x2){ry, rsqrtf(fmaxf(s1, 0.f) * (1.f / D) + EPS)}; }
        asm volatile("s_waitcnt lgkmcnt(0)" ::: "memory"); __builtin_amdgcn_s_barrier(); asm volatile("" ::: "memory");
        f32x4 gq[2][2];
#pragma unroll
        for (int bj = 0; bj < 2; ++bj) { gq[bj][0] = gpre ? *(const f32x4*)(gpre + col0 + bj * 128) : (f32x4){0.f, 0.f, 0.f, 0.f}; gq[bj][1] = gpre ? *(const f32x4*)(gpre + col0 + bj * 128 + 4) : (f32x4){0.f, 0.f, 0.f, 0.f}; }
#pragma unroll
        for (int ai = 0; ai < 2; ++ai)
#pragma unroll
            for (int m = 0; m < 4; ++m) {
                const int lr = lr0 + ai * 128 + m * 16; const size_t off = (size_t)(u.pm * 256 + lr) * D + col0; const f32x2 sr = SR[lr];
#pragma unroll
                for (int bj = 0; bj < 2; ++bj) { float xv[8], x1[8]; unpack8(*(const v4u*)(XB + off + bj * 128), xv);
#pragma unroll
                    for (int n = 0; n < 2; ++n)
#pragma unroll
                        for (int j = 0; j < 4; ++j) x1[4 * n + j] = xv[4 * n + j] + acc[ai][bj][m][n][j] * sr.x * gp[bj][n][j];
                    if (fout) { *(f32x4*)(fout + off + bj * 128) = (f32x4){x1[0], x1[1], x1[2], x1[3]}; *(f32x4*)(fout + off + bj * 128 + 4) = (f32x4){x1[4], x1[5], x1[6], x1[7]}; }
                    else { *(v4u*)(XB + off + bj * 128) = pack8(x1);
                        if (H) { float hv[8];
#pragma unroll
                            for (int n = 0; n < 2; ++n)
#pragma unroll
                                for (int j = 0; j < 4; ++j) hv[4 * n + j] = x1[4 * n + j] * sr.y * gq[bj][n][j];
                            *(v4u*)(H + off + bj * 128) = pack8(hv); } } }
                asm volatile("" ::: "memory"); }
    }
};
struct EpiSwiglu {
    static constexpr bool AFTER_DRAIN = false; static constexpr int NSTORE = 8;
    bf16* O;
    __device__ __forceinline__ void operator()(const f32x4 (&acc)[2][2][4][2], const pg8::Unit& u, int wr, int wc, int fr, int fq) const {
        { const int l_ = launder(lane_id()); fr = l_ & 15; fq = l_ >> 4; }
        const int row0 = u.pm * 256 + wr * 64 + fr, col0 = u.pn * 128 + wc * 32 + 8 * fq;
#pragma unroll
        for (int ai = 0; ai < 2; ++ai)
#pragma unroll
            for (int m = 0; m < 4; ++m) { bf16* rowp = O + (size_t)(row0 + ai * 128 + m * 16) * DFF + col0;
                float o[8];
#pragma unroll
                for (int j = 0; j < 4; ++j) { o[j] = silu(acc[ai][0][m][0][j]) * acc[ai][1][m][0][j]; o[4 + j] = silu(acc[ai][0][m][1][j]) * acc[ai][1][m][1][j]; }
                v4u w; w.x = pg8::cvt_pk_bf16(o[0], o[1]); w.y = pg8::cvt_pk_bf16(o[2], o[3]); w.z = pg8::cvt_pk_bf16(o[4], o[5]); w.w = pg8::cvt_pk_bf16(o[6], o[7]);
                *(v4u*)rowp = w; }
    }
};

__device__ __forceinline__ void transpose_item(const float* W, int ldw, int src_col0, int k0, bf16* WT, int ldt, int dst_row0, LAS float* scr, int lane, const float* rscale = nullptr) {
#pragma unroll 8
    for (int i = 0; i < 32; ++i) { const int kk = 2 * i + (lane >> 5); scr[kk * 33 + (lane & 31)] = W[(size_t)(k0 + kk) * ldw + src_col0 + (lane & 31)]; }
    LDS_WAIT(); asm volatile("" ::: "memory");
    const int c = lane & 7;
#pragma unroll
    for (int j = 0; j < 4; ++j) { const int n = (lane >> 3) + 8 * j; const LAS float* s = scr + (8 * c) * 33 + n; const float m = rscale ? rscale[n] : 1.f;
        v4u o; o.x = pk2(s[0 * 33] * m, s[1 * 33] * m); o.y = pk2(s[2 * 33] * m, s[3 * 33] * m); o.z = pk2(s[4 * 33] * m, s[5 * 33] * m); o.w = pk2(s[6 * 33] * m, s[7 * 33] * m);
        *(v4u*)(WT + (size_t)(dst_row0 + n) * ldt + k0 + 8 * c) = o; }
    LDS_WAIT(); asm volatile("" ::: "memory");
}
constexpr int IT_IN = 32 * 496, IT_BRA = 16 * 64, IT_BRB = 8 * 64, IT_BRC = 16 * 64, IT_POOL = 4 * 4 * 8, IT_OUT = 32 * 64, IT_GU = 32 * 352, IT_DOWN = 88 * 64;
constexpr int IT_LAYER = IT_IN + IT_BRA + IT_BRB + IT_BRC + IT_POOL + IT_OUT + IT_GU + IT_DOWN;
__device__ __forceinline__ void weight_item(Frame& F0, int l, int r, LAS float* scr) {
    RELANE(F0);
    unsigned char* wl = F.ws + WS_W + (size_t)l * WL_BYTES; const int lane = F.lane;
    if (r < IT_IN) { const int kb = r / 496, nb = r % 496, n0 = nb * 32; transpose_item(F.in[8] + (size_t)l * D * NIN_SRC, NIN_SRC, n0 + (n0 >= 4096 ? 16 : 0), kb * 64, (bf16*)(wl + WO_IN), D, n0, scr, lane); return; } r -= IT_IN;
    if (r < IT_BRA) { const int kb = r / 64, nb = r % 64; transpose_item(F.in[15] + (size_t)l * 1024 * D, D, nb * 32, kb * 64, (bf16*)(wl + WO_BRA), 1024, nb * 32, scr, lane); return; } r -= IT_BRA;
    if (r < IT_BRB) { const int kb = r / 64, nb = r % 64; transpose_item(F.in[16] + (size_t)l * 512 * D, D, nb * 32, kb * 64, (bf16*)(wl + WO_BRB), 512, nb * 32, scr, lane); return; } r -= IT_BRB;
    if (r < IT_BRC) { const int kb = r / 64, nb = r % 64; transpose_item(F.in[17] + (size_t)l * 1024 * D, D, nb * 32, kb * 64, (bf16*)(wl + WO_BRC), 1024, nb * 32, scr, lane); return; } r -= IT_BRC;
    if (r < IT_POOL) { const int g = r / 32, kb = (r % 32) / 8, nb = r % 8; transpose_item(F.in[13] + (size_t)(l * 4 + g) * 65536, 256, nb * 32, kb * 64, (bf16*)(wl + WO_POOL) + (size_t)g * 65536, 256, nb * 32, scr, lane, F.in[14] + (size_t)l * CPOOL + g * 256 + nb * 32); return; } r -= IT_POOL;
    if (r < IT_OUT) { const int kb = r / 64, nb = r % 64; transpose_item(F.in[18] + (size_t)l * D * D, D, nb * 32, kb * 64, (bf16*)(wl + WO_OUT), D, nb * 32, scr, lane); return; } r -= IT_OUT;
    if (r < IT_GU) { const int kb = r / 352, nb = r % 352, n0 = nb * 32, pn = n0 >> 8, bj = (n0 >> 7) & 1, rr = n0 & 127;
        transpose_item(F.in[19] + (size_t)l * D * 2 * DFF, 2 * DFF, bj * DFF + 128 * pn + rr, kb * 64, (bf16*)(wl + WO_GU), D, n0, scr, lane); return; } r -= IT_GU;
    { const int kb = r / 64, nb = r % 64; transpose_item(F.in[20] + (size_t)l * DFF * D, D, nb * 32, kb * 64, (bf16*)(wl + WO_DOWN), DFF, nb * 32, scr, lane); }
}

__device__ __forceinline__ void stage_wba(Frame& F0, int l) {
    RELANE(F0);
    LAS float* Wl = (LAS float*)F.lds; const float* w = F.in[8] + (size_t)l * D * NIN_SRC + 4096;
    for (int k0 = F.tid; k0 < D; k0 += NWAVES * 64) { const float* p = w + (size_t)k0 * NIN_SRC;
        const int k = (k0 & ~511) | (((k0 >> 2) & 1) << 8) | (((k0 >> 3) & 63) << 2) | (k0 & 3);
        const f32x4 a = *(const f32x4*)p, b = *(const f32x4*)(p + 4), c = *(const f32x4*)(p + 8), d = *(const f32x4*)(p + 12);
        Wl[0 * D + k] = a.x; Wl[1 * D + k] = a.y; Wl[2 * D + k] = a.z; Wl[3 * D + k] = a.w; Wl[4 * D + k] = b.x; Wl[5 * D + k] = b.y; Wl[6 * D + k] = b.z; Wl[7 * D + k] = b.w;
        Wl[8 * D + k] = c.x; Wl[9 * D + k] = c.y; Wl[10 * D + k] = c.z; Wl[11 * D + k] = c.w; Wl[12 * D + k] = d.x; Wl[13 * D + k] = d.y; Wl[14 * D + k] = d.z; Wl[15 * D + k] = d.w; }
    __syncthreads();
}
template <bool X32>
__device__ __forceinline__ void thin_rows(Frame& F0, const float* xa, const float* xb, const bf16* Y, const float* gpost, float* fout, const float* gpre, bool do_ba, int l_ba, int r_lo = 0) {
    RELANE(F0);
    if constexpr (!X32) { F.ws = launder_pg(F.ws); Y = launder_pg(Y); gpost = launder_pg(gpost); gpre = launder_pg(gpre); fout = launder_pg(fout); __builtin_amdgcn_s_waitcnt(0x0070); }
    const int lane = F.lane, gw = F.vcu * NWAVES + F.wave, NGW = F.G * NWAVES;
    bf16* H = (bf16*)(F.ws + WS_H); bf16* XB = (bf16*)(F.ws + WS_X1); float* GB = (float*)(F.ws + WS_GB);
    const LAS float* Wl = (const LAS float*)F.lds;
    f32x4 vn[8]; v4u xn[4], yn[4];
#define THIN_LOAD(rr) do { const int r_ = (rr); \
        if (X32) { const float* xr_ = (r_ < MP) ? xa + (size_t)r_ * D : xb + (size_t)(r_ - MP) * D; _Pragma("unroll") for (int j = 0; j < 4; ++j) { vn[2 * j] = *(const f32x4*)(xr_ + 8 * lane + 512 * j); vn[2 * j + 1] = *(const f32x4*)(xr_ + 8 * lane + 512 * j + 4); } } \
        else { _Pragma("unroll") for (int j = 0; j < 4; ++j) xn[j] = *(const v4u*)(XB + (size_t)r_ * D + 8 * lane + 512 * j); } \
        if (Y) { _Pragma("unroll") for (int j = 0; j < 4; ++j) yn[j] = *(const v4u*)(Y + (size_t)r_ * D + 8 * lane + 512 * j); } } while (0)
#pragma unroll
    for (int j = 0; j < 4; ++j) { yn[j] = (v4u){0u, 0u, 0u, 0u}; xn[j] = (v4u){0u, 0u, 0u, 0u}; vn[2 * j] = (f32x4){0.f, 0.f, 0.f, 0.f}; vn[2 * j + 1] = (f32x4){0.f, 0.f, 0.f, 0.f}; }
    if (r_lo + gw < MV) THIN_LOAD(r_lo + gw);
    for (int r = r_lo + gw; r < MV; r += NGW) {
        f32x4 v[8]; v4u yu[4];
#pragma unroll
        for (int j = 0; j < 4; ++j) {
            v[2 * j] = X32 ? vn[2 * j] : (f32x4){bf_lo(xn[j].x), bf_hi(xn[j].x), bf_lo(xn[j].y), bf_hi(xn[j].y)};
            v[2 * j + 1] = X32 ? vn[2 * j + 1] : (f32x4){bf_lo(xn[j].z), bf_hi(xn[j].z), bf_lo(xn[j].w), bf_hi(xn[j].w)}; yu[j] = yn[j]; }
        if (r + NGW < MV) THIN_LOAD(r + NGW);
        if (Y) {
            f32x4 y[8]; float ss = 0.f;
#pragma unroll
            for (int j = 0; j < 4; ++j) { const v4u u = yu[j]; y[2 * j] = (f32x4){bf_lo(u.x), bf_hi(u.x), bf_lo(u.y), bf_hi(u.y)}; y[2 * j + 1] = (f32x4){bf_lo(u.z), bf_hi(u.z), bf_lo(u.w), bf_hi(u.w)}; }
#pragma unroll
            for (int j = 0; j < 8; ++j) ss += (y[j].x * y[j].x + y[j].y * y[j].y) + (y[j].z * y[j].z + y[j].w * y[j].w);
            const float rstd = rsqrtf(wave_sum(ss) * (1.f / D) + EPS);
#pragma unroll
            for (int j = 0; j < 4; ++j) { const f32x4 g0 = *(const f32x4*)(gpost + 8 * lane + 512 * j), g1 = *(const f32x4*)(gpost + 8 * lane + 512 * j + 4);
                v[2 * j] = v[2 * j] + y[2 * j] * rstd * g0; v[2 * j + 1] = v[2 * j + 1] + y[2 * j + 1] * rstd * g1; }
        }
        if (fout) {
#pragma unroll
            for (int j = 0; j < 4; ++j) { *(f32x4*)(fout + (size_t)r * D + 8 * lane + 512 * j) = v[2 * j]; *(f32x4*)(fout + (size_t)r * D + 8 * lane + 512 * j + 4) = v[2 * j + 1]; }
        } else {
#pragma unroll
            for (int j = 0; j < 4; ++j) { v4u o; o.x = pk2(v[2 * j].x, v[2 * j].y); o.y = pk2(v[2 * j].z, v[2 * j].w); o.z = pk2(v[2 * j + 1].x, v[2 * j + 1].y); o.w = pk2(v[2 * j + 1].z, v[2 * j + 1].w);
                *(v4u*)(XB + (size_t)r * D + 8 * lane + 512 * j) = o; }
        }
        if (gpre) {
            float ss = 0.f;
#pragma unroll
            for (int j = 0; j < 8; ++j) ss += (v[j].x * v[j].x + v[j].y * v[j].y) + (v[j].z * v[j].z + v[j].w * v[j].w);
            const float rstd = rsqrtf(wave_sum(ss) * (1.f / D) + EPS);
#pragma unroll
            for (int j = 0; j < 4; ++j) { const f32x4 g0 = *(const f32x4*)(gpre + 8 * lane + 512 * j), g1 = *(const f32x4*)(gpre + 8 * lane + 512 * j + 4);
                v[2 * j] = v[2 * j] * rstd * g0; v[2 * j + 1] = v[2 * j + 1] * rstd * g1;
                v4u o; o.x = pk2(v[2 * j].x, v[2 * j].y); o.y = pk2(v[2 * j].z, v[2 * j].w); o.z = pk2(v[2 * j + 1].x, v[2 * j + 1].y); o.w = pk2(v[2 * j + 1].z, v[2 * j + 1].w);
                *(v4u*)(H + (size_t)r * D + 8 * lane + 512 * j) = o; }
            if (do_ba) {
                float pc[16], mine = 0.f;
#pragma unroll
                for (int c = 0; c < 16; ++c) { float p = 0.f;
#pragma unroll
                    for (int j = 0; j < 8; ++j) { const f32x4 w = *(const LAS f32x4*)(Wl + c * D + 256 * j + 4 * lane);
                        p += (v[j].x * w.x + v[j].y * w.y) + (v[j].z * w.z + v[j].w * w.w); }
                    pc[c] = row16_sum(p); }
#pragma unroll
                for (int c = 0; c < 16; ++c) pc[c] += __shfl_xor(pc[c], 16);
#pragma unroll
                for (int c = 0; c < 16; ++c) { pc[c] += __shfl_xor(pc[c], 32); mine = (lane == c) ? pc[c] : mine; }
                if (lane < 16) { float o;
                    if (lane < 8) o = sigm(mine);
                    else { const float al = F.in[10][l_ba * HA + lane - 8], dtb = F.in[11][l_ba * HA + lane - 8]; const float z = mine + dtb; const float sp = fmaxf(z, 0.f) + __logf(1.f + __expf(-fabsf(z))); o = -__expf(al) * sp; }
                    GB[(size_t)r * 16 + lane] = o; }
            }
        }
    }
}
#undef THIN_LOAD
__device__ __forceinline__ void ba_rows(Frame& F0, int l_ba) {
    RELANE(F0);
    const int lane = F.lane, gw = F.vcu * NWAVES + F.wave, NGW = F.G * NWAVES;
    const bf16* H = (const bf16*)(F.ws + WS_H); float* GB = (float*)(F.ws + WS_GB); const LAS float* Wl = (const LAS float*)F.lds;
    for (int r = gw; r < MP; r += NGW) {
        f32x4 v[8];
#pragma unroll
        for (int j = 0; j < 8; ++j) { const v2u u = *(const v2u*)(H + (size_t)r * D + 4 * lane + 256 * j); v[j] = (f32x4){bf_lo(u.x), bf_hi(u.x), bf_lo(u.y), bf_hi(u.y)}; }
        float mine = 0.f;
#pragma unroll 1
        for (int c = 0; c < 16; ++c) { float p = 0.f;
#pragma unroll
            for (int j = 0; j < 8; ++j) { const f32x4 w = *(const LAS f32x4*)(Wl + c * D + 256 * j + 4 * lane); p += (v[j].x * w.x + v[j].y * w.y) + (v[j].z * w.z + v[j].w * w.w); }
            p = wave_sum(p); if (lane == c) mine = p; }
        if (lane < 16) { float o;
            if (lane < 8) o = sigm(mine);
            else { const float al = F.in[10][l_ba * HA + lane - 8], dtb = F.in[11][l_ba * HA + lane - 8]; const float z = mine + dtb; const float sp = fmaxf(z, 0.f) + __logf(1.f + __expf(-fabsf(z))); o = -__expf(al) * sp; }
            GB[(size_t)r * 16 + lane] = o; }
    }
}

__device__ __forceinline__ void ld8f(const float* p, float (&x)[8]) { const f32x4 a = *(const f32x4*)p, b = *(const f32x4*)(p + 4); x[0] = a.x; x[1] = a.y; x[2] = a.z; x[3] = a.w; x[4] = b.x; x[5] = b.y; x[6] = b.z; x[7] = b.w; }
template <bool QK> __device__ __forceinline__ void conv_item(Frame& F0, int l, int row0, int T, int hmode, int sb, int j) {
    RELANE_G(F0);
    const int lane = F.lane;
    const bf16* PROJ = (const bf16*)(F.ws + WS_PROJ); const float* convw = F.in[9] + (size_t)l * 4 * CONVCH;
    const int c0 = QK ? 512 * j + 8 * lane : 2048 + 512 * j + 8 * lane, c1 = 1024 + 512 * j + 8 * lane;
    float w0[4][8], w1[4][8], x0[4][8], x1[4][8];
#pragma unroll
    for (int tap = 0; tap < 4; ++tap) { ld8f(convw + tap * CONVCH + c0, w0[tap]); if (QK) ld8f(convw + tap * CONVCH + c1, w1[tap]); }
#pragma unroll
    for (int i = 0; i < 3; ++i) {
        if (hmode == 1) { unpack8(*(const v4u*)(PROJ + (size_t)(row0 - 3 + i) * NIN + c0), x0[i + 1]); if (QK) unpack8(*(const v4u*)(PROJ + (size_t)(row0 - 3 + i) * NIN + c1), x1[i + 1]); }
        else if (hmode == 2) { const float* hp = F.in[6] + ((size_t)(l * DB + sb) * 3 + i) * CONVCH; ld8f(hp + c0, x0[i + 1]); if (QK) ld8f(hp + c1, x1[i + 1]); }
        else {
#pragma unroll
            for (int e = 0; e < 8; ++e) { x0[i + 1][e] = 0.f; x1[i + 1][e] = 0.f; } }
    }
    bf16* O0 = (bf16*)(F.ws + (QK ? WS_QN : WS_VV)) + 512 * j + 8 * lane; bf16* O1 = (bf16*)(F.ws + WS_KN) + 512 * j + 8 * lane;
    const float* GB = (const float*)(F.ws + WS_GB); f32x4* TOK = (f32x4*)(F.ws + WS_TOK); const int hd = 4 * j + (lane >> 4);
    v4u n0[4], n1[4]; float ng[4], nb[4];
#pragma unroll
    for (int u = 0; u < 4; ++u) { n0[u] = *(const v4u*)(PROJ + (size_t)(row0 + u) * NIN + c0); n1[u] = n0[u]; ng[u] = 0.f; nb[u] = 0.f; if (QK) { n1[u] = *(const v4u*)(PROJ + (size_t)(row0 + u) * NIN + c1); ng[u] = GB[(size_t)(row0 + u) * 16 + 8 + hd]; nb[u] = GB[(size_t)(row0 + u) * 16 + hd]; } }
    for (int tb = 0; tb < T; tb += 4) {
        v4u m0[4], m1[4]; float mg[4], mb[4];
#pragma unroll
        for (int u = 0; u < 4; ++u) { m0[u] = n0[u]; m1[u] = n1[u]; mg[u] = ng[u]; mb[u] = nb[u]; }
        if (tb + 4 < T) {
#pragma unroll
            for (int u = 0; u < 4; ++u) { n0[u] = *(const v4u*)(PROJ + (size_t)(row0 + tb + 4 + u) * NIN + c0); if (QK) { n1[u] = *(const v4u*)(PROJ + (size_t)(row0 + tb + 4 + u) * NIN + c1); ng[u] = GB[(size_t)(row0 + tb + 4 + u) * 16 + 8 + hd]; nb[u] = GB[(size_t)(row0 + tb + 4 + u) * 16 + hd]; } } }
#pragma unroll
        for (int u = 0; u < 4; ++u) {
            const int t = tb + u; const size_t r = (size_t)(row0 + t);
            unpack8(m0[u], x0[u]); if (QK) unpack8(m1[u], x1[u]);
            float a0[8], a1[8]; float s0 = 0.f, s1 = 0.f;
#pragma unroll
            for (int e = 0; e < 8; ++e) {
                a0[e] = silu(w0[3][e] * x0[u][e] + w0[2][e] * x0[(u + 3) & 3][e] + w0[1][e] * x0[(u + 2) & 3][e] + w0[0][e] * x0[(u + 1) & 3][e]); s0 += a0[e] * a0[e];
                if (QK) { a1[e] = silu(w1[3][e] * x1[u][e] + w1[2][e] * x1[(u + 3) & 3][e] + w1[1][e] * x1[(u + 2) & 3][e] + w1[0][e] * x1[(u + 1) & 3][e]); s1 += a1[e] * a1[e]; } }
            if (QK) {
                const float q_sc = rsqrtf(row16_sum(s0) + 1e-6f) * 0.08838834764831845f, k_sc = rsqrtf(row16_sum(s1) + 1e-6f); float p = 0.f;
#pragma unroll
                for (int e = 0; e < 8; ++e) { a0[e] *= q_sc; a1[e] *= k_sc; p += a0[e] * a1[e]; }
                p = row16_sum(p);
                *(v4u*)(O1 + r * 1024) = pack8(a1);
                if ((lane & 15) == 0) TOK[r * 8 + hd] = (f32x4){__expf(mg[u]), mb[u], p, mg[u]};
            }
            *(v4u*)(O0 + r * 1024) = pack8(a0);
        }
    }
}
__device__ __forceinline__ void pool_item(Frame& F0, int l, int row0, int T, int pos0, int hmode, int sb, int j) {
    RELANE_G(F0);
    const int lane = F.lane, win = 2 << (2 * j + (lane >> 5)), cc = 512 * j + 8 * lane;
    const bf16* U = (const bf16*)(F.ws + WS_PROJ) + PC_UC + cc; const float* hist = F.in[7] + (size_t)(l * DB + sb) * PHIST * CPOOL + cc;
    bf16* PO = (bf16*)(F.ws + WS_POOLED) + cc;
    float S[8];
#pragma unroll
    for (int e = 0; e < 8; ++e) S[e] = 0.f;
    if (hmode == 2) {
        for (int i = 1; i < 16; ++i) if (i < win) { float x[8]; ld8f(hist + (size_t)(PHIST - i) * CPOOL, x);
#pragma unroll
            for (int e = 0; e < 8; ++e) S[e] += x[e]; }
        for (int t = 0; t < T; ++t) {
            float xn[8], xo[8]; unpack8(*(const v4u*)(U + (size_t)(row0 + t) * NIN), xn);
            const int to = t - win + 1;
            if (to >= 0) unpack8(*(const v4u*)(U + (size_t)(row0 + to) * NIN), xo); else ld8f(hist + (size_t)(PHIST + to) * CPOOL, xo);
            const float inv = 1.f / (float)win; float o[8];
#pragma unroll
            for (int e = 0; e < 8; ++e) { S[e] += xn[e]; o[e] = S[e] * inv - xn[e]; S[e] -= xo[e]; }
            *(v4u*)(PO + (size_t)(row0 + t) * 1024) = pack8(o);
        }
        return;
    }
    {
        v4u h[15];
#pragma unroll
        for (int i = 1; i < 16; ++i) { const int back = (pos0 - i >= 0) ? i : pos0; h[i - 1] = *(const v4u*)(U + (size_t)(row0 - back) * NIN); }
#pragma unroll
        for (int i = 1; i < 16; ++i) { float x[8]; unpack8(h[i - 1], x); const float wgt = (i < win && pos0 - i >= 0) ? 1.f : 0.f;
#pragma unroll
            for (int e = 0; e < 8; ++e) S[e] += wgt * x[e]; }
    }
    v4u nn[4], no[4];
#define POOL_LD(tb_) do { _Pragma("unroll") for (int u = 0; u < 4; ++u) { const int t_ = (tb_) + u, to_ = t_ - win + 1; nn[u] = *(const v4u*)(U + (size_t)(row0 + t_) * NIN); no[u] = *(const v4u*)(U + (size_t)(row0 + (pos0 + to_ >= 0 ? to_ : -pos0)) * NIN); } } while (0)
    POOL_LD(0);
    for (int tb = 0; tb < T; tb += 4) {
        v4u mn[4], mo[4];
#pragma unroll
        for (int u = 0; u < 4; ++u) { mn[u] = nn[u]; mo[u] = no[u]; }
        if (tb + 4 < T) POOL_LD(tb + 4);
#pragma unroll
        for (int u = 0; u < 4; ++u) {
            const int t = tb + u, to = t - win + 1; const float wo = (pos0 + to >= 0) ? 1.f : 0.f;
            float xn[8], xo[8]; unpack8(mn[u], xn); unpack8(mo[u], xo);
            const float cnt = (float)(win < pos0 + t + 1 ? win : pos0 + t + 1), inv = __builtin_amdgcn_rcpf(cnt); float o[8];
#pragma unroll
            for (int e = 0; e < 8; ++e) { S[e] += xn[e]; o[e] = S[e] * inv - xn[e]; S[e] -= wo * xo[e]; }
            *(v4u*)(PO + (size_t)(row0 + t) * 1024) = pack8(o);
        }
    }
#undef POOL_LD
}
constexpr int CV_BLK = 16, CV_NB = SEQ / CV_BLK;
constexpr int CV_P_ITEMS = BATCH * CV_NB * 2, CV_S_ITEMS = DB * 2;
constexpr int PREP_ITEMS = 2 * (CV_P_ITEMS + CV_S_ITEMS) + CV_P_ITEMS + CV_S_ITEMS;
__device__ __forceinline__ void prep_item(Frame& F, int l, int it) {
    int kind = 0;
    if (it >= CV_P_ITEMS + CV_S_ITEMS) { it -= CV_P_ITEMS + CV_S_ITEMS; kind = 1; if (it >= CV_P_ITEMS + CV_S_ITEMS) { it -= CV_P_ITEMS + CV_S_ITEMS; kind = 2; } }
    int row0, T, hmode, sb = 0, pos0; const int j = it & 1;
    if (it < CV_P_ITEMS) { const int blk = (it >> 1) % CV_NB, b = (it >> 1) / CV_NB; row0 = b * SEQ + blk * CV_BLK; T = CV_BLK; hmode = blk ? 1 : 0; pos0 = blk * CV_BLK; }
    else { sb = (it - CV_P_ITEMS) >> 1; row0 = MP + DS * sb; T = DS; hmode = 2; pos0 = 0; }
    if (kind == 0) conv_item<true>(F, l, row0, T, hmode, sb, j); else if (kind == 1) conv_item<false>(F, l, row0, T, hmode, sb, j); else pool_item(F, l, row0, T, pos0, hmode, sb, j);
}

__device__ __forceinline__ void st8f(float* p, const v4u u) { float x[8]; unpack8(u, x); *(f32x4*)p = (f32x4){x[0], x[1], x[2], x[3]}; *(f32x4*)(p + 4) = (f32x4){x[4], x[5], x[6], x[7]}; }
__device__ __forceinline__ void prep_out_rows(Frame& F0, int l) {
    RELANE_G(F0);
    const int lane = F.lane, gw = F.vcu * NWAVES + F.wave, NGW = F.G * NWAVES;
    const bf16* PROJ = (const bf16*)(F.ws + WS_PROJ);
    float* out = F.out;
    for (int r = gw; r < MV; r += NGW) {
        const bool samp = r >= MP; const int b = samp ? (r - MP) / DS : r / SEQ, t = samp ? (r - MP) % DS : r % SEQ;
        const bf16* prow = PROJ + (size_t)r * NIN;
        const int ci = samp ? t - 1 : t - (SEQ - 3), pi = samp ? 11 + t : t - (SEQ - PHIST);
        v4u kvr[3][2], cv[6], pv[2];
#pragma unroll
        for (int gi = 0; gi < 3; ++gi) { kvr[gi][0] = *(const v4u*)(prow + PC_KB + gi * 512 + 8 * lane); kvr[gi][1] = *(const v4u*)(prow + PC_VB + gi * 512 + 8 * lane); }
        const bool needc = (ci >= 0) || (pi >= 0);
        if (needc) {
#pragma unroll
            for (int j = 0; j < 6; ++j) cv[j] = *(const v4u*)(prow + 512 * j + 8 * lane);
#pragma unroll
            for (int j = 0; j < 2; ++j) pv[j] = *(const v4u*)(prow + PC_UC + 512 * j + 8 * lane);
        }
#pragma unroll
        for (int gi = 0; gi < 3; ++gi) {
            const int win = 128 << (2 * gi); const int w = samp ? win - DS + t : t - (SEQ - win);
            if (w >= 0) {
                const size_t obase = samp ? (gi == 0 ? O_SW1 : gi == 1 ? O_SW2 : O_SW3) : (gi == 0 ? O_PW1 : gi == 1 ? O_PW2 : O_PW3);
                float* dst = out + obase + ((size_t)(l * (samp ? DB : BATCH) + b) * win + w) * 1024 + 8 * lane;
                st8f(dst, kvr[gi][0]); st8f(dst + 512, kvr[gi][1]);
            }
        }
        if (needc) {
            if (ci >= 0) { float* dst = out + (samp ? O_SCONV + ((size_t)(l * DB + b) * 3 + ci) * CONVCH : O_PCONV + ((size_t)(l * BATCH + b) * 3 + ci) * CONVCH) + 8 * lane;
#pragma unroll
                for (int j = 0; j < 6; ++j) st8f(dst + 512 * j, cv[j]); }
            if (pi >= 0) { float* dst = out + (samp ? O_SPOOL + ((size_t)(l * DB + b) * PHIST + pi) * CPOOL : O_PPOOL + ((size_t)(l * BATCH + b) * PHIST + pi) * CPOOL) + 8 * lane;
#pragma unroll
                for (int j = 0; j < 2; ++j) st8f(dst + 512 * j, pv[j]); }
            if (samp && t == 0) {
                const float* phist = F.in[7] + (size_t)(l * DB + b) * PHIST * CPOOL;
                float* dst = out + O_SPOOL + (size_t)(l * DB + b) * PHIST * CPOOL; const float* src = phist + 4 * CPOOL;
                for (int i = lane; i < 11 * CPOOL / 4; i += 64) *(f32x4*)(dst + 4 * i) = *(const f32x4*)(src + 4 * i);
            }
        }
    }
}

__device__ __forceinline__ void gdn_scan_item(Frame& F0, int row0, int h, int s, const float* S0, float* Sout) {
    RELANE(F0);
    const int lane = F.lane, dvl = lane & 15, kg = lane >> 4;
    const bf16* QN = (const bf16*)(F.ws + WS_QN); const bf16* KN = (const bf16*)(F.ws + WS_KN); const bf16* VV = (const bf16*)(F.ws + WS_VV);
    const f32x4* TOK = (const f32x4*)(F.ws + WS_TOK); float* ORAW = (float*)(F.ws + WS_ORAW);
    float S[32]; v4u ku[DS][4], qu[DS][4]; float vv[DS]; f32x4 tk[DS];
    const float* sp = S0 + (size_t)(32 * kg) * 128 + 16 * s + dvl;
#pragma unroll
    for (int i = 0; i < 32; ++i) S[i] = sp[(size_t)i * 128];
#pragma unroll
    for (int t = 0; t < DS; ++t) { const size_t r = (size_t)(row0 + t);
#pragma unroll
        for (int c = 0; c < 4; ++c) { ku[t][c] = *(const v4u*)(KN + r * 1024 + h * 128 + 32 * kg + 8 * c); qu[t][c] = *(const v4u*)(QN + r * 1024 + h * 128 + 32 * kg + 8 * c); }
        vv[t] = bf1(VV[r * 1024 + h * 128 + 16 * s + dvl]); tk[t] = TOK[r * 8 + h]; }
#pragma unroll
    for (int t = 0; t < DS; ++t) {
        float rk = 0.f, rq = 0.f; float kf[32];
#pragma unroll
        for (int c = 0; c < 4; ++c) { float k8[8], q8[8]; unpack8(ku[t][c], k8); unpack8(qu[t][c], q8);
#pragma unroll
            for (int e = 0; e < 8; ++e) { kf[8 * c + e] = k8[e]; rk += k8[e] * S[8 * c + e]; rq += q8[e] * S[8 * c + e]; } }
        rk += __shfl_xor(rk, 16); rq += __shfl_xor(rq, 16); rk += __shfl_xor(rk, 32); rq += __shfl_xor(rq, 32);
        const float a = tk[t].x, d = tk[t].y * (vv[t] - a * rk), o = a * rq + tk[t].z * d;
#pragma unroll
        for (int i = 0; i < 32; ++i) S[i] = a * S[i] + kf[i] * d;
        if (kg == 0) ORAW[(size_t)(row0 + t) * 1024 + h * 128 + 16 * s + dvl] = o;
    }
    float* op = Sout + (size_t)(32 * kg) * 128 + 16 * s + dvl;
#pragma unroll
    for (int i = 0; i < 32; ++i) op[(size_t)i * 128] = S[i];
}

__device__ __forceinline__ bf16x8 pack_acc(const f32x16& x, int sp) {
    v4u p; p.x = pk2(x[8 * sp + 0], x[8 * sp + 1]); p.y = pk2(x[8 * sp + 2], x[8 * sp + 3]); p.z = pk2(x[8 * sp + 4], x[8 * sp + 5]); p.w = pk2(x[8 * sp + 6], x[8 * sp + 7]);
    return __builtin_bit_cast(bf16x8, p);
}
constexpr int GA_PITCH = 272, GA_LT_PITCH = 36, GA_WAVE_LDS = 32 * GA_PITCH + 32 * GA_LT_PITCH * 4 + 384;
__device__ __forceinline__ void gdn_ga_item(Frame& F0, int ch) {
    RELANE_G(F0);
    const int lane = F.lane, r = lane & 31, h = lane >> 5;
    const int c = ch & 63, bh = ch >> 6, hd = bh & 7, b = bh >> 3, row0 = b * SEQ + 32 * c;
    LAS unsigned char* TL = F.lds + F.wave * GA_WAVE_LDS; LAS float* LT = (LAS float*)(TL + 32 * GA_PITCH); LAS float* GS = (LAS float*)(TL + 32 * GA_PITCH + 32 * GA_LT_PITCH * 4);
    const bf16* QN = (const bf16*)(F.ws + WS_QN); const bf16* KN = (const bf16*)(F.ws + WS_KN); const bf16* VV = (const bf16*)(F.ws + WS_VV); const f32x4* TOK = (const f32x4*)(F.ws + WS_TOK);
    { const f32x4 tk = TOK[(size_t)(row0 + r) * 8 + hd]; if (h == 0) { GS[r] = tk.w; GS[32 + r] = tk.y; } }
#pragma unroll
    for (int i = 0; i < 8; ++i) { const int p = lane + 64 * i, rw = p >> 4, c16 = p & 15; *(LAS v4u*)(TL + rw * GA_PITCH + 16 * c16) = *(const v4u*)(KN + (size_t)(row0 + rw) * 1024 + hd * 128 + 8 * c16); }
    asm volatile("s_waitcnt lgkmcnt(0)" ::: "memory");
    float gcv[32], bev[32];
#pragma unroll
    for (int i = 0; i < 8; ++i) { const f32x4 a = *(const LAS f32x4*)(GS + 4 * i), bq = *(const LAS f32x4*)(GS + 32 + 4 * i);
        gcv[4 * i] = a.x; gcv[4 * i + 1] = a.y; gcv[4 * i + 2] = a.z; gcv[4 * i + 3] = a.w; bev[4 * i] = bq.x; bev[4 * i + 1] = bq.y; bev[4 * i + 2] = bq.z; bev[4 * i + 3] = bq.w; }
#pragma unroll
    for (int i = 1; i < 32; ++i) gcv[i] += gcv[i - 1];
    if (lane == 0) {
#pragma unroll
        for (int i = 0; i < 8; ++i) *(LAS f32x4*)(GS + 64 + 4 * i) = (f32x4){gcv[4 * i], gcv[4 * i + 1], gcv[4 * i + 2], gcv[4 * i + 3]}; }
    asm volatile("s_waitcnt lgkmcnt(0)" ::: "memory");
    const float gc_own = GS[64 + r], fr = (float)r;
    const bf16* kp = KN + (size_t)(row0 + r) * 1024 + hd * 128 + 8 * h; const bf16* qp = QN + (size_t)(row0 + r) * 1024 + hd * 128 + 8 * h;
    f32x16 akk, aqk;
#pragma unroll
    for (int i = 0; i < 16; ++i) { akk[i] = 0.f; aqk[i] = 0.f; }
#pragma unroll
    for (int ks = 0; ks < 8; ++ks) { const bf16x8 kf = *(const bf16x8*)(kp + 16 * ks), qf = *(const bf16x8*)(qp + 16 * ks);
        akk = __builtin_amdgcn_mfma_f32_32x32x16_bf16(kf, kf, akk, 0, 0, 0); aqk = __builtin_amdgcn_mfma_f32_32x32x16_bf16(kf, qf, aqk, 0, 0, 0); }
#pragma unroll
    for (int g4 = 0; g4 < 4; ++g4) { f32x4 w;
#pragma unroll
        for (int e = 0; e < 4; ++e) { const int k0 = 8 * g4 + e, k1 = k0 + 4; const float gk = h ? gcv[k1] : gcv[k0], bk = h ? bev[k1] : bev[k0]; const int kk = h ? k1 : k0;
            const float lo = fminf(fmaxf((float)kk - fr, 0.f), 1.f);
            w[e] = lo * bk * akk[4 * g4 + e] * __expf(fminf(gk - gc_own, 0.f));
            aqk[4 * g4 + e] = (1.f - lo) * aqk[4 * g4 + e] * __expf(fminf(gc_own - gk, 0.f)); }
        *(LAS f32x4*)(LT + r * GA_LT_PITCH + 8 * g4 + 4 * h) = w; }
    bf16x8* AF = (bf16x8*)(F.ws + WS_AF) + (size_t)ch * 128;
    AF[lane] = pack_acc(aqk, 0); AF[64 + lane] = pack_acc(aqk, 1);
    asm volatile("s_waitcnt lgkmcnt(0)" ::: "memory");
    float t[32];
#pragma unroll
    for (int j = 31; j >= 0; --j) {
        float acc = 1.f - fminf(fabsf(fr - (float)j), 1.f);
#pragma unroll
        for (int gq = (j + 1) >> 2; gq < 8; ++gq) { const f32x4 lv = *(const LAS f32x4*)(LT + j * GA_LT_PITCH + 4 * gq);
#pragma unroll
            for (int e = 0; e < 4; ++e) if (4 * gq + e > j) acc -= t[4 * gq + e] * lv[e]; }
        t[j] = acc;
    }
    bf16x8 t1f[2], t2f[2];
#pragma unroll
    for (int sp = 0; sp < 2; ++sp) { float x1[8], x2[8];
#pragma unroll
        for (int e = 0; e < 8; ++e) { const int j0 = 16 * sp + e, j1 = j0 + 8; const float tv = h ? t[j1] : t[j0], bj = h ? bev[j1] : bev[j0], gj = h ? gcv[j1] : gcv[j0]; x1[e] = tv * bj; x2[e] = x1[e] * __expf(gj); }
        t1f[sp] = __builtin_bit_cast(bf16x8, pack8(x1)); t2f[sp] = __builtin_bit_cast(bf16x8, pack8(x2)); }
    { bf16x8* QFo = (bf16x8*)(F.ws + WS_QF) + (size_t)ch * 512; const bf16* qrow = QN + (size_t)(row0 + r) * 1024 + hd * 128 + 4 * h;
#pragma unroll
      for (int tl = 0; tl < 4; ++tl)
#pragma unroll
          for (int sp = 0; sp < 2; ++sp) { const v2u qlo = *(const v2u*)(qrow + 32 * tl + 16 * sp), qhi = *(const v2u*)(qrow + 32 * tl + 16 * sp + 8); v4u qu; qu.x = qlo.x; qu.y = qlo.y; qu.z = qhi.x; qu.w = qhi.y; QFo[(tl * 2 + sp) * 64 + lane] = __builtin_bit_cast(bf16x8, qu); } }
    const float g_last = gcv[31];
    bf16x8* WF = (bf16x8*)(F.ws + WS_WF) + (size_t)ch * 512; bf16x8* KF = (bf16x8*)(F.ws + WS_KF) + (size_t)ch * 512;
#pragma unroll
    for (int tl = 0; tl < 4; ++tl) {
        f32x16 acc;
#pragma unroll
        for (int i = 0; i < 16; ++i) acc[i] = 0.f;
        const LAS unsigned char* col = TL + (32 * tl + r) * 2;
#pragma unroll
        for (int sp = 0; sp < 2; ++sp) { unsigned w[4];
#pragma unroll
            for (int e = 0; e < 4; ++e) { const unsigned lo = *(const LAS unsigned short*)(col + (16 * sp + 8 * h + 2 * e) * GA_PITCH), hi = *(const LAS unsigned short*)(col + (16 * sp + 8 * h + 2 * e + 1) * GA_PITCH); w[e] = lo | (hi << 16); }
            v4u wu; wu.x = w[0]; wu.y = w[1]; wu.z = w[2]; wu.w = w[3];
            acc = __builtin_amdgcn_mfma_f32_32x32x16_bf16(__builtin_bit_cast(bf16x8, wu), t2f[sp], acc, 0, 0, 0); }
#pragma unroll
        for (int i = 0; i < 16; ++i) acc[i] = -acc[i];
#pragma unroll
        for (int sp = 0; sp < 2; ++sp) { WF[(tl * 2 + sp) * 64 + lane] = pack_acc(acc, sp);
            float x[8];
#pragma unroll
            for (int e = 0; e < 8; ++e) { const int j0 = 16 * sp + 8 * (e >> 2) + (e & 3), j1 = j0 + 4; const float gj = h ? gcv[j1] : gcv[j0];
                const unsigned kv = *(const LAS unsigned short*)(col + (j0 + 4 * h) * GA_PITCH); x[e] = __builtin_bit_cast(float, kv << 16) * __expf(g_last - gj); }
            KF[(tl * 2 + sp) * 64 + lane] = __builtin_bit_cast(bf16x8, pack8(x)); }
    }
    asm volatile("s_waitcnt lgkmcnt(0)" ::: "memory");
#pragma unroll
    for (int i = 0; i < 8; ++i) { const int p = lane + 64 * i, rw = p >> 4, c16 = p & 15; *(LAS v4u*)(TL + rw * GA_PITCH + 16 * c16) = *(const v4u*)(VV + (size_t)(row0 + rw) * 1024 + hd * 128 + 8 * c16); }
    asm volatile("s_waitcnt lgkmcnt(0)" ::: "memory");
    f32x4* UF = (f32x4*)(F.ws + WS_UF) + (size_t)ch * 1024;
#pragma unroll
    for (int tl = 0; tl < 4; ++tl) {
        f32x16 acc;
#pragma unroll
        for (int i = 0; i < 16; ++i) acc[i] = 0.f;
        const LAS unsigned char* col = TL + (32 * tl + r) * 2;
#pragma unroll
        for (int sp = 0; sp < 2; ++sp) { unsigned w[4];
#pragma unroll
            for (int e = 0; e < 4; ++e) { const unsigned lo = *(const LAS unsigned short*)(col + (16 * sp + 8 * h + 2 * e) * GA_PITCH), hi = *(const LAS unsigned short*)(col + (16 * sp + 8 * h + 2 * e + 1) * GA_PITCH); w[e] = lo | (hi << 16); }
            v4u wu; wu.x = w[0]; wu.y = w[1]; wu.z = w[2]; wu.w = w[3];
            acc = __builtin_amdgcn_mfma_f32_32x32x16_bf16(t1f[sp], __builtin_bit_cast(bf16x8, wu), acc, 0, 0, 0); }
#pragma unroll
        for (int g4 = 0; g4 < 4; ++g4) UF[(tl * 4 + g4) * 64 + lane] = (f32x4){acc[4 * g4], acc[4 * g4 + 1], acc[4 * g4 + 2], acc[4 * g4 + 3]};
    }
    if (h == 0) ((float*)(F.ws + WS_TB))[(size_t)ch * 32 + r] = __expf(gc_own);
    asm volatile("s_waitcnt lgkmcnt(0)" ::: "memory");
}

constexpr int GSC_ITEMS = BATCH * HA * 4;
constexpr int GSB_WF = 0, GSB_KF = 8192, GSB_QF = 16384, GSB_UF = 24576, GSB_AF = 28672, GSB_TB = 30720, GSB_AL = 34816, GSB_STRIDE = 36864;
__device__ __forceinline__ void gdn_chunk_scan(Frame& F0, int l, int item) {
    RELANE(F0);
    const int lane = F.lane, r = lane & 31, h = lane >> 5;
    const int sl = item & 3, bh = item >> 2, hd = bh & 7, b = bh >> 3;
    float* ORAW = launder_pg((float*)(F.ws + WS_ORAW));
    LAS unsigned char* buf = F.lds;
#define GS_DMA(src, off) __builtin_amdgcn_global_load_lds((const unsigned*)(src), (LAS unsigned*)(bp + (off)), 16, 0, 0)
#define GS_FETCH(cc, bsel) do { const size_t ch_ = (size_t)bh * 64 + (cc); LAS unsigned char* bp = buf + (bsel) * GSB_STRIDE; \
        const bf16x8* wf_ = (const bf16x8*)(F.ws + WS_WF) + ch_ * 512 + lane; const bf16x8* kf_ = (const bf16x8*)(F.ws + WS_KF) + ch_ * 512 + lane; const bf16x8* qf_ = (const bf16x8*)(F.ws + WS_QF) + ch_ * 512 + lane; \
        const f32x4* uf_ = (const f32x4*)(F.ws + WS_UF) + ch_ * 1024 + (size_t)sl * 256 + lane; const bf16x8* af_ = (const bf16x8*)(F.ws + WS_AF) + ch_ * 128 + lane; const float* tb_ = (const float*)(F.ws + WS_TB) + ch_ * 32; \
        _Pragma("unroll") for (int i_ = 0; i_ < 8; ++i_) { GS_DMA(wf_ + i_ * 64, GSB_WF + i_ * 1024); GS_DMA(qf_ + i_ * 64, GSB_QF + i_ * 1024); } \
        _Pragma("unroll") for (int i_ = 0; i_ < 4; ++i_) { GS_DMA(uf_ + i_ * 64, GSB_UF + i_ * 1024); GS_DMA(tb_ + 8 * i_ + 4 * h, GSB_TB + i_ * 1024); } \
        GS_DMA(af_, GSB_AF); GS_DMA(af_ + 64, GSB_AF + 1024); \
        _Pragma("unroll") for (int i_ = 0; i_ < 8; ++i_) GS_DMA(kf_ + i_ * 64, GSB_KF + i_ * 1024); } while (0)
    f32x16 S[4];
#pragma unroll
    for (int tl = 0; tl < 4; ++tl)
#pragma unroll
        for (int i = 0; i < 16; ++i) S[tl][i] = 0.f;
    GS_FETCH(0, 0); GS_FETCH(1, 1);
    int bsel = 0;
#pragma unroll 1
    for (int c = 0; c < SEQ / 32; ++c) {
        const int row0 = b * SEQ + 32 * c;
        if (c < 2) asm volatile("s_waitcnt vmcnt(34)" ::: "memory"); else if (c + 1 < SEQ / 32) asm volatile("s_waitcnt vmcnt(63)" ::: "memory"); else asm volatile("s_waitcnt vmcnt(0)" ::: "memory");
        if (c + 2 < SEQ / 32) GS_FETCH(c + 2, (bsel == 0 ? 2 : bsel - 1));
        const LAS unsigned char* bp = buf + bsel * GSB_STRIDE + lane * 16; bsel = (bsel == 2) ? 0 : bsel + 1;
        f32x16 P, O1;
#pragma unroll
        for (int g4 = 0; g4 < 4; ++g4) { const f32x4 u = *(const LAS f32x4*)(bp + GSB_UF + g4 * 1024); P[4 * g4] = u.x; P[4 * g4 + 1] = u.y; P[4 * g4 + 2] = u.z; P[4 * g4 + 3] = u.w; }
#pragma unroll
        for (int i = 0; i < 16; ++i) O1[i] = 0.f;
#pragma unroll
        for (int tl = 0; tl < 4; ++tl)
#pragma unroll
            for (int sp = 0; sp < 2; ++sp) {
                const bf16x8 sf = pack_acc(S[tl], sp);
                P = __builtin_amdgcn_mfma_f32_32x32x16_bf16(*(const LAS bf16x8*)(bp + GSB_WF + (tl * 2 + sp) * 1024), sf, P, 0, 0, 0);
                O1 = __builtin_amdgcn_mfma_f32_32x32x16_bf16(*(const LAS bf16x8*)(bp + GSB_QF + (tl * 2 + sp) * 1024), sf, O1, 0, 0, 0);
            }
        float eg3w = 0.f;
#pragma unroll
        for (int g4 = 0; g4 < 4; ++g4) { const f32x4 eg = *(const LAS f32x4*)(bp + GSB_TB + g4 * 1024); O1[4 * g4] *= eg.x; O1[4 * g4 + 1] *= eg.y; O1[4 * g4 + 2] *= eg.z; O1[4 * g4 + 3] *= eg.w; if (g4 == 3) eg3w = eg.w; }
        const bf16x8 vf0 = pack_acc(P, 0), vf1 = pack_acc(P, 1);
        O1 = __builtin_amdgcn_mfma_f32_32x32x16_bf16(*(const LAS bf16x8*)(bp + GSB_AF), vf0, O1, 0, 0, 0);
        O1 = __builtin_amdgcn_mfma_f32_32x32x16_bf16(*(const LAS bf16x8*)(bp + GSB_AF + 1024), vf1, O1, 0, 0, 0);
        const float a_last = __builtin_bit_cast(float, __builtin_amdgcn_readlane(__builtin_bit_cast(int, eg3w), 32));
#pragma unroll
        for (int tl = 0; tl < 4; ++tl) {
#pragma unroll
            for (int i = 0; i < 16; ++i) S[tl][i] *= a_last;
            S[tl] = __builtin_amdgcn_mfma_f32_32x32x16_bf16(*(const LAS bf16x8*)(bp + GSB_KF + (tl * 2) * 1024), vf0, S[tl], 0, 0, 0);
            S[tl] = __builtin_amdgcn_mfma_f32_32x32x16_bf16(*(const LAS bf16x8*)(bp + GSB_KF + (tl * 2 + 1) * 1024), vf1, S[tl], 0, 0, 0);
        }
        float* op = ORAW + (size_t)(row0 + 4 * h) * 1024 + hd * 128 + 32 * sl + r;
#pragma unroll
        for (int i = 0; i < 16; ++i) op[(size_t)((i & 3) + 8 * (i >> 2)) * 1024] = O1[i];
    }
#undef GS_DMA
#undef GS_FETCH
    float* Sout = F.out + O_PGDN + (size_t)((l * BATCH + b) * HA + hd) * 16384 + 32 * sl + r;
#pragma unroll
    for (int tl = 0; tl < 4; ++tl)
#pragma unroll
        for (int i = 0; i < 16; ++i) Sout[(size_t)(32 * tl + (i & 3) + 8 * (i >> 2) + 4 * h) * 128] = S[tl][i];
}

constexpr int VT_PITCH = 144, VT_WAVE_LDS = 64 * VT_PITCH, VT_ITEMS = BATCH * 3 * 4 * 2 * 32;
__device__ __forceinline__ void vt_item(Frame& F0, int item) {
    RELANE_G(F0);
    const int lane = F.lane; LAS unsigned char* T = F.lds + F.wave * VT_WAVE_LDS;
    const int ch = item & 31, dh = (item >> 5) & 1, hh = (item >> 6) & 3, bg = item >> 8, g = bg % 3, b = bg / 3;
    const int dil = 1 << (2 * g), Lc = SEQ >> (2 * g), pos0 = ch * 64, rho = pos0 / Lc, i0 = pos0 % Lc;
    const bf16* PROJ = (const bf16*)(F.ws + WS_PROJ); bf16* VT = (bf16*)(F.ws + WS_VT);
    const bf16* src = PROJ + ((size_t)b * SEQ + (size_t)(i0 + lane) * dil + rho) * NIN + PC_VB + g * 512 + hh * 128 + 64 * dh;
    v4u x[8];
#pragma unroll
    for (int c = 0; c < 8; ++c) x[c] = *(const v4u*)(src + 8 * c);
#pragma unroll
    for (int c = 0; c < 8; ++c) { const unsigned w[4] = {x[c].x, x[c].y, x[c].z, x[c].w};
#pragma unroll
        for (int e = 0; e < 4; ++e) { *(LAS unsigned short*)(T + (8 * c + 2 * e) * VT_PITCH + 2 * lane) = (unsigned short)(w[e] & 0xffffu); *(LAS unsigned short*)(T + (8 * c + 2 * e + 1) * VT_PITCH + 2 * lane) = (unsigned short)(w[e] >> 16); } }
    asm volatile("s_waitcnt lgkmcnt(0)" ::: "memory");
    bf16* dst = VT + ((size_t)((b * 3 + g) * 4 + hh) * 128 + 64 * dh) * 2048 + pos0;
#pragma unroll
    for (int it = 0; it < 8; ++it) { const int p = lane + 64 * it, row = p >> 3, cc = p & 7; const v4u v = *(const LAS v4u*)(T + row * VT_PITCH + 16 * cc); *(v4u*)(dst + (size_t)row * 2048 + 8 * cc) = v; }
    asm volatile("s_waitcnt lgkmcnt(0)" ::: "memory");
}

constexpr int ATT_UNITS = BATCH * 4 * 192;
__device__ __forceinline__ void attn_unit(Frame& F0, int unit) {
    RELANE(F0);
    const int lane = F.lane, r = lane & 31, h = lane >> 5;
    const int bh = unit / 192, b = bh >> 2, hh = bh & 3, u = unit % 192, g = u >> 6, v = u & 63;
    const int dil = 1 << (2 * g), ntpc = 64 >> (2 * g), rho = v / ntpc, i0 = (v % ntpc) * 32, Lc = SEQ >> (2 * g);
    const bf16* PROJ = (const bf16*)(F.ws + WS_PROJ);
    const bf16* cbase = PROJ + ((size_t)b * SEQ + rho) * NIN + g * 512 + hh * 128 + 8 * h;
    const bf16* qp = cbase + (size_t)(i0 + r) * dil * NIN + PC_QB;
    bf16x8 qf[8];
#pragma unroll
    for (int ks = 0; ks < 8; ++ks) qf[ks] = *(const bf16x8*)(qp + 16 * ks);
    f32x16 st[5]; float mx = -1e30f;
    bf16x8 kn[8];
    { const int k0 = i0 - 128; const bf16* kp = cbase + (size_t)((k0 >= 0 ? k0 : 0) + r) * dil * NIN + PC_KB;
#pragma unroll
      for (int ks = 0; ks < 8; ++ks) kn[ks] = *(const bf16x8*)(kp + 16 * ks); }
#pragma unroll
    for (int kt = 0; kt < 5; ++kt) {
        const int k0 = i0 - 128 + 32 * kt; const bool tv = k0 >= 0;
        bf16x8 kc[8];
#pragma unroll
        for (int ks = 0; ks < 8; ++ks) kc[ks] = kn[ks];
        if (kt < 4) { const int k1 = k0 + 32; const bf16* kp = cbase + (size_t)((k1 >= 0 ? k1 : 0) + r) * dil * NIN + PC_KB;
#pragma unroll
            for (int ks = 0; ks < 8; ++ks) kn[ks] = *(const bf16x8*)(kp + 16 * ks); }
        f32x16 acc;
#pragma unroll
        for (int i = 0; i < 16; ++i) acc[i] = 0.f;
#pragma unroll
        for (int ks = 0; ks < 8; ++ks) acc = __builtin_amdgcn_mfma_f32_32x32x16_bf16(kc[ks], qf[ks], acc, 0, 0, 0);
#pragma unroll
        for (int i = 0; i < 16; ++i) { const int row = (i & 3) + 8 * (i >> 2) + 4 * h; float sv = tv ? acc[i] : -1e30f;
            if (kt == 0 && row < r) sv = -1e30f;
            if (kt == 4 && row > r) sv = -1e30f;
            st[kt][i] = sv; mx = fmaxf(mx, sv); }
    }
    mx = fmaxf(mx, __shfl_xor(mx, 32));
    const float c = 0.08838834764831845f * 1.4426950408889634f, mc = mx * c; float ls = 0.f;
#pragma unroll
    for (int kt = 0; kt < 5; ++kt)
#pragma unroll
        for (int i = 0; i < 16; ++i) { const float p = __builtin_amdgcn_exp2f(st[kt][i] * c - mc); st[kt][i] = p; ls += p; }
    ls += __shfl_xor(ls, 32);
    f32x16 ot[4];
#pragma unroll
    for (int dt = 0; dt < 4; ++dt)
#pragma unroll
        for (int i = 0; i < 16; ++i) ot[dt][i] = 0.f;
    const bf16* vt = (const bf16*)(F.ws + WS_VT) + ((size_t)((b * 3 + g) * 4 + hh) * 128 + r) * 2048 + rho * Lc + 4 * h;
    v2u vn[2][4][2];
#define ATT_VLD(kt_) do { const int k0_ = i0 - 128 + 32 * (kt_), kc_ = k0_ >= 0 ? k0_ : 0; _Pragma("unroll") for (int sp = 0; sp < 2; ++sp) _Pragma("unroll") for (int dt = 0; dt < 4; ++dt) { \
            const bf16* vp = vt + (size_t)(32 * dt) * 2048 + kc_ + 16 * sp; vn[sp][dt][0] = *(const v2u*)vp; vn[sp][dt][1] = *(const v2u*)(vp + 8); } } while (0)
    ATT_VLD(0);
#pragma unroll
    for (int kt = 0; kt < 5; ++kt) {
        v2u vc[2][4][2];
#pragma unroll
        for (int sp = 0; sp < 2; ++sp)
#pragma unroll
            for (int dt = 0; dt < 4; ++dt) { vc[sp][dt][0] = vn[sp][dt][0]; vc[sp][dt][1] = vn[sp][dt][1]; }
        if (kt < 4) ATT_VLD(kt + 1);
#pragma unroll
        for (int sp = 0; sp < 2; ++sp) {
            v4u pu; pu.x = pk2(st[kt][8 * sp + 0], st[kt][8 * sp + 1]); pu.y = pk2(st[kt][8 * sp + 2], st[kt][8 * sp + 3]); pu.z = pk2(st[kt][8 * sp + 4], st[kt][8 * sp + 5]); pu.w = pk2(st[kt][8 * sp + 6], st[kt][8 * sp + 7]);
            const bf16x8 pf = __builtin_bit_cast(bf16x8, pu);
#pragma unroll
            for (int dt = 0; dt < 4; ++dt) {
                v4u vu; vu.x = vc[sp][dt][0].x; vu.y = vc[sp][dt][0].y; vu.z = vc[sp][dt][1].x; vu.w = vc[sp][dt][1].y;
                ot[dt] = __builtin_amdgcn_mfma_f32_32x32x16_bf16(__builtin_bit_cast(bf16x8, vu), pf, ot[dt], 0, 0, 0);
            }
        }
    }
#undef ATT_VLD
    const float inv = 1.f / ls; const size_t tok = (size_t)b * SEQ + (size_t)(i0 + r) * dil + rho;
    bf16* op = (bf16*)(F.ws + WS_OBG) + ((size_t)g * MV + tok) * 512 + hh * 128 + 4 * h;
#pragma unroll
    for (int dt = 0; dt < 4; ++dt)
#pragma unroll
        for (int g4 = 0; g4 < 4; ++g4) { v2u w; w.x = pk2(ot[dt][4 * g4] * inv, ot[dt][4 * g4 + 1] * inv); w.y = pk2(ot[dt][4 * g4 + 2] * inv, ot[dt][4 * g4 + 3] * inv); *(v2u*)(op + 32 * dt + 8 * g4) = w; }
    if (h == 0) *(f32x2*)((float*)(F.ws + WS_AST) + (((size_t)g * MV + tok) * 4 + hh) * 2) = (f32x2){mc, ls};
}


__device__ __forceinline__ void attn_sample_item(Frame& F0, int l, int item) {
    RELANE(F0);
    const int lane = F.lane, l16 = lane & 15;
    const int half = item & 1, it2 = item >> 1, g = it2 % 3, bt = it2 / 3, t = bt & 3, b = bt >> 2, dil = 1 << (2 * g), win = 128 * dil, jlo = half ? 65 : 0, part = g + 3 * half;
    const bf16* PROJ = (const bf16*)(F.ws + WS_PROJ);
    const int row = MP + DS * b + t;
    const float* cache = F.in[2 + g] + (size_t)(l * DB + b) * win * 1024 + 8 * lane;
    const bf16* newk = PROJ + (size_t)(MP + DS * b) * NIN + PC_KB + g * 512 + 8 * lane;
    float q[8]; unpack8(*(const v4u*)(PROJ + (size_t)row * NIN + PC_QB + g * 512 + 8 * lane), q);
    const int n_new = (g == 0) ? t + 1 : 1;
    const float c = 0.08838834764831845f * 1.4426950408889634f;
    float sc[5];
#pragma unroll
    for (int jr = 0; jr < 5; ++jr) {
        sc[jr] = -1e30f;
        const int jn = jr < 4 ? 16 : 1;
#pragma unroll 8
        for (int jl = 0; jl < jn; ++jl) {
            const int j = jlo + 16 * jr + jl, jc = j <= 128 ? j : 128; int idx = win + t - jc * dil; idx = idx < win ? idx : win - 1;
            const float* kp = cache + (size_t)idx * 1024; const f32x4 a = *(const f32x4*)kp, bq = *(const f32x4*)(kp + 4);
            float sv = (q[0] * a.x + q[1] * a.y) + (q[2] * a.z + q[3] * a.w) + (q[4] * bq.x + q[5] * bq.y) + (q[6] * bq.z + q[7] * bq.w);
            sv = j <= 128 ? row16_sum(sv) * c : -1e30f;
            sc[jr] = (l16 == jl) ? sv : sc[jr];
        }
    }
#pragma unroll
    for (int jj = 0; jj < 4; ++jj) {
        const int tk = t - jj >= 0 ? t - jj : 0; float k[8]; unpack8(*(const v4u*)(newk + (size_t)tk * NIN), k);
        float sv = (q[0] * k[0] + q[1] * k[1]) + (q[2] * k[2] + q[3] * k[3]) + (q[4] * k[4] + q[5] * k[5]) + (q[6] * k[6] + q[7] * k[7]);
        sv = row16_sum(sv) * c;
        sc[0] = (half == 0 && jj < n_new && l16 == jj) ? sv : sc[0];
    }
    float mx = -1e30f;
#pragma unroll
    for (int jr = 0; jr < 5; ++jr) mx = fmaxf(mx, sc[jr]);
    mx = fmaxf(mx, dpp_f<0xB1>(mx)); mx = fmaxf(mx, dpp_f<0x4E>(mx)); mx = fmaxf(mx, dpp_f<0x124>(mx)); mx = fmaxf(mx, dpp_f<0x128>(mx));
    float ls = 0.f;
#pragma unroll
    for (int jr = 0; jr < 5; ++jr) { sc[jr] = __builtin_amdgcn_exp2f(sc[jr] - mx); ls += sc[jr]; }
    ls = row16_sum(ls);
    float o[8];
#pragma unroll
    for (int e = 0; e < 8; ++e) o[e] = 0.f;
#pragma unroll
    for (int jj = 0; jj < 4; ++jj) {
        const int tk = t - jj >= 0 ? t - jj : 0; float vv[8]; unpack8(*(const v4u*)(newk + (size_t)tk * NIN + (PC_VB - PC_KB)), vv);
        const bool isnew = half == 0 && jj < n_new;
        const float p = isnew ? __shfl(sc[0], (lane & 48) | jj) : 0.f;
#pragma unroll
        for (int e = 0; e < 8; ++e) o[e] += p * vv[e];
        sc[0] = (isnew && l16 == jj) ? 0.f : sc[0];
    }
#pragma unroll
    for (int jr = 0; jr < 5; ++jr) {
        const int jn = jr < 4 ? 16 : 1;
#pragma unroll 8
        for (int jl = 0; jl < jn; ++jl) {
            const int j = jlo + 16 * jr + jl, jc = j <= 128 ? j : 128; int idx = win + t - jc * dil; idx = idx < win ? idx : win - 1;
            const float p = __shfl(sc[jr], (lane & 48) | jl);
            const float* vp = cache + (size_t)idx * 1024 + 512; const f32x4 a = *(const f32x4*)vp, bq = *(const f32x4*)(vp + 4);
            o[0] += p * a.x; o[1] += p * a.y; o[2] += p * a.z; o[3] += p * a.w; o[4] += p * bq.x; o[5] += p * bq.y; o[6] += p * bq.z; o[7] += p * bq.w;
        }
    }
    const float inv = 1.f / ls;
#pragma unroll
    for (int e = 0; e < 8; ++e) o[e] *= inv;
    *(v4u*)((bf16*)(F.ws + WS_OBG) + ((size_t)part * MV + row) * 512 + 8 * lane) = pack8(o);
    if (l16 == 0) *(f32x2*)((float*)(F.ws + WS_AST) + (((size_t)part * MV + row) * 4 + (lane >> 4)) * 2) = (f32x2){mx, ls};
}

__device__ __forceinline__ void gdn_gate_rows(Frame& F0, int l) {
    RELANE_G(F0);
    const int lane = F.lane, gw = F.vcu * NWAVES + F.wave, NGW = F.G * NWAVES;
    const float* ORAW = (const float*)(F.ws + WS_ORAW); const bf16* PROJ = (const bf16*)(F.ws + WS_PROJ); bf16* OUTA = (bf16*)(F.ws + WS_OUTA);
    const float* gain = F.in[12] + (size_t)l * 128;
    for (int r = gw; r < MV; r += NGW) {
#pragma unroll
        for (int j = 0; j < 4; ++j) {
            const int c0 = 256 * j + 4 * lane; const f32x4 o = *(const f32x4*)(ORAW + (size_t)r * 1024 + c0);
            float ss = (o.x * o.x + o.y * o.y) + (o.z * o.z + o.w * o.w);
            ss += __shfl_xor(ss, 1); ss += __shfl_xor(ss, 2); ss += __shfl_xor(ss, 4); ss += __shfl_xor(ss, 8); ss += __shfl_xor(ss, 16);
            const float rstd = rsqrtf(ss * (1.f / 128.f) + EPS);
            const f32x4 g = *(const f32x4*)(gain + (c0 & 127)); const v2u zu = *(const v2u*)(PROJ + (size_t)r * NIN + PC_ZA + c0);
            const float z0 = bf_lo(zu.x), z1 = bf_hi(zu.x), z2 = bf_lo(zu.y), z3 = bf_hi(zu.y);
            v2u w; w.x = pk2(o.x * rstd * g.x * silu(z0), o.y * rstd * g.y * silu(z1)); w.y = pk2(o.z * rstd * g.z * silu(z2), o.w * rstd * g.w * silu(z3));
            *(v2u*)(OUTA + (size_t)r * 1024 + c0) = w;
        }
        {
            const int c0 = 8 * lane, hh = lane >> 4; const float* ast = (const float*)(F.ws + WS_AST); const bf16* obg = (const bf16*)(F.ws + WS_OBG);
            const int np = r < MP ? 3 : 6;
            f32x2 sg[6]; v4u xo[6]; float M = -1e30f;
#pragma unroll
            for (int g = 0; g < 6; ++g) { const int gg = g < np ? g : 0; sg[g] = *(const f32x2*)(ast + (((size_t)gg * MV + r) * 4 + hh) * 2); xo[g] = *(const v4u*)(obg + ((size_t)gg * MV + r) * 512 + c0); }
#pragma unroll
            for (int g = 0; g < 6; ++g) { if (g >= np) sg[g] = (f32x2){-1e30f, 0.f}; M = fmaxf(M, sg[g].x); }
            float wg[6], den = 0.f;
#pragma unroll
            for (int g = 0; g < 6; ++g) { wg[g] = __builtin_amdgcn_exp2f(sg[g].x - M) * sg[g].y; den += wg[g]; }
            const float inv = 1.f / den; float o[8];
#pragma unroll
            for (int e = 0; e < 8; ++e) o[e] = 0.f;
#pragma unroll
            for (int g = 0; g < 6; ++g) { float x[8]; unpack8(xo[g], x); const float w = wg[g] * inv;
#pragma unroll
                for (int e = 0; e < 8; ++e) o[e] += w * x[e]; }
            *(v4u*)((bf16*)(F.ws + WS_OUTB) + (size_t)r * 512 + c0) = pack8(o);
        }
    }
}


constexpr int CP_PER_B = 31 + 127 + 511, CP_NSUB = DB * CP_PER_B;
constexpr int CP_TAIL_WG = 84, CP_TAIL_PER_WG = 64, CP_TAIL = CP_TAIL_WG * CP_TAIL_PER_WG;
__device__ __forceinline__ void copy_subchunk(Frame& F, int l, int c) {
    const int lane = F.lane, b = c / CP_PER_B, rc = c % CP_PER_B; const int gi = rc < 31 ? 0 : rc < 158 ? 1 : 2, k = rc - (gi == 0 ? 0 : gi == 1 ? 31 : 158), win = 128 << (2 * gi);
    const f32x4* src = (const f32x4*)(F.in[2 + gi] + ((size_t)(l * DB + b) * win + DS + 4 * k) * 1024) + lane;
    f32x4* dst = (f32x4*)(F.out + (gi == 0 ? O_SW1 : gi == 1 ? O_SW2 : O_SW3) + ((size_t)(l * DB + b) * win + 4 * k) * 1024) + lane;
    f32x4 v[16];
#pragma unroll
    for (int i = 0; i < 16; ++i) v[i] = __builtin_nontemporal_load(src + 64 * i);
#pragma unroll
    for (int i = 0; i < 16; ++i) __builtin_nontemporal_store(v[i], dst + 64 * i);
}
__device__ __forceinline__ void side_queue(Frame& F0, int l, volatile LAS unsigned* qctr) {
    RELANE(F0);
    const int lane = F.lane;
    const int nsub = CP_NSUB - (F.G == 256 ? CP_TAIL : 0);
    const int ncp = (nsub - (int)blockIdx.x + F.G - 1) / F.G;
    const int wper = 0,     w0 = (int)blockIdx.x * wper, nw = max(0, min(IT_LAYER, w0 + wper) - w0);
    LAS float* scr = (LAS float*)F.lds;
    for (;;) {
        unsigned q = 0; if (lane == 0) q = __hip_atomic_fetch_add((LAS unsigned*)qctr, 1u, __ATOMIC_RELAXED, __HIP_MEMORY_SCOPE_WORKGROUP);
        q = (unsigned)__builtin_amdgcn_readfirstlane((int)q);
        if ((int)q >= ncp + nw) break;
        if ((int)q < ncp) { copy_subchunk(F, l, (int)q * F.G + (int)blockIdx.x);
        } else weight_item(F, l + 1, w0 + (int)q - ncp, scr);
    }
}


__device__ __forceinline__ f32x16 skinny_kloop(const bf16* ap, const bf16* bp, int nks, f32x16 acc) {
    int ks = 0;
    for (; ks + 8 <= nks; ks += 8) { bf16x8 a[8], b[8];
#pragma unroll
        for (int u = 0; u < 8; ++u) { a[u] = *(const bf16x8*)(ap + 16 * (ks + u)); b[u] = *(const bf16x8*)(bp + 16 * (ks + u)); }
#pragma unroll
        for (int u = 0; u < 8; ++u) acc = __builtin_amdgcn_mfma_f32_32x32x16_bf16(a[u], b[u], acc, 0, 0, 0); }
    for (; ks < nks; ks += 4) { bf16x8 a[4], b[4];
#pragma unroll
        for (int u = 0; u < 4; ++u) { a[u] = *(const bf16x8*)(ap + 16 * (ks + u)); b[u] = *(const bf16x8*)(bp + 16 * (ks + u)); }
#pragma unroll
        for (int u = 0; u < 4; ++u) acc = __builtin_amdgcn_mfma_f32_32x32x16_bf16(a[u], b[u], acc, 0, 0, 0); }
    return acc;
}
__device__ __forceinline__ f32x2 skinny_reduce(Frame& F, const f32x16& acc) {
    LAS float* P = (LAS float*)F.lds; const int r = F.lane & 31, h = F.lane >> 5;
    __syncthreads();
#pragma unroll
    for (int i = 0; i < 16; ++i) P[(F.wave * 32 + (i & 3) + 8 * (i >> 2) + 4 * h) * 33 + r] = acc[i];
    __syncthreads();
    const int row = F.tid >> 4, col = 2 * (F.tid & 15); f32x2 o = {0.f, 0.f};
#pragma unroll
    for (int w = 0; w < 8; ++w) { o.x += P[(w * 32 + row) * 33 + col]; o.y += P[(w * 32 + row) * 33 + col + 1]; }
    return o;
}
__device__ __forceinline__ void skinny_store(Frame& F0, const bf16* A, int lda, const bf16* Bt, int K, bf16* O) {
    RELANE(F0);
    const int r = F.lane & 31, h = F.lane >> 5, kw = K / 8;
    for (int unit = launder_s((int)blockIdx.x); unit < 256; unit += F.G) {
        const int mt = unit >> 6, nt = unit & 63;
        f32x16 acc;
#pragma unroll
        for (int i = 0; i < 16; ++i) acc[i] = 0.f;
        acc = skinny_kloop(A + (size_t)(MP + 32 * mt + r) * lda + F.wave * kw + 8 * h, Bt + (size_t)(32 * nt + r) * K + F.wave * kw + 8 * h, kw / 16, acc);
        const f32x2 o = skinny_reduce(F, acc);
        *(unsigned*)(O + (size_t)(MP + 32 * mt + (F.tid >> 4)) * D + 32 * nt + 2 * (F.tid & 15)) = pk2(o.x, o.y);
    }
}
__device__ __forceinline__ void skinny_merge(Frame& F0, const unsigned char* wl) {
    RELANE(F0);
    const int r = F.lane & 31, h = F.lane >> 5; const bf16* PROJ = (const bf16*)(F.ws + WS_PROJ);
    for (int unit = launder_s((int)blockIdx.x); unit < 256; unit += F.G) {
        const int mt = unit >> 6, nt = unit & 63;
        f32x16 tot;
#pragma unroll
        for (int i = 0; i < 16; ++i) tot[i] = 0.f;
#pragma unroll
        for (int br = 0; br < 3; ++br) {
            const int K = br == 1 ? 512 : 1024, kw = K / 8;
            const bf16* A = (const bf16*)(F.ws + (br == 0 ? WS_OUTA : br == 1 ? WS_OUTB : WS_OC)); const bf16* Bt = (const bf16*)(wl + (br == 0 ? WO_BRA : br == 1 ? WO_BRB : WO_BRC));
            f32x16 acc;
#pragma unroll
            for (int i = 0; i < 16; ++i) acc[i] = 0.f;
            acc = skinny_kloop(A + (size_t)(MP + 32 * mt + r) * K + F.wave * kw + 8 * h, Bt + (size_t)(32 * nt + r) * K + F.wave * kw + 8 * h, kw / 16, acc);
            const bf16* gp = PROJ + (size_t)(MP + 32 * mt + 4 * h) * NIN + PC_GATE + br * 2048 + 32 * nt + r;
#pragma unroll
            for (int i = 0; i < 16; ++i) tot[i] += acc[i] * bf1(gp[(size_t)((i & 3) + 8 * (i >> 2)) * NIN]);
        }
        const f32x2 o = skinny_reduce(F, tot);
        *(unsigned*)((bf16*)(F.ws + WS_MERGED) + (size_t)(MP + 32 * mt + (F.tid >> 4)) * D + 32 * nt + 2 * (F.tid & 15)) = pk2(o.x, o.y);
    }
}

constexpr int N_PHASES = 1 + 11 * DEPTH;
__global__ void __launch_bounds__(NWAVES * 64, 2) fwd(Args args) {
    extern __shared__ __attribute__((aligned(16))) unsigned char lds_raw[];
    Frame F;
    F.lds = (LAS unsigned char*)lds_raw;
    F.tid = threadIdx.x; F.lane = F.tid & 63; F.wave = __builtin_amdgcn_readfirstlane(F.tid >> 6);
    F.G = gridDim.x; { const int bx = blockIdx.x; F.vcu = (F.G % 8 == 0) ? (bx % 8) * (F.G / 8) + bx / 8 : bx; }
    const CAS Args* const ap = (const CAS Args*)__builtin_amdgcn_kernarg_segment_ptr();
    F.in = ap->in; F.out = args.out; F.ws = args.ws;
    volatile LAS unsigned* MISC = (volatile LAS unsigned*)(F.lds + MISC_OFF);
    for (int u = F.tid; u < (LDS_BYTES - LDSCTL_OFF) / 4; u += NWAVES * 64) ((LAS unsigned*)(F.lds + LDSCTL_OFF))[u] = 0u;
    __syncthreads();
#if MK_ONE_LAUNCH
    XcdBarrier bar = xcd_barrier_post((unsigned*)(F.ws + WS_CTL) + CW_BAR, MISC + 8);
#define GRID_BAR() xcd_barrier(bar)
#else
#define GRID_BAR() do {} while (0)
#endif
    const int lo = args.ph_lo, hi = args.ph_hi;
#ifndef PHMASK
#define PHMASK 0xfff
#endif
#define IN(k) (lo <= (k) && (k) < hi)
#define EN(j) ((PHMASK >> (j)) & 1)
#ifndef REPMASK
#define REPMASK 0
#endif
#ifndef SUBREP
#define SUBREP 0
#endif
#define SUBR(j) for (int sr_ = 0; sr_ < 1 + ((SUBREP >> (j)) & 1); ++sr_)
#define REPEAT(j) for (int rep_ = 0; rep_ < 1 + ((REPMASK >> (j)) & 1); ++rep_)
#define REPBAR() do { if (rep_) GRID_BAR(); F.ws = launder_p(args.ws); F.out = launder_p(args.out); F.in = launder_k(ap->in); F.vcu = launder_s(vcu0); F.wave = launder_s(wave0); gw = F.vcu * NWAVES + F.wave; } while (0)
#define SEAM(k) do { if (IN(k) && IN((k) + 1)) GRID_BAR(); } while (0)
    const int vcu0 = F.vcu, wave0 = F.wave; int gw = F.vcu * NWAVES + F.wave; const int NGW = F.G * NWAVES;
    bf16* const H = (bf16*)(F.ws + WS_H); bf16* const PROJ = (bf16*)(F.ws + WS_PROJ);

    if (EN(0) && IN(0)) REPEAT(0) { REPBAR();
        LAS float* scr = (LAS float*)(F.lds + F.wave * 16384);
        for (int it = gw; it < 2 * IT_LAYER; it += NGW) { const int l = it >= IT_LAYER ? 1 : 0; weight_item(F, l, it - l * IT_LAYER, scr); }
        __syncthreads();
        stage_wba(F, 0);
        thin_rows<true>(F, F.in[0], F.in[1], nullptr, nullptr, nullptr, F.in[21], true, 0);
        __syncthreads();
    }
    SEAM(0);
#pragma unroll 1
    for (int l = 0; l < DEPTH; ++l) {
        const int pb = 1 + 11 * l;
        unsigned char* wl = F.ws + WS_W + (size_t)l * WL_BYTES;
        if (EN(1) && IN(pb + 0)) REPEAT(1) { REPBAR();
            pg8::Gemm g{H, (const bf16*)(wl + WO_IN), D, D, D, 0, (unsigned*)(F.ws + WS_PAD)}; pg8::StaticOrder S; S.init(MT, NIN, launder_s(F.G), launder_s((int)blockIdx.x));
            EpiStore E{PROJ, NIN, PC_GATE / 256};
            pg8::gemm_phase<EpiStore, pg8::StaticOrder, true, true>(F.lds, g, S, E);
        }
        SEAM(pb + 0);
        if (EN(2) && IN(pb + 1)) REPEAT(2) { REPBAR(); for (int it = gw; it < PREP_ITEMS; it += NGW) prep_item(F, l, it); prep_out_rows(F, l); for (int it = gw; it < VT_ITEMS; it += NGW) vt_item(F, it); }
        SEAM(pb + 1);
        if (EN(3) && IN(pb + 2)) REPEAT(3) { REPBAR(); for (int it = gw; it < GCH; it += NGW) gdn_ga_item(F, it); }
        SEAM(pb + 2);
        if (EN(4) && IN(pb + 3)) REPEAT(4) { REPBAR();
            if (F.tid == 0) MISC[16] = 0u;
            { pg8::Gemm g{(const bf16*)(F.ws + WS_POOLED), (const bf16*)(wl + WO_POOL), 1024, 256, 256, 512}; pg8::StaticOrder S; S.init(MT, 1024, launder_s(F.G), launder_s((int)blockIdx.x));
              EpiStore E{(bf16*)(F.ws + WS_OC), 1024, 1 << 30};
              pg8::gemm_phase<EpiStore, pg8::StaticOrder>(F.lds, g, S, E); }
            SUBR(3) for (int it = gw; it < DB * HA * 8; it += NGW) { const int s = it & 7, bh = it >> 3, b = bh >> 3, h = bh & 7;
                gdn_scan_item(F, MP + DS * b, h, s, F.in[5] + (size_t)((l * DB + b) * HA + h) * 16384, F.out + O_SGDN + (size_t)((l * DB + b) * HA + h) * 16384); }
            {
                const bool scanw = (F.wave == 0) && (F.vcu < GSC_ITEMS);
                if (scanw) { SUBR(0) gdn_chunk_scan(F, l, F.vcu); }
                else {
                    const int aw = F.vcu < GSC_ITEMS ? F.vcu * 7 + F.wave - 1 : GSC_ITEMS * 7 + (F.vcu - GSC_ITEMS) * 8 + F.wave, naw = F.G * 8 - GSC_ITEMS;
                    SUBR(1) for (int it = aw; it < ATT_UNITS; it += naw) attn_unit(F, it);
                    SUBR(2) for (int it = (aw + naw - ATT_UNITS % naw) % naw; it < MS * 6; it += naw) attn_sample_item(F, l, it);
                }
            }
            side_queue(F, l, MISC + 16);
        }
        SEAM(pb + 3);
        if (EN(5) && IN(pb + 4)) REPEAT(5) { REPBAR(); gdn_gate_rows(F, l); }
        SEAM(pb + 4);
        if (EN(6) && IN(pb + 5)) REPEAT(6) { REPBAR();
            pg8::StaticOrder S; S.init(MP, D, launder_s(F.G), launder_s((int)blockIdx.x)); bf16* MG = (bf16*)(F.ws + WS_MERGED);
            { pg8::Gemm g{(const bf16*)(F.ws + WS_OUTA), (const bf16*)(wl + WO_BRA), 1024, 1024, 1024, 0}; EpiMerge<false> E{MG, PROJ + PC_GATE}; pg8::gemm_phase<EpiMerge<false>, pg8::StaticOrder>(F.lds, g, S, E); }
            { pg8::Gemm g{(const bf16*)(F.ws + WS_OUTB), (const bf16*)(wl + WO_BRB), 512, 512, 512, 0}; EpiMerge<true> E{MG, PROJ + PC_GATE + 2048}; pg8::gemm_phase<EpiMerge<true>, pg8::StaticOrder>(F.lds, g, S, E); }
            { pg8::Gemm g{(const bf16*)(F.ws + WS_OC), (const bf16*)(wl + WO_BRC), 1024, 1024, 1024, 0}; EpiMerge<true> E{MG, PROJ + PC_GATE + 4096}; pg8::gemm_phase<EpiMerge<true>, pg8::StaticOrder>(F.lds, g, S, E); }
            skinny_merge(F, wl);
        }
        SEAM(pb + 5);
        if (EN(7) && IN(pb + 6)) REPEAT(7) { REPBAR();
            pg8::Gemm g{(const bf16*)(F.ws + WS_MERGED), (const bf16*)(wl + WO_OUT), D, D, D, 0}; pg8::StaticOrder S; S.init(MP, D, launder_s(F.G), launder_s((int)blockIdx.x));
            EpiStore E{(bf16*)(F.ws + WS_Y), D, 1 << 30};
            pg8::gemm_phase<EpiStore, pg8::StaticOrder>(F.lds, g, S, E);
            skinny_store(F, (const bf16*)(F.ws + WS_MERGED), D, (const bf16*)(wl + WO_OUT), D, (bf16*)(F.ws + WS_Y));
        }
        SEAM(pb + 6);
        if (EN(8) && IN(pb + 7)) REPEAT(8) { REPBAR();
            thin_rows<false>(F, nullptr, nullptr, (const bf16*)(F.ws + WS_Y), F.in[22] + (size_t)l * D, nullptr, F.in[23] + (size_t)l * D, false, 0, 0);
        }
        SEAM(pb + 7);
        if (EN(9) && IN(pb + 8)) REPEAT(9) { REPBAR();
            pg8::Gemm g{H, (const bf16*)(wl + WO_GU), D, D, D, 0, (unsigned*)(F.ws + WS_PAD)}; pg8::StaticOrder S; S.init(MT, 2 * DFF, launder_s(F.G), launder_s((int)blockIdx.x));
            EpiSwiglu E{(bf16*)(F.ws + WS_ACT)};
            pg8::gemm_phase<EpiSwiglu, pg8::StaticOrder, true, true>(F.lds, g, S, E);
            const int bxl = launder_s((int)blockIdx.x), Gl = launder_s(F.G);
            if (Gl == 256 && bxl >= 256 - CP_TAIL_WG) {
                Frame Fc = F; Fc.lane = launder(F.lane);
                const int base = CP_NSUB - CP_TAIL + (bxl - (256 - CP_TAIL_WG)) * CP_TAIL_PER_WG;
                for (int q = F.wave; q < CP_TAIL_PER_WG; q += NWAVES) copy_subchunk(Fc, 1 - l, base + q);
            }
        }
        SEAM(pb + 8);
        if (EN(10) && IN(pb + 9)) REPEAT(10) { REPBAR();
            pg8::Gemm g{(const bf16*)(F.ws + WS_ACT), (const bf16*)(wl + WO_DOWN), DFF, DFF, DFF, 0}; pg8::StaticOrder S; S.init(MP, D, launder_s(F.G), launder_s((int)blockIdx.x));
            EpiStore E{(bf16*)(F.ws + WS_Y), D, 1 << 30};
            pg8::gemm_phase<EpiStore, pg8::StaticOrder>(F.lds, g, S, E);
            skinny_store(F, (const bf16*)(F.ws + WS_ACT), DFF, (const bf16*)(wl + WO_DOWN), DFF, (bf16*)(F.ws + WS_Y));
        }
        SEAM(pb + 9);
        if (EN(11) && IN(pb + 10)) REPEAT(11) { REPBAR();
            if (l + 1 < DEPTH) { stage_wba(F, l + 1);
                thin_rows<false>(F, nullptr, nullptr, (const bf16*)(F.ws + WS_Y), F.in[24] + (size_t)l * D, nullptr, F.in[21] + (size_t)(l + 1) * D, true, l + 1, 0);
                __syncthreads(); }
            else thin_rows<false>(F, nullptr, nullptr, (const bf16*)(F.ws + WS_Y), F.in[24] + (size_t)l * D, F.out + O_YP, nullptr, false, 0, 0);
        }
        SEAM(pb + 10);
    }
#undef IN
#undef SEAM
}

extern "C" void kernel_launch(void* const* d_in, const int* in_sizes, int n_in, void* d_out, int out_size, void* d_ws, size_t ws_size, hipStream_t stream) {
    static int grid = 0;
    if (grid == 0) {
        if (n_in != 25 || (size_t)out_size != O_END || ws_size < WS_END) { fprintf(stderr, "kernel_launch: unexpected sizes n_in %d out %d ws %zu\n", n_in, out_size, ws_size); grid = -1; return; }
        int dev = 0, cus = 0, per_cu = 0;
        if (hipGetDevice(&dev) != hipSuccess || hipDeviceGetAttribute(&cus, hipDeviceAttributeMultiprocessorCount, dev) != hipSuccess) { grid = -1; return; }
        if (hipFuncSetAttribute((const void*)fwd, hipFuncAttributeMaxDynamicSharedMemorySize, LDS_BYTES) != hipSuccess) { fprintf(stderr, "kernel_launch: hipFuncSetAttribute failed\n"); grid = -1; return; }
        if (hipOccupancyMaxActiveBlocksPerMultiprocessor(&per_cu, (const void*)fwd, NWAVES * 64, LDS_BYTES) != hipSuccess || per_cu < 1) fprintf(stderr, "kernel_launch: occupancy query says %d\n", per_cu);
        (void)hipGetLastError();
        grid = cus;
    }
    if (grid < 0) return;
    if (hipMemsetAsync((char*)d_ws + WS_CTL, 0, CTL_BYTES, stream) != hipSuccess) return;
    Args a{};
    for (int i = 0; i < 25; ++i) a.in[i] = (const float*)d_in[i];
    a.out = (float*)d_out; a.ws = (unsigned char*)d_ws;
#if MK_ONE_LAUNCH
    a.ph_lo = 0; a.ph_hi = N_PHASES;
    hipLaunchKernelGGL(fwd, dim3(grid), dim3(NWAVES * 64), LDS_BYTES, stream, a);
#else
    for (int p = 0; p < N_PHASES; ++p) { a.ph_lo = p; a.ph_hi = p + 1; hipLaunchKernelGGL(fwd, dim3(grid), dim3(NWAVES * 64), LDS_BYTES, stream, a); }
#endif
}
```
